# Optimizing an MI355X kernel written in HIP

```python
import jax, jax.numpy as jnp
from jax import lax
import numpy as np

D_MODEL = 1024
BATCH = 8
SEQ = 4096
DEPTH = 2
DEC_BATCH = 32
DEC_SEQ = 32
PAST_LEN = 2048

CHUNK = 64
N_META = 16
Q_BLOCK = 128
N_MIXERS = 2
N_FOX = (DEPTH + 1) // 2
N_MLSTM = DEPTH // 2
FOX_HEADS = 16
FOX_HEAD_DIM = D_MODEL // FOX_HEADS
MLSTM_HEADS = 4
MLSTM_DV = D_MODEL // MLSTM_HEADS
MLSTM_DK = MLSTM_DV // 2
D_FF = 4 * D_MODEL
EPS = 1e-6
NEG = -1e30
FOX_IN = 3 * D_MODEL + FOX_HEADS
FOX_SPLITS = [D_MODEL, 2 * D_MODEL, 3 * D_MODEL]
_HK = MLSTM_HEADS * MLSTM_DK
_HV = MLSTM_HEADS * MLSTM_DV
MLSTM_IN = 2 * _HK + 2 * _HV + 2 * MLSTM_HEADS
MLSTM_SPLITS = [_HK, 2 * _HK, 2 * _HK + _HV, 2 * _HK + 2 * _HV, 2 * _HK + 2 * _HV + MLSTM_HEADS]
MLSTM_PAD = (-N_META) % CHUNK

kernel_name = "fox_mlstm_streaming_step"


def rmsnorm(x, g):
    xf = x.astype(jnp.float32)
    y = xf * lax.rsqrt(jnp.mean(xf * xf, axis=-1, keepdims=True) + EPS)
    return (y * g.astype(jnp.float32)).astype(x.dtype)


def sq_relu_mlp(h, w_up, w_down):
    u = jnp.einsum('btd,df->btf', h, w_up)
    return jnp.einsum('btf,fd->btd', jnp.square(jax.nn.relu(u)), w_down)


def fox_attend(q, k, v, Fq, Fk, q_offset):
    B, Tq, H, dh = q.shape
    Tk = k.shape[1]
    blk = min(Q_BLOCK, Tq)
    nb = -(-Tq // blk)
    pad = nb * blk - Tq
    qp = jnp.pad(q, ((0, 0), (0, pad), (0, 0), (0, 0)))
    Fqp = jnp.pad(Fq, ((0, 0), (0, pad), (0, 0)))
    q_blocks = qp.reshape(B, nb, blk, H, dh).transpose(1, 0, 2, 3, 4)
    F_blocks = Fqp.reshape(B, nb, blk, H).transpose(1, 0, 3, 2)
    starts = q_offset + jnp.arange(nb) * blk
    Fk_t = Fk.transpose(0, 2, 1)
    kpos = jnp.arange(Tk)
    scale = FOX_HEAD_DIM ** -0.5

    def one_block(args):
        qb, Fb, s0 = args
        qpos = s0 + jnp.arange(blk)
        logits = jnp.einsum('bqhd,bkhd->bhqk', qb, k, preferred_element_type=jnp.float32) * scale
        logits = logits + Fb[..., :, None] - Fk_t[..., None, :]
        logits = jnp.where(kpos[None, None, None, :] <= qpos[None, None, :, None], logits, -jnp.inf)
        p = jax.nn.softmax(logits, axis=-1)
        return jnp.einsum('bhqk,bkhd->bqhd', p.astype(v.dtype), v)

    out = lax.map(one_block, (q_blocks, F_blocks, starts))
    return out.transpose(1, 0, 2, 3, 4).reshape(B, nb * blk, H, dh)[:, :Tq]


def fox_mixer(h, w_in, b_f, g_q, g_k, w_out, past):
    B, T, _ = h.shape
    proj = jnp.einsum('btd,de->bte', h, w_in)
    q, k, v, f = jnp.split(proj, FOX_SPLITS, axis=-1)
    shp = (B, T, FOX_HEADS, FOX_HEAD_DIM)
    q = rmsnorm(q.reshape(shp), g_q)
    k = rmsnorm(k.reshape(shp), g_k)
    v = v.reshape(shp)
    logf = jax.nn.log_sigmoid((f + b_f).astype(jnp.float32))
    if past is None:
        k_all, v_all, logf_all, offset = k, v, logf, 0
    else:
        k_past, v_past, logf_past = past
        offset = k_past.shape[1]
        k_all = jnp.concatenate([k_past.astype(k.dtype), k], axis=1)
        v_all = jnp.concatenate([v_past.astype(v.dtype), v], axis=1)
        logf_all = jnp.concatenate([logf_past.astype(jnp.float32), logf], axis=1)
    F = jnp.cumsum(logf_all, axis=1)
    o = fox_attend(q, k_all, v_all, F[:, offset:], F, offset)
    y = jnp.einsum('bte,ed->btd', o.reshape(B, T, D_MODEL), w_out)
    return y, (k, v, logf)


def mlstm_chunkwise(q, k, v, i_pre, logf, C0, n0, m0, block):
    B, L, H, _ = q.shape
    nb = L // block

    def to_blocks(a):
        a = a.reshape((B, nb, block) + a.shape[2:])
        return jnp.moveaxis(a, (1, 3), (0, 2))

    tri = jnp.tril(jnp.ones((block, block), dtype=bool))

    def step(carry, xs):
        C, n, m = carry
        qb, kb, vb, ib, fb = xs
        b = jnp.cumsum(fb, axis=-1)
        Dm = jnp.where(tri, b[..., :, None] - b[..., None, :] + ib[..., None, :], -jnp.inf)
        inter = b + m[..., None]
        mt = jnp.maximum(inter, jnp.max(Dm, axis=-1))
        w_inter = jnp.exp(inter - mt)
        S = jnp.einsum('bhtk,bhsk->bhts', qb, kb) * jnp.exp(Dm - mt[..., None])
        num = w_inter[..., None] * jnp.einsum('bhtk,bhvk->bhtv', qb, C) + jnp.einsum('bhts,bhsv->bhtv', S, vb)
        den = w_inter * jnp.einsum('bhtk,bhk->bht', qb, n) + jnp.sum(S, axis=-1)
        h = num / jnp.maximum(jnp.abs(den), jnp.exp(-mt))[..., None]
        m_new = mt[..., -1]
        g = b[..., -1:] - b + ib
        decay = jnp.exp(b[..., -1] + m - m_new)
        wg = jnp.exp(g - m_new[..., None])
        C_new = decay[..., None, None] * C + jnp.einsum('bhs,bhsv,bhsk->bhvk', wg, vb, kb)
        n_new = decay[..., None] * n + jnp.einsum('bhs,bhsk->bhk', wg, kb)
        return (C_new, n_new, m_new), h

    xs = (to_blocks(q), to_blocks(k), to_blocks(v), to_blocks(i_pre), to_blocks(logf))
    (C, n, m), hs = lax.scan(step, (C0, n0, m0), xs)
    h = jnp.moveaxis(hs, (0, 2), (1, 3)).reshape(B, L, H, hs.shape[-1])
    return h, C, n, m


def mlstm_mixer(h, w_in, b_i, b_f, g_h, w_out, C0, n0, m0, block, pad_front):
    B, T, _ = h.shape
    H, DK, DV = MLSTM_HEADS, MLSTM_DK, MLSTM_DV
    proj = jnp.einsum('btd,de->bte', h, w_in).astype(jnp.float32)
    q, k, v, o, ig, fg = jnp.split(proj, MLSTM_SPLITS, axis=-1)
    q = q.reshape(B, T, H, DK)
    k = k.reshape(B, T, H, DK) * (DK ** -0.5)
    v = v.reshape(B, T, H, DV)
    i_pre = ig + b_i.astype(jnp.float32)
    logf = jax.nn.log_sigmoid(fg + b_f.astype(jnp.float32))
    if pad_front:
        p4 = ((0, 0), (pad_front, 0), (0, 0), (0, 0))
        p3 = ((0, 0), (pad_front, 0), (0, 0))
        q, k, v = jnp.pad(q, p4), jnp.pad(k, p4), jnp.pad(v, p4)
        i_pre = jnp.pad(i_pre, p3, constant_values=NEG)
        logf = jnp.pad(logf, p3)
    hh, C, n, m = mlstm_chunkwise(q, k, v, i_pre, logf, C0.astype(jnp.float32),
                                  n0.astype(jnp.float32), m0.astype(jnp.float32), block)
    hh = rmsnorm(hh[:, pad_front:], g_h)
    o = jax.nn.sigmoid(o.reshape(B, T, H, DV))
    y = jnp.einsum('bte,ed->btd', (hh * o).reshape(B, T, H * DV).astype(h.dtype), w_out)
    return y, (C, n, m)


def run_trunk(x, fox_past, mlstm_init, mlstm_block, mlstm_pad,
              g_mix, g_ffn, fox_w_in, fox_b_f, fox_g_q, fox_g_k, fox_w_out,
              mlstm_w_in, mlstm_b_i, mlstm_b_f, mlstm_g_h, mlstm_w_out,
              ffn_w_up, ffn_w_down, g_final):
    fox_new, mlstm_new = [], []
    for i in range(DEPTH):
        h = rmsnorm(x, g_mix[i])
        j = i // N_MIXERS
        if i % N_MIXERS == 0:
            past = None if fox_past is None else (fox_past[0][j], fox_past[1][j], fox_past[2][j])
            y, st = fox_mixer(h, fox_w_in[j], fox_b_f[j], fox_g_q[j], fox_g_k[j], fox_w_out[j], past)
            fox_new.append(st)
        else:
            y, st = mlstm_mixer(h, mlstm_w_in[j], mlstm_b_i[j], mlstm_b_f[j], mlstm_g_h[j], mlstm_w_out[j],
                                mlstm_init[0][j], mlstm_init[1][j], mlstm_init[2][j], mlstm_block, mlstm_pad)
            mlstm_new.append(st)
        x = x + y
        x = x + sq_relu_mlp(rmsnorm(x, g_ffn[i]), ffn_w_up[i], ffn_w_down[i])
    out = rmsnorm(x, g_final)
    fk = jnp.stack([s[0] for s in fox_new])
    fv = jnp.stack([s[1] for s in fox_new])
    fl = jnp.stack([s[2] for s in fox_new])
    mC = jnp.stack([s[0] for s in mlstm_new])
    mn = jnp.stack([s[1] for s in mlstm_new])
    mm = jnp.stack([s[2] for s in mlstm_new])
    return out, fk, fv, fl, mC, mn, mm


def setup_inputs(seed: int = 0) -> dict:
    key = jax.random.key(seed)
    ks = jax.random.split(key, 26)
    f32 = jnp.float32

    def nrm(k, shape, scale):
        return jax.random.normal(k, shape, f32) * scale

    H, dh = FOX_HEADS, FOX_HEAD_DIM
    MH, DK, DV = MLSTM_HEADS, MLSTM_DK, MLSTM_DV
    return {
        'x_prompt': nrm(ks[0], (BATCH, SEQ, D_MODEL), 1.0),
        'x_sample': nrm(ks[1], (DEC_BATCH, DEC_SEQ, D_MODEL), 1.0),
        'cache_fox_k': nrm(ks[2], (N_FOX, DEC_BATCH, PAST_LEN, H, dh), 1.0),
        'cache_fox_v': nrm(ks[3], (N_FOX, DEC_BATCH, PAST_LEN, H, dh), 1.0),
        'cache_fox_logf': jax.nn.log_sigmoid(3.0 + nrm(ks[4], (N_FOX, DEC_BATCH, PAST_LEN, H), 1.0)),
        'state_mlstm_C': nrm(ks[5], (N_MLSTM, DEC_BATCH, MH, DV, DK), 0.1),
        'state_mlstm_n': nrm(ks[6], (N_MLSTM, DEC_BATCH, MH, DK), 0.1),
        'state_mlstm_m': nrm(ks[7], (N_MLSTM, DEC_BATCH, MH), 1.0),
        'meta_tokens': nrm(ks[8], (N_META, D_MODEL), 1.0),
        'g_mix': 1.0 + nrm(ks[9], (DEPTH, D_MODEL), 0.02),
        'g_ffn': 1.0 + nrm(ks[10], (DEPTH, D_MODEL), 0.02),
        'fox_w_in': nrm(ks[11], (N_FOX, D_MODEL, FOX_IN), D_MODEL ** -0.5),
        'fox_b_f': 3.0 + nrm(ks[12], (N_FOX, H), 0.1),
        'fox_g_q': 1.0 + nrm(ks[13], (N_FOX, dh), 0.02),
        'fox_g_k': 1.0 + nrm(ks[14], (N_FOX, dh), 0.02),
        'fox_w_out': nrm(ks[15], (N_FOX, D_MODEL, D_MODEL), D_MODEL ** -0.5),
        'mlstm_w_in': nrm(ks[16], (N_MLSTM, D_MODEL, MLSTM_IN), D_MODEL ** -0.5),
        'mlstm_b_i': nrm(ks[17], (N_MLSTM, MH), 0.1),
        'mlstm_b_f': 3.0 + nrm(ks[18], (N_MLSTM, MH), 0.1),
        'mlstm_g_h': 1.0 + nrm(ks[19], (N_MLSTM, MH, DV), 0.02),
        'mlstm_w_out': nrm(ks[20], (N_MLSTM, MH * DV, D_MODEL), (MH * DV) ** -0.5),
        'ffn_w_up': nrm(ks[21], (DEPTH, D_MODEL, D_FF), D_MODEL ** -0.5),
        'ffn_w_down': nrm(ks[22], (DEPTH, D_FF, D_MODEL), D_FF ** -0.5),
        'g_final': 1.0 + nrm(ks[23], (D_MODEL,), 0.02),
    }


def reference(x_prompt, x_sample, cache_fox_k, cache_fox_v, cache_fox_logf,
              state_mlstm_C, state_mlstm_n, state_mlstm_m, meta_tokens,
              g_mix, g_ffn, fox_w_in, fox_b_f, fox_g_q, fox_g_k, fox_w_out,
              mlstm_w_in, mlstm_b_i, mlstm_b_f, mlstm_g_h, mlstm_w_out,
              ffn_w_up, ffn_w_down, g_final):
    weights = (g_mix, g_ffn, fox_w_in, fox_b_f, fox_g_q, fox_g_k, fox_w_out,
               mlstm_w_in, mlstm_b_i, mlstm_b_f, mlstm_g_h, mlstm_w_out,
               ffn_w_up, ffn_w_down, g_final)

    B = x_prompt.shape[0]
    meta = jnp.broadcast_to(meta_tokens.astype(x_prompt.dtype)[None], (B, N_META, D_MODEL))
    xp = jnp.concatenate([meta, x_prompt], axis=1)
    init = (jnp.zeros((N_MLSTM, B, MLSTM_HEADS, MLSTM_DV, MLSTM_DK), jnp.float32),
            jnp.zeros((N_MLSTM, B, MLSTM_HEADS, MLSTM_DK), jnp.float32),
            jnp.zeros((N_MLSTM, B, MLSTM_HEADS), jnp.float32))
    yp, fk_p, fv_p, fl_p, mC_p, mn_p, mm_p = run_trunk(xp, None, init, CHUNK, MLSTM_PAD, *weights)
    y_prompt = yp[:, N_META:]

    T = x_sample.shape[1]
    ys, fk_s, fv_s, fl_s, mC_s, mn_s, mm_s = run_trunk(
        x_sample, (cache_fox_k, cache_fox_v, cache_fox_logf),
        (state_mlstm_C, state_mlstm_n, state_mlstm_m), T, 0, *weights)

    return (y_prompt, ys, fk_p, fv_p, fl_p, mC_p, mn_p, mm_p, fk_s, fv_s, fl_s, mC_s, mn_s, mm_s)
```

```cpp
#include <hip/hip_runtime.h>
#include <hip/hip_cooperative_groups.h>
#include <cstdio>
#include <cstdint>
namespace cg = cooperative_groups;

constexpr int DM = 1024, TP = 4112, NB = 8, SEQL = 4096, NMETA = 16, DB = 32, DT = 32, PAST = 2048, DFF = 4096;
constexpr int MP = NB * TP;
constexpr int MTOT = MP + DB * DT;
constexpr int MPAD = 34048;
constexpr int NIN = 3328;
constexpr int PPAD = 240;
constexpr int PLEN = 4352;
constexpr int GSLEN = 2112;
constexpr float EPSN = 1e-6f;
constexpr float LOG2E = 1.4426950408889634f;
constexpr float QSCALE = 0.125f * LOG2E;

constexpr int NWAVES = 8, NTHR = 512;
constexpr int LDS_BYTES = 147456;
constexpr size_t MiB = 1u << 20;
constexpr size_t WS_CTL = 0;
constexpr size_t WS_WFIN = 1 * MiB, WS_WFOUT = 8 * MiB, WS_WMIN = 10 * MiB, WS_WMOUT = 17 * MiB, WS_WUP0 = 19 * MiB, WS_WUP1 = 27 * MiB, WS_WDN0 = 35 * MiB, WS_WDN1 = 43 * MiB;
constexpr size_t WS_SSQ = 51 * MiB, WS_G = 54 * MiB, WS_GS = 57 * MiB, WS_GI = 62 * MiB, WS_GF = 63 * MiB, WS_HSSQ = 64 * MiB;
constexpr size_t WS_X = 74 * MiB, WS_XB = 207 * MiB;
constexpr size_t WS_QB = 274 * MiB, WS_KB = 343 * MiB, WS_VB = 411 * MiB, WS_OB = 478 * MiB, WS_H = 274 * MiB;
constexpr size_t WS_MQ = 546 * MiB, WS_MK = 580 * MiB, WS_MV = 614 * MiB, WS_MO = 682 * MiB, WS_MH = 750 * MiB, WS_U = 818 * MiB, WS_RS = 958 * MiB, WS_NU = 959 * MiB, WS_P = 961 * MiB, WS_BBC = 1001 * MiB, WS_PMC = 1002 * MiB, WS_END = 1003 * MiB;
static_assert(WS_H + (size_t)MPAD * DFF * 2 <= WS_MQ && WS_OB + (size_t)MPAD * DM * 2 <= WS_MQ && WS_VB + (size_t)MPAD * DM * 2 <= WS_OB && WS_KB + (size_t)MPAD * DM * 2 <= WS_VB - MiB && WS_QB + (size_t)MPAD * DM * 2 <= WS_KB - MiB, "ws map");
static_assert(WS_G + (size_t)NB * 16 * PLEN * 4 <= WS_GS && WS_GS + (size_t)DB * 16 * GSLEN * 4 <= WS_GI && WS_HSSQ + (size_t)MPAD * 64 * 4 <= WS_X && WS_SSQ + (size_t)MPAD * 64 <= WS_G, "ws map 2");

struct Args { const float* in[24]; float* out; unsigned char* ws; };

constexpr size_t O_YP = 0, O_YS = O_YP + (size_t)NB * SEQL * DM, O_FKP = O_YS + (size_t)DB * DT * DM, O_FVP = O_FKP + (size_t)MP * DM, O_FLP = O_FVP + (size_t)MP * DM,
    O_MCP = O_FLP + (size_t)MP * 16, O_MNP = O_MCP + (size_t)NB * 4 * 256 * 128, O_MMP = O_MNP + (size_t)NB * 4 * 128, O_FKS = O_MMP + (size_t)NB * 4,
    O_FVS = O_FKS + (size_t)DB * DT * DM, O_FLS = O_FVS + (size_t)DB * DT * DM, O_MCS = O_FLS + (size_t)DB * DT * 16, O_MNS = O_MCS + (size_t)DB * 4 * 256 * 128,
    O_MMS = O_MNS + (size_t)DB * 4 * 128, O_END = O_MMS + (size_t)DB * 4;

namespace pg8 {
#define PG8_LAS __attribute__((address_space(3)))
typedef unsigned short bf16_t;
typedef short bf16x8 __attribute__((ext_vector_type(8)));
typedef float f32x4 __attribute__((ext_vector_type(4)));
typedef unsigned u32x4 __attribute__((ext_vector_type(4)));
constexpr int BM = 256, BK = 64, HALF = 128, HTB = HALF * BK * 2  , STAGE_BYTES = 8 * HTB, NXCD = 8, WGM = 8;

__host__ __device__ __forceinline__ int lds_byte(int r, int c) { const int st = (r >> 4) * 2 + (c >> 5), rr = r & 15, cc = c & 31, ob = rr * 64 + cc * 2; return st * 1024 + (ob ^ (((ob >> 9) & 1) << 5)); }
__host__ __device__ __forceinline__ void stage_rc(int b, int& R, int& C) { const int st = b / 1024, sb = b % 1024, swz = sb ^ (((sb >> 9) & 1) << 5); R = (st >> 1) * 16 + swz / 64; C = (st & 1) * 32 + (swz % 64) / 2; }
__host__ __device__ __forceinline__ int perm32(int rho) { const int n = rho >> 4, i = rho & 15; return 8 * (i >> 2) + 4 * n + (i & 3); }

struct Unit { int pm, pn, aux; };
struct Gemm { const bf16_t* A; const bf16_t* Bt; int M, N, K, ld; };

struct StaticOrder {
    int nM, nN, nwg, G, c, lim;
    __host__ __device__ void init(int M, int N, int G_, int c_) { nM = M / BM; nN = N / BM; nwg = nM * nN; G = G_; c = c_; lim = nwg; }
    __host__ __device__ bool next(int i, Unit& u) const { const long L = (long)i * G + c; if (L >= lim) return false; map((int)L, u); return true; }
    __host__ __device__ void map(int L, Unit& u) const {
        int wgid = L; { const int q = nwg / NXCD, r = nwg % NXCD, xcd = wgid % NXCD, off = wgid / NXCD; wgid = (xcd < r ? xcd * (q + 1) : r * (q + 1) + (xcd - r) * q) + off; }
        const int nig = WGM * nN, gid = wgid / nig, fm = gid * WGM, gsz = (nM - fm) < WGM ? (nM - fm) : WGM;
        u.pm = fm + ((wgid % nig) % gsz); u.pn = (wgid % nig) / gsz;
    }
    __device__ __forceinline__ void a_ready(const Unit&) const {}
    __device__ __forceinline__ void done(const Unit&) const {}
};


struct TailOrder {
    StaticOrder base; int first, ntail, slices, c;
    __device__ bool next(int i, Unit& u) const { if (i > 0) return false; const int tu = c / slices; if (tu >= ntail) return false; base.map(first + tu, u); u.aux = c; return true; }
    __device__ __forceinline__ void a_ready(const Unit&) const {}
    __device__ __forceinline__ void done(const Unit&) const {}
};

typedef float f32x2_cv __attribute__((ext_vector_type(2))); typedef __bf16 bf16x2_cv __attribute__((ext_vector_type(2)));
__device__ __forceinline__ unsigned cvt_pk_bf16(float lo, float hi) { const f32x2_cv v = {lo, hi}; const bf16x2_cv b = __builtin_convertvector(v, bf16x2_cv); return __builtin_bit_cast(unsigned, b); }
__device__ __forceinline__ u32x4 pack8(const f32x4 a, const f32x4 b) { u32x4 w; w.x = cvt_pk_bf16(a[0], a[1]); w.y = cvt_pk_bf16(a[2], a[3]); w.z = cvt_pk_bf16(b[0], b[1]); w.w = cvt_pk_bf16(b[2], b[3]); return w; }
__device__ __forceinline__ float row_rstd(const float* ssq, int row, int fq) {
    const f32x4 v = *(const f32x4*)(ssq + (size_t)row * 16 + 4 * fq);
    float s = (v[0] + v[1]) + (v[2] + v[3]);
    s += __shfl_xor(s, 16); s += __shfl_xor(s, 32);
    return __builtin_amdgcn_rsqf(s * (1.0f / 1024.0f) + EPSN);
}
__device__ __forceinline__ float log_sigmoid_f(float x) { return fminf(x, 0.f) - log1pf(__expf(-fabsf(x))); }

struct EpiFoxIn {
    static constexpr bool PERM = true, AFTER_DRAIN = false;
    const float* ssq; const float* gq; const float* gk; const float* bfv;
    unsigned char* ws; float* out;
    __device__ __forceinline__ void operator()(const f32x4 (&acc)[2][2][4][2], const Unit& u, int wr, int wc, int fr, int fq) const {
        const int pn = u.pn, sect = pn >> 2;
        f32x4 gv[2][2];
        if (sect < 2) {
#pragma unroll
            for (int bj = 0; bj < 2; ++bj)
#pragma unroll
                for (int n = 0; n < 2; ++n) { const f32x4 a = *(const f32x4*)(gq + 32 * bj + 8 * fq + 4 * n) * QSCALE, b = *(const f32x4*)(gk + 32 * bj + 8 * fq + 4 * n); gv[bj][n] = sect == 0 ? a : b; } }
        const int cb = (pn & 3) * 256 + wc * 64 + 8 * fq;
        float rsv[2][4];
#pragma unroll
        for (int ai = 0; ai < 2; ++ai)
#pragma unroll
            for (int m = 0; m < 4; ++m) rsv[ai][m] = row_rstd(ssq, u.pm * BM + ai * HALF + wr * 64 + m * 16 + fr, fq);
#pragma unroll
        for (int ai = 0; ai < 2; ++ai)
#pragma unroll
            for (int m = 0; m < 4; ++m) {
                const int row = u.pm * BM + ai * HALF + wr * 64 + m * 16 + fr;
                const float rs = rsv[ai][m];
                f32x4 v[2][2];
#pragma unroll
                for (int bj = 0; bj < 2; ++bj)
#pragma unroll
                    for (int n = 0; n < 2; ++n) v[bj][n] = acc[ai][bj][m][n] * rs;
                if (sect < 2) {
                    float ss = 0.f;
#pragma unroll
                    for (int bj = 0; bj < 2; ++bj)
#pragma unroll
                        for (int n = 0; n < 2; ++n) { const f32x4 x = v[bj][n]; ss += (x[0] * x[0] + x[1] * x[1]) + (x[2] * x[2] + x[3] * x[3]); }
                    ss += __shfl_xor(ss, 16); ss += __shfl_xor(ss, 32);
                    const float hr = __builtin_amdgcn_rsqf(ss * (1.0f / 64.0f) + EPSN);
#pragma unroll
                    for (int bj = 0; bj < 2; ++bj)
#pragma unroll
                        for (int n = 0; n < 2; ++n) v[bj][n] = v[bj][n] * hr * gv[bj][n];
                }
                const bool real = row < MTOT; const int grp = row < MP ? 0 : 1; const size_t orow = grp == 0 ? (size_t)row : (size_t)(row - MP);
                if (sect == 0) {
#pragma unroll
                    for (int bj = 0; bj < 2; ++bj) *(u32x4*)((bf16_t*)(ws + WS_QB) + (size_t)row * DM + cb + 32 * bj) = pack8(v[bj][0], v[bj][1]);
                } else if (sect < 3) {
                    bf16_t* B16 = (bf16_t*)(ws + (sect == 1 ? WS_KB : WS_VB)); float* of = out + (sect == 1 ? (grp == 0 ? O_FKP : O_FKS) : (grp == 0 ? O_FVP : O_FVS));
#pragma unroll
                    for (int bj = 0; bj < 2; ++bj) *(u32x4*)(B16 + (size_t)row * DM + cb + 32 * bj) = pack8(v[bj][0], v[bj][1]);
                    (void)of; (void)real;
                } else if (pn == 12 && wc == 0 && fq < 2 && real) {
#pragma unroll
                    for (int n = 0; n < 2; ++n) { const int h0 = 8 * fq + 4 * n; const f32x4 bb = *(const f32x4*)(bfv + h0); f32x4 o;
#pragma unroll
                        for (int j = 0; j < 4; ++j) o[j] = log_sigmoid_f(v[0][n][j] + bb[j]);
                        *(f32x4*)(out + (grp == 0 ? O_FLP : O_FLS) + orow * 16 + h0) = o; }
                }
            }
    }
};

struct EpiResid {
    static constexpr bool PERM = true, AFTER_DRAIN = false;
    float* X; bf16_t* XB; float* ssq;
    __device__ __forceinline__ void operator()(const f32x4 (&acc)[2][2][4][2], const Unit& u, int wr, int wc, int fr, int fq) const {
#pragma unroll
        for (int ai = 0; ai < 2; ++ai)
#pragma unroll
            for (int m = 0; m < 4; ++m) {
                const int row = u.pm * BM + ai * HALF + wr * 64 + m * 16 + fr; float ss = 0.f;
#pragma unroll
                for (int bj = 0; bj < 2; ++bj) { const size_t off = (size_t)row * DM + u.pn * BM + bj * HALF + wc * 32 + 8 * fq;
                    f32x4 x0 = *(const f32x4*)(X + off), x1 = *(const f32x4*)(X + off + 4);
                    x0 = x0 + acc[ai][bj][m][0]; x1 = x1 + acc[ai][bj][m][1];
                    *(f32x4*)(X + off) = x0; *(f32x4*)(X + off + 4) = x1; *(u32x4*)(XB + off) = pack8(x0, x1);
                    ss += (x0[0] * x0[0] + x0[1] * x0[1]) + (x0[2] * x0[2] + x0[3] * x0[3]) + (x1[0] * x1[0] + x1[1] * x1[1]) + (x1[2] * x1[2] + x1[3] * x1[3]); }
                ss += __shfl_xor(ss, 16); ss += __shfl_xor(ss, 32);
                if (fq == 0) ssq[(size_t)row * 16 + u.pn * 4 + wc] = ss;
                if (m & 1) asm volatile("" ::: "memory");
            }
    }
};

struct EpiUp {
    static constexpr bool PERM = true, AFTER_DRAIN = false;
    const float* ssq; bf16_t* H;
    __device__ __forceinline__ void operator()(const f32x4 (&acc)[2][2][4][2], const Unit& u, int wr, int wc, int fr, int fq) const {
#pragma unroll
        for (int ai = 0; ai < 2; ++ai)
#pragma unroll
            for (int m = 0; m < 4; ++m) {
                const int row = u.pm * BM + ai * HALF + wr * 64 + m * 16 + fr; const float rs = row_rstd(ssq, row, fq);
#pragma unroll
                for (int bj = 0; bj < 2; ++bj) { f32x4 a = acc[ai][bj][m][0] * rs, b = acc[ai][bj][m][1] * rs;
#pragma unroll
                    for (int j = 0; j < 4; ++j) { a[j] = fmaxf(a[j], 0.f); a[j] *= a[j]; b[j] = fmaxf(b[j], 0.f); b[j] *= b[j]; }
                    *(u32x4*)(H + (size_t)row * DFF + u.pn * BM + bj * HALF + wc * 32 + 8 * fq) = pack8(a, b); }
            }
    }
};

struct EpiMlstmIn {
    static constexpr bool PERM = true, AFTER_DRAIN = false;
    const float* ssq; const float* bi; const float* bfv;
    bf16_t* MQ; bf16_t* MK; bf16_t* MV; bf16_t* MO; float* GI; float* GF;
    __device__ __forceinline__ void operator()(const f32x4 (&acc)[2][2][4][2], const Unit& u, int wr, int wc, int fr, int fq) const {
        const int pn = u.pn;
#pragma unroll
        for (int ai = 0; ai < 2; ++ai)
#pragma unroll
            for (int m = 0; m < 4; ++m) {
                const int row = u.pm * BM + ai * HALF + wr * 64 + m * 16 + fr; const float rs = row_rstd(ssq, row, fq);
                if (pn < 12) {
#pragma unroll
                    for (int bj = 0; bj < 2; ++bj) { f32x4 a = acc[ai][bj][m][0] * rs, b = acc[ai][bj][m][1] * rs; const int c = pn * BM + bj * HALF + wc * 32 + 8 * fq;
                        if (pn < 2) *(u32x4*)(MQ + (size_t)row * 512 + c) = pack8(a, b);
                        else if (pn < 4) { a = a * 0.08838834764831845f; b = b * 0.08838834764831845f; *(u32x4*)(MK + (size_t)row * 512 + (c - 512)) = pack8(a, b); }
                        else if (pn < 8) *(u32x4*)(MV + (size_t)row * DM + (c - 1024)) = pack8(a, b);
                        else {
#pragma unroll
                            for (int j = 0; j < 4; ++j) { a[j] = 1.0f / (1.0f + __expf(-a[j])); b[j] = 1.0f / (1.0f + __expf(-b[j])); }
                            *(u32x4*)(MO + (size_t)row * DM + (c - 2048)) = pack8(a, b); } }
                } else if (wc == 0 && fq == 0) {
                    const f32x4 a = acc[ai][0][m][0] * rs, b = acc[ai][0][m][1] * rs; const f32x4 vbi = *(const f32x4*)bi, vbf = *(const f32x4*)bfv; f32x4 oi, of;
#pragma unroll
                    for (int j = 0; j < 4; ++j) { oi[j] = a[j] + vbi[j]; of[j] = log_sigmoid_f(b[j] + vbf[j]); }
                    *(f32x4*)(GI + (size_t)row * 4) = oi; *(f32x4*)(GF + (size_t)row * 4) = of;
                }
            }
    }
};


struct EpiPartial {
    static constexpr bool PERM = true, AFTER_DRAIN = false;
    float* P;
    __device__ __forceinline__ void operator()(const f32x4 (&acc)[2][2][4][2], const Unit& u, int wr, int wc, int fr, int fq) const {
#pragma unroll
        for (int ai = 0; ai < 2; ++ai)
#pragma unroll
            for (int m = 0; m < 4; ++m)
#pragma unroll
                for (int bj = 0; bj < 2; ++bj) { float* p = P + (size_t)u.aux * 65536 + (size_t)(ai * HALF + wr * 64 + m * 16 + fr) * 256 + bj * HALF + wc * 32 + 8 * fq;
                    *(f32x4*)p = acc[ai][bj][m][0]; *(f32x4*)(p + 4) = acc[ai][bj][m][1]; }
    }
};
template <class Epi, class Sched, bool ALIGN_EPI = false, bool SP2 = false>
__device__ __forceinline__ void gemm_phase(PG8_LAS unsigned char* lds, const Gemm g, const Sched& S, const Epi& E) {
    int tid_o = threadIdx.x; asm volatile("" : "+v"(tid_o));
    const int tid = tid_o, wid = __builtin_amdgcn_readfirstlane(tid >> 6), lane = tid & 63, wr = wid >> 2, wc = wid & 3, fr = lane & 15, fq = lane >> 4;
    const int K = g.K, nt = K / BK, ld = g.ld ? g.ld : g.K;
    unsigned voffA[2], voffB[2];
#pragma unroll
    for (int i = 0; i < 2; ++i) { int R, C; stage_rc(tid * 16 + i * 8192, R, C); const int Rb = Epi::PERM ? ((R & ~31) + perm32(R & 31)) : R;
        voffA[i] = (unsigned)(R * ld + C) * 2u; voffB[i] = (unsigned)(Rb * ld + C) * 2u; }
    const size_t kstep = (size_t)(BK * 2);
    const size_t hstep = (size_t)HALF * ld * 2;
    const size_t tstep = 2 * hstep;
    const unsigned ldsw = (unsigned)wid * 1024u;
    const int aoff = lds_byte(wr * 64 + fr, fq * 8), boff = lds_byte(wc * 32 + fr, fq * 8);
#define PG8_SA(b, h) (((b) * 2 + (h)) * HTB)
#define PG8_SB(b, h) ((4 + (b) * 2 + (h)) * HTB)
#define PG8_STAGE(bufoff, gbase, voff) do { _Pragma("unroll") for (int _i = 0; _i < 2; ++_i) \
        __builtin_amdgcn_global_load_lds((const unsigned*)((const char*)(gbase) + (voff)[_i]), (PG8_LAS unsigned*)(lds + (bufoff) + ldsw + _i * 8192), 16, 0, 0); } while (0)
#define PG8_LDA(dst, b, h) do { _Pragma("unroll") for (int m = 0; m < 4; ++m) _Pragma("unroll") for (int k = 0; k < 2; ++k) dst[m][k] = *(const PG8_LAS bf16x8*)(lds + PG8_SA(b, h) + aoff + m * 2048 + k * 1024); } while (0)
#define PG8_LDB(dst, b, h) do { _Pragma("unroll") for (int n = 0; n < 2; ++n) _Pragma("unroll") for (int k = 0; k < 2; ++k) dst[n][k] = *(const PG8_LAS bf16x8*)(lds + PG8_SB(b, h) + boff + n * 2048 + k * 1024); } while (0)
#define PG8_MMA(ai, bj, At, Bt) do { __builtin_amdgcn_s_setprio(1); _Pragma("unroll") for (int m = 0; m < 4; ++m) _Pragma("unroll") for (int n = 0; n < 2; ++n) _Pragma("unroll") for (int k = 0; k < 2; ++k) \
        acc[ai][bj][m][n] = __builtin_amdgcn_mfma_f32_16x16x32_bf16(Bt[n][k], At[m][k], acc[ai][bj][m][n], 0, 0, 0); __builtin_amdgcn_s_setprio(0); } while (0)
#define PG8_WAIT_V(n) asm volatile("s_waitcnt vmcnt(" #n ")" ::: "memory")
#define PG8_WAIT_L(n) asm volatile("s_waitcnt lgkmcnt(" #n ")" ::: "memory")
#define PG8_BAR __builtin_amdgcn_s_barrier()
#define PG8_SCHED __builtin_amdgcn_sched_barrier(0)
    Unit cur, nxt; int ui = 0;
    if (!S.next(0, cur)) return;
    f32x4 acc[2][2][4][2];
#pragma unroll
    for (int a = 0; a < 2; ++a)
#pragma unroll
        for (int b = 0; b < 2; ++b)
#pragma unroll
            for (int m = 0; m < 4; ++m)
#pragma unroll
                for (int n = 0; n < 2; ++n) acc[a][b][m][n] = (f32x4){0.f, 0.f, 0.f, 0.f};
    bf16x8 At[4][2], B0[2][2], B1[2][2];
    const char* cA = (const char*)g.A + (size_t)cur.pm * tstep; const char* cB = (const char*)g.Bt + (size_t)cur.pn * tstep;
    S.a_ready(cur);
    if constexpr (SP2) {
        PG8_STAGE(PG8_SB(0, 0), cB, voffB); PG8_STAGE(PG8_SB(0, 1), cB + hstep, voffB); PG8_STAGE(PG8_SA(0, 0), cA, voffA); PG8_STAGE(PG8_SA(0, 1), cA + hstep, voffA);
        if (wr == 1) PG8_BAR;
        PG8_WAIT_V(2); PG8_BAR;
        PG8_STAGE(PG8_SB(1, 0), cB + kstep, voffB); PG8_STAGE(PG8_SA(1, 0), cA + kstep, voffA); PG8_STAGE(PG8_SB(1, 1), cB + hstep + kstep, voffB);
        PG8_WAIT_V(6); PG8_BAR;
    } else {
        PG8_STAGE(PG8_SB(0, 0), cB, voffB); PG8_STAGE(PG8_SA(0, 0), cA, voffA); PG8_STAGE(PG8_SB(0, 1), cB + hstep, voffB); PG8_STAGE(PG8_SA(0, 1), cA + hstep, voffA);
        if (wr == 1) PG8_BAR;
        PG8_WAIT_V(4); PG8_BAR;
        PG8_STAGE(PG8_SB(1, 0), cB + kstep, voffB); PG8_STAGE(PG8_SA(1, 0), cA + kstep, voffA); PG8_STAGE(PG8_SB(1, 1), cB + hstep + kstep, voffB);
        PG8_WAIT_V(6); PG8_BAR;
    }
    for (;;) {
        const bool has_next = S.next(ui + 1, nxt);
        const char* nA = has_next ? (const char*)g.A + (size_t)nxt.pm * tstep : cA; const char* nB = has_next ? (const char*)g.Bt + (size_t)nxt.pn * tstep : cB;
        for (int t = 0; t < nt; t += 2) {
            const bool last = (t == nt - 2);
            const char* a1 = cA + (size_t)(t + 1) * kstep;
            const char* a2 = last ? nA : cA + (size_t)(t + 2) * kstep; const char* b2 = last ? nB : cB + (size_t)(t + 2) * kstep;
            const char* a3 = a2 + kstep; const char* b3 = b2 + kstep;
            if (last && has_next) S.a_ready(nxt);
            if constexpr (SP2) {
            PG8_LDB(B0, 0, 0); PG8_LDB(B1, 0, 1); PG8_SCHED; PG8_LDA(At, 0, 0); PG8_STAGE(PG8_SA(1, 1), a1 + hstep, voffA);
            PG8_WAIT_V(8); PG8_WAIT_L(0); PG8_BAR; PG8_MMA(0, 0, At, B0); PG8_MMA(0, 1, At, B1); PG8_BAR; PG8_SCHED;
            PG8_LDA(At, 0, 1); PG8_STAGE(PG8_SB(0, 0), b2, voffB); PG8_STAGE(PG8_SB(0, 1), b2 + hstep, voffB); PG8_STAGE(PG8_SA(0, 0), a2, voffA);
            PG8_WAIT_V(8); PG8_WAIT_L(0); PG8_BAR; PG8_MMA(1, 0, At, B0); PG8_MMA(1, 1, At, B1); PG8_BAR; PG8_SCHED;
            PG8_LDB(B0, 1, 0); PG8_LDB(B1, 1, 1); PG8_SCHED; PG8_LDA(At, 1, 0); PG8_STAGE(PG8_SA(0, 1), a2 + hstep, voffA);
            PG8_WAIT_V(8); PG8_WAIT_L(0); PG8_BAR; PG8_MMA(0, 0, At, B0); PG8_MMA(0, 1, At, B1); PG8_BAR; PG8_SCHED;
            PG8_LDA(At, 1, 1); PG8_STAGE(PG8_SB(1, 0), b3, voffB); PG8_STAGE(PG8_SB(1, 1), b3 + hstep, voffB); PG8_STAGE(PG8_SA(1, 0), a3, voffA);
            PG8_WAIT_V(8); PG8_WAIT_L(0); PG8_BAR; PG8_MMA(1, 0, At, B0); PG8_MMA(1, 1, At, B1); PG8_BAR; PG8_SCHED;
            } else {
            PG8_LDB(B0, 0, 0); PG8_SCHED; PG8_LDA(At, 0, 0); PG8_STAGE(PG8_SA(1, 1), a1 + hstep, voffA);
            PG8_WAIT_L(8); PG8_BAR; PG8_WAIT_L(0); PG8_MMA(0, 0, At, B0); PG8_BAR; PG8_SCHED;
            PG8_LDB(B1, 0, 1); PG8_STAGE(PG8_SB(0, 0), b2, voffB);
            PG8_BAR; PG8_WAIT_L(0); PG8_MMA(0, 1, At, B1); PG8_BAR;
            PG8_LDA(At, 0, 1); PG8_STAGE(PG8_SA(0, 0), a2, voffA);
            PG8_BAR; PG8_WAIT_L(0); PG8_MMA(1, 0, At, B0); PG8_BAR; PG8_SCHED;
            PG8_STAGE(PG8_SB(0, 1), b2 + hstep, voffB);
            PG8_WAIT_V(6); PG8_BAR; PG8_MMA(1, 1, At, B1); PG8_BAR;
            PG8_LDB(B0, 1, 0); PG8_SCHED; PG8_LDA(At, 1, 0); PG8_STAGE(PG8_SA(0, 1), a2 + hstep, voffA);
            PG8_WAIT_L(8); PG8_BAR; PG8_WAIT_L(0); PG8_MMA(0, 0, At, B0); PG8_BAR; PG8_SCHED;
            PG8_LDB(B1, 1, 1); PG8_STAGE(PG8_SB(1, 0), b3, voffB);
            PG8_BAR; PG8_WAIT_L(0); PG8_MMA(0, 1, At, B1); PG8_BAR;
            PG8_LDA(At, 1, 1); PG8_STAGE(PG8_SA(1, 0), a3, voffA);
            PG8_BAR; PG8_WAIT_L(0); PG8_MMA(1, 0, At, B0); PG8_BAR; PG8_SCHED;
            PG8_STAGE(PG8_SB(1, 1), b3 + hstep, voffB);
            PG8_WAIT_V(6); PG8_BAR; PG8_MMA(1, 1, At, B1); PG8_BAR;
            }
        }
        if constexpr (ALIGN_EPI) { if (wr == 0) PG8_BAR; }
        if constexpr (!Epi::AFTER_DRAIN) { E(acc, cur, wr, wc, fr, fq); S.done(cur); }
        if (!has_next) break;
#pragma unroll
        for (int a = 0; a < 2; ++a)
#pragma unroll
            for (int b = 0; b < 2; ++b)
#pragma unroll
                for (int m = 0; m < 4; ++m)
#pragma unroll
                    for (int n = 0; n < 2; ++n) acc[a][b][m][n] = (f32x4){0.f, 0.f, 0.f, 0.f};
        cur = nxt; cA = nA; cB = nB; ++ui;
        if constexpr (ALIGN_EPI) { if (wr == 1) PG8_BAR; }
    }
    PG8_WAIT_V(0);
    if constexpr (!ALIGN_EPI) { if (wr == 0) PG8_BAR; }
    PG8_BAR;
    if constexpr (Epi::AFTER_DRAIN) { E.fused(acc, cur, wr, wc, fr, fq, lds, wid, lane); S.done(cur); }
#undef PG8_SA
#undef PG8_SB
#undef PG8_STAGE
#undef PG8_LDA
#undef PG8_LDB
#undef PG8_MMA
#undef PG8_WAIT_V
#undef PG8_WAIT_L
#undef PG8_BAR
#undef PG8_SCHED
}
}

#ifndef PG8_SP2
#define PG8_SP2 true
#endif
#ifndef PG8_ALIGN
#define PG8_ALIGN true
#endif

#define LAS __attribute__((address_space(3)))
typedef unsigned short bf16;
typedef unsigned u32x4 __attribute__((ext_vector_type(4)));
typedef unsigned u32x2 __attribute__((ext_vector_type(2)));
typedef float f32x4 __attribute__((ext_vector_type(4)));
typedef float f32x16 __attribute__((ext_vector_type(16)));
typedef short bf16x8 __attribute__((ext_vector_type(8)));
typedef short v4i16_t __attribute__((ext_vector_type(4)));
typedef LAS unsigned char* lptr;
typedef const LAS unsigned char* clptr;

__device__ __forceinline__ unsigned f2bf(float f) { unsigned u = __builtin_bit_cast(unsigned, f); return (u + 0x7fffu + ((u >> 16) & 1u)) >> 16; }
__device__ __forceinline__ unsigned pk2(float lo, float hi) { return pg8::cvt_pk_bf16(lo, hi); }
__device__ __forceinline__ float bf2f(unsigned short b) { return __builtin_bit_cast(float, (unsigned)b << 16); }
__device__ __forceinline__ float wave_sum(float v) {
#pragma unroll
    for (int o = 1; o < 64; o <<= 1) v += __shfl_xor(v, o);
    return v;
}
#define LDS_WAIT() asm volatile("s_waitcnt lgkmcnt(0)" ::: "memory")
#define LDS_BARRIER() asm volatile("s_waitcnt lgkmcnt(0)\n\ts_barrier" ::: "memory")

__device__ __forceinline__ void p0_transpose_item(const float* W, int K, int N, bf16* WT, const float* g, bool foxperm, LAS float* scr, int item, int nblk, int lane) {
    const int kb = item / nblk, nb = item % nblk, k0 = 64 * kb, n0 = 32 * nb;
#pragma unroll 8
    for (int i = 0; i < 32; ++i) { const int kk = 2 * i + (lane >> 5); const int n = n0 + (lane & 31); float v = n < N ? W[(size_t)(k0 + kk) * N + n] : 0.f; if (g) v *= g[k0 + kk]; scr[kk * 33 + (lane & 31)] = v; }
    LDS_WAIT(); asm volatile("" ::: "memory");
    const int c = lane & 7;
    int prow0 = n0;
    if (foxperm) { const int l = n0 & 255; prow0 = (n0 & ~255) + 128 * ((l >> 5) & 1) + 32 * ((l >> 6) & 3); }
#pragma unroll
    for (int j = 0; j < 4; ++j) { const int n = (lane >> 3) + 8 * j; const LAS float* s = scr + (8 * c) * 33 + n;
        u32x4 o; o.x = pk2(s[0 * 33], s[1 * 33]); o.y = pk2(s[2 * 33], s[3 * 33]); o.z = pk2(s[4 * 33], s[5 * 33]); o.w = pk2(s[6 * 33], s[7 * 33]);
        *(u32x4*)(WT + (size_t)(prow0 + n) * K + k0 + 8 * c) = o; }
    LDS_WAIT(); asm volatile("" ::: "memory");
}

__device__ __forceinline__ void p0_prologue(const Args& A, lptr lds, int gw, int NGW, int wave, int lane) {
    unsigned char* ws = A.ws;
    LAS float* scr = (LAS float*)(lds + wave * 16384);
    int base = 0;
#define WJOB(Wp, K_, N_, NP_, dst_, g_, perm_) do { const int nblk = (NP_) / 32, nitems = ((K_) / 64) * nblk; int first = (gw - base) % NGW; if (first < 0) first += NGW; \
        for (int it = first; it < nitems; it += NGW) p0_transpose_item((Wp), (K_), (N_), (bf16*)(ws + (dst_)), (g_), (perm_), scr, it, nblk, lane); base = (base + nitems) % NGW; } while (0)
    WJOB(A.in[11], DM, 3088, NIN, WS_WFIN, A.in[9], true);
    WJOB(A.in[15], DM, DM, DM, WS_WFOUT, (const float*)nullptr, false);
    WJOB(A.in[16], DM, 3080, NIN, WS_WMIN, A.in[9] + DM, false);
    WJOB(A.in[20], DM, DM, DM, WS_WMOUT, A.in[19], false);
    WJOB(A.in[21], DM, DFF, DFF, WS_WUP0, A.in[10], false);
    WJOB(A.in[21] + (size_t)DM * DFF, DM, DFF, DFF, WS_WUP1, A.in[10] + DM, false);
    WJOB(A.in[22], DFF, DM, DM, WS_WDN0, (const float*)nullptr, false);
    WJOB(A.in[22] + (size_t)DFF * DM, DFF, DM, DM, WS_WDN1, (const float*)nullptr, false);
#undef WJOB
    float* X = (float*)(ws + WS_X); bf16* XB = (bf16*)(ws + WS_XB); float* ssq = (float*)(ws + WS_SSQ);
    for (int row0 = gw; row0 < MPAD; row0 += 4 * NGW) {
        f32x4 v[4][4];
#pragma unroll
        for (int u = 0; u < 4; ++u) { const int row = row0 + u * NGW; const float* src = nullptr;
            if (row < MP) { const int b = row / TP, t = row - b * TP; src = t < NMETA ? A.in[8] + (size_t)t * DM : A.in[0] + ((size_t)b * SEQL + (t - NMETA)) * DM; }
            else if (row < MTOT) src = A.in[1] + (size_t)(row - MP) * DM;
#pragma unroll
            for (int j = 0; j < 4; ++j) v[u][j] = src ? *(const f32x4*)(src + 256 * j + 4 * lane) : (f32x4){0.f, 0.f, 0.f, 0.f}; }
#pragma unroll
        for (int u = 0; u < 4; ++u) { const int row = row0 + u * NGW; if (row >= MPAD) break;
            float s = 0.f;
#pragma unroll
            for (int j = 0; j < 4; ++j) { const f32x4 x = v[u][j];
                *(f32x4*)(X + (size_t)row * DM + 256 * j + 4 * lane) = x; u32x2 o; o.x = pk2(x[0], x[1]); o.y = pk2(x[2], x[3]); *(u32x2*)(XB + (size_t)row * DM + 256 * j + 4 * lane) = o;
                s += (x[0] * x[0] + x[1] * x[1]) + (x[2] * x[2] + x[3] * x[3]); }
            s = wave_sum(s);
            if (lane < 16) ssq[(size_t)row * 16 + lane] = lane == 0 ? s : 0.f; }
    }
    { const u32x4 z = {0u, 0u, 0u, 0u}; const int nchunk = PPAD * DM * 2 / 16;
        for (int i = gw * 64 + lane; i < nchunk; i += NGW * 64) { *(u32x4*)(ws + WS_KB - (size_t)PPAD * DM * 2 + (size_t)i * 16) = z; *(u32x4*)(ws + WS_VB - (size_t)PPAD * DM * 2 + (size_t)i * 16) = z; }
        const int nch2 = (MPAD - MTOT) * DM * 2 / 16;
        for (int i = gw * 64 + lane; i < nch2; i += NGW * 64) { *(u32x4*)(ws + WS_OB + (size_t)MTOT * DM * 2 + (size_t)i * 16) = z; *(u32x4*)(ws + WS_MH + (size_t)MTOT * DM * 2 + (size_t)i * 16) = z; } }
}

__device__ __forceinline__ float wave_scan_add(float v, int lane) {
#pragma unroll
    for (int o = 1; o < 64; o <<= 1) { const float t = __shfl_up(v, o); if (lane >= o) v += t; }
    return v;
}
__device__ __forceinline__ float wave_scan_max(float v, int lane) {
#pragma unroll
    for (int o = 1; o < 64; o <<= 1) { const float t = __shfl_up(v, o); if (lane >= o) v = fmaxf(v, t); }
    return v;
}
__device__ __forceinline__ void p2_cumsum(const Args& A, int gw, int NGW, int lane) {
    float* G = (float*)(A.ws + WS_G); float* GS = (float*)(A.ws + WS_GS);
    const float* lp = A.out + O_FLP; const float* lsn = A.out + O_FLS; const float* lc = A.in[4];
    for (int it = gw; it < NB * 16 + DB * 16; it += NGW) {
        if (it < NB * 16) { const int b = it >> 4, h = it & 15; float* g = G + (size_t)it * PLEN;
            for (int i = lane; i < PPAD; i += 64) g[i] = 0.f;
            float carry = 0.f;
#pragma unroll 1
            for (int c0 = 0; c0 < 65; c0 += 13) { float v[13];
#pragma unroll
                for (int c = 0; c < 13; ++c) { const int t = 64 * (c0 + c) + lane; v[c] = t < TP ? lp[((size_t)b * TP + t) * 16 + h] : 0.f; }
#pragma unroll
                for (int c = 0; c < 13; ++c) { const int t = 64 * (c0 + c) + lane; const float x = wave_scan_add(v[c], lane) + carry; if (t < TP) g[PPAD + t] = -LOG2E * x; carry = __shfl(x, 63); } }
        } else { const int i2 = it - NB * 16, b = i2 >> 4, h = i2 & 15; float* g = GS + (size_t)i2 * GSLEN;
            float carry = 0.f;
#pragma unroll 1
            for (int c0 = 0; c0 < 33; c0 += 11) { float v[11];
#pragma unroll
                for (int c = 0; c < 11; ++c) { const int s = 64 * (c0 + c) + lane; v[c] = 0.f; if (s < PAST) v[c] = lc[((size_t)b * PAST + s) * 16 + h]; else if (s < PAST + DT) v[c] = lsn[((size_t)b * DT + (s - PAST)) * 16 + h]; }
#pragma unroll
                for (int c = 0; c < 11; ++c) { const int s = 64 * (c0 + c) + lane; const float x = wave_scan_add(v[c], lane) + carry; g[s] = s < PAST + DT ? -LOG2E * x : 0.f; carry = __shfl(x, 63); } }
        }
    }
}

__device__ __forceinline__ int crow(int r, int hi) { return (r & 3) + 8 * (r >> 2) + 4 * hi; }
__device__ __forceinline__ v4i16_t vtr(clptr p) { return __builtin_amdgcn_ds_read_tr16_b64_v4i16((LAS v4i16_t*)p); }
constexpr int AT_KSTR = 144, AT_V = 9216, AT_B = 17408, AT_BUF = 17664;

template <bool MASK>
__device__ __forceinline__ void attn_tile(clptr Kt, clptr Vt, clptr Bt, const bf16x8 (&qr)[4], f32x16& o0, f32x16& o1, float& m, float& l, int qpos, int kpos0, int kmin, int lane) {
    const int r32 = lane & 31, hi = lane >> 5;
    f32x16 p0, p1;
#pragma unroll
    for (int r = 0; r < 16; ++r) { p0[r] = 0.f; p1[r] = 0.f; }
#pragma unroll
    for (int d0 = 0; d0 < 4; ++d0) {
        const bf16x8 a0 = *(const LAS bf16x8*)(Kt + r32 * AT_KSTR + d0 * 32 + hi * 16);
        const bf16x8 a1 = *(const LAS bf16x8*)(Kt + (32 + r32) * AT_KSTR + d0 * 32 + hi * 16);
        p0 = __builtin_amdgcn_mfma_f32_32x32x16_bf16(a0, qr[d0], p0, 0, 0, 0);
        p1 = __builtin_amdgcn_mfma_f32_32x32x16_bf16(a1, qr[d0], p1, 0, 0, 0);
    }
#pragma unroll
    for (int g = 0; g < 4; ++g) { const f32x4 b0 = *(const LAS f32x4*)(Bt + (8 * g + 4 * hi) * 4), b1 = *(const LAS f32x4*)(Bt + (32 + 8 * g + 4 * hi) * 4);
#pragma unroll
        for (int i = 0; i < 4; ++i) { p0[4 * g + i] += b0[i]; p1[4 * g + i] += b1[i]; } }
    if (MASK) {
#pragma unroll
        for (int r = 0; r < 16; ++r) { const int kp = kpos0 + crow(r, hi); if (kp > qpos || kp < kmin) p0[r] = -INFINITY; if (kp + 32 > qpos || kp + 32 < kmin) p1[r] = -INFINITY; }
    }
    float mx = fmaxf(p0[0], p1[0]);
#pragma unroll
    for (int r = 1; r < 16; ++r) mx = fmaxf(mx, fmaxf(p0[r], p1[r]));
    mx = fmaxf(mx, __shfl_xor(mx, 32));
    const float mnew = fmaxf(m, mx);
    if (__any(mnew > m)) {
        const float alpha = __builtin_amdgcn_exp2f(m - mnew); m = mnew; l *= alpha;
#pragma unroll
        for (int r = 0; r < 16; ++r) { o0[r] *= alpha; o1[r] *= alpha; } }
    float ls = 0.f;
#pragma unroll
    for (int r = 0; r < 16; ++r) { p0[r] = __builtin_amdgcn_exp2f(p0[r] - m); p1[r] = __builtin_amdgcn_exp2f(p1[r] - m); ls += p0[r] + p1[r]; }
    l += ls;
    u32x4 pw[4];
#pragma unroll
    for (int i = 0; i < 4; ++i) { pw[0][i] = pk2(p0[2 * i], p0[2 * i + 1]); pw[1][i] = pk2(p0[8 + 2 * i], p0[9 + 2 * i]); pw[2][i] = pk2(p1[2 * i], p1[2 * i + 1]); pw[3][i] = pk2(p1[8 + 2 * i], p1[9 + 2 * i]); }
    const clptr vb = Vt + ((lane >> 5) * 4 + ((lane & 15) >> 2)) * 64 + (((lane >> 4) & 1) * 16 + (lane & 3) * 4) * 2;
#pragma unroll
    for (int ks = 0; ks < 4; ++ks) {
        const v4i16_t l0 = vtr(vb + ks * 1024), h0 = vtr(vb + ks * 1024 + 512), l1 = vtr(vb + 4096 + ks * 1024), h1 = vtr(vb + 4096 + ks * 1024 + 512);
        const bf16x8 v0 = {l0[0], l0[1], l0[2], l0[3], h0[0], h0[1], h0[2], h0[3]}, v1 = {l1[0], l1[1], l1[2], l1[3], h1[0], h1[1], h1[2], h1[3]};
        const bf16x8 pb = __builtin_bit_cast(bf16x8, pw[ks]);
        o0 = __builtin_amdgcn_mfma_f32_32x32x16_bf16(v0, pb, o0, 0, 0, 0);
        o1 = __builtin_amdgcn_mfma_f32_32x32x16_bf16(v1, pb, o1, 0, 0, 0);
    }
}

__device__ __forceinline__ void kv_out_rows(const bf16* KB, const bf16* VB, float* outK, float* outV, size_t wsrow0, size_t outrow0, int nrows, int h, int tid) {
    const int ch = tid & 7, tsel = (tid >> 3) & 1, r0 = tid >> 4;
    const bf16* src = (tsel ? VB : KB) + h * 64 + ch * 8; float* dst = (tsel ? outV : outK) + h * 64 + ch * 8;
    asm volatile("" ::: "memory");
#pragma unroll 1
    for (int i0 = 0; i0 < 8; i0 += 4) { u32x4 v[4];
#pragma unroll
        for (int i = 0; i < 4; ++i) { const int r = r0 + 32 * (i0 + i); v[i] = r < nrows ? *(const u32x4*)(src + (wsrow0 + r) * DM) : (u32x4){0u, 0u, 0u, 0u}; }
#pragma unroll
        for (int i = 0; i < 4; ++i) { const int r = r0 + 32 * (i0 + i); if (r < nrows) { f32x4 a, b;
            a[0] = bf2f((unsigned short)(v[i].x & 0xffffu)); a[1] = bf2f((unsigned short)(v[i].x >> 16)); a[2] = bf2f((unsigned short)(v[i].y & 0xffffu)); a[3] = bf2f((unsigned short)(v[i].y >> 16));
            b[0] = bf2f((unsigned short)(v[i].z & 0xffffu)); b[1] = bf2f((unsigned short)(v[i].z >> 16)); b[2] = bf2f((unsigned short)(v[i].w & 0xffffu)); b[3] = bf2f((unsigned short)(v[i].w >> 16));
            *(f32x4*)(dst + (outrow0 + r) * DM) = a; *(f32x4*)(dst + (outrow0 + r) * DM + 4) = b; } } }
}

constexpr float AT_SKIP_T = 40.0f;
__device__ __forceinline__ void attn_prompt_unit(int b, int h, int j, const bf16* QB, const bf16* KB, const bf16* VB, const float* G, bf16* OB, lptr lds, int tid, int w, int lane, float kb, float* outK, float* outV) {
    const int r32 = lane & 31, hi = lane >> 5;
    const int qp = 256 * j + 32 * w + r32, t = qp - PPAD; const bool qvalid = t >= 0; const bool wave_active = (256 * j + 32 * w + 31) >= PPAD;
    const size_t qrow = (size_t)b * TP + (t > 0 ? t : 0);
    bf16x8 qr[4];
#pragma unroll
    for (int d0 = 0; d0 < 4; ++d0) qr[d0] = *(const bf16x8*)(QB + qrow * DM + h * 64 + d0 * 16 + hi * 8);
    const int lrow = tid >> 3, lch = tid & 7;
    const long krow0 = (long)b * TP - PPAD + lrow;
    const bf16* kg = KB + krow0 * DM + h * 64 + lch * 8; const bf16* vg = VB + krow0 * DM + h * 64 + lch * 8; const float* gg = G + (size_t)(b * 16 + h) * PLEN;
    f32x16 o0, o1;
#pragma unroll
    for (int r = 0; r < 16; ++r) { o0[r] = 0.f; o1[r] = 0.f; }
    float m = -1e30f, l = 0.f;
    const int kt1 = 4 * j + 3, ktw = 4 * j + (w >> 1), kmin = qp >= PPAD ? PPAD : 0;
    int kt0 = 3;
    { const int ta = 3 + lane, tb = 67 + lane;
        const float g0 = gg[j == 0 ? PPAD : 256 * j], ga = ta < 4 * j ? gg[64 * ta + 63] : 3.0e38f, gb = tb < 4 * j ? gg[64 * tb + 63] : 3.0e38f;
        const float thr = g0 - 2.0f * kb - AT_SKIP_T;
        const bool sa = ga <= thr, sb = gb <= thr;
        kt0 = 3 + __popcll(__ballot(sa)) + __popcll(__ballot(sb)); }
    u32x4 kreg[2][2], vreg[2][2]; float breg[2] = {0.f, 0.f};
    LAS int* vote = (LAS int*)(lds + 4 * AT_BUF);
#define AT_LOADPAIR(S, KH) do { _Pragma("unroll") for (int i_ = 0; i_ < 2; ++i_) { const int kk_ = (KH) - i_ >= kt0 ? (KH) - i_ : kt0; kreg[S][i_] = *(const u32x4*)(kg + (size_t)kk_ * 64 * DM); vreg[S][i_] = *(const u32x4*)(vg + (size_t)kk_ * 64 * DM); } \
        if (tid < 128) { const int kk_ = (KH) - (tid >> 6) >= kt0 ? (KH) - (tid >> 6) : kt0; breg[S] = gg[kk_ * 64 + (tid & 63)]; } } while (0)
#define AT_STEP(S, KH, STEPI) { const int kh_ = (KH); const lptr base = lds + (S) * 2 * AT_BUF; \
        _Pragma("unroll") for (int i = 0; i < 2; ++i) { *(LAS u32x4*)(base + i * AT_BUF + lrow * AT_KSTR + lch * 16) = kreg[S][i]; *(LAS u32x4*)(base + i * AT_BUF + AT_V + (lch >> 2) * 4096 + lrow * 64 + (lch & 3) * 16) = vreg[S][i]; } \
        if (tid < 128) *(LAS float*)(base + (tid >> 6) * AT_BUF + AT_B + (tid & 63) * 4) = breg[S]; \
        LDS_BARRIER(); \
        if ((STEPI) > 0) { const LAS int* vp_ = vote + (((STEPI) - 1) & 1) * 8; int all_ = 1; _Pragma("unroll") for (int i = 0; i < 8; ++i) all_ &= vp_[i]; if (all_) break; } \
        if (kh_ - 4 >= kt0) AT_LOADPAIR(S, kh_ - 4); \
        int done_ = wave_active ? 0 : 1; \
        _Pragma("unroll") for (int i = 0; i < 2; ++i) { const int k2 = kh_ - i; const lptr b2 = base + i * AT_BUF; \
            if (wave_active && k2 <= ktw && k2 >= kt0) { \
                if (k2 == 3 || k2 == ktw) attn_tile<true>(b2, b2 + AT_V, b2 + AT_B, qr, o0, o1, m, l, qp, 64 * k2, kmin, lane); \
                else attn_tile<false>(b2, b2 + AT_V, b2 + AT_B, qr, o0, o1, m, l, qp, 64 * k2, kmin, lane); \
                done_ = k2 > kt0 ? (__all(kb + *(const LAS float*)(b2 + AT_B) <= m - AT_SKIP_T) ? 1 : 0) : 1; } } \
        if (lane == 0) vote[((STEPI) & 1) * 8 + w] = done_; }
    AT_LOADPAIR(0, kt1);
    if (kt1 - 2 >= kt0) AT_LOADPAIR(1, kt1 - 2);
    for (int kh = kt1, si = 0; kh >= kt0; kh -= 4, si += 2) { AT_STEP(0, kh, si) if (kh - 2 >= kt0) AT_STEP(1, kh - 2, si + 1) }
#undef AT_STEP
#undef AT_LOADPAIR
    const float lt = l + __shfl_xor(l, 32), inv = 1.0f / lt;
    if (wave_active && qvalid) { bf16* op = OB + qrow * DM + h * 64 + 4 * hi;
#pragma unroll
        for (int g = 0; g < 4; ++g) { u32x2 a, c; a.x = pk2(o0[4 * g] * inv, o0[4 * g + 1] * inv); a.y = pk2(o0[4 * g + 2] * inv, o0[4 * g + 3] * inv); c.x = pk2(o1[4 * g] * inv, o1[4 * g + 1] * inv); c.y = pk2(o1[4 * g + 2] * inv, o1[4 * g + 3] * inv);
            *(u32x2*)(op + 8 * g) = a; *(u32x2*)(op + 32 + 8 * g) = c; } }
    { const int t0 = j == 0 ? 0 : 256 * j - PPAD, nr = j == 0 ? 256 - PPAD : 256;
        kv_out_rows(KB, VB, outK, outV, (size_t)b * TP + t0, (size_t)b * TP + t0, nr, h, tid); }
    __syncthreads();
}

__device__ __forceinline__ void attn_sample_unit(int b, int h, const float* cK, const float* cV, const bf16* QB, const bf16* KB, const bf16* VB, const float* GS, bf16* OB, lptr lds, int tid, int w, int lane, float kb, float* outK, float* outV) {
    const int r32 = lane & 31, hi = lane >> 5;
    const lptr base = lds + w * AT_BUF;
    const size_t qrow = (size_t)MP + b * DT + r32;
    bf16x8 qr[4];
#pragma unroll
    for (int d0 = 0; d0 < 4; ++d0) qr[d0] = *(const bf16x8*)(QB + qrow * DM + h * 64 + d0 * 16 + hi * 8);
    f32x16 o0, o1;
#pragma unroll
    for (int r = 0; r < 16; ++r) { o0[r] = 0.f; o1[r] = 0.f; }
    float m = -1e30f, l = 0.f;
    const float* gs = GS + (size_t)(b * 16 + h) * GSLEN;
    int ti0 = 0;
    { const float thr = gs[PAST] - 2.0f * kb - AT_SKIP_T; const bool sk = lane < 32 && gs[64 * lane + 63] <= thr; ti0 = __popcll(__ballot(sk)); }
#pragma unroll 1
    for (int ti = ti0 + w; ti < 33; ti += 8) {
        const float bias_l = gs[64 * ti + lane];
        if (ti < 32) {
            const float* ck0 = cK + (((size_t)b * PAST + 64 * ti + (lane >> 4)) * 16 + h) * 64 + 4 * (lane & 15); const float* cv0 = cV + (ck0 - cK);
            const lptr kw0 = base + (lane >> 4) * AT_KSTR + (lane & 15) * 8, vw0 = base + AT_V + ((lane & 15) >> 3) * 4096 + (lane >> 4) * 64 + (lane & 7) * 8;
#pragma unroll
            for (int half = 0; half < 2; ++half) {
                f32x4 kv[8], vv[8];
#pragma unroll
                for (int i = 0; i < 8; ++i) { kv[i] = *(const f32x4*)(ck0 + (half * 32 + i * 4) * 1024); vv[i] = *(const f32x4*)(cv0 + (half * 32 + i * 4) * 1024); }
#pragma unroll
                for (int i = 0; i < 8; ++i) { u32x2 a, c; a.x = pk2(kv[i][0], kv[i][1]); a.y = pk2(kv[i][2], kv[i][3]); c.x = pk2(vv[i][0], vv[i][1]); c.y = pk2(vv[i][2], vv[i][3]);
                    *(LAS u32x2*)(kw0 + (half * 32 + i * 4) * AT_KSTR) = a; *(LAS u32x2*)(vw0 + (half * 32 + i * 4) * 64) = c; }
                asm volatile("" ::: "memory");
            }
        } else {
            const size_t off0 = ((size_t)MP + b * DT + (lane >> 3)) * DM + h * 64 + (lane & 7) * 8;
            const lptr kw0 = base + (lane >> 3) * AT_KSTR + (lane & 7) * 16, vw0 = base + AT_V + ((lane & 7) >> 2) * 4096 + (lane >> 3) * 64 + (lane & 3) * 16;
#pragma unroll
            for (int i = 0; i < 8; ++i) { const u32x4 a = *(const u32x4*)(KB + off0 + (size_t)i * 8 * DM), c = *(const u32x4*)(VB + off0 + (size_t)i * 8 * DM);
                *(LAS u32x4*)(kw0 + i * 8 * AT_KSTR) = a; *(LAS u32x4*)(vw0 + i * 8 * 64) = c; }
        }
        *(LAS float*)(base + AT_B + lane * 4) = bias_l;
        LDS_WAIT();
        if (ti < 32) attn_tile<false>(base, base + AT_V, base + AT_B, qr, o0, o1, m, l, 0, 0, 0, lane);
        else attn_tile<true>(base, base + AT_V, base + AT_B, qr, o0, o1, m, l, r32, 0, 0, lane);
        asm volatile("" ::: "memory");
    }
    const float lt = l + __shfl_xor(l, 32);
    LDS_WAIT();
    LAS float* of = (LAS float*)base;
#pragma unroll
    for (int r = 0; r < 16; ++r) { of[crow(r, hi) * 32 + r32] = o0[r]; of[(32 + crow(r, hi)) * 32 + r32] = o1[r]; }
    if (hi == 0) { of[2048 + r32] = m; of[2080 + r32] = lt; }
    __syncthreads();
    { const int q = tid & 31, dg = tid >> 5; float M = -1e30f;
#pragma unroll
        for (int ww = 0; ww < 8; ++ww) M = fmaxf(M, ((LAS float*)(lds + ww * AT_BUF))[2048 + q]);
        float L = 0.f, o[4] = {0.f, 0.f, 0.f, 0.f};
#pragma unroll
        for (int ww = 0; ww < 8; ++ww) { const LAS float* p = (LAS float*)(lds + ww * AT_BUF); const float f = __builtin_amdgcn_exp2f(p[2048 + q] - M); L += f * p[2080 + q];
#pragma unroll
            for (int i = 0; i < 4; ++i) o[i] += f * p[(4 * dg + i) * 32 + q]; }
        const float inv = 1.0f / L; u32x2 a; a.x = pk2(o[0] * inv, o[1] * inv); a.y = pk2(o[2] * inv, o[3] * inv);
        *(u32x2*)(OB + ((size_t)MP + b * DT + q) * DM + h * 64 + 4 * dg) = a; }
    kv_out_rows(KB, VB, outK, outV, (size_t)MP + b * DT, (size_t)b * DT, DT, h, tid);
    __syncthreads();
}

__device__ __forceinline__ void p3_attention(const Args& A, lptr lds, int tid, int w, int lane, int rep) {
    unsigned char* ws = A.ws;
    const bf16* QB = (const bf16*)(ws + WS_QB); const bf16* KB = (const bf16*)(ws + WS_KB); const bf16* VB = (const bf16*)(ws + WS_VB); bf16* OB = (bf16*)(ws + WS_OB);
    const float* G = (const float*)(ws + WS_G); const float* GS = (const float*)(ws + WS_GS);
    unsigned* ctr = (unsigned*)(ws + WS_CTL) + 64 * rep;
    LAS unsigned* su = (LAS unsigned*)(lds + LDS_BYTES - 64);
    constexpr int NPU = 17 * NB * 16, NSU = DB * 16, NU = NPU + NSU;
    float gqm = 0.f, gkm = 0.f;
    for (int i = 0; i < 64; ++i) { gqm = fmaxf(gqm, fabsf(A.in[13][i])); gkm = fmaxf(gkm, fabsf(A.in[14][i])); }
    const float kb = 8.0f * LOG2E * gqm * gkm * 1.02f;
    for (;;) {
        if (tid == 0) *su = atomicAdd(ctr, 1u);
        __syncthreads();
        const int u = (int)*su;
        __syncthreads();
        if (u >= NU) break;
        const bool is_s = (u % 5 == 4) && (u / 5 < NSU);
        if (is_s) { const int s = u / 5; attn_sample_unit(s >> 4, s & 15, A.in[2], A.in[3], QB, KB, VB, GS, OB, lds, tid, w, lane, kb, A.out + O_FKS, A.out + O_FVS); }
        else { const int k = u / 5, pidx = u - (k < NSU ? k : NSU); const int j = 16 - pidx / (NB * 16), bh = pidx % (NB * 16); attn_prompt_unit(bh >> 4, bh & 15, j, QB, KB, VB, G, OB, lds, tid, w, lane, kb, A.out + O_FKP, A.out + O_FVP); }
    }
#ifdef PROBE_SAMPLE
    for (;;) { if (tid == 0) *su = atomicAdd(ctr + 128, 1u); __syncthreads(); const int u = (int)*su; __syncthreads(); if (u >= NSU) break;
        attn_sample_unit(u >> 4, u & 15, A.in[2], A.in[3], QB, KB, VB, GS, OB, lds, tid, w, lane, kb, A.out + O_FKS, A.out + O_FVS); }
#endif
}

constexpr int ML_QS = 272, ML_TS = 144;
constexpr int MA_VS = 544;
constexpr int MA_Q = 0, MA_K = 17408, MA_KW = 34816, MA_V = 52224, MA_SP = 87040, MA_VEC = 96256;
__device__ __forceinline__ bf16x8 tr_frag(clptr p, int rowstride4) { const v4i16_t lo = vtr(p), hi = vtr(p + rowstride4); return (bf16x8){lo[0], lo[1], lo[2], lo[3], hi[0], hi[1], hi[2], hi[3]}; }
constexpr int NUA = NB * 4 * 65 + DB * 4;
__device__ __forceinline__ f32x4 mfma16(bf16x8 a, bf16x8 b, f32x4 c) { return __builtin_amdgcn_mfma_f32_16x16x32_bf16(a, b, c, 0, 0, 0); }

__device__ __forceinline__ void mlstm_a_unit(const Args& A, int uid, lptr lds, int tid, int w, int lane) {
    unsigned char* ws = A.ws;
    const bf16* MQ = (const bf16*)(ws + WS_MQ); const bf16* MK = (const bf16*)(ws + WS_MK); const bf16* MV = (const bf16*)(ws + WS_MV); bf16* MH = (bf16*)(ws + WS_MH);
    const float* GI = (const float*)(ws + WS_GI); const float* GF = (const float*)(ws + WS_GF); float* RS = (float*)(ws + WS_RS); float* NU = (float*)(ws + WS_NU); bf16* U = (bf16*)(ws + WS_U) + (size_t)uid * 32768;
    const bool prompt = uid < NB * 4 * 65; const int bh = prompt ? uid / 65 : uid - NB * 4 * 65, c = prompt ? uid - bh * 65 : 0, b = bh >> 2, h = bh & 3;
    const size_t row_base = prompt ? (size_t)b * TP : (size_t)MP + (size_t)b * DT; const int tok0 = prompt ? 64 * c - 48 : 0, tlim = prompt ? TP : DT;
    LAS float* vec = (LAS float*)(lds + MA_VEC); LAS float* v_b = vec, *v_a = vec + 64, *v_ml = vec + 128, *v_rs = vec + 192;
    const int l15 = lane & 15, lg = lane >> 4;
    float gi = -1e30f, gf = 0.f;
    { const int tk = tok0 + lane; if (tk >= 0 && tk < tlim) { gi = GI[(row_base + tk) * 4 + h]; gf = GF[(row_base + tk) * 4 + h]; } }
    const float bb = wave_scan_add(gf, lane), aa = gi - bb, pm = wave_scan_max(aa, lane), mloc = bb + pm;
    const float b_last = __shfl(bb, 63), ml_last = __shfl(mloc, 63), wgl = __expf(b_last + aa - ml_last);
    if (w == 0) { v_b[lane] = bb; v_a[lane] = aa; v_ml[lane] = mloc; }
    if (w == 0) { ((float*)(ws + WS_BBC))[(size_t)uid * 64 + lane] = bb; ((float*)(ws + WS_PMC))[(size_t)uid * 64 + lane] = pm; }
#pragma unroll
    for (int i = 0; i < 2; ++i) { const int id = tid + 512 * i, r = id >> 4, ch = id & 15; const int tk = tok0 + r; const bool ok = tk >= 0 && tk < tlim;
        u32x4 q = {0u, 0u, 0u, 0u}, k = {0u, 0u, 0u, 0u};
        if (ok) { q = *(const u32x4*)(MQ + (row_base + tk) * 512 + h * 128 + ch * 8); k = *(const u32x4*)(MK + (row_base + tk) * 512 + h * 128 + ch * 8); }
        *(LAS u32x4*)(lds + MA_Q + r * ML_QS + ch * 16) = q; *(LAS u32x4*)(lds + MA_K + r * ML_QS + ch * 16) = k;
        const float wgr = __shfl(wgl, r); u32x4 kw;
#pragma unroll
        for (int e = 0; e < 4; ++e) kw[e] = pk2(bf2f((unsigned short)(k[e] & 0xffffu)) * wgr, bf2f((unsigned short)(k[e] >> 16)) * wgr);
        *(LAS u32x4*)(lds + MA_KW + r * ML_QS + ch * 16) = kw; }
#pragma unroll
    for (int i = 0; i < 4; ++i) { const int id = tid + 512 * i, r = id >> 5, ch = id & 31; const int tk = tok0 + r; const bool ok = tk >= 0 && tk < tlim;
        u32x4 v = {0u, 0u, 0u, 0u}; if (ok) v = *(const u32x4*)(MV + (row_base + tk) * DM + h * 256 + ch * 8);
        *(LAS u32x4*)(lds + MA_V + r * MA_VS + ch * 16) = v; }
    __syncthreads();
    { const int tr = w >> 1; float rs[4] = {0.f, 0.f, 0.f, 0.f};
#pragma unroll
        for (int i = 0; i < 2; ++i) { const int tc = 2 * (w & 1) + i; f32x4 acc = {0.f, 0.f, 0.f, 0.f};
#pragma unroll
            for (int k0 = 0; k0 < 128; k0 += 32) { const bf16x8 a = *(const LAS bf16x8*)(lds + MA_Q + (16 * tr + l15) * ML_QS + (k0 + 8 * lg) * 2), bq = *(const LAS bf16x8*)(lds + MA_K + (16 * tc + l15) * ML_QS + (k0 + 8 * lg) * 2); acc = mfma16(a, bq, acc); }
            const int s = 16 * tc + l15; const float as = v_a[s];
#pragma unroll
            for (int r = 0; r < 4; ++r) { const int t = 16 * tr + 4 * lg + r; const float d = s <= t ? __expf(v_b[t] + as - v_ml[t]) : 0.f; const float sp = acc[r] * d; rs[r] += sp;
                *(LAS unsigned short*)(lds + MA_SP + t * ML_TS + s * 2) = (unsigned short)f2bf(sp); } }
#pragma unroll
        for (int r = 0; r < 4; ++r) { float x = rs[r]; x += __shfl_xor(x, 1); x += __shfl_xor(x, 2); x += __shfl_xor(x, 4); x += __shfl_xor(x, 8); if (l15 == 0) v_rs[(w & 1) * 64 + 16 * tr + 4 * lg + r] = x; } }
    const clptr vtb = lds + MA_V + (8 * lg + (l15 >> 2)) * MA_VS + (l15 & 3) * 8;
    {
        const clptr kwb = lds + MA_KW + (8 * lg + (l15 >> 2)) * ML_QS + (l15 & 3) * 8 + w * 32;
        const bf16x8 a0 = tr_frag(kwb, 4 * ML_QS), a1 = tr_frag(kwb + 32 * ML_QS, 4 * ML_QS);
#pragma unroll 4
        for (int dvt = 0; dvt < 16; ++dvt) { const bf16x8 b0 = tr_frag(vtb + dvt * 32, 4 * MA_VS), b1 = tr_frag(vtb + 32 * MA_VS + dvt * 32, 4 * MA_VS);
            f32x4 acc = {0.f, 0.f, 0.f, 0.f}; acc = mfma16(a0, b0, acc); acc = mfma16(a1, b1, acc);
            u32x2 o; o.x = pk2(acc[0], acc[1]); o.y = pk2(acc[2], acc[3]); *(u32x2*)(U + (size_t)(16 * dvt + l15) * 128 + 16 * w + 4 * lg) = o; } }
    if (tid < 128) { float x = 0.f;
#pragma unroll 8
        for (int s = 0; s < 64; ++s) x += bf2f(*(const LAS unsigned short*)(lds + MA_KW + s * ML_QS + tid * 2));
        NU[(size_t)uid * 128 + tid] = x; }
    __syncthreads();
    if (tid < 64) { const int tk = tok0 + tid; if (tk >= 0 && tk < tlim) RS[(row_base + tk) * 4 + h] = v_rs[tid] + v_rs[64 + tid]; }
    {
        const int tt = w & 3; const bf16x8 b0 = *(const LAS bf16x8*)(lds + MA_SP + (16 * tt + l15) * ML_TS + (8 * lg) * 2), b1 = *(const LAS bf16x8*)(lds + MA_SP + (16 * tt + l15) * ML_TS + (32 + 8 * lg) * 2);
        const int tk = tok0 + 16 * tt + l15; const bool ok = tk >= 0 && tk < tlim; bf16* dst = MH + (row_base + (ok ? tk : 0)) * DM + h * 256 + 4 * lg;
#pragma unroll 4
        for (int i = 0; i < 8; ++i) { const int dvt = 8 * (w >> 2) + i; const bf16x8 a0 = tr_frag(vtb + dvt * 32, 4 * MA_VS), a1 = tr_frag(vtb + 32 * MA_VS + dvt * 32, 4 * MA_VS);
            f32x4 acc = {0.f, 0.f, 0.f, 0.f}; acc = mfma16(a0, b0, acc); acc = mfma16(a1, b1, acc);
            if (ok) { u32x2 o; o.x = pk2(acc[0], acc[1]); o.y = pk2(acc[2], acc[3]); *(u32x2*)(dst + 16 * dvt) = o; } } }
    __syncthreads();
}

constexpr int MB_QSZ = 17408, MB_CBSZ = 48 * ML_QS, MB_Q = 0, MB_CB = 2 * MB_QSZ, MB_END = MB_CB + 2 * MB_CBSZ;
__device__ __forceinline__ void mlstm_b_item(const Args& A, int it, lptr lds, int tid, int w, int lane) {
    unsigned char* ws = A.ws;
    const bf16* MQ = (const bf16*)(ws + WS_MQ); bf16* MH = (bf16*)(ws + WS_MH); const float* GI = (const float*)(ws + WS_GI); const float* GF = (const float*)(ws + WS_GF);
    const float* RS = (const float*)(ws + WS_RS); const float* NU = (const float*)(ws + WS_NU); float* HSSQ = (float*)(ws + WS_HSSQ);
    const bool prompt = it < 256; const int i2 = prompt ? it : it - 256; const int b = i2 >> 5, h = (i2 >> 3) & 3, sl = i2 & 7; const int nch = prompt ? 65 : 1;
    const int uid0 = prompt ? (b * 4 + h) * 65 : NB * 4 * 65 + (b * 4 + h);
    const size_t row_base = prompt ? (size_t)b * TP : (size_t)MP + (size_t)b * DT; const int tlim = prompt ? TP : DT;
    const bf16* Ub = (const bf16*)(ws + WS_U) + (size_t)uid0 * 32768 + (size_t)(sl * 32 + (tid >> 4)) * 128 + (tid & 15) * 8;
    const int l15 = lane & 15, lg = lane >> 4, tt = w & 3, dvt = w >> 2, cdv = tid >> 4, cdk = (tid & 15) * 8;
    float C[8]; float nreg = 0.f, m_run = 0.f;
    {
        if (prompt) {
#pragma unroll
            for (int i = 0; i < 8; ++i) C[i] = 0.f;
        } else { const float* C0 = A.in[5] + ((size_t)(b * 4 + h) * 256 + sl * 32 + cdv) * 128 + cdk; const f32x4 c0 = *(const f32x4*)C0, c1 = *(const f32x4*)(C0 + 4);
#pragma unroll
            for (int i = 0; i < 4; ++i) { C[i] = c0[i]; C[4 + i] = c1[i]; }
            if (tid < 128) nreg = A.in[6][(size_t)(b * 4 + h) * 128 + tid]; m_run = A.in[7][b * 4 + h]; }
        u32x4 o; o.x = pk2(C[0], C[1]); o.y = pk2(C[2], C[3]); o.z = pk2(C[4], C[5]); o.w = pk2(C[6], C[7]);
        *(LAS u32x4*)(lds + MB_CB + cdv * ML_QS + cdk * 2) = o;
        if (tid < 256) { const int r = 32 + (tid >> 4); const u32x4 z = {0u, 0u, 0u, 0u}; *(LAS u32x4*)(lds + MB_CB + r * ML_QS + (tid & 15) * 16) = z; *(LAS u32x4*)(lds + MB_CB + MB_CBSZ + r * ML_QS + (tid & 15) * 16) = z; }
    }
    __syncthreads();
    if (tid < 128) *(LAS unsigned short*)(lds + MB_CB + 32 * ML_QS + tid * 2) = (unsigned short)f2bf(nreg);
    u32x4 q0_[2], q1_[2], uc_[2]; u32x2 nl_[2]; float gi_[2], gf_[2], rs_[2], nu_[2];
#define MB_LOADQ(S, cc) do { const int tok0_ = prompt ? 64 * (cc) - 48 : 0; \
        { const int r_ = tid >> 4, tk_ = tok0_ + r_; const bool ok_ = tk_ >= 0 && tk_ < tlim; q0_[S] = (u32x4){0u, 0u, 0u, 0u}; if (ok_) q0_[S] = *(const u32x4*)(MQ + (row_base + tk_) * 512 + h * 128 + (tid & 15) * 8); } \
        { const int r_ = 32 + (tid >> 4), tk_ = tok0_ + r_; const bool ok_ = tk_ >= 0 && tk_ < tlim; q1_[S] = (u32x4){0u, 0u, 0u, 0u}; if (ok_) q1_[S] = *(const u32x4*)(MQ + (row_base + tk_) * 512 + h * 128 + (tid & 15) * 8); } } while (0)
#define MB_LOAD(S, cc) do { const int tok0_ = prompt ? 64 * (cc) - 48 : 0; \
        uc_[S] = *(const u32x4*)(Ub + (size_t)(cc) * 32768); \
        { const int tk_ = tok0_ + lane; gi_[S] = ((const float*)(ws + WS_PMC))[(size_t)(uid0 + (cc)) * 64 + lane]; gf_[S] = ((const float*)(ws + WS_BBC))[(size_t)(uid0 + (cc)) * 64 + lane]; rs_[S] = 0.f; if (tk_ >= 0 && tk_ < tlim) rs_[S] = RS[(row_base + tk_) * 4 + h]; } \
        nu_[S] = tid < 128 ? NU[(size_t)(uid0 + (cc)) * 128 + tid] : 0.f; \
        { const int tk_ = tok0_ + 16 * tt + l15; nl_[S] = (u32x2){0u, 0u}; if (tk_ >= 0 && tk_ < tlim) nl_[S] = *(const u32x2*)(MH + (row_base + tk_) * DM + h * 256 + sl * 32 + 16 * dvt + 4 * lg); } } while (0)
    MB_LOADQ(0, 0); MB_LOAD(0, 0);
    if (nch > 1) MB_LOAD(1, 1);
    *(LAS u32x4*)(lds + MB_Q + (tid >> 4) * ML_QS + (tid & 15) * 16) = q0_[0]; *(LAS u32x4*)(lds + MB_Q + (32 + (tid >> 4)) * ML_QS + (tid & 15) * 16) = q1_[0];
    __syncthreads();
    if (nch > 1) MB_LOADQ(1, 1);
    if (nch > 2) MB_LOADQ(0, 2);
#pragma unroll 1
    for (int c2 = 0; c2 < nch; c2 += 2) {
        { constexpr int S = 0; const int c = c2;
        const int tok0 = prompt ? 64 * c - 48 : 0;
        const float bb = gf_[S], pm = gi_[S];
        const float mx = fmaxf(m_run, pm), mt = bb + mx, win = __expf(m_run - mx), scl = __expf(pm - mx), einv = __expf(-mt);
        const float b_last = __shfl(bb, 63), m_new = __shfl(mt, 63), pm_last = __shfl(pm, 63), mx_last = fmaxf(m_run, pm_last);
        const float decay = __expf(m_run - mx_last), usc = __expf(pm_last - mx_last);
        (void)b_last;
        const u32x4 uc = uc_[S]; const u32x2 nlc = nl_[S]; const float rsc = rs_[S], nuc = nu_[S];
        f32x4 acc = {0.f, 0.f, 0.f, 0.f}, acc2 = {0.f, 0.f, 0.f, 0.f};
#pragma unroll
        for (int k0 = 0; k0 < 128; k0 += 32) { const bf16x8 bq = *(const LAS bf16x8*)(lds + MB_Q + S * MB_QSZ + (16 * tt + l15) * ML_QS + (k0 + 8 * lg) * 2);
            const bf16x8 a = *(const LAS bf16x8*)(lds + MB_CB + S * MB_CBSZ + (16 * dvt + l15) * ML_QS + (k0 + 8 * lg) * 2), an = *(const LAS bf16x8*)(lds + MB_CB + S * MB_CBSZ + (32 + l15) * ML_QS + (k0 + 8 * lg) * 2);
            acc = mfma16(a, bq, acc); acc2 = mfma16(an, bq, acc2); }
        {
            const int t = 16 * tt + l15; const int tk = tok0 + t; const bool ok = tk >= 0 && tk < tlim;
            const float qn = __shfl(acc2[0], l15), win_t = __shfl(win, t), scl_t = __shfl(scl, t), einv_t = __shfl(einv, t), rs_t = __shfl(rsc, t);
            const float den = win_t * qn + scl_t * rs_t, rden = 1.0f / fmaxf(fabsf(den), einv_t);
            const float n0 = bf2f((unsigned short)(nlc.x & 0xffffu)), n1 = bf2f((unsigned short)(nlc.x >> 16)), n2 = bf2f((unsigned short)(nlc.y & 0xffffu)), n3 = bf2f((unsigned short)(nlc.y >> 16));
            const float h0 = (win_t * acc[0] + scl_t * n0) * rden, h1 = (win_t * acc[1] + scl_t * n1) * rden, h2 = (win_t * acc[2] + scl_t * n2) * rden, h3 = (win_t * acc[3] + scl_t * n3) * rden;
            float x = (h0 * h0 + h1 * h1) + (h2 * h2 + h3 * h3); x += __shfl_xor(x, 16); x += __shfl_xor(x, 32);
            if (ok) { u32x2 o; o.x = pk2(h0, h1); o.y = pk2(h2, h3); *(u32x2*)(MH + (row_base + tk) * DM + h * 256 + sl * 32 + 16 * dvt + 4 * lg) = o; if (lg == 0) HSSQ[((row_base + tk) * 4 + h) * 16 + sl * 2 + dvt] = x; }
        }
        {
            C[0] = decay * C[0] + usc * bf2f((unsigned short)(uc.x & 0xffffu)); C[1] = decay * C[1] + usc * bf2f((unsigned short)(uc.x >> 16));
            C[2] = decay * C[2] + usc * bf2f((unsigned short)(uc.y & 0xffffu)); C[3] = decay * C[3] + usc * bf2f((unsigned short)(uc.y >> 16));
            C[4] = decay * C[4] + usc * bf2f((unsigned short)(uc.z & 0xffffu)); C[5] = decay * C[5] + usc * bf2f((unsigned short)(uc.z >> 16));
            C[6] = decay * C[6] + usc * bf2f((unsigned short)(uc.w & 0xffffu)); C[7] = decay * C[7] + usc * bf2f((unsigned short)(uc.w >> 16));
            u32x4 o; o.x = pk2(C[0], C[1]); o.y = pk2(C[2], C[3]); o.z = pk2(C[4], C[5]); o.w = pk2(C[6], C[7]);
            *(LAS u32x4*)(lds + MB_CB + (S ^ 1) * MB_CBSZ + cdv * ML_QS + cdk * 2) = o;
            if (tid < 128) { nreg = decay * nreg + usc * nuc; *(LAS unsigned short*)(lds + MB_CB + (S ^ 1) * MB_CBSZ + 32 * ML_QS + tid * 2) = (unsigned short)f2bf(nreg); }
            if (c + 1 < nch) { *(LAS u32x4*)(lds + MB_Q + (S ^ 1) * MB_QSZ + (tid >> 4) * ML_QS + (tid & 15) * 16) = q0_[S ^ 1]; *(LAS u32x4*)(lds + MB_Q + (S ^ 1) * MB_QSZ + (32 + (tid >> 4)) * ML_QS + (tid & 15) * 16) = q1_[S ^ 1]; }
        }
        m_run = m_new;
        LDS_BARRIER();
        if (c + 2 < nch) MB_LOAD(S, c + 2);
        if (c + 3 < nch) MB_LOADQ(S ^ 1, c + 3);
        }
        if (c2 + 1 < nch) { constexpr int S = 1; const int c = c2 + 1;
        const int tok0 = prompt ? 64 * c - 48 : 0;
        const float bb = gf_[S], pm = gi_[S];
        const float mx = fmaxf(m_run, pm), mt = bb + mx, win = __expf(m_run - mx), scl = __expf(pm - mx), einv = __expf(-mt);
        const float b_last = __shfl(bb, 63), m_new = __shfl(mt, 63), pm_last = __shfl(pm, 63), mx_last = fmaxf(m_run, pm_last);
        const float decay = __expf(m_run - mx_last), usc = __expf(pm_last - mx_last);
        (void)b_last;
        const u32x4 uc = uc_[S]; const u32x2 nlc = nl_[S]; const float rsc = rs_[S], nuc = nu_[S];
        f32x4 acc = {0.f, 0.f, 0.f, 0.f}, acc2 = {0.f, 0.f, 0.f, 0.f};
#pragma unroll
        for (int k0 = 0; k0 < 128; k0 += 32) { const bf16x8 bq = *(const LAS bf16x8*)(lds + MB_Q + S * MB_QSZ + (16 * tt + l15) * ML_QS + (k0 + 8 * lg) * 2);
            const bf16x8 a = *(const LAS bf16x8*)(lds + MB_CB + S * MB_CBSZ + (16 * dvt + l15) * ML_QS + (k0 + 8 * lg) * 2), an = *(const LAS bf16x8*)(lds + MB_CB + S * MB_CBSZ + (32 + l15) * ML_QS + (k0 + 8 * lg) * 2);
            acc = mfma16(a, bq, acc); acc2 = mfma16(an, bq, acc2); }
        {
            const int t = 16 * tt + l15; const int tk = tok0 + t; const bool ok = tk >= 0 && tk < tlim;
            const float qn = __shfl(acc2[0], l15), win_t = __shfl(win, t), scl_t = __shfl(scl, t), einv_t = __shfl(einv, t), rs_t = __shfl(rsc, t);
            const float den = win_t * qn + scl_t * rs_t, rden = 1.0f / fmaxf(fabsf(den), einv_t);
            const float n0 = bf2f((unsigned short)(nlc.x & 0xffffu)), n1 = bf2f((unsigned short)(nlc.x >> 16)), n2 = bf2f((unsigned short)(nlc.y & 0xffffu)), n3 = bf2f((unsigned short)(nlc.y >> 16));
            const float h0 = (win_t * acc[0] + scl_t * n0) * rden, h1 = (win_t * acc[1] + scl_t * n1) * rden, h2 = (win_t * acc[2] + scl_t * n2) * rden, h3 = (win_t * acc[3] + scl_t * n3) * rden;
            float x = (h0 * h0 + h1 * h1) + (h2 * h2 + h3 * h3); x += __shfl_xor(x, 16); x += __shfl_xor(x, 32);
            if (ok) { u32x2 o; o.x = pk2(h0, h1); o.y = pk2(h2, h3); *(u32x2*)(MH + (row_base + tk) * DM + h * 256 + sl * 32 + 16 * dvt + 4 * lg) = o; if (lg == 0) HSSQ[((row_base + tk) * 4 + h) * 16 + sl * 2 + dvt] = x; }
        }
        {
            C[0] = decay * C[0] + usc * bf2f((unsigned short)(uc.x & 0xffffu)); C[1] = decay * C[1] + usc * bf2f((unsigned short)(uc.x >> 16));
            C[2] = decay * C[2] + usc * bf2f((unsigned short)(uc.y & 0xffffu)); C[3] = decay * C[3] + usc * bf2f((unsigned short)(uc.y >> 16));
            C[4] = decay * C[4] + usc * bf2f((unsigned short)(uc.z & 0xffffu)); C[5] = decay * C[5] + usc * bf2f((unsigned short)(uc.z >> 16));
            C[6] = decay * C[6] + usc * bf2f((unsigned short)(uc.w & 0xffffu)); C[7] = decay * C[7] + usc * bf2f((unsigned short)(uc.w >> 16));
            u32x4 o; o.x = pk2(C[0], C[1]); o.y = pk2(C[2], C[3]); o.z = pk2(C[4], C[5]); o.w = pk2(C[6], C[7]);
            *(LAS u32x4*)(lds + MB_CB + (S ^ 1) * MB_CBSZ + cdv * ML_QS + cdk * 2) = o;
            if (tid < 128) { nreg = decay * nreg + usc * nuc; *(LAS unsigned short*)(lds + MB_CB + (S ^ 1) * MB_CBSZ + 32 * ML_QS + tid * 2) = (unsigned short)f2bf(nreg); }
            if (c + 1 < nch) { *(LAS u32x4*)(lds + MB_Q + (S ^ 1) * MB_QSZ + (tid >> 4) * ML_QS + (tid & 15) * 16) = q0_[S ^ 1]; *(LAS u32x4*)(lds + MB_Q + (S ^ 1) * MB_QSZ + (32 + (tid >> 4)) * ML_QS + (tid & 15) * 16) = q1_[S ^ 1]; }
        }
        m_run = m_new;
        LDS_BARRIER();
        if (c + 2 < nch) MB_LOAD(S, c + 2);
        if (c + 3 < nch) MB_LOADQ(S ^ 1, c + 3);
        }
    }
#undef MB_LOAD
#undef MB_LOADQ
    { float* Co = A.out + (prompt ? O_MCP : O_MCS) + ((size_t)(b * 4 + h) * 256 + sl * 32 + cdv) * 128 + cdk;
        *(f32x4*)Co = (f32x4){C[0], C[1], C[2], C[3]}; *(f32x4*)(Co + 4) = (f32x4){C[4], C[5], C[6], C[7]};
        if (sl == 0) { if (tid < 128) (A.out + (prompt ? O_MNP : O_MNS))[(size_t)(b * 4 + h) * 128 + tid] = nreg; if (tid == 0) (A.out + (prompt ? O_MMP : O_MMS))[b * 4 + h] = m_run; } }
    __syncthreads();
}

__device__ __forceinline__ void p9_gate(const Args& A, int gw, int NGW, int lane) {
    unsigned char* ws = A.ws; bf16* MH = (bf16*)(ws + WS_MH); const bf16* MO = (const bf16*)(ws + WS_MO); const float* HSSQ = (const float*)(ws + WS_HSSQ);
    const int hd = lane >> 4;
    for (int row0 = gw; row0 < MTOT; row0 += 4 * NGW) {
        f32x4 p[4][4]; u32x4 hv[4][2], ov[4][2];
#pragma unroll
        for (int u = 0; u < 4; ++u) { const int row = row0 + u * NGW < MTOT ? row0 + u * NGW : row0; const float* pp = HSSQ + ((size_t)row * 4 + hd) * 16;
#pragma unroll
            for (int i = 0; i < 4; ++i) p[u][i] = *(const f32x4*)(pp + 4 * i);
#pragma unroll
            for (int i = 0; i < 2; ++i) { const size_t off = (size_t)row * DM + lane * 16 + i * 8; hv[u][i] = *(const u32x4*)(MH + off); ov[u][i] = *(const u32x4*)(MO + off); } }
#pragma unroll
        for (int u = 0; u < 4; ++u) { const int row = row0 + u * NGW; if (row >= MTOT) break;
            float s = 0.f;
#pragma unroll
            for (int i = 0; i < 4; ++i) s += (p[u][i][0] + p[u][i][1]) + (p[u][i][2] + p[u][i][3]);
            const float rs = __builtin_amdgcn_rsqf(s * (1.0f / 256.0f) + EPSN);
#pragma unroll
            for (int i = 0; i < 2; ++i) { const size_t off = (size_t)row * DM + lane * 16 + i * 8; u32x4 o;
#pragma unroll
                for (int e2 = 0; e2 < 4; ++e2) { const float a = bf2f((unsigned short)(hv[u][i][e2] & 0xffffu)) * rs * bf2f((unsigned short)(ov[u][i][e2] & 0xffffu)), c = bf2f((unsigned short)(hv[u][i][e2] >> 16)) * rs * bf2f((unsigned short)(ov[u][i][e2] >> 16)); o[e2] = pk2(a, c); }
                *(u32x4*)(MH + off) = o; } }
    }
}

__device__ __forceinline__ void p13_final(const Args& A, int gw, int NGW, int lane) {
    unsigned char* ws = A.ws; const float* X = (const float*)(ws + WS_X); const float* ssq = (const float*)(ws + WS_SSQ); const float* g = A.in[23];
    f32x4 gg[4];
#pragma unroll
    for (int j = 0; j < 4; ++j) gg[j] = *(const f32x4*)(g + 256 * j + 4 * lane);
    for (int row0 = gw; row0 < MTOT; row0 += 4 * NGW) {
        f32x4 v[4][4]; float sq[4];
#pragma unroll
        for (int u = 0; u < 4; ++u) { const int row = row0 + u * NGW < MTOT ? row0 + u * NGW : row0; sq[u] = lane < 16 ? ssq[(size_t)row * 16 + lane] : 0.f;
#pragma unroll
            for (int j = 0; j < 4; ++j) v[u][j] = *(const f32x4*)(X + (size_t)row * DM + 256 * j + 4 * lane); }
#pragma unroll
        for (int u = 0; u < 4; ++u) { const int row = row0 + u * NGW; if (row >= MTOT) break;
            float* dst;
            if (row < MP) { const int b = row / TP, t = row - b * TP; if (t < NMETA) continue; dst = A.out + O_YP + ((size_t)b * SEQL + (t - NMETA)) * DM; }
            else dst = A.out + O_YS + (size_t)(row - MP) * DM;
            const float rs = __builtin_amdgcn_rsqf(wave_sum(sq[u]) * (1.0f / 1024.0f) + EPSN);
#pragma unroll
            for (int j = 0; j < 4; ++j) *(f32x4*)(dst + 256 * j + 4 * lane) = v[u][j] * rs * gg[j]; }
    }
}

__device__ __forceinline__ void tail_finish(const float* P, unsigned* cnt, const pg8::StaticOrder& base, int first, int ntail, int slices, int c, float* X, bf16* XB, float* ssq, lptr lds, int tid) {
    const int tu = c / slices; if (tu >= ntail) return;
    asm volatile("s_waitcnt vmcnt(0)" ::: "memory"); __syncthreads();
    if (tid == 0) { __builtin_amdgcn_fence(__ATOMIC_RELEASE, "agent"); asm volatile("s_waitcnt vmcnt(0)" ::: "memory");
        (void)__hip_atomic_fetch_add(cnt + tu, 1u, __ATOMIC_RELAXED, __HIP_MEMORY_SCOPE_AGENT);
        while (__hip_atomic_load(cnt + tu, __ATOMIC_RELAXED, __HIP_MEMORY_SCOPE_AGENT) < (unsigned)slices) __builtin_amdgcn_s_sleep(2); }
    __syncthreads();
    __builtin_amdgcn_fence(__ATOMIC_ACQUIRE, "agent"); asm volatile("s_waitcnt vmcnt(0)" ::: "memory");
    pg8::Unit u; base.map(first + tu, u);
    const int nrow = 256 / slices, rbase = (c % slices) * nrow;
    const int cc = tid & 31, r0 = tid >> 5;
    const float* p0 = P + (size_t)(tu * slices) * 65536 + cc * 8;
#pragma unroll 2
    for (int rr = 0; rr < nrow; rr += 16) { const int row = rbase + rr + r0;
        const size_t xoff = (size_t)(u.pm * 256 + row) * DM + u.pn * 256 + cc * 8;
        f32x4 a = *(const f32x4*)(X + xoff), b = *(const f32x4*)(X + xoff + 4);
        for (int s = 0; s < slices; ++s) { a = a + *(const f32x4*)(p0 + (size_t)s * 65536 + row * 256); b = b + *(const f32x4*)(p0 + (size_t)s * 65536 + row * 256 + 4); }
        *(f32x4*)(X + xoff) = a; *(f32x4*)(X + xoff + 4) = b; *(u32x4*)(XB + xoff) = pg8::pack8(a, b);
        float q = (a[0] * a[0] + a[1] * a[1]) + (a[2] * a[2] + a[3] * a[3]) + (b[0] * b[0] + b[1] * b[1]) + (b[2] * b[2] + b[3] * b[3]);
        q += __shfl_xor(q, 1); q += __shfl_xor(q, 2); q += __shfl_xor(q, 4);
        if ((cc & 7) == 0) ssq[(size_t)(u.pm * 256 + row) * 16 + u.pn * 4 + (cc >> 3)] = q; }
}

#define XB_TMO      128
#define XB_XCNT(j)  (256  + 64 * (j))
#define XB_XSUB(j)  (1280 + 64 * (j))
#define XB_XGEN(j)  (2304 + 64 * (j))
#define XB_TOP      3328
#define XB_TOPGEN   3392
#define XCD_BAR_WORDS 3456
#define XB_SPIN_CAP (1u << 18)

__device__ __forceinline__ unsigned xb_ld(unsigned* p)              { return __hip_atomic_load(p, __ATOMIC_RELAXED, __HIP_MEMORY_SCOPE_AGENT); }
__device__ __forceinline__ unsigned xb_add(unsigned* p, unsigned v) { return __hip_atomic_fetch_add(p, v, __ATOMIC_RELAXED, __HIP_MEMORY_SCOPE_AGENT); }
__device__ __forceinline__ unsigned xb_xcc_id() { return (unsigned)__builtin_amdgcn_s_getreg((3 << 11) | 20) & 0xFu; }
#define XB_SPIN(cond, bar) do { unsigned _sp = 0; while (cond) { __builtin_amdgcn_s_sleep(1); \
    if ((++_sp & 255u) == 0u) { if (xb_ld(&(bar)[XB_TMO])) break; if (_sp > XB_SPIN_CAP) { atomicAdd(&(bar)[XB_TMO], 1u); break; } } } } while (0)

struct XcdBarrier {
    unsigned* bar; unsigned x;
    volatile LAS unsigned* st;
};

__device__ __forceinline__ XcdBarrier xcd_barrier_post(unsigned* bar, volatile LAS unsigned* st) {
    XcdBarrier b; b.bar = bar; b.x = xb_xcc_id(); b.st = st;
    if (threadIdx.x == 0) (void)xb_add(&bar[XB_XCNT(b.x)], 1u);
    return b;
}
__device__ __forceinline__ void xcd_barrier_complete(unsigned* bar, unsigned x, unsigned& nloc, unsigned& nx) {
    const unsigned G = gridDim.x * gridDim.y * gridDim.z;
    unsigned sum, cnt, mine, sp = 0u;
    for (;;) {
        sum = 0u; cnt = 0u; mine = 0u;
#pragma unroll
        for (unsigned j = 0; j < 16; ++j) { const unsigned c = xb_ld(&bar[XB_XCNT(j)]); sum += c; cnt += (c > 0u) ? 1u : 0u; mine = (j == x) ? c : mine; }
        if (sum == G) break;
        __builtin_amdgcn_s_sleep(1);
        if ((++sp & 255u) == 0u) { if (xb_ld(&bar[XB_TMO])) break; if (sp > XB_SPIN_CAP) { atomicAdd(&bar[XB_TMO], 1u); break; } }
    }
    nloc = mine > 0u ? mine : 1u; nx = cnt > 0u ? cnt : 1u;
}

__device__ __forceinline__ void xcd_barrier(const XcdBarrier& b) {
    asm volatile("s_waitcnt vmcnt(0)" ::: "memory");
    __syncthreads();
    if (threadIdx.x == 0) {
        unsigned* bar = b.bar;
        __builtin_amdgcn_s_waitcnt(0);
        unsigned nloc = b.st[0], nx = b.st[1];
        if (nloc == 0u) { xcd_barrier_complete(bar, b.x, nloc, nx); b.st[0] = nloc; b.st[1] = nx; }
        const unsigned old = xb_add(&bar[XB_XSUB(b.x)], 1u);
        const unsigned gen = old / nloc;
        if (old + 1u == (gen + 1u) * nloc) {
            __builtin_amdgcn_fence(__ATOMIC_RELEASE, "agent");
            asm volatile("s_waitcnt vmcnt(0)" ::: "memory");
            const unsigned og = xb_add(&bar[XB_TOP], 1u);
            const unsigned tg = og / nx;
            if (og + 1u == (tg + 1u) * nx) xb_add(&bar[XB_TOPGEN], 1u);
            else XB_SPIN(xb_ld(&bar[XB_TOPGEN]) == tg, bar);
            __builtin_amdgcn_fence(__ATOMIC_ACQUIRE, "agent");
            xb_add(&bar[XB_XGEN(b.x)], 1u);
            asm volatile("s_waitcnt vmcnt(0)" ::: "memory");
        } else {
            XB_SPIN(xb_ld(&bar[XB_XGEN(b.x)]) == gen, bar);
            __builtin_amdgcn_fence(__ATOMIC_ACQUIRE, "agent");
            asm volatile("s_waitcnt vmcnt(0)" ::: "memory");
        }
    }
    __syncthreads();
}

__global__ void __launch_bounds__(NTHR, 2) fwd_megakernel(Args args) {
    extern __shared__ __attribute__((aligned(16))) unsigned char lds_raw[];
    cg::grid_group grid = cg::this_grid();
    { LAS unsigned* misc_ = (LAS unsigned*)(lds_raw) ; (void)misc_; }
#define GRID_SYNC() do { asm volatile("s_waitcnt vmcnt(0) lgkmcnt(0)" ::: "memory"); __syncthreads(); \
        if (threadIdx.x == 0) { __builtin_amdgcn_fence(__ATOMIC_RELEASE, "agent"); asm volatile("s_waitcnt vmcnt(0)" ::: "memory"); } \
        GSYNC(); \
        __builtin_amdgcn_fence(__ATOMIC_ACQUIRE, "agent"); asm volatile("s_waitcnt vmcnt(0)" ::: "memory"); __syncthreads(); } while (0)
    const lptr lds = (lptr)lds_raw;
    const int G = gridDim.x, bx = blockIdx.x, NGW = G * NWAVES;
#define TIDS int tid = threadIdx.x; asm volatile("" : "+v"(tid)); const int lane = tid & 63, w = __builtin_amdgcn_readfirstlane(tid >> 6), gw = bx * NWAVES + w; (void)gw; (void)lane
    unsigned char* ws = args.ws;
    bf16* XB = (bf16*)(ws + WS_XB); float* X = (float*)(ws + WS_X); float* ssq = (float*)(ws + WS_SSQ);
    volatile LAS unsigned* xb_st = (volatile LAS unsigned*)(lds + LDS_BYTES - 256);
    if (threadIdx.x < 2) xb_st[threadIdx.x] = 0u;
    __syncthreads();
    const XcdBarrier xbar = xcd_barrier_post((unsigned*)(ws + WS_CTL) + 4096, xb_st);
#ifndef USE_CG_SYNC
#define GSYNC() xcd_barrier(xbar)
#else
#define GSYNC() grid.sync()
#endif

#ifndef SKIP_P0
    { TIDS; p0_prologue(args, lds, gw, NGW, w, lane); }
#endif
#ifdef PROBE_P0
    { TIDS; p0_prologue(args, lds, gw, NGW, w, lane); }
#endif
    grid.sync();
    xcd_barrier(xbar);
#ifdef PROBE_P1
    { pg8::Gemm g{XB, (const bf16*)(ws + WS_WFIN), MPAD, NIN, DM}; pg8::StaticOrder S; S.init(MPAD, NIN, G, bx); pg8::EpiFoxIn E{ssq, args.in[13], args.in[14], args.in[12], ws, args.out};
      pg8::gemm_phase<pg8::EpiFoxIn, pg8::StaticOrder, PG8_ALIGN, PG8_SP2>(lds, g, S, E); }
    GSYNC();
#endif
#ifndef SKIP_P1
    {
        pg8::Gemm g{XB, (const bf16*)(ws + WS_WFIN), MPAD, NIN, DM}; pg8::StaticOrder S; S.init(MPAD, NIN, G, bx);
        pg8::EpiFoxIn E{ssq, args.in[13], args.in[14], args.in[12], ws, args.out};
        pg8::gemm_phase<pg8::EpiFoxIn, pg8::StaticOrder, PG8_ALIGN, PG8_SP2>(lds, g, S, E);
    }
#endif
    GSYNC();
#ifndef SKIP_P2
    { TIDS; p2_cumsum(args, gw, NGW, lane); }
#endif
    GSYNC();
#ifndef SKIP_P3
    { TIDS; p3_attention(args, lds, tid, w, lane, 0); }
#ifdef PROBE_P3
    GSYNC();
    { TIDS; p3_attention(args, lds, tid, w, lane, 1); }
#endif
#endif
    GSYNC();
#define RESID_GEMM(Ap, Wp, KK, CNTI) do { \
    pg8::StaticOrder S; S.init(MPAD, DM, G, bx); const int full_ = (S.nwg / G) * G, ntail_ = S.nwg - full_; S.lim = full_; \
    { pg8::Gemm g{(Ap), (Wp), MPAD, DM, (KK), (KK)}; pg8::EpiResid E{X, XB, ssq}; pg8::gemm_phase<pg8::EpiResid, pg8::StaticOrder, PG8_ALIGN, PG8_SP2>(lds, g, S, E); } \
    if (ntail_ > 0) { const int sl_ = ntail_ * 8 <= G ? 8 : (ntail_ * 4 <= G ? 4 : (ntail_ * 2 <= G ? 2 : 1)); const int ks_ = (KK) / sl_; \
        pg8::TailOrder T{S, full_, ntail_, sl_, bx}; pg8::Gemm g{(Ap) + (bx % sl_) * ks_, (Wp) + (bx % sl_) * ks_, MPAD, DM, ks_, (KK)}; pg8::EpiPartial E{(float*)(ws + WS_P)}; \
        pg8::gemm_phase<pg8::EpiPartial, pg8::TailOrder, false, PG8_SP2>(lds, g, T, E); \
        { int tid_ = threadIdx.x; asm volatile("" : "+v"(tid_)); tail_finish((const float*)(ws + WS_P), (unsigned*)(ws + WS_CTL) + 256 + (CNTI), S, full_, ntail_, sl_, bx, X, XB, ssq, lds, tid_); } } } while (0)
#ifdef PROBE_UP
#define PROBE_UP_BODY(WUP) { pg8::Gemm g{XB, (const bf16*)(ws + (WUP)), MPAD, DFF, DM}; pg8::StaticOrder S; S.init(MPAD, DFF, G, bx); pg8::EpiUp E{ssq, (bf16*)(ws + WS_H)}; \
      pg8::gemm_phase<pg8::EpiUp, pg8::StaticOrder, PG8_ALIGN, PG8_SP2>(lds, g, S, E); } GSYNC();
#else
#define PROBE_UP_BODY(WUP)
#endif
#define LAYER_TAIL(AOP, WOUT, WUP, WDN, CNT0) do { \
    RESID_GEMM((const bf16*)(AOP), (const bf16*)(ws + (WOUT)), DM, CNT0); \
    GSYNC(); \
    { pg8::Gemm g{XB, (const bf16*)(ws + (WUP)), MPAD, DFF, DM}; pg8::StaticOrder S; S.init(MPAD, DFF, G, bx); pg8::EpiUp E{ssq, (bf16*)(ws + WS_H)}; \
      pg8::gemm_phase<pg8::EpiUp, pg8::StaticOrder, PG8_ALIGN, PG8_SP2>(lds, g, S, E); } \
    GSYNC(); \
    PROBE_UP_BODY(WUP) \
    RESID_GEMM((const bf16*)(ws + WS_H), (const bf16*)(ws + (WDN)), DFF, CNT0 + 32); \
    GSYNC(); } while (0)
#ifndef SKIP_L0
    LAYER_TAIL(ws + WS_OB, WS_WFOUT, WS_WUP0, WS_WDN0, 0);
#endif
#ifndef SKIP_P7
    {
        pg8::Gemm g{XB, (const bf16*)(ws + WS_WMIN), MPAD, NIN, DM}; pg8::StaticOrder S; S.init(MPAD, NIN, G, bx);
        pg8::EpiMlstmIn E{ssq, args.in[17], args.in[18], (bf16*)(ws + WS_MQ), (bf16*)(ws + WS_MK), (bf16*)(ws + WS_MV), (bf16*)(ws + WS_MO), (float*)(ws + WS_GI), (float*)(ws + WS_GF)};
        pg8::gemm_phase<pg8::EpiMlstmIn, pg8::StaticOrder, PG8_ALIGN, PG8_SP2>(lds, g, S, E);
    }
#endif
    GSYNC();
#ifndef SKIP_P8
    { TIDS; for (int u = bx; u < NUA; u += G) mlstm_a_unit(args, u, lds, tid, w, lane); }
    GSYNC();
#ifdef PROBE_MA
    { TIDS; for (int u = bx; u < NUA; u += G) mlstm_a_unit(args, u, lds, tid, w, lane); }
    GSYNC();
#endif
    { TIDS; for (int it = bx; it < 256 + 1024; it += G) mlstm_b_item(args, it, lds, tid, w, lane); }
#ifdef PROBE_MAB
    GSYNC();
    { TIDS; for (int u = bx; u < NUA; u += G) mlstm_a_unit(args, u, lds, tid, w, lane); }
    GSYNC();
    { TIDS; for (int it = bx; it < 256 + 1024; it += G) mlstm_b_item(args, it, lds, tid, w, lane); }
#endif
#endif
    GSYNC();
#ifndef SKIP_P9
    { TIDS; p9_gate(args, gw, NGW, lane); }
#endif
    GSYNC();
#ifndef SKIP_L1
    LAYER_TAIL(ws + WS_MH, WS_WMOUT, WS_WUP1, WS_WDN1, 64);
#endif
#ifndef SKIP_P13
    { TIDS; p13_final(args, gw, NGW, lane); }
#ifdef PROBE_SYNC
    for (int i_ = 0; i_ < 16; ++i_) grid.sync();
#endif
#endif
}

extern "C" void kernel_launch(void* const* d_in, const int* in_sizes, int n_in, void* d_out, int out_size, void* d_ws, size_t ws_size, hipStream_t stream) {
    static int grid = 0;
    if (grid == 0) {
        if (n_in != 24 || (size_t)out_size != O_END || ws_size < WS_END) { fprintf(stderr, "kernel_launch: unexpected shapes: n_in %d out %d (want %zu) ws %zu (want >= %zu)\n", n_in, out_size, (size_t)O_END, ws_size, (size_t)WS_END); grid = -1; return; }
        int dev = 0, cus = 0, per_cu = 0;
        if (hipGetDevice(&dev) != hipSuccess || hipDeviceGetAttribute(&cus, hipDeviceAttributeMultiprocessorCount, dev) != hipSuccess) { grid = -1; return; }
        if (hipFuncSetAttribute((const void*)fwd_megakernel, hipFuncAttributeMaxDynamicSharedMemorySize, LDS_BYTES) != hipSuccess) { fprintf(stderr, "kernel_launch: hipFuncSetAttribute failed\n"); grid = -1; return; }
        if (hipOccupancyMaxActiveBlocksPerMultiprocessor(&per_cu, (const void*)fwd_megakernel, NTHR, LDS_BYTES) != hipSuccess || per_cu < 1) { fprintf(stderr, "kernel_launch: occupancy query says %d blocks per CU\n", per_cu); grid = -1; return; }
        grid = cus;
    }
    if (grid < 0) return;
    (void)hipMemsetAsync((char*)d_ws + WS_CTL, 0, 65536, stream);
    Args a{};
    for (int i = 0; i < 24; ++i) a.in[i] = (const float*)d_in[i];
    a.out = (float*)d_out; a.ws = (unsigned char*)d_ws;
    void* kargs[] = {&a};
    const hipError_t e = hipLaunchCooperativeKernel((const void*)fwd_megakernel, dim3(grid), dim3(NTHR), kargs, LDS_BYTES, stream);
    if (e != hipSuccess) fprintf(stderr, "kernel_launch: cooperative launch failed: %s (grid %d)\n", hipGetErrorString(e), grid);
}
```

```cpp
#include <hip/hip_runtime.h>
#include <hip/hip_cooperative_groups.h>
#include <cstdio>
#include <cstdint>
namespace cg = cooperative_groups;

constexpr int DM = 1024, TP = 4112, NB = 8, SEQL = 4096, NMETA = 16, DB = 32, DT = 32, PAST = 2048, DFF = 4096;
constexpr int MP = NB * TP;
constexpr int MTOT = MP + DB * DT;
constexpr int MPAD = 34048;
constexpr int NIN = 3328;
constexpr int PPAD = 240;
constexpr int PLEN = 4352;
constexpr int GSLEN = 2112;
constexpr float EPSN = 1e-6f;
constexpr float LOG2E = 1.4426950408889634f;
constexpr float QSCALE = 0.125f * LOG2E;

constexpr int NWAVES = 8, NTHR = 512;
constexpr int LDS_BYTES = 147456;
constexpr size_t MiB = 1u << 20;
constexpr size_t WS_CTL = 0;
constexpr size_t WS_WFIN = 1 * MiB, WS_WFOUT = 8 * MiB, WS_WMIN = 10 * MiB, WS_WMOUT = 17 * MiB, WS_WUP0 = 19 * MiB, WS_WUP1 = 27 * MiB, WS_WDN0 = 35 * MiB, WS_WDN1 = 43 * MiB;
constexpr size_t WS_SSQ = 51 * MiB, WS_G = 54 * MiB, WS_GS = 57 * MiB, WS_GI = 62 * MiB, WS_GF = 63 * MiB, WS_HSSQ = 64 * MiB;
constexpr size_t WS_X = 74 * MiB, WS_XB = 207 * MiB;
constexpr size_t WS_QB = 274 * MiB, WS_KB = 343 * MiB, WS_VB = 411 * MiB, WS_OB = 478 * MiB, WS_H = 274 * MiB;
constexpr size_t WS_MQ = 546 * MiB, WS_MK = 580 * MiB, WS_MV = 614 * MiB, WS_MO = 682 * MiB, WS_MH = 750 * MiB, WS_U = 818 * MiB, WS_RS = 958 * MiB, WS_NU = 959 * MiB, WS_P = 961 * MiB, WS_BBC = 1001 * MiB, WS_PMC = 1002 * MiB, WS_END = 1003 * MiB;
static_assert(WS_H + (size_t)MPAD * DFF * 2 <= WS_MQ && WS_OB + (size_t)MPAD * DM * 2 <= WS_MQ && WS_VB + (size_t)MPAD * DM * 2 <= WS_OB && WS_KB + (size_t)MPAD * DM * 2 <= WS_VB - MiB && WS_QB + (size_t)MPAD * DM * 2 <= WS_KB - MiB, "ws map");
static_assert(WS_G + (size_t)NB * 16 * PLEN * 4 <= WS_GS && WS_GS + (size_t)DB * 16 * GSLEN * 4 <= WS_GI && WS_HSSQ + (size_t)MPAD * 64 * 4 <= WS_X && WS_SSQ + (size_t)MPAD * 64 <= WS_G, "ws map 2");

struct Args { const float* in[24]; float* out; unsigned char* ws; };

constexpr size_t O_YP = 0, O_YS = O_YP + (size_t)NB * SEQL * DM, O_FKP = O_YS + (size_t)DB * DT * DM, O_FVP = O_FKP + (size_t)MP * DM, O_FLP = O_FVP + (size_t)MP * DM,
    O_MCP = O_FLP + (size_t)MP * 16, O_MNP = O_MCP + (size_t)NB * 4 * 256 * 128, O_MMP = O_MNP + (size_t)NB * 4 * 128, O_FKS = O_MMP + (size_t)NB * 4,
    O_FVS = O_FKS + (size_t)DB * DT * DM, O_FLS = O_FVS + (size_t)DB * DT * DM, O_MCS = O_FLS + (size_t)DB * DT * 16, O_MNS = O_MCS + (size_t)DB * 4 * 256 * 128,
    O_MMS = O_MNS + (size_t)DB * 4 * 128, O_END = O_MMS + (size_t)DB * 4;

namespace pg8 {
#define PG8_LAS __attribute__((address_space(3)))
typedef unsigned short bf16_t;
typedef short bf16x8 __attribute__((ext_vector_type(8)));
typedef float f32x4 __attribute__((ext_vector_type(4)));
typedef unsigned u32x4 __attribute__((ext_vector_type(4)));
constexpr int BM = 256, BK = 64, HALF = 128, HTB = HALF * BK * 2  , STAGE_BYTES = 8 * HTB, NXCD = 8, WGM = 8;

__host__ __device__ __forceinline__ int lds_byte(int r, int c) { const int st = (r >> 4) * 2 + (c >> 5), rr = r & 15, cc = c & 31, ob = rr * 64 + cc * 2; return st * 1024 + (ob ^ (((ob >> 9) & 1) << 5)); }
__host__ __device__ __forceinline__ void stage_rc(int b, int& R, int& C) { const int st = b / 1024, sb = b % 1024, swz = sb ^ (((sb >> 9) & 1) << 5); R = (st >> 1) * 16 + swz / 64; C = (st & 1) * 32 + (swz % 64) / 2; }
__host__ __device__ __forceinline__ int perm32(int rho) { const int n = rho >> 4, i = rho & 15; return 8 * (i >> 2) + 4 * n + (i & 3); }

struct Unit { int pm, pn, aux; };
struct Gemm { const bf16_t* A; const bf16_t* Bt; int M, N, K, ld; };

struct StaticOrder {
    int nM, nN, nwg, G, c, lim;
    __host__ __device__ void init(int M, int N, int G_, int c_) { nM = M / BM; nN = N / BM; nwg = nM * nN; G = G_; c = c_; lim = nwg; }
    __host__ __device__ bool next(int i, Unit& u) const { const long L = (long)i * G + c; if (L >= lim) return false; map((int)L, u); return true; }
    __host__ __device__ void map(int L, Unit& u) const {
        int wgid = L; { const int q = nwg / NXCD, r = nwg % NXCD, xcd = wgid % NXCD, off = wgid / NXCD; wgid = (xcd < r ? xcd * (q + 1) : r * (q + 1) + (xcd - r) * q) + off; }
        const int nig = WGM * nN, gid = wgid / nig, fm = gid * WGM, gsz = (nM - fm) < WGM ? (nM - fm) : WGM;
        u.pm = fm + ((wgid % nig) % gsz); u.pn = (wgid % nig) / gsz;
    }
    __device__ __forceinline__ void a_ready(const Unit&) const {}
    __device__ __forceinline__ void done(const Unit&) const {}
};


struct TailOrder {
    StaticOrder base; int first, ntail, slices, c;
    __device__ bool next(int i, Unit& u) const { if (i > 0) return false; const int tu = c / slices; if (tu >= ntail) return false; base.map(first + tu, u); u.aux = c; return true; }
    __device__ __forceinline__ void a_ready(const Unit&) const {}
    __device__ __forceinline__ void done(const Unit&) const {}
};

typedef float f32x2_cv __attribute__((ext_vector_type(2))); typedef __bf16 bf16x2_cv __attribute__((ext_vector_type(2)));
__device__ __forceinline__ unsigned cvt_pk_bf16(float lo, float hi) { const f32x2_cv v = {lo, hi}; const bf16x2_cv b = __builtin_convertvector(v, bf16x2_cv); return __builtin_bit_cast(unsigned, b); }
__device__ __forceinline__ u32x4 pack8(const f32x4 a, const f32x4 b) { u32x4 w; w.x = cvt_pk_bf16(a[0], a[1]); w.y = cvt_pk_bf16(a[2], a[3]); w.z = cvt_pk_bf16(b[0], b[1]); w.w = cvt_pk_bf16(b[2], b[3]); return w; }
__device__ __forceinline__ float row_rstd(const float* ssq, int row, int fq) {
    const f32x4 v = *(const f32x4*)(ssq + (size_t)row * 16 + 4 * fq);
    float s = (v[0] + v[1]) + (v[2] + v[3]);
    s += __shfl_xor(s, 16); s += __shfl_xor(s, 32);
    return __builtin_amdgcn_rsqf(s * (1.0f / 1024.0f) + EPSN);
}
__device__ __forceinline__ float log_sigmoid_f(float x) { return fminf(x, 0.f) - log1pf(__expf(-fabsf(x))); }

struct EpiFoxIn {
    static constexpr bool PERM = true, AFTER_DRAIN = false;
    const float* ssq; const float* gq; const float* gk; const float* bfv;
    unsigned char* ws; float* out;
    __device__ __forceinline__ void operator()(const f32x4 (&acc)[2][2][4][2], const Unit& u, int wr, int wc, int fr, int fq) const {
        const int pn = u.pn, sect = pn >> 2;
        f32x4 gv[2][2];
        if (sect < 2) {
#pragma unroll
            for (int bj = 0; bj < 2; ++bj)
#pragma unroll
                for (int n = 0; n < 2; ++n) { const f32x4 a = *(const f32x4*)(gq + 32 * bj + 8 * fq + 4 * n) * QSCALE, b = *(const f32x4*)(gk + 32 * bj + 8 * fq + 4 * n); gv[bj][n] = sect == 0 ? a : b; } }
        const int cb = (pn & 3) * 256 + wc * 64 + 8 * fq;
        float rsv[2][4];
#pragma unroll
        for (int ai = 0; ai < 2; ++ai)
#pragma unroll
            for (int m = 0; m < 4; ++m) rsv[ai][m] = row_rstd(ssq, u.pm * BM + ai * HALF + wr * 64 + m * 16 + fr, fq);
#pragma unroll
        for (int ai = 0; ai < 2; ++ai)
#pragma unroll
            for (int m = 0; m < 4; ++m) {
                const int row = u.pm * BM + ai * HALF + wr * 64 + m * 16 + fr;
                const float rs = rsv[ai][m];
                f32x4 v[2][2];
#pragma unroll
                for (int bj = 0; bj < 2; ++bj)
#pragma unroll
                    for (int n = 0; n < 2; ++n) v[bj][n] = acc[ai][bj][m][n] * rs;
                if (sect < 2) {
                    float ss = 0.f;
#pragma unroll
                    for (int bj = 0; bj < 2; ++bj)
#pragma unroll
                        for (int n = 0; n < 2; ++n) { const f32x4 x = v[bj][n]; ss += (x[0] * x[0] + x[1] * x[1]) + (x[2] * x[2] + x[3] * x[3]); }
                    ss += __shfl_xor(ss, 16); ss += __shfl_xor(ss, 32);
                    const float hr = __builtin_amdgcn_rsqf(ss * (1.0f / 64.0f) + EPSN);
#pragma unroll
                    for (int bj = 0; bj < 2; ++bj)
#pragma unroll
                        for (int n = 0; n < 2; ++n) v[bj][n] = v[bj][n] * hr * gv[bj][n];
                }
                const bool real = row < MTOT; const int grp = row < MP ? 0 : 1; const size_t orow = grp == 0 ? (size_t)row : (size_t)(row - MP);
                if (sect == 0) {
#pragma unroll
                    for (int bj = 0; bj < 2; ++bj) *(u32x4*)((bf16_t*)(ws + WS_QB) + (size_t)row * DM + cb + 32 * bj) = pack8(v[bj][0], v[bj][1]);
                } else if (sect < 3) {
                    bf16_t* B16 = (bf16_t*)(ws + (sect == 1 ? WS_KB : WS_VB)); float* of = out + (sect == 1 ? (grp == 0 ? O_FKP : O_FKS) : (grp == 0 ? O_FVP : O_FVS));
#pragma unroll
                    for (int bj = 0; bj < 2; ++bj) *(u32x4*)(B16 + (size_t)row * DM + cb + 32 * bj) = pack8(v[bj][0], v[bj][1]);
                    (void)of; (void)real;
                } else if (pn == 12 && wc == 0 && fq < 2 && real) {
#pragma unroll
                    for (int n = 0; n < 2; ++n) { const int h0 = 8 * fq + 4 * n; const f32x4 bb = *(const f32x4*)(bfv + h0); f32x4 o;
#pragma unroll
                        for (int j = 0; j < 4; ++j) o[j] = log_sigmoid_f(v[0][n][j] + bb[j]);
                        *(f32x4*)(out + (grp == 0 ? O_FLP : O_FLS) + orow * 16 + h0) = o; }
                }
            }
    }
};

struct EpiResid {
    static constexpr bool PERM = true, AFTER_DRAIN = false;
    float* X; bf16_t* XB; float* ssq;
    __device__ __forceinline__ void operator()(const f32x4 (&acc)[2][2][4][2], const Unit& u, int wr, int wc, int fr, int fq) const {
#pragma unroll
        for (int ai = 0; ai < 2; ++ai)
#pragma unroll
            for (int m = 0; m < 4; ++m) {
                const int row = u.pm * BM + ai * HALF + wr * 64 + m * 16 + fr; float ss = 0.f;
#pragma unroll
                for (int bj = 0; bj < 2; ++bj) { const size_t off = (size_t)row * DM + u.pn * BM + bj * HALF + wc * 32 + 8 * fq;
                    f32x4 x0 = *(const f32x4*)(X + off), x1 = *(const f32x4*)(X + off + 4);
                    x0 = x0 + acc[ai][bj][m][0]; x1 = x1 + acc[ai][bj][m][1];
                    *(f32x4*)(X + off) = x0; *(f32x4*)(X + off + 4) = x1; *(u32x4*)(XB + off) = pack8(x0, x1);
                    ss += (x0[0] * x0[0] + x0[1] * x0[1]) + (x0[2] * x0[2] + x0[3] * x0[3]) + (x1[0] * x1[0] + x1[1] * x1[1]) + (x1[2] * x1[2] + x1[3] * x1[3]); }
                ss += __shfl_xor(ss, 16); ss += __shfl_xor(ss, 32);
                if (fq == 0) ssq[(size_t)row * 16 + u.pn * 4 + wc] = ss;
                if (m & 1) asm volatile("" ::: "memory");
            }
    }
};

struct EpiUp {
    static constexpr bool PERM = true, AFTER_DRAIN = false;
    const float* ssq; bf16_t* H;
    __device__ __forceinline__ void operator()(const f32x4 (&acc)[2][2][4][2], const Unit& u, int wr, int wc, int fr, int fq) const {
#pragma unroll
        for (int ai = 0; ai < 2; ++ai)
#pragma unroll
            for (int m = 0; m < 4; ++m) {
                const int row = u.pm * BM + ai * HALF + wr * 64 + m * 16 + fr; const float rs = row_rstd(ssq, row, fq);
#pragma unroll
                for (int bj = 0; bj < 2; ++bj) { f32x4 a = acc[ai][bj][m][0] * rs, b = acc[ai][bj][m][1] * rs;
#pragma unroll
                    for (int j = 0; j < 4; ++j) { a[j] = fmaxf(a[j], 0.f); a[j] *= a[j]; b[j] = fmaxf(b[j], 0.f); b[j] *= b[j]; }
                    *(u32x4*)(H + (size_t)row * DFF + u.pn * BM + bj * HALF + wc * 32 + 8 * fq) = pack8(a, b); }
            }
    }
};

struct EpiMlstmIn {
    static constexpr bool PERM = true, AFTER_DRAIN = false;
    const float* ssq; const float* bi; const float* bfv;
    bf16_t* MQ; bf16_t* MK; bf16_t* MV; bf16_t* MO; float* GI; float* GF;
    __device__ __forceinline__ void operator()(const f32x4 (&acc)[2][2][4][2], const Unit& u, int wr, int wc, int fr, int fq) const {
        const int pn = u.pn;
#pragma unroll
        for (int ai = 0; ai < 2; ++ai)
#pragma unroll
            for (int m = 0; m < 4; ++m) {
                const int row = u.pm * BM + ai * HALF + wr * 64 + m * 16 + fr; const float rs = row_rstd(ssq, row, fq);
                if (pn < 12) {
#pragma unroll
                    for (int bj = 0; bj < 2; ++bj) { f32x4 a = acc[ai][bj][m][0] * rs, b = acc[ai][bj][m][1] * rs; const int c = pn * BM + bj * HALF + wc * 32 + 8 * fq;
                        if (pn < 2) *(u32x4*)(MQ + (size_t)row * 512 + c) = pack8(a, b);
                        else if (pn < 4) { a = a * 0.08838834764831845f; b = b * 0.08838834764831845f; *(u32x4*)(MK + (size_t)row * 512 + (c - 512)) = pack8(a, b); }
                        else if (pn < 8) *(u32x4*)(MV + (size_t)row * DM + (c - 1024)) = pack8(a, b);
                        else {
#pragma unroll
                            for (int j = 0; j < 4; ++j) { a[j] = 1.0f / (1.0f + __expf(-a[j])); b[j] = 1.0f / (1.0f + __expf(-b[j])); }
                            *(u32x4*)(MO + (size_t)row * DM + (c - 2048)) = pack8(a, b); } }
                } else if (wc == 0 && fq == 0) {
                    const f32x4 a = acc[ai][0][m][0] * rs, b = acc[ai][0][m][1] * rs; const f32x4 vbi = *(const f32x4*)bi, vbf = *(const f32x4*)bfv; f32x4 oi, of;
#pragma unroll
                    for (int j = 0; j < 4; ++j) { oi[j] = a[j] + vbi[j]; of[j] = log_sigmoid_f(b[j] + vbf[j]); }
                    *(f32x4*)(GI + (size_t)row * 4) = oi; *(f32x4*)(GF + (size_t)row * 4) = of;
                }
            }
    }
};


struct EpiPartial {
    static constexpr bool PERM = true, AFTER_DRAIN = false;
    float* P;
    __device__ __forceinline__ void operator()(const f32x4 (&acc)[2][2][4][2], const Unit& u, int wr, int wc, int fr, int fq) const {
#pragma unroll
        for (int ai = 0; ai < 2; ++ai)
#pragma unroll
            for (int m = 0; m < 4; ++m)
#pragma unroll
                for (int bj = 0; bj < 2; ++bj) { float* p = P + (size_t)u.aux * 65536 + (size_t)(ai * HALF + wr * 64 + m * 16 + fr) * 256 + bj * HALF + wc * 32 + 8 * fq;
                    *(f32x4*)p = acc[ai][bj][m][0]; *(f32x4*)(p + 4) = acc[ai][bj][m][1]; }
    }
};
template <class Epi, class Sched, bool ALIGN_EPI = false, bool SP2 = false>
__device__ __forceinline__ void gemm_phase(PG8_LAS unsigned char* lds, const Gemm g, const Sched& S, const Epi& E) {
    int tid_o = threadIdx.x; asm volatile("" : "+v"(tid_o));
    const int tid = tid_o, wid = __builtin_amdgcn_readfirstlane(tid >> 6), lane = tid & 63, wr = wid >> 2, wc = wid & 3, fr = lane & 15, fq = lane >> 4;
    const int K = g.K, nt = K / BK, ld = g.ld ? g.ld : g.K;
    unsigned voffA[2], voffB[2];
#pragma unroll
    for (int i = 0; i < 2; ++i) { int R, C; stage_rc(tid * 16 + i * 8192, R, C); const int Rb = Epi::PERM ? ((R & ~31) + perm32(R & 31)) : R;
        voffA[i] = (unsigned)(R * ld + C) * 2u; voffB[i] = (unsigned)(Rb * ld + C) * 2u; }
    const size_t kstep = (size_t)(BK * 2);
    const size_t hstep = (size_t)HALF * ld * 2;
    const size_t tstep = 2 * hstep;
    const unsigned ldsw = (unsigned)wid * 1024u;
    const int aoff = lds_byte(wr * 64 + fr, fq * 8), boff = lds_byte(wc * 32 + fr, fq * 8);
#define PG8_SA(b, h) (((b) * 2 + (h)) * HTB)
#define PG8_SB(b, h) ((4 + (b) * 2 + (h)) * HTB)
#define PG8_STAGE(bufoff, gbase, voff) do { _Pragma("unroll") for (int _i = 0; _i < 2; ++_i) \
        __builtin_amdgcn_global_load_lds((const unsigned*)((const char*)(gbase) + (voff)[_i]), (PG8_LAS unsigned*)(lds + (bufoff) + ldsw + _i * 8192), 16, 0, 0); } while (0)
#define PG8_LDA(dst, b, h) do { _Pragma("unroll") for (int m = 0; m < 4; ++m) _Pragma("unroll") for (int k = 0; k < 2; ++k) dst[m][k] = *(const PG8_LAS bf16x8*)(lds + PG8_SA(b, h) + aoff + m * 2048 + k * 1024); } while (0)
#define PG8_LDB(dst, b, h) do { _Pragma("unroll") for (int n = 0; n < 2; ++n) _Pragma("unroll") for (int k = 0; k < 2; ++k) dst[n][k] = *(const PG8_LAS bf16x8*)(lds + PG8_SB(b, h) + boff + n * 2048 + k * 1024); } while (0)
#define PG8_MMA(ai, bj, At, Bt) do { __builtin_amdgcn_s_setprio(1); _Pragma("unroll") for (int m = 0; m < 4; ++m) _Pragma("unroll") for (int n = 0; n < 2; ++n) _Pragma("unroll") for (int k = 0; k < 2; ++k) \
        acc[ai][bj][m][n] = __builtin_amdgcn_mfma_f32_16x16x32_bf16(Bt[n][k], At[m][k], acc[ai][bj][m][n], 0, 0, 0); __builtin_amdgcn_s_setprio(0); } while (0)
#define PG8_WAIT_V(n) asm volatile("s_waitcnt vmcnt(" #n ")" ::: "memory")
#define PG8_WAIT_L(n) asm volatile("s_waitcnt lgkmcnt(" #n ")" ::: "memory")
#define PG8_BAR __builtin_amdgcn_s_barrier()
#define PG8_SCHED __builtin_amdgcn_sched_barrier(0)
    Unit cur, nxt; int ui = 0;
    if (!S.next(0, cur)) return;
    f32x4 acc[2][2][4][2];
#pragma unroll
    for (int a = 0; a < 2; ++a)
#pragma unroll
        for (int b = 0; b < 2; ++b)
#pragma unroll
            for (int m = 0; m < 4; ++m)
#pragma unroll
                for (int n = 0; n < 2; ++n) acc[a][b][m][n] = (f32x4){0.f, 0.f, 0.f, 0.f};
    bf16x8 At[4][2], B0[2][2], B1[2][2];
    const char* cA = (const char*)g.A + (size_t)cur.pm * tstep; const char* cB = (const char*)g.Bt + (size_t)cur.pn * tstep;
    S.a_ready(cur);
    if constexpr (SP2) {
        PG8_STAGE(PG8_SB(0, 0), cB, voffB); PG8_STAGE(PG8_SB(0, 1), cB + hstep, voffB); PG8_STAGE(PG8_SA(0, 0), cA, voffA); PG8_STAGE(PG8_SA(0, 1), cA + hstep, voffA);
        if (wr == 1) PG8_BAR;
        PG8_WAIT_V(2); PG8_BAR;
        PG8_STAGE(PG8_SB(1, 0), cB + kstep, voffB); PG8_STAGE(PG8_SA(1, 0), cA + kstep, voffA); PG8_STAGE(PG8_SB(1, 1), cB + hstep + kstep, voffB);
        PG8_WAIT_V(6); PG8_BAR;
    } else {
        PG8_STAGE(PG8_SB(0, 0), cB, voffB); PG8_STAGE(PG8_SA(0, 0), cA, voffA); PG8_STAGE(PG8_SB(0, 1), cB + hstep, voffB); PG8_STAGE(PG8_SA(0, 1), cA + hstep, voffA);
        if (wr == 1) PG8_BAR;
        PG8_WAIT_V(4); PG8_BAR;
        PG8_STAGE(PG8_SB(1, 0), cB + kstep, voffB); PG8_STAGE(PG8_SA(1, 0), cA + kstep, voffA); PG8_STAGE(PG8_SB(1, 1), cB + hstep + kstep, voffB);
        PG8_WAIT_V(6); PG8_BAR;
    }
    for (;;) {
        const bool has_next = S.next(ui + 1, nxt);
        const char* nA = has_next ? (const char*)g.A + (size_t)nxt.pm * tstep : cA; const char* nB = has_next ? (const char*)g.Bt + (size_t)nxt.pn * tstep : cB;
        for (int t = 0; t < nt; t += 2) {
            const bool last = (t == nt - 2);
            const char* a1 = cA + (size_t)(t + 1) * kstep;
            const char* a2 = last ? nA : cA + (size_t)(t + 2) * kstep; const char* b2 = last ? nB : cB + (size_t)(t + 2) * kstep;
            const char* a3 = a2 + kstep; const char* b3 = b2 + kstep;
            if (last && has_next) S.a_ready(nxt);
            if constexpr (SP2) {
            PG8_LDB(B0, 0, 0); PG8_LDB(B1, 0, 1); PG8_SCHED; PG8_LDA(At, 0, 0); PG8_STAGE(PG8_SA(1, 1), a1 + hstep, voffA);
            PG8_WAIT_V(8); PG8_WAIT_L(0); PG8_BAR; PG8_MMA(0, 0, At, B0); PG8_MMA(0, 1, At, B1); PG8_BAR; PG8_SCHED;
            PG8_LDA(At, 0, 1); PG8_STAGE(PG8_SB(0, 0), b2, voffB); PG8_STAGE(PG8_SB(0, 1), b2 + hstep, voffB); PG8_STAGE(PG8_SA(0, 0), a2, voffA);
            PG8_WAIT_V(8); PG8_WAIT_L(0); PG8_BAR; PG8_MMA(1, 0, At, B0); PG8_MMA(1, 1, At, B1); PG8_BAR; PG8_SCHED;
            PG8_LDB(B0, 1, 0); PG8_LDB(B1, 1, 1); PG8_SCHED; PG8_LDA(At, 1, 0); PG8_STAGE(PG8_SA(0, 1), a2 + hstep, voffA);
            PG8_WAIT_V(8); PG8_WAIT_L(0); PG8_BAR; PG8_MMA(0, 0, At, B0); PG8_MMA(0, 1, At, B1); PG8_BAR; PG8_SCHED;
            PG8_LDA(At, 1, 1); PG8_STAGE(PG8_SB(1, 0), b3, voffB); PG8_STAGE(PG8_SB(1, 1), b3 + hstep, voffB); PG8_STAGE(PG8_SA(1, 0), a3, voffA);
            PG8_WAIT_V(8); PG8_WAIT_L(0); PG8_BAR; PG8_MMA(1, 0, At, B0); PG8_MMA(1, 1, At, B1); PG8_BAR; PG8_SCHED;
            } else {
            PG8_LDB(B0, 0, 0); PG8_SCHED; PG8_LDA(At, 0, 0); PG8_STAGE(PG8_SA(1, 1), a1 + hstep, voffA);
            PG8_WAIT_L(8); PG8_BAR; PG8_WAIT_L(0); PG8_MMA(0, 0, At, B0); PG8_BAR; PG8_SCHED;
            PG8_LDB(B1, 0, 1); PG8_STAGE(PG8_SB(0, 0), b2, voffB);
            PG8_BAR; PG8_WAIT_L(0); PG8_MMA(0, 1, At, B1); PG8_BAR;
            PG8_LDA(At, 0, 1); PG8_STAGE(PG8_SA(0, 0), a2, voffA);
            PG8_BAR; PG8_WAIT_L(0); PG8_MMA(1, 0, At, B0); PG8_BAR; PG8_SCHED;
            PG8_STAGE(PG8_SB(0, 1), b2 + hstep, voffB);
            PG8_WAIT_V(6); PG8_BAR; PG8_MMA(1, 1, At, B1); PG8_BAR;
            PG8_LDB(B0, 1, 0); PG8_SCHED; PG8_LDA(At, 1, 0); PG8_STAGE(PG8_SA(0, 1), a2 + hstep, voffA);
            PG8_WAIT_L(8); PG8_BAR; PG8_WAIT_L(0); PG8_MMA(0, 0, At, B0); PG8_BAR; PG8_SCHED;
            PG8_LDB(B1, 1, 1); PG8_STAGE(PG8_SB(1, 0), b3, voffB);
            PG8_BAR; PG8_WAIT_L(0); PG8_MMA(0, 1, At, B1); PG8_BAR;
            PG8_LDA(At, 1, 1); PG8_STAGE(PG8_SA(1, 0), a3, voffA);
            PG8_BAR; PG8_WAIT_L(0); PG8_MMA(1, 0, At, B0); PG8_BAR; PG8_SCHED;
            PG8_STAGE(PG8_SB(1, 1), b3 + hstep, voffB);
            PG8_WAIT_V(6); PG8_BAR; PG8_MMA(1, 1, At, B1); PG8_BAR;
            }
        }
        if constexpr (ALIGN_EPI) { if (wr == 0) PG8_BAR; }
        if constexpr (!Epi::AFTER_DRAIN) { E(acc, cur, wr, wc, fr, fq); S.done(cur); }
        if (!has_next) break;
#pragma unroll
        for (int a = 0; a < 2; ++a)
#pragma unroll
            for (int b = 0; b < 2; ++b)
#pragma unroll
                for (int m = 0; m < 4; ++m)
#pragma unroll
                    for (int n = 0; n < 2; ++n) acc[a][b][m][n] = (f32x4){0.f, 0.f, 0.f, 0.f};
        cur = nxt; cA = nA; cB = nB; ++ui;
        if constexpr (ALIGN_EPI) { if (wr == 1) PG8_BAR; }
    }
    PG8_WAIT_V(0);
    if constexpr (!ALIGN_EPI) { if (wr == 0) PG8_BAR; }
    PG8_BAR;
    if constexpr (Epi::AFTER_DRAIN) { E.fused(acc, cur, wr, wc, fr, fq, lds, wid, lane); S.done(cur); }
#undef PG8_SA
#undef PG8_SB
#undef PG8_STAGE
#undef PG8_LDA
#undef PG8_LDB
#undef PG8_MMA
#undef PG8_WAIT_V
#undef PG8_WAIT_L
#undef PG8_BAR
#undef PG8_SCHED
}
}

#ifndef PG8_SP2
#define PG8_SP2 true
#endif
#ifndef PG8_ALIGN
#define PG8_ALIGN true
#endif

#define LAS __attribute__((address_space(3)))
typedef unsigned short bf16;
typedef unsigned u32x4 __attribute__((ext_vector_type(4)));
typedef unsigned u32x2 __attribute__((ext_vector_type(2)));
typedef float f32x4 __attribute__((ext_vector_type(4)));
typedef float f32x16 __attribute__((ext_vector_type(16)));
typedef short bf16x8 __attribute__((ext_vector_type(8)));
typedef short v4i16_t __attribute__((ext_vector_type(4)));
typedef LAS unsigned char* lptr;
typedef const LAS unsigned char* clptr;

__device__ __forceinline__ unsigned f2bf(float f) { unsigned u = __builtin_bit_cast(unsigned, f); return (u + 0x7fffu + ((u >> 16) & 1u)) >> 16; }
__device__ __forceinline__ unsigned pk2(float lo, float hi) { return pg8::cvt_pk_bf16(lo, hi); }
__device__ __forceinline__ float bf2f(unsigned short b) { return __builtin_bit_cast(float, (unsigned)b << 16); }
__device__ __forceinline__ float wave_sum(float v) {
#pragma unroll
    for (int o = 1; o < 64; o <<= 1) v += __shfl_xor(v, o);
    return v;
}
#define LDS_WAIT() asm volatile("s_waitcnt lgkmcnt(0)" ::: "memory")
#define LDS_BARRIER() asm volatile("s_waitcnt lgkmcnt(0)\n\ts_barrier" ::: "memory")

__device__ __forceinline__ void p0_transpose_item(const float* W, int K, int N, bf16* WT, const float* g, bool foxperm, LAS float* scr, int item, int nblk, int lane) {
    const int kb = item / nblk, nb = item % nblk, k0 = 64 * kb, n0 = 32 * nb;
#pragma unroll 8
    for (int i = 0; i < 32; ++i) { const int kk = 2 * i + (lane >> 5); const int n = n0 + (lane & 31); float v = n < N ? W[(size_t)(k0 + kk) * N + n] : 0.f; if (g) v *= g[k0 + kk]; scr[kk * 33 + (lane & 31)] = v; }
    LDS_WAIT(); asm volatile("" ::: "memory");
    const int c = lane & 7;
    int prow0 = n0;
    if (foxperm) { const int l = n0 & 255; prow0 = (n0 & ~255) + 128 * ((l >> 5) & 1) + 32 * ((l >> 6) & 3); }
#pragma unroll
    for (int j = 0; j < 4; ++j) { const int n = (lane >> 3) + 8 * j; const LAS float* s = scr + (8 * c) * 33 + n;
        u32x4 o; o.x = pk2(s[0 * 33], s[1 * 33]); o.y = pk2(s[2 * 33], s[3 * 33]); o.z = pk2(s[4 * 33], s[5 * 33]); o.w = pk2(s[6 * 33], s[7 * 33]);
        *(u32x4*)(WT + (size_t)(prow0 + n) * K + k0 + 8 * c) = o; }
    LDS_WAIT(); asm volatile("" ::: "memory");
}

__device__ __forceinline__ void p0_prologue(const Args& A, lptr lds, int gw, int NGW, int wave, int lane) {
    unsigned char* ws = A.ws;
    LAS float* scr = (LAS float*)(lds + wave * 16384);
    int base = 0;
#define WJOB(Wp, K_, N_, NP_, dst_, g_, perm_) do { const int nblk = (NP_) / 32, nitems = ((K_) / 64) * nblk; int first = (gw - base) % NGW; if (first < 0) first += NGW; \
        for (int it = first; it < nitems; it += NGW) p0_transpose_item((Wp), (K_), (N_), (bf16*)(ws + (dst_)), (g_), (perm_), scr, it, nblk, lane); base = (base + nitems) % NGW; } while (0)
    WJOB(A.in[11], DM, 3088, NIN, WS_WFIN, A.in[9], true);
    WJOB(A.in[15], DM, DM, DM, WS_WFOUT, (const float*)nullptr, false);
    WJOB(A.in[16], DM, 3080, NIN, WS_WMIN, A.in[9] + DM, false);
    WJOB(A.in[20], DM, DM, DM, WS_WMOUT, A.in[19], false);
    WJOB(A.in[21], DM, DFF, DFF, WS_WUP0, A.in[10], false);
    WJOB(A.in[21] + (size_t)DM * DFF, DM, DFF, DFF, WS_WUP1, A.in[10] + DM, false);
    WJOB(A.in[22], DFF, DM, DM, WS_WDN0, (const float*)nullptr, false);
    WJOB(A.in[22] + (size_t)DFF * DM, DFF, DM, DM, WS_WDN1, (const float*)nullptr, false);
#undef WJOB
    float* X = (float*)(ws + WS_X); bf16* XB = (bf16*)(ws + WS_XB); float* ssq = (float*)(ws + WS_SSQ);
    for (int row0 = gw; row0 < MPAD; row0 += 4 * NGW) {
        f32x4 v[4][4];
#pragma unroll
        for (int u = 0; u < 4; ++u) { const int row = row0 + u * NGW; const float* src = nullptr;
            if (row < MP) { const int b = row / TP, t = row - b * TP; src = t < NMETA ? A.in[8] + (size_t)t * DM : A.in[0] + ((size_t)b * SEQL + (t - NMETA)) * DM; }
            else if (row < MTOT) src = A.in[1] + (size_t)(row - MP) * DM;
#pragma unroll
            for (int j = 0; j < 4; ++j) v[u][j] = src ? *(const f32x4*)(src + 256 * j + 4 * lane) : (f32x4){0.f, 0.f, 0.f, 0.f}; }
#pragma unroll
        for (int u = 0; u < 4; ++u) { const int row = row0 + u * NGW; if (row >= MPAD) break;
            float s = 0.f;
#pragma unroll
            for (int j = 0; j < 4; ++j) { const f32x4 x = v[u][j];
                *(f32x4*)(X + (size_t)row * DM + 256 * j + 4 * lane) = x; u32x2 o; o.x = pk2(x[0], x[1]); o.y = pk2(x[2], x[3]); *(u32x2*)(XB + (size_t)row * DM + 256 * j + 4 * lane) = o;
                s += (x[0] * x[0] + x[1] * x[1]) + (x[2] * x[2] + x[3] * x[3]); }
            s = wave_sum(s);
            if (lane < 16) ssq[(size_t)row * 16 + lane] = lane == 0 ? s : 0.f; }
    }
    { const u32x4 z = {0u, 0u, 0u, 0u}; const int nchunk = PPAD * DM * 2 / 16;
        for (int i = gw * 64 + lane; i < nchunk; i += NGW * 64) { *(u32x4*)(ws + WS_KB - (size_t)PPAD * DM * 2 + (size_t)i * 16) = z; *(u32x4*)(ws + WS_VB - (size_t)PPAD * DM * 2 + (size_t)i * 16) = z; }
        const int nch2 = (MPAD - MTOT) * DM * 2 / 16;
        for (int i = gw * 64 + lane; i < nch2; i += NGW * 64) { *(u32x4*)(ws + WS_OB + (size_t)MTOT * DM * 2 + (size_t)i * 16) = z; *(u32x4*)(ws + WS_MH + (size_t)MTOT * DM * 2 + (size_t)i * 16) = z; } }
}

__device__ __forceinline__ float wave_scan_add(float v, int lane) {
#pragma unroll
    for (int o = 1; o < 64; o <<= 1) { const float t = __shfl_up(v, o); if (lane >= o) v += t; }
    return v;
}
__device__ __forceinline__ float wave_scan_max(float v, int lane) {
#pragma unroll
    for (int o = 1; o < 64; o <<= 1) { const float t = __shfl_up(v, o); if (lane >= o) v = fmaxf(v, t); }
    return v;
}
__device__ __forceinline__ void p2_cumsum(const Args& A, int gw, int NGW, int lane) {
    float* G = (float*)(A.ws + WS_G); float* GS = (float*)(A.ws + WS_GS);
    const float* lp = A.out + O_FLP; const float* lsn = A.out + O_FLS; const float* lc = A.in[4];
    for (int it = gw; it < NB * 16 + DB * 16; it += NGW) {
        if (it < NB * 16) { const int b = it >> 4, h = it & 15; float* g = G + (size_t)it * PLEN;
            for (int i = lane; i < PPAD; i += 64) g[i] = 0.f;
            float carry = 0.f;
#pragma unroll 1
            for (int c0 = 0; c0 < 65; c0 += 13) { float v[13];
#pragma unroll
                for (int c = 0; c < 13; ++c) { const int t = 64 * (c0 + c) + lane; v[c] = t < TP ? lp[((size_t)b * TP + t) * 16 + h] : 0.f; }
#pragma unroll
                for (int c = 0; c < 13; ++c) { const int t = 64 * (c0 + c) + lane; const float x = wave_scan_add(v[c], lane) + carry; if (t < TP) g[PPAD + t] = -LOG2E * x; carry = __shfl(x, 63); } }
        } else { const int i2 = it - NB * 16, b = i2 >> 4, h = i2 & 15; float* g = GS + (size_t)i2 * GSLEN;
            float carry = 0.f;
#pragma unroll 1
            for (int c0 = 0; c0 < 33; c0 += 11) { float v[11];
#pragma unroll
                for (int c = 0; c < 11; ++c) { const int s = 64 * (c0 + c) + lane; v[c] = 0.f; if (s < PAST) v[c] = lc[((size_t)b * PAST + s) * 16 + h]; else if (s < PAST + DT) v[c] = lsn[((size_t)b * DT + (s - PAST)) * 16 + h]; }
#pragma unroll
                for (int c = 0; c < 11; ++c) { const int s = 64 * (c0 + c) + lane; const float x = wave_scan_add(v[c], lane) + carry; g[s] = s < PAST + DT ? -LOG2E * x : 0.f; carry = __shfl(x, 63); } }
        }
    }
}

__device__ __forceinline__ int crow(int r, int hi) { return (r & 3) + 8 * (r >> 2) + 4 * hi; }
__device__ __forceinline__ v4i16_t vtr(clptr p) { return __builtin_amdgcn_ds_read_tr16_b64_v4i16((LAS v4i16_t*)p); }
constexpr int AT_KSTR = 144, AT_V = 9216, AT_B = 17408, AT_BUF = 17664;

template <bool MASK>
__device__ __forceinline__ void attn_tile(clptr Kt, clptr Vt, clptr Bt, const bf16x8 (&qr)[4], f32x16& o0, f32x16& o1, float& m, float& l, int qpos, int kpos0, int kmin, int lane) {
    const int r32 = lane & 31, hi = lane >> 5;
    f32x16 p0, p1;
#pragma unroll
    for (int r = 0; r < 16; ++r) { p0[r] = 0.f; p1[r] = 0.f; }
#pragma unroll
    for (int d0 = 0; d0 < 4; ++d0) {
        const bf16x8 a0 = *(const LAS bf16x8*)(Kt + r32 * AT_KSTR + d0 * 32 + hi * 16);
        const bf16x8 a1 = *(const LAS bf16x8*)(Kt + (32 + r32) * AT_KSTR + d0 * 32 + hi * 16);
        p0 = __builtin_amdgcn_mfma_f32_32x32x16_bf16(a0, qr[d0], p0, 0, 0, 0);
        p1 = __builtin_amdgcn_mfma_f32_32x32x16_bf16(a1, qr[d0], p1, 0, 0, 0);
    }
#pragma unroll
    for (int g = 0; g < 4; ++g) { const f32x4 b0 = *(const LAS f32x4*)(Bt + (8 * g + 4 * hi) * 4), b1 = *(const LAS f32x4*)(Bt + (32 + 8 * g + 4 * hi) * 4);
#pragma unroll
        for (int i = 0; i < 4; ++i) { p0[4 * g + i] += b0[i]; p1[4 * g + i] += b1[i]; } }
    if (MASK) {
#pragma unroll
        for (int r = 0; r < 16; ++r) { const int kp = kpos0 + crow(r, hi); if (kp > qpos || kp < kmin) p0[r] = -INFINITY; if (kp + 32 > qpos || kp + 32 < kmin) p1[r] = -INFINITY; }
    }
    float mx = fmaxf(p0[0], p1[0]);
#pragma unroll
    for (int r = 1; r < 16; ++r) mx = fmaxf(mx, fmaxf(p0[r], p1[r]));
    mx = fmaxf(mx, __shfl_xor(mx, 32));
    const float mnew = fmaxf(m, mx);
    if (__any(mnew > m)) {
        const float alpha = __builtin_amdgcn_exp2f(m - mnew); m = mnew; l *= alpha;
#pragma unroll
        for (int r = 0; r < 16; ++r) { o0[r] *= alpha; o1[r] *= alpha; } }
    float ls = 0.f;
#pragma unroll
    for (int r = 0; r < 16; ++r) { p0[r] = __builtin_amdgcn_exp2f(p0[r] - m); p1[r] = __builtin_amdgcn_exp2f(p1[r] - m); ls += p0[r] + p1[r]; }
    l += ls;
    u32x4 pw[4];
#pragma unroll
    for (int i = 0; i < 4; ++i) { pw[0][i] = pk2(p0[2 * i], p0[2 * i + 1]); pw[1][i] = pk2(p0[8 + 2 * i], p0[9 + 2 * i]); pw[2][i] = pk2(p1[2 * i], p1[2 * i + 1]); pw[3][i] = pk2(p1[8 + 2 * i], p1[9 + 2 * i]); }
    const clptr vb = Vt + ((lane >> 5) * 4 + ((lane & 15) >> 2)) * 64 + (((lane >> 4) & 1) * 16 + (lane & 3) * 4) * 2;
#pragma unroll
    for (int ks = 0; ks < 4; ++ks) {
        const v4i16_t l0 = vtr(vb + ks * 1024), h0 = vtr(vb + ks * 1024 + 512), l1 = vtr(vb + 4096 + ks * 1024), h1 = vtr(vb + 4096 + ks * 1024 + 512);
        const bf16x8 v0 = {l0[0], l0[1], l0[2], l0[3], h0[0], h0[1], h0[2], h0[3]}, v1 = {l1[0], l1[1], l1[2], l1[3], h1[0], h1[1], h1[2], h1[3]};
        const bf16x8 pb = __builtin_bit_cast(bf16x8, pw[ks]);
        o0 = __builtin_amdgcn_mfma_f32_32x32x16_bf16(v0, pb, o0, 0, 0, 0);
        o1 = __builtin_amdgcn_mfma_f32_32x32x16_bf16(v1, pb, o1, 0, 0, 0);
    }
}

__device__ __forceinline__ void kv_out_rows(const bf16* KB, const bf16* VB, float* outK, float* outV, size_t wsrow0, size_t outrow0, int nrows, int h, int tid) {
    const int ch = tid & 7, tsel = (tid >> 3) & 1, r0 = tid >> 4;
    const bf16* src = (tsel ? VB : KB) + h * 64 + ch * 8; float* dst = (tsel ? outV : outK) + h * 64 + ch * 8;
    asm volatile("" ::: "memory");
#pragma unroll 1
    for (int i0 = 0; i0 < 8; i0 += 4) { u32x4 v[4];
#pragma unroll
        for (int i = 0; i < 4; ++i) { const int r = r0 + 32 * (i0 + i); v[i] = r < nrows ? *(const u32x4*)(src + (wsrow0 + r) * DM) : (u32x4){0u, 0u, 0u, 0u}; }
#pragma unroll
        for (int i = 0; i < 4; ++i) { const int r = r0 + 32 * (i0 + i); if (r < nrows) { f32x4 a, b;
            a[0] = bf2f((unsigned short)(v[i].x & 0xffffu)); a[1] = bf2f((unsigned short)(v[i].x >> 16)); a[2] = bf2f((unsigned short)(v[i].y & 0xffffu)); a[3] = bf2f((unsigned short)(v[i].y >> 16));
            b[0] = bf2f((unsigned short)(v[i].z & 0xffffu)); b[1] = bf2f((unsigned short)(v[i].z >> 16)); b[2] = bf2f((unsigned short)(v[i].w & 0xffffu)); b[3] = bf2f((unsigned short)(v[i].w >> 16));
            *(f32x4*)(dst + (outrow0 + r) * DM) = a; *(f32x4*)(dst + (outrow0 + r) * DM + 4) = b; } } }
}

constexpr float AT_SKIP_T = 40.0f;
__device__ __forceinline__ void attn_prompt_unit(int b, int h, int j, const bf16* QB, const bf16* KB, const bf16* VB, const float* G, bf16* OB, lptr lds, int tid, int w, int lane, float kb, float* outK, float* outV) {
    const int r32 = lane & 31, hi = lane >> 5;
    const int qp = 256 * j + 32 * w + r32, t = qp - PPAD; const bool qvalid = t >= 0; const bool wave_active = (256 * j + 32 * w + 31) >= PPAD;
    const size_t qrow = (size_t)b * TP + (t > 0 ? t : 0);
    bf16x8 qr[4];
#pragma unroll
    for (int d0 = 0; d0 < 4; ++d0) qr[d0] = *(const bf16x8*)(QB + qrow * DM + h * 64 + d0 * 16 + hi * 8);
    const int lrow = tid >> 3, lch = tid & 7;
    const long krow0 = (long)b * TP - PPAD + lrow;
    const bf16* kg = KB + krow0 * DM + h * 64 + lch * 8; const bf16* vg = VB + krow0 * DM + h * 64 + lch * 8; const float* gg = G + (size_t)(b * 16 + h) * PLEN;
    f32x16 o0, o1;
#pragma unroll
    for (int r = 0; r < 16; ++r) { o0[r] = 0.f; o1[r] = 0.f; }
    float m = -1e30f, l = 0.f;
    const int kt1 = 4 * j + 3, ktw = 4 * j + (w >> 1), kmin = qp >= PPAD ? PPAD : 0;
    int kt0 = 3;
    { const int ta = 3 + lane, tb = 67 + lane;
        const float g0 = gg[j == 0 ? PPAD : 256 * j], ga = ta < 4 * j ? gg[64 * ta + 63] : 3.0e38f, gb = tb < 4 * j ? gg[64 * tb + 63] : 3.0e38f;
        const float thr = g0 - 2.0f * kb - AT_SKIP_T;
        const bool sa = ga <= thr, sb = gb <= thr;
        kt0 = 3 + __popcll(__ballot(sa)) + __popcll(__ballot(sb)); }
    u32x4 kreg[2][2], vreg[2][2]; float breg[2] = {0.f, 0.f};
    LAS int* vote = (LAS int*)(lds + 4 * AT_BUF);
#define AT_LOADPAIR(S, KH) do { _Pragma("unroll") for (int i_ = 0; i_ < 2; ++i_) { const int kk_ = (KH) - i_ >= kt0 ? (KH) - i_ : kt0; kreg[S][i_] = *(const u32x4*)(kg + (size_t)kk_ * 64 * DM); vreg[S][i_] = *(const u32x4*)(vg + (size_t)kk_ * 64 * DM); } \
        if (tid < 128) { const int kk_ = (KH) - (tid >> 6) >= kt0 ? (KH) - (tid >> 6) : kt0; breg[S] = gg[kk_ * 64 + (tid & 63)]; } } while (0)
#define AT_STEP(S, KH, STEPI) { const int kh_ = (KH); const lptr base = lds + (S) * 2 * AT_BUF; \
        _Pragma("unroll") for (int i = 0; i < 2; ++i) { *(LAS u32x4*)(base + i * AT_BUF + lrow * AT_KSTR + lch * 16) = kreg[S][i]; *(LAS u32x4*)(base + i * AT_BUF + AT_V + (lch >> 2) * 4096 + lrow * 64 + (lch & 3) * 16) = vreg[S][i]; } \
        if (tid < 128) *(LAS float*)(base + (tid >> 6) * AT_BUF + AT_B + (tid & 63) * 4) = breg[S]; \
        LDS_BARRIER(); \
        if ((STEPI) > 0) { const LAS int* vp_ = vote + (((STEPI) - 1) & 1) * 8; int all_ = 1; _Pragma("unroll") for (int i = 0; i < 8; ++i) all_ &= vp_[i]; if (all_) break; } \
        if (kh_ - 4 >= kt0) AT_LOADPAIR(S, kh_ - 4); \
        int done_ = wave_active ? 0 : 1; \
        _Pragma("unroll") for (int i = 0; i < 2; ++i) { const int k2 = kh_ - i; const lptr b2 = base + i * AT_BUF; \
            if (wave_active && k2 <= ktw && k2 >= kt0) { \
                if (k2 == 3 || k2 == ktw) attn_tile<true>(b2, b2 + AT_V, b2 + AT_B, qr, o0, o1, m, l, qp, 64 * k2, kmin, lane); \
                else attn_tile<false>(b2, b2 + AT_V, b2 + AT_B, qr, o0, o1, m, l, qp, 64 * k2, kmin, lane); \
                done_ = k2 > kt0 ? (__all(kb + *(const LAS float*)(b2 + AT_B) <= m - AT_SKIP_T) ? 1 : 0) : 1; } } \
        if (lane == 0) vote[((STEPI) & 1) * 8 + w] = done_; }
    AT_LOADPAIR(0, kt1);
    if (kt1 - 2 >= kt0) AT_LOADPAIR(1, kt1 - 2);
    for (int kh = kt1, si = 0; kh >= kt0; kh -= 4, si += 2) { AT_STEP(0, kh, si) if (kh - 2 >= kt0) AT_STEP(1, kh - 2, si + 1) }
#undef AT_STEP
#undef AT_LOADPAIR
    const float lt = l + __shfl_xor(l, 32), inv = 1.0f / lt;
    if (wave_active && qvalid) { bf16* op = OB + qrow * DM + h * 64 + 4 * hi;
#pragma unroll
        for (int g = 0; g < 4; ++g) { u32x2 a, c; a.x = pk2(o0[4 * g] * inv, o0[4 * g + 1] * inv); a.y = pk2(o0[4 * g + 2] * inv, o0[4 * g + 3] * inv); c.x = pk2(o1[4 * g] * inv, o1[4 * g + 1] * inv); c.y = pk2(o1[4 * g + 2] * inv, o1[4 * g + 3] * inv);
            *(u32x2*)(op + 8 * g) = a; *(u32x2*)(op + 32 + 8 * g) = c; } }
    { const int t0 = j == 0 ? 0 : 256 * j - PPAD, nr = j == 0 ? 256 - PPAD : 256;
        kv_out_rows(KB, VB, outK, outV, (size_t)b * TP + t0, (size_t)b * TP + t0, nr, h, tid); }
    __syncthreads();
}

__device__ __forceinline__ void attn_sample_unit(int b, int h, const float* cK, const float* cV, const bf16* QB, const bf16* KB, const bf16* VB, const float* GS, bf16* OB, lptr lds, int tid, int w, int lane, float kb, float* outK, float* outV) {
    const int r32 = lane & 31, hi = lane >> 5;
    const lptr base = lds + w * AT_BUF;
    const size_t qrow = (size_t)MP + b * DT + r32;
    bf16x8 qr[4];
#pragma unroll
    for (int d0 = 0; d0 < 4; ++d0) qr[d0] = *(const bf16x8*)(QB + qrow * DM + h * 64 + d0 * 16 + hi * 8);
    f32x16 o0, o1;
#pragma unroll
    for (int r = 0; r < 16; ++r) { o0[r] = 0.f; o1[r] = 0.f; }
    float m = -1e30f, l = 0.f;
    const float* gs = GS + (size_t)(b * 16 + h) * GSLEN;
    int ti0 = 0;
    { const float thr = gs[PAST] - 2.0f * kb - AT_SKIP_T; const bool sk = lane < 32 && gs[64 * lane + 63] <= thr; ti0 = __popcll(__ballot(sk)); }
#pragma unroll 1
    for (int ti = ti0 + w; ti < 33; ti += 8) {
        const float bias_l = gs[64 * ti + lane];
        if (ti < 32) {
            const float* ck0 = cK + (((size_t)b * PAST + 64 * ti + (lane >> 4)) * 16 + h) * 64 + 4 * (lane & 15); const float* cv0 = cV + (ck0 - cK);
            const lptr kw0 = base + (lane >> 4) * AT_KSTR + (lane & 15) * 8, vw0 = base + AT_V + ((lane & 15) >> 3) * 4096 + (lane >> 4) * 64 + (lane & 7) * 8;
#pragma unroll
            for (int half = 0; half < 2; ++half) {
                f32x4 kv[8], vv[8];
#pragma unroll
                for (int i = 0; i < 8; ++i) { kv[i] = *(const f32x4*)(ck0 + (half * 32 + i * 4) * 1024); vv[i] = *(const f32x4*)(cv0 + (half * 32 + i * 4) * 1024); }
#pragma unroll
                for (int i = 0; i < 8; ++i) { u32x2 a, c; a.x = pk2(kv[i][0], kv[i][1]); a.y = pk2(kv[i][2], kv[i][3]); c.x = pk2(vv[i][0], vv[i][1]); c.y = pk2(vv[i][2], vv[i][3]);
                    *(LAS u32x2*)(kw0 + (half * 32 + i * 4) * AT_KSTR) = a; *(LAS u32x2*)(vw0 + (half * 32 + i * 4) * 64) = c; }
                asm volatile("" ::: "memory");
            }
        } else {
            const size_t off0 = ((size_t)MP + b * DT + (lane >> 3)) * DM + h * 64 + (lane & 7) * 8;
            const lptr kw0 = base + (lane >> 3) * AT_KSTR + (lane & 7) * 16, vw0 = base + AT_V + ((lane & 7) >> 2) * 4096 + (lane >> 3) * 64 + (lane & 3) * 16;
#pragma unroll
            for (int i = 0; i < 8; ++i) { const u32x4 a = *(const u32x4*)(KB + off0 + (size_t)i * 8 * DM), c = *(const u32x4*)(VB + off0 + (size_t)i * 8 * DM);
                *(LAS u32x4*)(kw0 + i * 8 * AT_KSTR) = a; *(LAS u32x4*)(vw0 + i * 8 * 64) = c; }
        }
        *(LAS float*)(base + AT_B + lane * 4) = bias_l;
        LDS_WAIT();
        if (ti < 32) attn_tile<false>(base, base + AT_V, base + AT_B, qr, o0, o1, m, l, 0, 0, 0, lane);
        else attn_tile<true>(base, base + AT_V, base + AT_B, qr, o0, o1, m, l, r32, 0, 0, lane);
        asm volatile("" ::: "memory");
    }
    const float lt = l + __shfl_xor(l, 32);
    LDS_WAIT();
    LAS float* of = (LAS float*)base;
#pragma unroll
    for (int r = 0; r < 16; ++r) { of[crow(r, hi) * 32 + r32] = o0[r]; of[(32 + crow(r, hi)) * 32 + r32] = o1[r]; }
    if (hi == 0) { of[2048 + r32] = m; of[2080 + r32] = lt; }
    __syncthreads();
    { const int q = tid & 31, dg = tid >> 5; float M = -1e30f;
#pragma unroll
        for (int ww = 0; ww < 8; ++ww) M = fmaxf(M, ((LAS float*)(lds + ww * AT_BUF))[2048 + q]);
        float L = 0.f, o[4] = {0.f, 0.f, 0.f, 0.f};
#pragma unroll
        for (int ww = 0; ww < 8; ++ww) { const LAS float* p = (LAS float*)(lds + ww * AT_BUF); const float f = __builtin_amdgcn_exp2f(p[2048 + q] - M); L += f * p[2080 + q];
#pragma unroll
            for (int i = 0; i < 4; ++i) o[i] += f * p[(4 * dg + i) * 32 + q]; }
        const float inv = 1.0f / L; u32x2 a; a.x = pk2(o[0] * inv, o[1] * inv); a.y = pk2(o[2] * inv, o[3] * inv);
        *(u32x2*)(OB + ((size_t)MP + b * DT + q) * DM + h * 64 + 4 * dg) = a; }
    kv_out_rows(KB, VB, outK, outV, (size_t)MP + b * DT, (size_t)b * DT, DT, h, tid);
    __syncthreads();
}

__device__ __forceinline__ void p3_attention(const Args& A, lptr lds, int tid, int w, int lane, int rep) {
    unsigned char* ws = A.ws;
    const bf16* QB = (const bf16*)(ws + WS_QB); const bf16* KB = (const bf16*)(ws + WS_KB); const bf16* VB = (const bf16*)(ws + WS_VB); bf16* OB = (bf16*)(ws + WS_OB);
    const float* G = (const float*)(ws + WS_G); const float* GS = (const float*)(ws + WS_GS);
    unsigned* ctr = (unsigned*)(ws + WS_CTL) + 64 * rep;
    LAS unsigned* su = (LAS unsigned*)(lds + LDS_BYTES - 64);
    constexpr int NPU = 17 * NB * 16, NSU = DB * 16, NU = NPU + NSU;
    float gqm = 0.f, gkm = 0.f;
    for (int i = 0; i < 64; ++i) { gqm = fmaxf(gqm, fabsf(A.in[13][i])); gkm = fmaxf(gkm, fabsf(A.in[14][i])); }
    const float kb = 8.0f * LOG2E * gqm * gkm * 1.02f;
    for (;;) {
        if (tid == 0) *su = atomicAdd(ctr, 1u);
        __syncthreads();
        const int u = (int)*su;
        __syncthreads();
        if (u >= NU) break;
        const bool is_s = (u % 5 == 4) && (u / 5 < NSU);
        if (is_s) { const int s = u / 5; attn_sample_unit(s >> 4, s & 15, A.in[2], A.in[3], QB, KB, VB, GS, OB, lds, tid, w, lane, kb, A.out + O_FKS, A.out + O_FVS); }
        else { const int k = u / 5, pidx = u - (k < NSU ? k : NSU); const int j = 16 - pidx / (NB * 16), bh = pidx % (NB * 16); attn_prompt_unit(bh >> 4, bh & 15, j, QB, KB, VB, G, OB, lds, tid, w, lane, kb, A.out + O_FKP, A.out + O_FVP); }
    }
#ifdef PROBE_SAMPLE
    for (;;) { if (tid == 0) *su = atomicAdd(ctr + 128, 1u); __syncthreads(); const int u = (int)*su; __syncthreads(); if (u >= NSU) break;
        attn_sample_unit(u >> 4, u & 15, A.in[2], A.in[3], QB, KB, VB, GS, OB, lds, tid, w, lane, kb, A.out + O_FKS, A.out + O_FVS); }
#endif
}

constexpr int ML_QS = 272, ML_TS = 144;
constexpr int MA_VS = 544;
constexpr int MA_Q = 0, MA_K = 17408, MA_KW = 34816, MA_V = 52224, MA_SP = 87040, MA_VEC = 96256;
__device__ __forceinline__ bf16x8 tr_frag(clptr p, int rowstride4) { const v4i16_t lo = vtr(p), hi = vtr(p + rowstride4); return (bf16x8){lo[0], lo[1], lo[2], lo[3], hi[0], hi[1], hi[2], hi[3]}; }
constexpr int NUA = NB * 4 * 65 + DB * 4;
__device__ __forceinline__ f32x4 mfma16(bf16x8 a, bf16x8 b, f32x4 c) { return __builtin_amdgcn_mfma_f32_16x16x32_bf16(a, b, c, 0, 0, 0); }

__device__ __forceinline__ void mlstm_a_phase(const Args& A, int first, int stride, lptr lds, int tid, int w, int lane) {
    unsigned char* ws = A.ws;
    u32x4 pq[2], pk[2], pv[4]; float pgi = -1e30f, pgf = 0.f;
#define MA_LOAD(UID) do { const int uid_ = (UID); const bool pr_ = uid_ < NB * 4 * 65; const int bh_ = pr_ ? uid_ / 65 : uid_ - NB * 4 * 65, c_ = pr_ ? uid_ - bh_ * 65 : 0, b_ = bh_ >> 2, h_ = bh_ & 3; \
        const size_t rb_ = pr_ ? (size_t)b_ * TP : (size_t)MP + (size_t)b_ * DT; const int t0_ = pr_ ? 64 * c_ - 48 : 0, tl_ = pr_ ? TP : DT; \
        { const int tk_ = t0_ + lane; pgi = -1e30f; pgf = 0.f; if (tk_ >= 0 && tk_ < tl_) { pgi = ((const float*)(ws + WS_GI))[(rb_ + tk_) * 4 + h_]; pgf = ((const float*)(ws + WS_GF))[(rb_ + tk_) * 4 + h_]; } } \
        _Pragma("unroll") for (int i_ = 0; i_ < 2; ++i_) { const int id_ = tid + 512 * i_, r_ = id_ >> 4, ch_ = id_ & 15; const int tk_ = t0_ + r_; pq[i_] = (u32x4){0u, 0u, 0u, 0u}; pk[i_] = (u32x4){0u, 0u, 0u, 0u}; \
            if (tk_ >= 0 && tk_ < tl_) { pq[i_] = *(const u32x4*)((const bf16*)(ws + WS_MQ) + (rb_ + tk_) * 512 + h_ * 128 + ch_ * 8); pk[i_] = *(const u32x4*)((const bf16*)(ws + WS_MK) + (rb_ + tk_) * 512 + h_ * 128 + ch_ * 8); } } \
        _Pragma("unroll") for (int i_ = 0; i_ < 4; ++i_) { const int id_ = tid + 512 * i_, r_ = id_ >> 5, ch_ = id_ & 31; const int tk_ = t0_ + r_; pv[i_] = (u32x4){0u, 0u, 0u, 0u}; \
            if (tk_ >= 0 && tk_ < tl_) pv[i_] = *(const u32x4*)((const bf16*)(ws + WS_MV) + (rb_ + tk_) * DM + h_ * 256 + ch_ * 8); } } while (0)
    if (first < NUA) MA_LOAD(first);
#pragma unroll 1
    for (int uid = first; uid < NUA; uid += stride) {
    bf16* MH = (bf16*)(ws + WS_MH);
    float* RS = (float*)(ws + WS_RS); float* NU = (float*)(ws + WS_NU); bf16* U = (bf16*)(ws + WS_U) + (size_t)uid * 32768;
    const bool prompt = uid < NB * 4 * 65; const int bh = prompt ? uid / 65 : uid - NB * 4 * 65, c = prompt ? uid - bh * 65 : 0, b = bh >> 2, h = bh & 3;
    const size_t row_base = prompt ? (size_t)b * TP : (size_t)MP + (size_t)b * DT; const int tok0 = prompt ? 64 * c - 48 : 0, tlim = prompt ? TP : DT;
    LAS float* vec = (LAS float*)(lds + MA_VEC); LAS float* v_b = vec, *v_a = vec + 64, *v_ml = vec + 128, *v_rs = vec + 192;
    const int l15 = lane & 15, lg = lane >> 4;
    const float gi = pgi, gf = pgf;
    const float bb = wave_scan_add(gf, lane), aa = gi - bb, pm = wave_scan_max(aa, lane), mloc = bb + pm;
    const float b_last = __shfl(bb, 63), ml_last = __shfl(mloc, 63), wgl = __expf(b_last + aa - ml_last);
    if (w == 0) { v_b[lane] = bb; v_a[lane] = aa; v_ml[lane] = mloc; }
    if (w == 0) { ((float*)(ws + WS_BBC))[(size_t)uid * 64 + lane] = bb; ((float*)(ws + WS_PMC))[(size_t)uid * 64 + lane] = pm; }
#pragma unroll
    for (int i = 0; i < 2; ++i) { const int id = tid + 512 * i, r = id >> 4, ch = id & 15; const int tk = tok0 + r; const bool ok = tk >= 0 && tk < tlim;
        const u32x4 q = pq[i], k = pk[i]; (void)ok;
        *(LAS u32x4*)(lds + MA_Q + r * ML_QS + ch * 16) = q; *(LAS u32x4*)(lds + MA_K + r * ML_QS + ch * 16) = k;
        const float wgr = __shfl(wgl, r); u32x4 kw;
#pragma unroll
        for (int e = 0; e < 4; ++e) kw[e] = pk2(bf2f((unsigned short)(k[e] & 0xffffu)) * wgr, bf2f((unsigned short)(k[e] >> 16)) * wgr);
        *(LAS u32x4*)(lds + MA_KW + r * ML_QS + ch * 16) = kw; }
#pragma unroll
    for (int i = 0; i < 4; ++i) { const int id = tid + 512 * i, r = id >> 5, ch = id & 31; const int tk = tok0 + r; const bool ok = tk >= 0 && tk < tlim;
        const u32x4 v = pv[i]; (void)ok;
        *(LAS u32x4*)(lds + MA_V + r * MA_VS + ch * 16) = v; }
    LDS_BARRIER();
    if (uid + stride < NUA) MA_LOAD(uid + stride);
    { const int tr = w >> 1; float rs[4] = {0.f, 0.f, 0.f, 0.f};
#pragma unroll
        for (int i = 0; i < 2; ++i) { const int tc = 2 * (w & 1) + i; f32x4 acc = {0.f, 0.f, 0.f, 0.f};
#pragma unroll
            for (int k0 = 0; k0 < 128; k0 += 32) { const bf16x8 a = *(const LAS bf16x8*)(lds + MA_Q + (16 * tr + l15) * ML_QS + (k0 + 8 * lg) * 2), bq = *(const LAS bf16x8*)(lds + MA_K + (16 * tc + l15) * ML_QS + (k0 + 8 * lg) * 2); acc = mfma16(a, bq, acc); }
            const int s = 16 * tc + l15; const float as = v_a[s];
#pragma unroll
            for (int r = 0; r < 4; ++r) { const int t = 16 * tr + 4 * lg + r; const float d = s <= t ? __expf(v_b[t] + as - v_ml[t]) : 0.f; const float sp = acc[r] * d; rs[r] += sp;
                *(LAS unsigned short*)(lds + MA_SP + t * ML_TS + s * 2) = (unsigned short)f2bf(sp); } }
#pragma unroll
        for (int r = 0; r < 4; ++r) { float x = rs[r]; x += __shfl_xor(x, 1); x += __shfl_xor(x, 2); x += __shfl_xor(x, 4); x += __shfl_xor(x, 8); if (l15 == 0) v_rs[(w & 1) * 64 + 16 * tr + 4 * lg + r] = x; } }
    const clptr vtb = lds + MA_V + (8 * lg + (l15 >> 2)) * MA_VS + (l15 & 3) * 8;
    {
        const clptr kwb = lds + MA_KW + (8 * lg + (l15 >> 2)) * ML_QS + (l15 & 3) * 8 + w * 32;
        const bf16x8 a0 = tr_frag(kwb, 4 * ML_QS), a1 = tr_frag(kwb + 32 * ML_QS, 4 * ML_QS);
#pragma unroll 4
        for (int dvt = 0; dvt < 16; ++dvt) { const bf16x8 b0 = tr_frag(vtb + dvt * 32, 4 * MA_VS), b1 = tr_frag(vtb + 32 * MA_VS + dvt * 32, 4 * MA_VS);
            f32x4 acc = {0.f, 0.f, 0.f, 0.f}; acc = mfma16(a0, b0, acc); acc = mfma16(a1, b1, acc);
            u32x2 o; o.x = pk2(acc[0], acc[1]); o.y = pk2(acc[2], acc[3]); *(u32x2*)(U + (size_t)(16 * dvt + l15) * 128 + 16 * w + 4 * lg) = o; } }
    if (tid < 128) { float x = 0.f;
#pragma unroll 8
        for (int s = 0; s < 64; ++s) x += bf2f(*(const LAS unsigned short*)(lds + MA_KW + s * ML_QS + tid * 2));
        NU[(size_t)uid * 128 + tid] = x; }
    LDS_BARRIER();
    if (tid < 64) { const int tk = tok0 + tid; if (tk >= 0 && tk < tlim) RS[(row_base + tk) * 4 + h] = v_rs[tid] + v_rs[64 + tid]; }
    {
        const int tt = w & 3; const bf16x8 b0 = *(const LAS bf16x8*)(lds + MA_SP + (16 * tt + l15) * ML_TS + (8 * lg) * 2), b1 = *(const LAS bf16x8*)(lds + MA_SP + (16 * tt + l15) * ML_TS + (32 + 8 * lg) * 2);
        const int tk = tok0 + 16 * tt + l15; const bool ok = tk >= 0 && tk < tlim; bf16* dst = MH + (row_base + (ok ? tk : 0)) * DM + h * 256 + 4 * lg;
#pragma unroll 4
        for (int i = 0; i < 8; ++i) { const int dvt = 8 * (w >> 2) + i; const bf16x8 a0 = tr_frag(vtb + dvt * 32, 4 * MA_VS), a1 = tr_frag(vtb + 32 * MA_VS + dvt * 32, 4 * MA_VS);
            f32x4 acc = {0.f, 0.f, 0.f, 0.f}; acc = mfma16(a0, b0, acc); acc = mfma16(a1, b1, acc);
            if (ok) { u32x2 o; o.x = pk2(acc[0], acc[1]); o.y = pk2(acc[2], acc[3]); *(u32x2*)(dst + 16 * dvt) = o; } } }
    LDS_BARRIER();
    }
#undef MA_LOAD
    __syncthreads();
}

constexpr int MB_QSZ = 17408, MB_CBSZ = 48 * ML_QS, MB_Q = 0, MB_CB = 2 * MB_QSZ, MB_END = MB_CB + 2 * MB_CBSZ;
__device__ __forceinline__ void mlstm_b_item(const Args& A, int it, lptr lds, int tid, int w, int lane) {
    unsigned char* ws = A.ws;
    const bf16* MQ = (const bf16*)(ws + WS_MQ); bf16* MH = (bf16*)(ws + WS_MH); const float* GI = (const float*)(ws + WS_GI); const float* GF = (const float*)(ws + WS_GF);
    const float* RS = (const float*)(ws + WS_RS); const float* NU = (const float*)(ws + WS_NU); float* HSSQ = (float*)(ws + WS_HSSQ);
    const bool prompt = it < 256; const int i2 = prompt ? it : it - 256; const int b = i2 >> 5, h = (i2 >> 3) & 3, sl = i2 & 7; const int nch = prompt ? 65 : 1;
    const int uid0 = prompt ? (b * 4 + h) * 65 : NB * 4 * 65 + (b * 4 + h);
    const size_t row_base = prompt ? (size_t)b * TP : (size_t)MP + (size_t)b * DT; const int tlim = prompt ? TP : DT;
    const bf16* Ub = (const bf16*)(ws + WS_U) + (size_t)uid0 * 32768 + (size_t)(sl * 32 + (tid >> 4)) * 128 + (tid & 15) * 8;
    const int l15 = lane & 15, lg = lane >> 4, tt = w & 3, dvt = w >> 2, cdv = tid >> 4, cdk = (tid & 15) * 8;
    float C[8]; float nreg = 0.f, m_run = 0.f;
    {
        if (prompt) {
#pragma unroll
            for (int i = 0; i < 8; ++i) C[i] = 0.f;
        } else { const float* C0 = A.in[5] + ((size_t)(b * 4 + h) * 256 + sl * 32 + cdv) * 128 + cdk; const f32x4 c0 = *(const f32x4*)C0, c1 = *(const f32x4*)(C0 + 4);
#pragma unroll
            for (int i = 0; i < 4; ++i) { C[i] = c0[i]; C[4 + i] = c1[i]; }
            if (tid < 128) nreg = A.in[6][(size_t)(b * 4 + h) * 128 + tid]; m_run = A.in[7][b * 4 + h]; }
        u32x4 o; o.x = pk2(C[0], C[1]); o.y = pk2(C[2], C[3]); o.z = pk2(C[4], C[5]); o.w = pk2(C[6], C[7]);
        *(LAS u32x4*)(lds + MB_CB + cdv * ML_QS + cdk * 2) = o;
        if (tid < 256) { const int r = 32 + (tid >> 4); const u32x4 z = {0u, 0u, 0u, 0u}; *(LAS u32x4*)(lds + MB_CB + r * ML_QS + (tid & 15) * 16) = z; *(LAS u32x4*)(lds + MB_CB + MB_CBSZ + r * ML_QS + (tid & 15) * 16) = z; }
    }
    __syncthreads();
    if (tid < 128) *(LAS unsigned short*)(lds + MB_CB + 32 * ML_QS + tid * 2) = (unsigned short)f2bf(nreg);
    u32x4 q0_[2], q1_[2], uc_[2]; u32x2 nl_[2]; float gi_[2], gf_[2], rs_[2], nu_[2];
#define MB_LOADQ(S, cc) do { const int tok0_ = prompt ? 64 * (cc) - 48 : 0; \
        { const int r_ = tid >> 4, tk_ = tok0_ + r_; const bool ok_ = tk_ >= 0 && tk_ < tlim; q0_[S] = (u32x4){0u, 0u, 0u, 0u}; if (ok_) q0_[S] = *(const u32x4*)(MQ + (row_base + tk_) * 512 + h * 128 + (tid & 15) * 8); } \
        { const int r_ = 32 + (tid >> 4), tk_ = tok0_ + r_; const bool ok_ = tk_ >= 0 && tk_ < tlim; q1_[S] = (u32x4){0u, 0u, 0u, 0u}; if (ok_) q1_[S] = *(const u32x4*)(MQ + (row_base + tk_) * 512 + h * 128 + (tid & 15) * 8); } } while (0)
#define MB_LOAD(S, cc) do { const int tok0_ = prompt ? 64 * (cc) - 48 : 0; \
        uc_[S] = *(const u32x4*)(Ub + (size_t)(cc) * 32768); \
        { const int tk_ = tok0_ + lane; gi_[S] = ((const float*)(ws + WS_PMC))[(size_t)(uid0 + (cc)) * 64 + lane]; gf_[S] = ((const float*)(ws + WS_BBC))[(size_t)(uid0 + (cc)) * 64 + lane]; rs_[S] = 0.f; if (tk_ >= 0 && tk_ < tlim) rs_[S] = RS[(row_base + tk_) * 4 + h]; } \
        nu_[S] = tid < 128 ? NU[(size_t)(uid0 + (cc)) * 128 + tid] : 0.f; \
        { const int tk_ = tok0_ + 16 * tt + l15; nl_[S] = (u32x2){0u, 0u}; if (tk_ >= 0 && tk_ < tlim) nl_[S] = *(const u32x2*)(MH + (row_base + tk_) * DM + h * 256 + sl * 32 + 16 * dvt + 4 * lg); } } while (0)
    MB_LOADQ(0, 0); MB_LOAD(0, 0);
    if (nch > 1) MB_LOAD(1, 1);
    *(LAS u32x4*)(lds + MB_Q + (tid >> 4) * ML_QS + (tid & 15) * 16) = q0_[0]; *(LAS u32x4*)(lds + MB_Q + (32 + (tid >> 4)) * ML_QS + (tid & 15) * 16) = q1_[0];
    __syncthreads();
    if (nch > 1) MB_LOADQ(1, 1);
    if (nch > 2) MB_LOADQ(0, 2);
#pragma unroll 1
    for (int c2 = 0; c2 < nch; c2 += 2) {
        { constexpr int S = 0; const int c = c2;
        const int tok0 = prompt ? 64 * c - 48 : 0;
        const float bb = gf_[S], pm = gi_[S];
        const float mx = fmaxf(m_run, pm), mt = bb + mx, win = __expf(m_run - mx), scl = __expf(pm - mx), einv = __expf(-mt);
        const float b_last = __shfl(bb, 63), m_new = __shfl(mt, 63), pm_last = __shfl(pm, 63), mx_last = fmaxf(m_run, pm_last);
        const float decay = __expf(m_run - mx_last), usc = __expf(pm_last - mx_last);
        (void)b_last;
        const u32x4 uc = uc_[S]; const u32x2 nlc = nl_[S]; const float rsc = rs_[S], nuc = nu_[S];
        f32x4 acc = {0.f, 0.f, 0.f, 0.f}, acc2 = {0.f, 0.f, 0.f, 0.f};
#pragma unroll
        for (int k0 = 0; k0 < 128; k0 += 32) { const bf16x8 bq = *(const LAS bf16x8*)(lds + MB_Q + S * MB_QSZ + (16 * tt + l15) * ML_QS + (k0 + 8 * lg) * 2);
            const bf16x8 a = *(const LAS bf16x8*)(lds + MB_CB + S * MB_CBSZ + (16 * dvt + l15) * ML_QS + (k0 + 8 * lg) * 2), an = *(const LAS bf16x8*)(lds + MB_CB + S * MB_CBSZ + (32 + l15) * ML_QS + (k0 + 8 * lg) * 2);
            acc = mfma16(a, bq, acc); acc2 = mfma16(an, bq, acc2); }
        {
            const int t = 16 * tt + l15; const int tk = tok0 + t; const bool ok = tk >= 0 && tk < tlim;
            const float qn = __shfl(acc2[0], l15), win_t = __shfl(win, t), scl_t = __shfl(scl, t), einv_t = __shfl(einv, t), rs_t = __shfl(rsc, t);
            const float den = win_t * qn + scl_t * rs_t, rden = 1.0f / fmaxf(fabsf(den), einv_t);
            const float n0 = bf2f((unsigned short)(nlc.x & 0xffffu)), n1 = bf2f((unsigned short)(nlc.x >> 16)), n2 = bf2f((unsigned short)(nlc.y & 0xffffu)), n3 = bf2f((unsigned short)(nlc.y >> 16));
            const float h0 = (win_t * acc[0] + scl_t * n0) * rden, h1 = (win_t * acc[1] + scl_t * n1) * rden, h2 = (win_t * acc[2] + scl_t * n2) * rden, h3 = (win_t * acc[3] + scl_t * n3) * rden;
            float x = (h0 * h0 + h1 * h1) + (h2 * h2 + h3 * h3); x += __shfl_xor(x, 16); x += __shfl_xor(x, 32);
            if (ok) { u32x2 o; o.x = pk2(h0, h1); o.y = pk2(h2, h3); *(u32x2*)(MH + (row_base + tk) * DM + h * 256 + sl * 32 + 16 * dvt + 4 * lg) = o; if (lg == 0) HSSQ[((row_base + tk) * 4 + h) * 16 + sl * 2 + dvt] = x; }
        }
        {
            C[0] = decay * C[0] + usc * bf2f((unsigned short)(uc.x & 0xffffu)); C[1] = decay * C[1] + usc * bf2f((unsigned short)(uc.x >> 16));
            C[2] = decay * C[2] + usc * bf2f((unsigned short)(uc.y & 0xffffu)); C[3] = decay * C[3] + usc * bf2f((unsigned short)(uc.y >> 16));
            C[4] = decay * C[4] + usc * bf2f((unsigned short)(uc.z & 0xffffu)); C[5] = decay * C[5] + usc * bf2f((unsigned short)(uc.z >> 16));
            C[6] = decay * C[6] + usc * bf2f((unsigned short)(uc.w & 0xffffu)); C[7] = decay * C[7] + usc * bf2f((unsigned short)(uc.w >> 16));
            u32x4 o; o.x = pk2(C[0], C[1]); o.y = pk2(C[2], C[3]); o.z = pk2(C[4], C[5]); o.w = pk2(C[6], C[7]);
            *(LAS u32x4*)(lds + MB_CB + (S ^ 1) * MB_CBSZ + cdv * ML_QS + cdk * 2) = o;
            if (tid < 128) { nreg = decay * nreg + usc * nuc; *(LAS unsigned short*)(lds + MB_CB + (S ^ 1) * MB_CBSZ + 32 * ML_QS + tid * 2) = (unsigned short)f2bf(nreg); }
            if (c + 1 < nch) { *(LAS u32x4*)(lds + MB_Q + (S ^ 1) * MB_QSZ + (tid >> 4) * ML_QS + (tid & 15) * 16) = q0_[S ^ 1]; *(LAS u32x4*)(lds + MB_Q + (S ^ 1) * MB_QSZ + (32 + (tid >> 4)) * ML_QS + (tid & 15) * 16) = q1_[S ^ 1]; }
        }
        m_run = m_new;
        LDS_BARRIER();
        if (c + 2 < nch) MB_LOAD(S, c + 2);
        if (c + 3 < nch) MB_LOADQ(S ^ 1, c + 3);
        }
        if (c2 + 1 < nch) { constexpr int S = 1; const int c = c2 + 1;
        const int tok0 = prompt ? 64 * c - 48 : 0;
        const float bb = gf_[S], pm = gi_[S];
        const float mx = fmaxf(m_run, pm), mt = bb + mx, win = __expf(m_run - mx), scl = __expf(pm - mx), einv = __expf(-mt);
        const float b_last = __shfl(bb, 63), m_new = __shfl(mt, 63), pm_last = __shfl(pm, 63), mx_last = fmaxf(m_run, pm_last);
        const float decay = __expf(m_run - mx_last), usc = __expf(pm_last - mx_last);
        (void)b_last;
        const u32x4 uc = uc_[S]; const u32x2 nlc = nl_[S]; const float rsc = rs_[S], nuc = nu_[S];
        f32x4 acc = {0.f, 0.f, 0.f, 0.f}, acc2 = {0.f, 0.f, 0.f, 0.f};
#pragma unroll
        for (int k0 = 0; k0 < 128; k0 += 32) { const bf16x8 bq = *(const LAS bf16x8*)(lds + MB_Q + S * MB_QSZ + (16 * tt + l15) * ML_QS + (k0 + 8 * lg) * 2);
            const bf16x8 a = *(const LAS bf16x8*)(lds + MB_CB + S * MB_CBSZ + (16 * dvt + l15) * ML_QS + (k0 + 8 * lg) * 2), an = *(const LAS bf16x8*)(lds + MB_CB + S * MB_CBSZ + (32 + l15) * ML_QS + (k0 + 8 * lg) * 2);
            acc = mfma16(a, bq, acc); acc2 = mfma16(an, bq, acc2); }
        {
            const int t = 16 * tt + l15; const int tk = tok0 + t; const bool ok = tk >= 0 && tk < tlim;
            const float qn = __shfl(acc2[0], l15), win_t = __shfl(win, t), scl_t = __shfl(scl, t), einv_t = __shfl(einv, t), rs_t = __shfl(rsc, t);
            const float den = win_t * qn + scl_t * rs_t, rden = 1.0f / fmaxf(fabsf(den), einv_t);
            const float n0 = bf2f((unsigned short)(nlc.x & 0xffffu)), n1 = bf2f((unsigned short)(nlc.x >> 16)), n2 = bf2f((unsigned short)(nlc.y & 0xffffu)), n3 = bf2f((unsigned short)(nlc.y >> 16));
            const float h0 = (win_t * acc[0] + scl_t * n0) * rden, h1 = (win_t * acc[1] + scl_t * n1) * rden, h2 = (win_t * acc[2] + scl_t * n2) * rden, h3 = (win_t * acc[3] + scl_t * n3) * rden;
            float x = (h0 * h0 + h1 * h1) + (h2 * h2 + h3 * h3); x += __shfl_xor(x, 16); x += __shfl_xor(x, 32);
            if (ok) { u32x2 o; o.x = pk2(h0, h1); o.y = pk2(h2, h3); *(u32x2*)(MH + (row_base + tk) * DM + h * 256 + sl * 32 + 16 * dvt + 4 * lg) = o; if (lg == 0) HSSQ[((row_base + tk) * 4 + h) * 16 + sl * 2 + dvt] = x; }
        }
        {
            C[0] = decay * C[0] + usc * bf2f((unsigned short)(uc.x & 0xffffu)); C[1] = decay * C[1] + usc * bf2f((unsigned short)(uc.x >> 16));
            C[2] = decay * C[2] + usc * bf2f((unsigned short)(uc.y & 0xffffu)); C[3] = decay * C[3] + usc * bf2f((unsigned short)(uc.y >> 16));
            C[4] = decay * C[4] + usc * bf2f((unsigned short)(uc.z & 0xffffu)); C[5] = decay * C[5] + usc * bf2f((unsigned short)(uc.z >> 16));
            C[6] = decay * C[6] + usc * bf2f((unsigned short)(uc.w & 0xffffu)); C[7] = decay * C[7] + usc * bf2f((unsigned short)(uc.w >> 16));
            u32x4 o; o.x = pk2(C[0], C[1]); o.y = pk2(C[2], C[3]); o.z = pk2(C[4], C[5]); o.w = pk2(C[6], C[7]);
            *(LAS u32x4*)(lds + MB_CB + (S ^ 1) * MB_CBSZ + cdv * ML_QS + cdk * 2) = o;
            if (tid < 128) { nreg = decay * nreg + usc * nuc; *(LAS unsigned short*)(lds + MB_CB + (S ^ 1) * MB_CBSZ + 32 * ML_QS + tid * 2) = (unsigned short)f2bf(nreg); }
            if (c + 1 < nch) { *(LAS u32x4*)(lds + MB_Q + (S ^ 1) * MB_QSZ + (tid >> 4) * ML_QS + (tid & 15) * 16) = q0_[S ^ 1]; *(LAS u32x4*)(lds + MB_Q + (S ^ 1) * MB_QSZ + (32 + (tid >> 4)) * ML_QS + (tid & 15) * 16) = q1_[S ^ 1]; }
        }
        m_run = m_new;
        LDS_BARRIER();
        if (c + 2 < nch) MB_LOAD(S, c + 2);
        if (c + 3 < nch) MB_LOADQ(S ^ 1, c + 3);
        }
    }
#undef MB_LOAD
#undef MB_LOADQ
    { float* Co = A.out + (prompt ? O_MCP : O_MCS) + ((size_t)(b * 4 + h) * 256 + sl * 32 + cdv) * 128 + cdk;
        *(f32x4*)Co = (f32x4){C[0], C[1], C[2], C[3]}; *(f32x4*)(Co + 4) = (f32x4){C[4], C[5], C[6], C[7]};
        if (sl == 0) { if (tid < 128) (A.out + (prompt ? O_MNP : O_MNS))[(size_t)(b * 4 + h) * 128 + tid] = nreg; if (tid == 0) (A.out + (prompt ? O_MMP : O_MMS))[b * 4 + h] = m_run; } }
    __syncthreads();
}

__device__ __forceinline__ void p9_gate(const Args& A, int gw, int NGW, int lane) {
    unsigned char* ws = A.ws; bf16* MH = (bf16*)(ws + WS_MH); const bf16* MO = (const bf16*)(ws + WS_MO); const float* HSSQ = (const float*)(ws + WS_HSSQ);
    const int hd = lane >> 4;
    for (int row0 = gw; row0 < MTOT; row0 += 4 * NGW) {
        f32x4 p[4][4]; u32x4 hv[4][2], ov[4][2];
#pragma unroll
        for (int u = 0; u < 4; ++u) { const int row = row0 + u * NGW < MTOT ? row0 + u * NGW : row0; const float* pp = HSSQ + ((size_t)row * 4 + hd) * 16;
#pragma unroll
            for (int i = 0; i < 4; ++i) p[u][i] = *(const f32x4*)(pp + 4 * i);
#pragma unroll
            for (int i = 0; i < 2; ++i) { const size_t off = (size_t)row * DM + lane * 16 + i * 8; hv[u][i] = *(const u32x4*)(MH + off); ov[u][i] = *(const u32x4*)(MO + off); } }
#pragma unroll
        for (int u = 0; u < 4; ++u) { const int row = row0 + u * NGW; if (row >= MTOT) break;
            float s = 0.f;
#pragma unroll
            for (int i = 0; i < 4; ++i) s += (p[u][i][0] + p[u][i][1]) + (p[u][i][2] + p[u][i][3]);
            const float rs = __builtin_amdgcn_rsqf(s * (1.0f / 256.0f) + EPSN);
#pragma unroll
            for (int i = 0; i < 2; ++i) { const size_t off = (size_t)row * DM + lane * 16 + i * 8; u32x4 o;
#pragma unroll
                for (int e2 = 0; e2 < 4; ++e2) { const float a = bf2f((unsigned short)(hv[u][i][e2] & 0xffffu)) * rs * bf2f((unsigned short)(ov[u][i][e2] & 0xffffu)), c = bf2f((unsigned short)(hv[u][i][e2] >> 16)) * rs * bf2f((unsigned short)(ov[u][i][e2] >> 16)); o[e2] = pk2(a, c); }
                *(u32x4*)(MH + off) = o; } }
    }
}

__device__ __forceinline__ void p13_final(const Args& A, int gw, int NGW, int lane) {
    unsigned char* ws = A.ws; const float* X = (const float*)(ws + WS_X); const float* ssq = (const float*)(ws + WS_SSQ); const float* g = A.in[23];
    f32x4 gg[4];
#pragma unroll
    for (int j = 0; j < 4; ++j) gg[j] = *(const f32x4*)(g + 256 * j + 4 * lane);
    for (int row0 = gw; row0 < MTOT; row0 += 4 * NGW) {
        f32x4 v[4][4]; float sq[4];
#pragma unroll
        for (int u = 0; u < 4; ++u) { const int row = row0 + u * NGW < MTOT ? row0 + u * NGW : row0; sq[u] = lane < 16 ? ssq[(size_t)row * 16 + lane] : 0.f;
#pragma unroll
            for (int j = 0; j < 4; ++j) v[u][j] = *(const f32x4*)(X + (size_t)row * DM + 256 * j + 4 * lane); }
#pragma unroll
        for (int u = 0; u < 4; ++u) { const int row = row0 + u * NGW; if (row >= MTOT) break;
            float* dst;
            if (row < MP) { const int b = row / TP, t = row - b * TP; if (t < NMETA) continue; dst = A.out + O_YP + ((size_t)b * SEQL + (t - NMETA)) * DM; }
            else dst = A.out + O_YS + (size_t)(row - MP) * DM;
            const float rs = __builtin_amdgcn_rsqf(wave_sum(sq[u]) * (1.0f / 1024.0f) + EPSN);
#pragma unroll
            for (int j = 0; j < 4; ++j) *(f32x4*)(dst + 256 * j + 4 * lane) = v[u][j] * rs * gg[j]; }
    }
}

__device__ __forceinline__ void tail_finish(const float* P, unsigned* cnt, const pg8::StaticOrder& base, int first, int ntail, int slices, int c, float* X, bf16* XB, float* ssq, lptr lds, int tid) {
    const int tu = c / slices; if (tu >= ntail) return;
    asm volatile("s_waitcnt vmcnt(0)" ::: "memory"); __syncthreads();
    if (tid == 0) { __builtin_amdgcn_fence(__ATOMIC_RELEASE, "agent"); asm volatile("s_waitcnt vmcnt(0)" ::: "memory");
        (void)__hip_atomic_fetch_add(cnt + tu, 1u, __ATOMIC_RELAXED, __HIP_MEMORY_SCOPE_AGENT);
        while (__hip_atomic_load(cnt + tu, __ATOMIC_RELAXED, __HIP_MEMORY_SCOPE_AGENT) < (unsigned)slices) __builtin_amdgcn_s_sleep(2); }
    __syncthreads();
    __builtin_amdgcn_fence(__ATOMIC_ACQUIRE, "agent"); asm volatile("s_waitcnt vmcnt(0)" ::: "memory");
    pg8::Unit u; base.map(first + tu, u);
    const int nrow = 256 / slices, rbase = (c % slices) * nrow;
    const int cc = tid & 31, r0 = tid >> 5;
    const float* p0 = P + (size_t)(tu * slices) * 65536 + cc * 8;
#pragma unroll 2
    for (int rr = 0; rr < nrow; rr += 16) { const int row = rbase + rr + r0;
        const size_t xoff = (size_t)(u.pm * 256 + row) * DM + u.pn * 256 + cc * 8;
        f32x4 a = *(const f32x4*)(X + xoff), b = *(const f32x4*)(X + xoff + 4);
        for (int s = 0; s < slices; ++s) { a = a + *(const f32x4*)(p0 + (size_t)s * 65536 + row * 256); b = b + *(const f32x4*)(p0 + (size_t)s * 65536 + row * 256 + 4); }
        *(f32x4*)(X + xoff) = a; *(f32x4*)(X + xoff + 4) = b; *(u32x4*)(XB + xoff) = pg8::pack8(a, b);
        float q = (a[0] * a[0] + a[1] * a[1]) + (a[2] * a[2] + a[3] * a[3]) + (b[0] * b[0] + b[1] * b[1]) + (b[2] * b[2] + b[3] * b[3]);
        q += __shfl_xor(q, 1); q += __shfl_xor(q, 2); q += __shfl_xor(q, 4);
        if ((cc & 7) == 0) ssq[(size_t)(u.pm * 256 + row) * 16 + u.pn * 4 + (cc >> 3)] = q; }
}

#define XB_TMO      128
#define XB_XCNT(j)  (256  + 64 * (j))
#define XB_XSUB(j)  (1280 + 64 * (j))
#define XB_XGEN(j)  (2304 + 64 * (j))
#define XB_TOP      3328
#define XB_TOPGEN   3392
#define XCD_BAR_WORDS 3456
#define XB_SPIN_CAP (1u << 18)

__device__ __forceinline__ unsigned xb_ld(unsigned* p)              { return __hip_atomic_load(p, __ATOMIC_RELAXED, __HIP_MEMORY_SCOPE_AGENT); }
__device__ __forceinline__ unsigned xb_add(unsigned* p, unsigned v) { return __hip_atomic_fetch_add(p, v, __ATOMIC_RELAXED, __HIP_MEMORY_SCOPE_AGENT); }
__device__ __forceinline__ unsigned xb_xcc_id() { return (unsigned)__builtin_amdgcn_s_getreg((3 << 11) | 20) & 0xFu; }
#define XB_SPIN(cond, bar) do { unsigned _sp = 0; while (cond) { __builtin_amdgcn_s_sleep(1); \
    if ((++_sp & 255u) == 0u) { if (xb_ld(&(bar)[XB_TMO])) break; if (_sp > XB_SPIN_CAP) { atomicAdd(&(bar)[XB_TMO], 1u); break; } } } } while (0)

struct XcdBarrier {
    unsigned* bar; unsigned x;
    volatile LAS unsigned* st;
};

__device__ __forceinline__ XcdBarrier xcd_barrier_post(unsigned* bar, volatile LAS unsigned* st) {
    XcdBarrier b; b.bar = bar; b.x = xb_xcc_id(); b.st = st;
    if (threadIdx.x == 0) (void)xb_add(&bar[XB_XCNT(b.x)], 1u);
    return b;
}
__device__ __forceinline__ void xcd_barrier_complete(unsigned* bar, unsigned x, unsigned& nloc, unsigned& nx) {
    const unsigned G = gridDim.x * gridDim.y * gridDim.z;
    unsigned sum, cnt, mine, sp = 0u;
    for (;;) {
        sum = 0u; cnt = 0u; mine = 0u;
#pragma unroll
        for (unsigned j = 0; j < 16; ++j) { const unsigned c = xb_ld(&bar[XB_XCNT(j)]); sum += c; cnt += (c > 0u) ? 1u : 0u; mine = (j == x) ? c : mine; }
        if (sum == G) break;
        __builtin_amdgcn_s_sleep(1);
        if ((++sp & 255u) == 0u) { if (xb_ld(&bar[XB_TMO])) break; if (sp > XB_SPIN_CAP) { atomicAdd(&bar[XB_TMO], 1u); break; } }
    }
    nloc = mine > 0u ? mine : 1u; nx = cnt > 0u ? cnt : 1u;
}

__device__ __forceinline__ void xcd_barrier(const XcdBarrier& b) {
    asm volatile("s_waitcnt vmcnt(0)" ::: "memory");
    __syncthreads();
    if (threadIdx.x == 0) {
        unsigned* bar = b.bar;
        __builtin_amdgcn_s_waitcnt(0);
        unsigned nloc = b.st[0], nx = b.st[1];
        if (nloc == 0u) { xcd_barrier_complete(bar, b.x, nloc, nx); b.st[0] = nloc; b.st[1] = nx; }
        const unsigned old = xb_add(&bar[XB_XSUB(b.x)], 1u);
        const unsigned gen = old / nloc;
        if (old + 1u == (gen + 1u) * nloc) {
            __builtin_amdgcn_fence(__ATOMIC_RELEASE, "agent");
            asm volatile("s_waitcnt vmcnt(0)" ::: "memory");
            const unsigned og = xb_add(&bar[XB_TOP], 1u);
            const unsigned tg = og / nx;
            if (og + 1u == (tg + 1u) * nx) xb_add(&bar[XB_TOPGEN], 1u);
            else XB_SPIN(xb_ld(&bar[XB_TOPGEN]) == tg, bar);
            __builtin_amdgcn_fence(__ATOMIC_ACQUIRE, "agent");
            xb_add(&bar[XB_XGEN(b.x)], 1u);
            asm volatile("s_waitcnt vmcnt(0)" ::: "memory");
        } else {
            XB_SPIN(xb_ld(&bar[XB_XGEN(b.x)]) == gen, bar);
            __builtin_amdgcn_fence(__ATOMIC_ACQUIRE, "agent");
            asm volatile("s_waitcnt vmcnt(0)" ::: "memory");
        }
    }
    __syncthreads();
}

__global__ void __launch_bounds__(NTHR, 2) fwd_megakernel(Args args) {
    extern __shared__ __attribute__((aligned(16))) unsigned char lds_raw[];
    cg::grid_group grid = cg::this_grid();
    { LAS unsigned* misc_ = (LAS unsigned*)(lds_raw) ; (void)misc_; }
#define GRID_SYNC() do { asm volatile("s_waitcnt vmcnt(0) lgkmcnt(0)" ::: "memory"); __syncthreads(); \
        if (threadIdx.x == 0) { __builtin_amdgcn_fence(__ATOMIC_RELEASE, "agent"); asm volatile("s_waitcnt vmcnt(0)" ::: "memory"); } \
        GSYNC(); \
        __builtin_amdgcn_fence(__ATOMIC_ACQUIRE, "agent"); asm volatile("s_waitcnt vmcnt(0)" ::: "memory"); __syncthreads(); } while (0)
    const lptr lds = (lptr)lds_raw;
    const int G = gridDim.x, bx = blockIdx.x, NGW = G * NWAVES;
#define TIDS int tid = threadIdx.x; asm volatile("" : "+v"(tid)); const int lane = tid & 63, w = __builtin_amdgcn_readfirstlane(tid >> 6), gw = bx * NWAVES + w; (void)gw; (void)lane
    unsigned char* ws = args.ws;
    bf16* XB = (bf16*)(ws + WS_XB); float* X = (float*)(ws + WS_X); float* ssq = (float*)(ws + WS_SSQ);
    volatile LAS unsigned* xb_st = (volatile LAS unsigned*)(lds + LDS_BYTES - 256);
    if (threadIdx.x < 2) xb_st[threadIdx.x] = 0u;
    __syncthreads();
    const XcdBarrier xbar = xcd_barrier_post((unsigned*)(ws + WS_CTL) + 4096, xb_st);
#ifndef USE_CG_SYNC
#define GSYNC() xcd_barrier(xbar)
#else
#define GSYNC() grid.sync()
#endif

#ifndef SKIP_P0
    { TIDS; p0_prologue(args, lds, gw, NGW, w, lane); }
#endif
#ifdef PROBE_P0
    { TIDS; p0_prologue(args, lds, gw, NGW, w, lane); }
#endif
    grid.sync();
    xcd_barrier(xbar);
#ifdef PROBE_P1
    { pg8::Gemm g{XB, (const bf16*)(ws + WS_WFIN), MPAD, NIN, DM}; pg8::StaticOrder S; S.init(MPAD, NIN, G, bx); pg8::EpiFoxIn E{ssq, args.in[13], args.in[14], args.in[12], ws, args.out};
      pg8::gemm_phase<pg8::EpiFoxIn, pg8::StaticOrder, PG8_ALIGN, PG8_SP2>(lds, g, S, E); }
    GSYNC();
#endif
#ifndef SKIP_P1
    {
        pg8::Gemm g{XB, (const bf16*)(ws + WS_WFIN), MPAD, NIN, DM}; pg8::StaticOrder S; S.init(MPAD, NIN, G, bx);
        pg8::EpiFoxIn E{ssq, args.in[13], args.in[14], args.in[12], ws, args.out};
        pg8::gemm_phase<pg8::EpiFoxIn, pg8::StaticOrder, PG8_ALIGN, PG8_SP2>(lds, g, S, E);
    }
#endif
    GSYNC();
#ifndef SKIP_P2
    { TIDS; p2_cumsum(args, gw, NGW, lane); }
#endif
    GSYNC();
#ifndef SKIP_P3
    { TIDS; p3_attention(args, lds, tid, w, lane, 0); }
#ifdef PROBE_P3
    GSYNC();
    { TIDS; p3_attention(args, lds, tid, w, lane, 1); }
#endif
#endif
    GSYNC();
#define RESID_GEMM(Ap, Wp, KK, CNTI) do { \
    pg8::StaticOrder S; S.init(MPAD, DM, G, bx); const int full_ = (S.nwg / G) * G, ntail_ = S.nwg - full_; S.lim = full_; \
    { pg8::Gemm g{(Ap), (Wp), MPAD, DM, (KK), (KK)}; pg8::EpiResid E{X, XB, ssq}; pg8::gemm_phase<pg8::EpiResid, pg8::StaticOrder, PG8_ALIGN, PG8_SP2>(lds, g, S, E); } \
    if (ntail_ > 0) { const int sl_ = ntail_ * 8 <= G ? 8 : (ntail_ * 4 <= G ? 4 : (ntail_ * 2 <= G ? 2 : 1)); const int ks_ = (KK) / sl_; \
        pg8::TailOrder T{S, full_, ntail_, sl_, bx}; pg8::Gemm g{(Ap) + (bx % sl_) * ks_, (Wp) + (bx % sl_) * ks_, MPAD, DM, ks_, (KK)}; pg8::EpiPartial E{(float*)(ws + WS_P)}; \
        pg8::gemm_phase<pg8::EpiPartial, pg8::TailOrder, false, PG8_SP2>(lds, g, T, E); \
        { int tid_ = threadIdx.x; asm volatile("" : "+v"(tid_)); tail_finish((const float*)(ws + WS_P), (unsigned*)(ws + WS_CTL) + 256 + (CNTI), S, full_, ntail_, sl_, bx, X, XB, ssq, lds, tid_); } } } while (0)
#ifdef PROBE_UP
#define PROBE_UP_BODY(WUP) { pg8::Gemm g{XB, (const bf16*)(ws + (WUP)), MPAD, DFF, DM}; pg8::StaticOrder S; S.init(MPAD, DFF, G, bx); pg8::EpiUp E{ssq, (bf16*)(ws + WS_H)}; \
      pg8::gemm_phase<pg8::EpiUp, pg8::StaticOrder, PG8_ALIGN, PG8_SP2>(lds, g, S, E); } GSYNC();
#else
#define PROBE_UP_BODY(WUP)
#endif
#define LAYER_TAIL(AOP, WOUT, WUP, WDN, CNT0) do { \
    RESID_GEMM((const bf16*)(AOP), (const bf16*)(ws + (WOUT)), DM, CNT0); \
    GSYNC(); \
    { pg8::Gemm g{XB, (const bf16*)(ws + (WUP)), MPAD, DFF, DM}; pg8::StaticOrder S; S.init(MPAD, DFF, G, bx); pg8::EpiUp E{ssq, (bf16*)(ws + WS_H)}; \
      pg8::gemm_phase<pg8::EpiUp, pg8::StaticOrder, PG8_ALIGN, PG8_SP2>(lds, g, S, E); } \
    GSYNC(); \
    PROBE_UP_BODY(WUP) \
    RESID_GEMM((const bf16*)(ws + WS_H), (const bf16*)(ws + (WDN)), DFF, CNT0 + 32); \
    GSYNC(); } while (0)
#ifndef SKIP_L0
    LAYER_TAIL(ws + WS_OB, WS_WFOUT, WS_WUP0, WS_WDN0, 0);
#endif
#ifndef SKIP_P7
    {
        pg8::Gemm g{XB, (const bf16*)(ws + WS_WMIN), MPAD, NIN, DM}; pg8::StaticOrder S; S.init(MPAD, NIN, G, bx);
        pg8::EpiMlstmIn E{ssq, args.in[17], args.in[18], (bf16*)(ws + WS_MQ), (bf16*)(ws + WS_MK), (bf16*)(ws + WS_MV), (bf16*)(ws + WS_MO), (float*)(ws + WS_GI), (float*)(ws + WS_GF)};
        pg8::gemm_phase<pg8::EpiMlstmIn, pg8::StaticOrder, PG8_ALIGN, PG8_SP2>(lds, g, S, E);
    }
#endif
    GSYNC();
#ifndef SKIP_P8
    { TIDS; mlstm_a_phase(args, bx, G, lds, tid, w, lane); }
    GSYNC();
#ifdef PROBE_MA
    { TIDS; mlstm_a_phase(args, bx, G, lds, tid, w, lane); }
    GSYNC();
#endif
    { TIDS; for (int it = bx; it < 256 + 1024; it += G) mlstm_b_item(args, it, lds, tid, w, lane); }
#ifdef PROBE_MAB
    GSYNC();
    { TIDS; mlstm_a_phase(args, bx, G, lds, tid, w, lane); }
    GSYNC();
    { TIDS; for (int it = bx; it < 256 + 1024; it += G) mlstm_b_item(args, it, lds, tid, w, lane); }
#endif
#endif
    GSYNC();
#ifndef SKIP_P9
    { TIDS; p9_gate(args, gw, NGW, lane); }
#endif
    GSYNC();
#ifndef SKIP_L1
    LAYER_TAIL(ws + WS_MH, WS_WMOUT, WS_WUP1, WS_WDN1, 64);
#endif
#ifndef SKIP_P13
    { TIDS; p13_final(args, gw, NGW, lane); }
#ifdef PROBE_SYNC
    for (int i_ = 0; i_ < 16; ++i_) grid.sync();
#endif
#endif
}

extern "C" void kernel_launch(void* const* d_in, const int* in_sizes, int n_in, void* d_out, int out_size, void* d_ws, size_t ws_size, hipStream_t stream) {
    static int grid = 0;
    if (grid == 0) {
        if (n_in != 24 || (size_t)out_size != O_END || ws_size < WS_END) { fprintf(stderr, "kernel_launch: unexpected shapes: n_in %d out %d (want %zu) ws %zu (want >= %zu)\n", n_in, out_size, (size_t)O_END, ws_size, (size_t)WS_END); grid = -1; return; }
        int dev = 0, cus = 0, per_cu = 0;
        if (hipGetDevice(&dev) != hipSuccess || hipDeviceGetAttribute(&cus, hipDeviceAttributeMultiprocessorCount, dev) != hipSuccess) { grid = -1; return; }
        if (hipFuncSetAttribute((const void*)fwd_megakernel, hipFuncAttributeMaxDynamicSharedMemorySize, LDS_BYTES) != hipSuccess) { fprintf(stderr, "kernel_launch: hipFuncSetAttribute failed\n"); grid = -1; return; }
        if (hipOccupancyMaxActiveBlocksPerMultiprocessor(&per_cu, (const void*)fwd_megakernel, NTHR, LDS_BYTES) != hipSuccess || per_cu < 1) { fprintf(stderr, "kernel_launch: occupancy query says %d blocks per CU\n", per_cu); grid = -1; return; }
        grid = cus;
    }
    if (grid < 0) return;
    (void)hipMemsetAsync((char*)d_ws + WS_CTL, 0, 65536, stream);
    Args a{};
    for (int i = 0; i < 24; ++i) a.in[i] = (const float*)d_in[i];
    a.out = (float*)d_out; a.ws = (unsigned char*)d_ws;
    void* kargs[] = {&a};
    const hipError_t e = hipLaunchCooperativeKernel((const void*)fwd_megakernel, dim3(grid), dim3(NTHR), kargs, LDS_BYTES, stream);
    if (e != hipSuccess) fprintf(stderr, "kernel_launch: cooperative launch failed: %s (grid %d)\n", hipGetErrorString(e), grid);
}
```

```cpp
#include <hip/hip_runtime.h>
#include <hip/hip_cooperative_groups.h>
#include <cstdio>
#include <cstdint>
namespace cg = cooperative_groups;

constexpr int DM = 1024, TP = 4112, NB = 8, SEQL = 4096, NMETA = 16, DB = 32, DT = 32, PAST = 2048, DFF = 4096;
constexpr int MP = NB * TP;
constexpr int MTOT = MP + DB * DT;
constexpr int MPAD = 34048;
constexpr int NIN = 3328;
constexpr int PPAD = 240;
constexpr int PLEN = 4352;
constexpr int GSLEN = 2112;
constexpr float EPSN = 1e-6f;
constexpr float LOG2E = 1.4426950408889634f;
constexpr float QSCALE = 0.125f * LOG2E;

constexpr int NWAVES = 8, NTHR = 512;
constexpr int LDS_BYTES = 147456;
constexpr size_t MiB = 1u << 20;
constexpr size_t WS_CTL = 0;
constexpr size_t WS_WFIN = 1 * MiB, WS_WFOUT = 8 * MiB, WS_WMIN = 10 * MiB, WS_WMOUT = 17 * MiB, WS_WUP0 = 19 * MiB, WS_WUP1 = 27 * MiB, WS_WDN0 = 35 * MiB, WS_WDN1 = 43 * MiB;
constexpr size_t WS_SSQ = 51 * MiB, WS_G = 54 * MiB, WS_GS = 57 * MiB, WS_GI = 62 * MiB, WS_GF = 63 * MiB, WS_HSSQ = 64 * MiB;
constexpr size_t WS_X = 74 * MiB, WS_XB = 207 * MiB;
constexpr size_t WS_QB = 274 * MiB, WS_KB = 343 * MiB, WS_VB = 411 * MiB, WS_OB = 478 * MiB, WS_H = 274 * MiB;
constexpr size_t WS_MQ = 546 * MiB, WS_MK = 580 * MiB, WS_MV = 614 * MiB, WS_MO = 682 * MiB, WS_MH = 750 * MiB, WS_U = 818 * MiB, WS_RS = 958 * MiB, WS_NU = 959 * MiB, WS_P = 961 * MiB, WS_BBC = 1001 * MiB, WS_PMC = 1002 * MiB, WS_END = 1003 * MiB;
static_assert(WS_H + (size_t)MPAD * DFF * 2 <= WS_MQ && WS_OB + (size_t)MPAD * DM * 2 <= WS_MQ && WS_VB + (size_t)MPAD * DM * 2 <= WS_OB && WS_KB + (size_t)MPAD * DM * 2 <= WS_VB - MiB && WS_QB + (size_t)MPAD * DM * 2 <= WS_KB - MiB, "ws map");
static_assert(WS_G + (size_t)NB * 16 * PLEN * 4 <= WS_GS && WS_GS + (size_t)DB * 16 * GSLEN * 4 <= WS_GI && WS_HSSQ + (size_t)MPAD * 64 * 4 <= WS_X && WS_SSQ + (size_t)MPAD * 64 <= WS_G, "ws map 2");

struct Args { const float* in[24]; float* out; unsigned char* ws; };

constexpr size_t O_YP = 0, O_YS = O_YP + (size_t)NB * SEQL * DM, O_FKP = O_YS + (size_t)DB * DT * DM, O_FVP = O_FKP + (size_t)MP * DM, O_FLP = O_FVP + (size_t)MP * DM,
    O_MCP = O_FLP + (size_t)MP * 16, O_MNP = O_MCP + (size_t)NB * 4 * 256 * 128, O_MMP = O_MNP + (size_t)NB * 4 * 128, O_FKS = O_MMP + (size_t)NB * 4,
    O_FVS = O_FKS + (size_t)DB * DT * DM, O_FLS = O_FVS + (size_t)DB * DT * DM, O_MCS = O_FLS + (size_t)DB * DT * 16, O_MNS = O_MCS + (size_t)DB * 4 * 256 * 128,
    O_MMS = O_MNS + (size_t)DB * 4 * 128, O_END = O_MMS + (size_t)DB * 4;

namespace pg8 {
#define PG8_LAS __attribute__((address_space(3)))
typedef unsigned short bf16_t;
typedef short bf16x8 __attribute__((ext_vector_type(8)));
typedef float f32x4 __attribute__((ext_vector_type(4)));
typedef unsigned u32x4 __attribute__((ext_vector_type(4)));
constexpr int BM = 256, BK = 64, HALF = 128, HTB = HALF * BK * 2  , STAGE_BYTES = 8 * HTB, NXCD = 8, WGM = 8;

__host__ __device__ __forceinline__ int lds_byte(int r, int c) { const int st = (r >> 4) * 2 + (c >> 5), rr = r & 15, cc = c & 31, ob = rr * 64 + cc * 2; return st * 1024 + (ob ^ (((ob >> 9) & 1) << 5)); }
__host__ __device__ __forceinline__ void stage_rc(int b, int& R, int& C) { const int st = b / 1024, sb = b % 1024, swz = sb ^ (((sb >> 9) & 1) << 5); R = (st >> 1) * 16 + swz / 64; C = (st & 1) * 32 + (swz % 64) / 2; }
__host__ __device__ __forceinline__ int perm32(int rho) { const int n = rho >> 4, i = rho & 15; return 8 * (i >> 2) + 4 * n + (i & 3); }

struct Unit { int pm, pn, aux; };
struct Gemm { const bf16_t* A; const bf16_t* Bt; int M, N, K, ld; };

struct StaticOrder {
    int nM, nN, nwg, G, c, lim;
    __host__ __device__ void init(int M, int N, int G_, int c_) { nM = M / BM; nN = N / BM; nwg = nM * nN; G = G_; c = c_; lim = nwg; }
    __host__ __device__ bool next(int i, Unit& u) const { const long L = (long)i * G + c; if (L >= lim) return false; map((int)L, u); return true; }
    __host__ __device__ void map(int L, Unit& u) const {
        int wgid = L; { const int q = nwg / NXCD, r = nwg % NXCD, xcd = wgid % NXCD, off = wgid / NXCD; wgid = (xcd < r ? xcd * (q + 1) : r * (q + 1) + (xcd - r) * q) + off; }
        const int nig = WGM * nN, gid = wgid / nig, fm = gid * WGM, gsz = (nM - fm) < WGM ? (nM - fm) : WGM;
        u.pm = fm + ((wgid % nig) % gsz); u.pn = (wgid % nig) / gsz;
    }
    __device__ __forceinline__ void a_ready(const Unit&) const {}
    __device__ __forceinline__ void done(const Unit&) const {}
};


struct TailOrder {
    StaticOrder base; int first, ntail, slices, c;
    __device__ bool next(int i, Unit& u) const { if (i > 0) return false; const int tu = c / slices; if (tu >= ntail) return false; base.map(first + tu, u); u.aux = c; return true; }
    __device__ __forceinline__ void a_ready(const Unit&) const {}
    __device__ __forceinline__ void done(const Unit&) const {}
};

typedef float f32x2_cv __attribute__((ext_vector_type(2))); typedef __bf16 bf16x2_cv __attribute__((ext_vector_type(2)));
__device__ __forceinline__ unsigned cvt_pk_bf16(float lo, float hi) { const f32x2_cv v = {lo, hi}; const bf16x2_cv b = __builtin_convertvector(v, bf16x2_cv); return __builtin_bit_cast(unsigned, b); }
__device__ __forceinline__ u32x4 pack8(const f32x4 a, const f32x4 b) { u32x4 w; w.x = cvt_pk_bf16(a[0], a[1]); w.y = cvt_pk_bf16(a[2], a[3]); w.z = cvt_pk_bf16(b[0], b[1]); w.w = cvt_pk_bf16(b[2], b[3]); return w; }
__device__ __forceinline__ float row_rstd(const float* ssq, int row, int fq) {
    const f32x4 v = *(const f32x4*)(ssq + (size_t)row * 16 + 4 * fq);
    float s = (v[0] + v[1]) + (v[2] + v[3]);
    s += __shfl_xor(s, 16); s += __shfl_xor(s, 32);
    return __builtin_amdgcn_rsqf(s * (1.0f / 1024.0f) + EPSN);
}
__device__ __forceinline__ float log_sigmoid_f(float x) { return fminf(x, 0.f) - log1pf(__expf(-fabsf(x))); }

struct EpiFoxIn {
    static constexpr bool PERM = true, AFTER_DRAIN = false;
    const float* ssq; const float* gq; const float* gk; const float* bfv;
    unsigned char* ws; float* out;
    __device__ __forceinline__ void operator()(const f32x4 (&acc)[2][2][4][2], const Unit& u, int wr, int wc, int fr, int fq) const {
        const int pn = u.pn, sect = pn >> 2;
        f32x4 gv[2][2];
        if (sect < 2) {
#pragma unroll
            for (int bj = 0; bj < 2; ++bj)
#pragma unroll
                for (int n = 0; n < 2; ++n) { const f32x4 a = *(const f32x4*)(gq + 32 * bj + 8 * fq + 4 * n) * QSCALE, b = *(const f32x4*)(gk + 32 * bj + 8 * fq + 4 * n); gv[bj][n] = sect == 0 ? a : b; } }
        const int cb = (pn & 3) * 256 + wc * 64 + 8 * fq;
        float rsv[2][4];
#pragma unroll
        for (int ai = 0; ai < 2; ++ai)
#pragma unroll
            for (int m = 0; m < 4; ++m) rsv[ai][m] = row_rstd(ssq, u.pm * BM + ai * HALF + wr * 64 + m * 16 + fr, fq);
#pragma unroll
        for (int ai = 0; ai < 2; ++ai)
#pragma unroll
            for (int m = 0; m < 4; ++m) {
                const int row = u.pm * BM + ai * HALF + wr * 64 + m * 16 + fr;
                const float rs = rsv[ai][m];
                f32x4 v[2][2];
#pragma unroll
                for (int bj = 0; bj < 2; ++bj)
#pragma unroll
                    for (int n = 0; n < 2; ++n) v[bj][n] = acc[ai][bj][m][n] * rs;
                if (sect < 2) {
                    float ss = 0.f;
#pragma unroll
                    for (int bj = 0; bj < 2; ++bj)
#pragma unroll
                        for (int n = 0; n < 2; ++n) { const f32x4 x = v[bj][n]; ss += (x[0] * x[0] + x[1] * x[1]) + (x[2] * x[2] + x[3] * x[3]); }
                    ss += __shfl_xor(ss, 16); ss += __shfl_xor(ss, 32);
                    const float hr = __builtin_amdgcn_rsqf(ss * (1.0f / 64.0f) + EPSN);
#pragma unroll
                    for (int bj = 0; bj < 2; ++bj)
#pragma unroll
                        for (int n = 0; n < 2; ++n) v[bj][n] = v[bj][n] * hr * gv[bj][n];
                }
                const bool real = row < MTOT; const int grp = row < MP ? 0 : 1; const size_t orow = grp == 0 ? (size_t)row : (size_t)(row - MP);
                if (sect == 0) {
#pragma unroll
                    for (int bj = 0; bj < 2; ++bj) *(u32x4*)((bf16_t*)(ws + WS_QB) + (size_t)row * DM + cb + 32 * bj) = pack8(v[bj][0], v[bj][1]);
                } else if (sect < 3) {
                    bf16_t* B16 = (bf16_t*)(ws + (sect == 1 ? WS_KB : WS_VB)); float* of = out + (sect == 1 ? (grp == 0 ? O_FKP : O_FKS) : (grp == 0 ? O_FVP : O_FVS));
#pragma unroll
                    for (int bj = 0; bj < 2; ++bj) *(u32x4*)(B16 + (size_t)row * DM + cb + 32 * bj) = pack8(v[bj][0], v[bj][1]);
                    (void)of; (void)real;
                } else if (pn == 12 && wc == 0 && fq < 2 && real) {
#pragma unroll
                    for (int n = 0; n < 2; ++n) { const int h0 = 8 * fq + 4 * n; const f32x4 bb = *(const f32x4*)(bfv + h0); f32x4 o;
#pragma unroll
                        for (int j = 0; j < 4; ++j) o[j] = log_sigmoid_f(v[0][n][j] + bb[j]);
                        *(f32x4*)(out + (grp == 0 ? O_FLP : O_FLS) + orow * 16 + h0) = o; }
                }
            }
    }
};

__device__ __forceinline__ void first_resid(const float* xp, const float* xs, const float* meta, int row, int col, f32x4& x0, f32x4& x1) {
    x0 = (f32x4){0.f, 0.f, 0.f, 0.f}; x1 = x0;
    if (row < MP) { const int b = row / TP, t = row - b * TP;
        if (t < NMETA) { const float* p = meta + (size_t)t * DM + col; x0 = *(const f32x4*)p; x1 = *(const f32x4*)(p + 4); }
        else { const float* p = xp + ((size_t)b * SEQL + (t - NMETA)) * DM + col; x0 = *(const f32x4*)p; x1 = *(const f32x4*)(p + 4); } }
    else if (row < MTOT) { const float* p = xs + (size_t)(row - MP) * DM + col; x0 = *(const f32x4*)p; x1 = *(const f32x4*)(p + 4); }
}
template <bool FIRST> struct EpiResidT {
    static constexpr bool PERM = true, AFTER_DRAIN = false;
    float* X; bf16_t* XB; float* ssq; const float* xp; const float* xs; const float* meta;
    __device__ __forceinline__ void operator()(const f32x4 (&acc)[2][2][4][2], const Unit& u, int wr, int wc, int fr, int fq) const {
#pragma unroll
        for (int ai = 0; ai < 2; ++ai)
#pragma unroll
            for (int m = 0; m < 4; ++m) {
                const int row = u.pm * BM + ai * HALF + wr * 64 + m * 16 + fr; float ss = 0.f;
#pragma unroll
                for (int bj = 0; bj < 2; ++bj) { const size_t off = (size_t)row * DM + u.pn * BM + bj * HALF + wc * 32 + 8 * fq;
                    f32x4 x0, x1;
                    if (FIRST) first_resid(xp, xs, meta, row, u.pn * BM + bj * HALF + wc * 32 + 8 * fq, x0, x1); else { x0 = *(const f32x4*)(X + off); x1 = *(const f32x4*)(X + off + 4); }
                    x0 = x0 + acc[ai][bj][m][0]; x1 = x1 + acc[ai][bj][m][1];
                    *(f32x4*)(X + off) = x0; *(f32x4*)(X + off + 4) = x1; *(u32x4*)(XB + off) = pack8(x0, x1);
                    ss += (x0[0] * x0[0] + x0[1] * x0[1]) + (x0[2] * x0[2] + x0[3] * x0[3]) + (x1[0] * x1[0] + x1[1] * x1[1]) + (x1[2] * x1[2] + x1[3] * x1[3]); }
                ss += __shfl_xor(ss, 16); ss += __shfl_xor(ss, 32);
                if (fq == 0) ssq[(size_t)row * 16 + u.pn * 4 + wc] = ss;
                if (m & 1) asm volatile("" ::: "memory");
            }
    }
};

struct EpiUp {
    static constexpr bool PERM = true, AFTER_DRAIN = false;
    const float* ssq; bf16_t* H;
    __device__ __forceinline__ void operator()(const f32x4 (&acc)[2][2][4][2], const Unit& u, int wr, int wc, int fr, int fq) const {
#pragma unroll
        for (int ai = 0; ai < 2; ++ai)
#pragma unroll
            for (int m = 0; m < 4; ++m) {
                const int row = u.pm * BM + ai * HALF + wr * 64 + m * 16 + fr; const float rs = row_rstd(ssq, row, fq);
#pragma unroll
                for (int bj = 0; bj < 2; ++bj) { f32x4 a = acc[ai][bj][m][0] * rs, b = acc[ai][bj][m][1] * rs;
#pragma unroll
                    for (int j = 0; j < 4; ++j) { a[j] = fmaxf(a[j], 0.f); a[j] *= a[j]; b[j] = fmaxf(b[j], 0.f); b[j] *= b[j]; }
                    *(u32x4*)(H + (size_t)row * DFF + u.pn * BM + bj * HALF + wc * 32 + 8 * fq) = pack8(a, b); }
            }
    }
};

struct EpiMlstmIn {
    static constexpr bool PERM = true, AFTER_DRAIN = false;
    const float* ssq; const float* bi; const float* bfv;
    bf16_t* MQ; bf16_t* MK; bf16_t* MV; bf16_t* MO; float* GI; float* GF;
    __device__ __forceinline__ void operator()(const f32x4 (&acc)[2][2][4][2], const Unit& u, int wr, int wc, int fr, int fq) const {
        const int pn = u.pn;
#pragma unroll
        for (int ai = 0; ai < 2; ++ai)
#pragma unroll
            for (int m = 0; m < 4; ++m) {
                const int row = u.pm * BM + ai * HALF + wr * 64 + m * 16 + fr; const float rs = row_rstd(ssq, row, fq);
                if (pn < 12) {
#pragma unroll
                    for (int bj = 0; bj < 2; ++bj) { f32x4 a = acc[ai][bj][m][0] * rs, b = acc[ai][bj][m][1] * rs; const int c = pn * BM + bj * HALF + wc * 32 + 8 * fq;
                        if (pn < 2) *(u32x4*)(MQ + (size_t)row * 512 + c) = pack8(a, b);
                        else if (pn < 4) { a = a * 0.08838834764831845f; b = b * 0.08838834764831845f; *(u32x4*)(MK + (size_t)row * 512 + (c - 512)) = pack8(a, b); }
                        else if (pn < 8) *(u32x4*)(MV + (size_t)row * DM + (c - 1024)) = pack8(a, b);
                        else {
#pragma unroll
                            for (int j = 0; j < 4; ++j) { a[j] = 1.0f / (1.0f + __expf(-a[j])); b[j] = 1.0f / (1.0f + __expf(-b[j])); }
                            *(u32x4*)(MO + (size_t)row * DM + (c - 2048)) = pack8(a, b); } }
                } else if (wc == 0 && fq == 0) {
                    const f32x4 a = acc[ai][0][m][0] * rs, b = acc[ai][0][m][1] * rs; const f32x4 vbi = *(const f32x4*)bi, vbf = *(const f32x4*)bfv; f32x4 oi, of;
#pragma unroll
                    for (int j = 0; j < 4; ++j) { oi[j] = a[j] + vbi[j]; of[j] = log_sigmoid_f(b[j] + vbf[j]); }
                    *(f32x4*)(GI + (size_t)row * 4) = oi; *(f32x4*)(GF + (size_t)row * 4) = of;
                }
            }
    }
};


struct EpiPartial {
    static constexpr bool PERM = true, AFTER_DRAIN = false;
    float* P;
    __device__ __forceinline__ void operator()(const f32x4 (&acc)[2][2][4][2], const Unit& u, int wr, int wc, int fr, int fq) const {
#pragma unroll
        for (int ai = 0; ai < 2; ++ai)
#pragma unroll
            for (int m = 0; m < 4; ++m)
#pragma unroll
                for (int bj = 0; bj < 2; ++bj) { float* p = P + (size_t)u.aux * 65536 + (size_t)(ai * HALF + wr * 64 + m * 16 + fr) * 256 + bj * HALF + wc * 32 + 8 * fq;
                    *(f32x4*)p = acc[ai][bj][m][0]; *(f32x4*)(p + 4) = acc[ai][bj][m][1]; }
    }
};
template <class Epi, class Sched, bool ALIGN_EPI = false, bool SP2 = false>
__device__ __forceinline__ void gemm_phase(PG8_LAS unsigned char* lds, const Gemm g, const Sched& S, const Epi& E) {
    int tid_o = threadIdx.x; asm volatile("" : "+v"(tid_o));
    const int tid = tid_o, wid = __builtin_amdgcn_readfirstlane(tid >> 6), lane = tid & 63, wr = wid >> 2, wc = wid & 3, fr = lane & 15, fq = lane >> 4;
    const int K = g.K, nt = K / BK, ld = g.ld ? g.ld : g.K;
    unsigned voffA[2], voffB[2];
#pragma unroll
    for (int i = 0; i < 2; ++i) { int R, C; stage_rc(tid * 16 + i * 8192, R, C); const int Rb = Epi::PERM ? ((R & ~31) + perm32(R & 31)) : R;
        voffA[i] = (unsigned)(R * ld + C) * 2u; voffB[i] = (unsigned)(Rb * ld + C) * 2u; }
    const size_t kstep = (size_t)(BK * 2);
    const size_t hstep = (size_t)HALF * ld * 2;
    const size_t tstep = 2 * hstep;
    const unsigned ldsw = (unsigned)wid * 1024u;
    const int aoff = lds_byte(wr * 64 + fr, fq * 8), boff = lds_byte(wc * 32 + fr, fq * 8);
#define PG8_SA(b, h) (((b) * 2 + (h)) * HTB)
#define PG8_SB(b, h) ((4 + (b) * 2 + (h)) * HTB)
#define PG8_STAGE(bufoff, gbase, voff) do { _Pragma("unroll") for (int _i = 0; _i < 2; ++_i) \
        __builtin_amdgcn_global_load_lds((const unsigned*)((const char*)(gbase) + (voff)[_i]), (PG8_LAS unsigned*)(lds + (bufoff) + ldsw + _i * 8192), 16, 0, 0); } while (0)
#define PG8_LDA(dst, b, h) do { _Pragma("unroll") for (int m = 0; m < 4; ++m) _Pragma("unroll") for (int k = 0; k < 2; ++k) dst[m][k] = *(const PG8_LAS bf16x8*)(lds + PG8_SA(b, h) + aoff + m * 2048 + k * 1024); } while (0)
#define PG8_LDB(dst, b, h) do { _Pragma("unroll") for (int n = 0; n < 2; ++n) _Pragma("unroll") for (int k = 0; k < 2; ++k) dst[n][k] = *(const PG8_LAS bf16x8*)(lds + PG8_SB(b, h) + boff + n * 2048 + k * 1024); } while (0)
#define PG8_MMA(ai, bj, At, Bt) do { __builtin_amdgcn_s_setprio(1); _Pragma("unroll") for (int m = 0; m < 4; ++m) _Pragma("unroll") for (int n = 0; n < 2; ++n) _Pragma("unroll") for (int k = 0; k < 2; ++k) \
        acc[ai][bj][m][n] = __builtin_amdgcn_mfma_f32_16x16x32_bf16(Bt[n][k], At[m][k], acc[ai][bj][m][n], 0, 0, 0); __builtin_amdgcn_s_setprio(0); } while (0)
#define PG8_WAIT_V(n) asm volatile("s_waitcnt vmcnt(" #n ")" ::: "memory")
#define PG8_WAIT_L(n) asm volatile("s_waitcnt lgkmcnt(" #n ")" ::: "memory")
#define PG8_BAR __builtin_amdgcn_s_barrier()
#define PG8_SCHED __builtin_amdgcn_sched_barrier(0)
    Unit cur, nxt; int ui = 0;
    if (!S.next(0, cur)) return;
    f32x4 acc[2][2][4][2];
#pragma unroll
    for (int a = 0; a < 2; ++a)
#pragma unroll
        for (int b = 0; b < 2; ++b)
#pragma unroll
            for (int m = 0; m < 4; ++m)
#pragma unroll
                for (int n = 0; n < 2; ++n) acc[a][b][m][n] = (f32x4){0.f, 0.f, 0.f, 0.f};
    bf16x8 At[4][2], B0[2][2], B1[2][2];
    const char* cA = (const char*)g.A + (size_t)cur.pm * tstep; const char* cB = (const char*)g.Bt + (size_t)cur.pn * tstep;
    S.a_ready(cur);
    if constexpr (SP2) {
        PG8_STAGE(PG8_SB(0, 0), cB, voffB); PG8_STAGE(PG8_SB(0, 1), cB + hstep, voffB); PG8_STAGE(PG8_SA(0, 0), cA, voffA); PG8_STAGE(PG8_SA(0, 1), cA + hstep, voffA);
        if (wr == 1) PG8_BAR;
        PG8_WAIT_V(2); PG8_BAR;
        PG8_STAGE(PG8_SB(1, 0), cB + kstep, voffB); PG8_STAGE(PG8_SA(1, 0), cA + kstep, voffA); PG8_STAGE(PG8_SB(1, 1), cB + hstep + kstep, voffB);
        PG8_WAIT_V(6); PG8_BAR;
    } else {
        PG8_STAGE(PG8_SB(0, 0), cB, voffB); PG8_STAGE(PG8_SA(0, 0), cA, voffA); PG8_STAGE(PG8_SB(0, 1), cB + hstep, voffB); PG8_STAGE(PG8_SA(0, 1), cA + hstep, voffA);
        if (wr == 1) PG8_BAR;
        PG8_WAIT_V(4); PG8_BAR;
        PG8_STAGE(PG8_SB(1, 0), cB + kstep, voffB); PG8_STAGE(PG8_SA(1, 0), cA + kstep, voffA); PG8_STAGE(PG8_SB(1, 1), cB + hstep + kstep, voffB);
        PG8_WAIT_V(6); PG8_BAR;
    }
    for (;;) {
        const bool has_next = S.next(ui + 1, nxt);
        const char* nA = has_next ? (const char*)g.A + (size_t)nxt.pm * tstep : cA; const char* nB = has_next ? (const char*)g.Bt + (size_t)nxt.pn * tstep : cB;
        for (int t = 0; t < nt; t += 2) {
            const bool last = (t == nt - 2);
            const char* a1 = cA + (size_t)(t + 1) * kstep;
            const char* a2 = last ? nA : cA + (size_t)(t + 2) * kstep; const char* b2 = last ? nB : cB + (size_t)(t + 2) * kstep;
            const char* a3 = a2 + kstep; const char* b3 = b2 + kstep;
            if (last && has_next) S.a_ready(nxt);
            if constexpr (SP2) {
            PG8_LDB(B0, 0, 0); PG8_LDB(B1, 0, 1); PG8_SCHED; PG8_LDA(At, 0, 0); PG8_STAGE(PG8_SA(1, 1), a1 + hstep, voffA);
            PG8_WAIT_V(8); PG8_WAIT_L(0); PG8_BAR; PG8_MMA(0, 0, At, B0); PG8_MMA(0, 1, At, B1); PG8_BAR; PG8_SCHED;
            PG8_LDA(At, 0, 1); PG8_STAGE(PG8_SB(0, 0), b2, voffB); PG8_STAGE(PG8_SB(0, 1), b2 + hstep, voffB); PG8_STAGE(PG8_SA(0, 0), a2, voffA);
            PG8_WAIT_V(8); PG8_WAIT_L(0); PG8_BAR; PG8_MMA(1, 0, At, B0); PG8_MMA(1, 1, At, B1); PG8_BAR; PG8_SCHED;
            PG8_LDB(B0, 1, 0); PG8_LDB(B1, 1, 1); PG8_SCHED; PG8_LDA(At, 1, 0); PG8_STAGE(PG8_SA(0, 1), a2 + hstep, voffA);
            PG8_WAIT_V(8); PG8_WAIT_L(0); PG8_BAR; PG8_MMA(0, 0, At, B0); PG8_MMA(0, 1, At, B1); PG8_BAR; PG8_SCHED;
            PG8_LDA(At, 1, 1); PG8_STAGE(PG8_SB(1, 0), b3, voffB); PG8_STAGE(PG8_SB(1, 1), b3 + hstep, voffB); PG8_STAGE(PG8_SA(1, 0), a3, voffA);
            PG8_WAIT_V(8); PG8_WAIT_L(0); PG8_BAR; PG8_MMA(1, 0, At, B0); PG8_MMA(1, 1, At, B1); PG8_BAR; PG8_SCHED;
            } else {
            PG8_LDB(B0, 0, 0); PG8_SCHED; PG8_LDA(At, 0, 0); PG8_STAGE(PG8_SA(1, 1), a1 + hstep, voffA);
            PG8_WAIT_L(8); PG8_BAR; PG8_WAIT_L(0); PG8_MMA(0, 0, At, B0); PG8_BAR; PG8_SCHED;
            PG8_LDB(B1, 0, 1); PG8_STAGE(PG8_SB(0, 0), b2, voffB);
            PG8_BAR; PG8_WAIT_L(0); PG8_MMA(0, 1, At, B1); PG8_BAR;
            PG8_LDA(At, 0, 1); PG8_STAGE(PG8_SA(0, 0), a2, voffA);
            PG8_BAR; PG8_WAIT_L(0); PG8_MMA(1, 0, At, B0); PG8_BAR; PG8_SCHED;
            PG8_STAGE(PG8_SB(0, 1), b2 + hstep, voffB);
            PG8_WAIT_V(6); PG8_BAR; PG8_MMA(1, 1, At, B1); PG8_BAR;
            PG8_LDB(B0, 1, 0); PG8_SCHED; PG8_LDA(At, 1, 0); PG8_STAGE(PG8_SA(0, 1), a2 + hstep, voffA);
            PG8_WAIT_L(8); PG8_BAR; PG8_WAIT_L(0); PG8_MMA(0, 0, At, B0); PG8_BAR; PG8_SCHED;
            PG8_LDB(B1, 1, 1); PG8_STAGE(PG8_SB(1, 0), b3, voffB);
            PG8_BAR; PG8_WAIT_L(0); PG8_MMA(0, 1, At, B1); PG8_BAR;
            PG8_LDA(At, 1, 1); PG8_STAGE(PG8_SA(1, 0), a3, voffA);
            PG8_BAR; PG8_WAIT_L(0); PG8_MMA(1, 0, At, B0); PG8_BAR; PG8_SCHED;
            PG8_STAGE(PG8_SB(1, 1), b3 + hstep, voffB);
            PG8_WAIT_V(6); PG8_BAR; PG8_MMA(1, 1, At, B1); PG8_BAR;
            }
        }
        if constexpr (ALIGN_EPI) { if (wr == 0) PG8_BAR; }
        if constexpr (!Epi::AFTER_DRAIN) { E(acc, cur, wr, wc, fr, fq); S.done(cur); }
        if (!has_next) break;
#pragma unroll
        for (int a = 0; a < 2; ++a)
#pragma unroll
            for (int b = 0; b < 2; ++b)
#pragma unroll
                for (int m = 0; m < 4; ++m)
#pragma unroll
                    for (int n = 0; n < 2; ++n) acc[a][b][m][n] = (f32x4){0.f, 0.f, 0.f, 0.f};
        cur = nxt; cA = nA; cB = nB; ++ui;
        if constexpr (ALIGN_EPI) { if (wr == 1) PG8_BAR; }
    }
    PG8_WAIT_V(0);
    if constexpr (!ALIGN_EPI) { if (wr == 0) PG8_BAR; }
    PG8_BAR;
    if constexpr (Epi::AFTER_DRAIN) { E.fused(acc, cur, wr, wc, fr, fq, lds, wid, lane); S.done(cur); }
#undef PG8_SA
#undef PG8_SB
#undef PG8_STAGE
#undef PG8_LDA
#undef PG8_LDB
#undef PG8_MMA
#undef PG8_WAIT_V
#undef PG8_WAIT_L
#undef PG8_BAR
#undef PG8_SCHED
}
}

#ifndef PG8_SP2
#define PG8_SP2 true
#endif
#ifndef PG8_ALIGN
#define PG8_ALIGN true
#endif

#define LAS __attribute__((address_space(3)))
typedef unsigned short bf16;
typedef unsigned u32x4 __attribute__((ext_vector_type(4)));
typedef unsigned u32x2 __attribute__((ext_vector_type(2)));
typedef float f32x4 __attribute__((ext_vector_type(4)));
typedef float f32x16 __attribute__((ext_vector_type(16)));
typedef short bf16x8 __attribute__((ext_vector_type(8)));
typedef short v4i16_t __attribute__((ext_vector_type(4)));
typedef LAS unsigned char* lptr;
typedef const LAS unsigned char* clptr;

__device__ __forceinline__ unsigned f2bf(float f) { unsigned u = __builtin_bit_cast(unsigned, f); return (u + 0x7fffu + ((u >> 16) & 1u)) >> 16; }
__device__ __forceinline__ unsigned pk2(float lo, float hi) { return pg8::cvt_pk_bf16(lo, hi); }
__device__ __forceinline__ float bf2f(unsigned short b) { return __builtin_bit_cast(float, (unsigned)b << 16); }
__device__ __forceinline__ float wave_sum(float v) {
#pragma unroll
    for (int o = 1; o < 64; o <<= 1) v += __shfl_xor(v, o);
    return v;
}
#define LDS_WAIT() asm volatile("s_waitcnt lgkmcnt(0)" ::: "memory")
#define LDS_BARRIER() asm volatile("s_waitcnt lgkmcnt(0)\n\ts_barrier" ::: "memory")

__device__ __forceinline__ void p0_transpose_item(const float* W, int K, int N, bf16* WT, const float* g, bool foxperm, LAS float* scr, int item, int nblk, int lane) {
    const int kb = item / nblk, nb = item % nblk, k0 = 64 * kb, n0 = 32 * nb;
#pragma unroll 8
    for (int i = 0; i < 32; ++i) { const int kk = 2 * i + (lane >> 5); const int n = n0 + (lane & 31); float v = n < N ? W[(size_t)(k0 + kk) * N + n] : 0.f; if (g) v *= g[k0 + kk]; scr[kk * 33 + (lane & 31)] = v; }
    LDS_WAIT(); asm volatile("" ::: "memory");
    const int c = lane & 7;
    int prow0 = n0;
    if (foxperm) { const int l = n0 & 255; prow0 = (n0 & ~255) + 128 * ((l >> 5) & 1) + 32 * ((l >> 6) & 3); }
#pragma unroll
    for (int j = 0; j < 4; ++j) { const int n = (lane >> 3) + 8 * j; const LAS float* s = scr + (8 * c) * 33 + n;
        u32x4 o; o.x = pk2(s[0 * 33], s[1 * 33]); o.y = pk2(s[2 * 33], s[3 * 33]); o.z = pk2(s[4 * 33], s[5 * 33]); o.w = pk2(s[6 * 33], s[7 * 33]);
        *(u32x4*)(WT + (size_t)(prow0 + n) * K + k0 + 8 * c) = o; }
    LDS_WAIT(); asm volatile("" ::: "memory");
}

__device__ __forceinline__ void p0_prologue(const Args& A, lptr lds, int gw, int NGW, int wave, int lane) {
    unsigned char* ws = A.ws;
    LAS float* scr = (LAS float*)(lds + wave * 16384);
    int base = 0;
#define WJOB(Wp, K_, N_, NP_, dst_, g_, perm_) do { const int nblk = (NP_) / 32, nitems = ((K_) / 64) * nblk; int first = (gw - base) % NGW; if (first < 0) first += NGW; \
        for (int it = first; it < nitems; it += NGW) p0_transpose_item((Wp), (K_), (N_), (bf16*)(ws + (dst_)), (g_), (perm_), scr, it, nblk, lane); base = (base + nitems) % NGW; } while (0)
    WJOB(A.in[11], DM, 3088, NIN, WS_WFIN, A.in[9], true);
    WJOB(A.in[15], DM, DM, DM, WS_WFOUT, (const float*)nullptr, false);
    WJOB(A.in[16], DM, 3080, NIN, WS_WMIN, A.in[9] + DM, false);
    WJOB(A.in[20], DM, DM, DM, WS_WMOUT, A.in[19], false);
    WJOB(A.in[21], DM, DFF, DFF, WS_WUP0, A.in[10], false);
    WJOB(A.in[21] + (size_t)DM * DFF, DM, DFF, DFF, WS_WUP1, A.in[10] + DM, false);
    WJOB(A.in[22], DFF, DM, DM, WS_WDN0, (const float*)nullptr, false);
    WJOB(A.in[22] + (size_t)DFF * DM, DFF, DM, DM, WS_WDN1, (const float*)nullptr, false);
#undef WJOB
    bf16* XB = (bf16*)(ws + WS_XB); float* ssq = (float*)(ws + WS_SSQ);
    for (int row0 = gw; row0 < MPAD; row0 += 4 * NGW) {
        f32x4 v[4][4];
#pragma unroll
        for (int u = 0; u < 4; ++u) { const int row = row0 + u * NGW; const float* src = nullptr;
            if (row < MP) { const int b = row / TP, t = row - b * TP; src = t < NMETA ? A.in[8] + (size_t)t * DM : A.in[0] + ((size_t)b * SEQL + (t - NMETA)) * DM; }
            else if (row < MTOT) src = A.in[1] + (size_t)(row - MP) * DM;
#pragma unroll
            for (int j = 0; j < 4; ++j) v[u][j] = src ? *(const f32x4*)(src + 256 * j + 4 * lane) : (f32x4){0.f, 0.f, 0.f, 0.f}; }
#pragma unroll
        for (int u = 0; u < 4; ++u) { const int row = row0 + u * NGW; if (row >= MPAD) break;
            float s = 0.f;
#pragma unroll
            for (int j = 0; j < 4; ++j) { const f32x4 x = v[u][j];
                u32x2 o;
                o.x = pk2(x[0], x[1]); o.y = pk2(x[2], x[3]); *(u32x2*)(XB + (size_t)row * DM + 256 * j + 4 * lane) = o;
                s += (x[0] * x[0] + x[1] * x[1]) + (x[2] * x[2] + x[3] * x[3]); }
            s = wave_sum(s);
            if (lane < 16) ssq[(size_t)row * 16 + lane] = lane == 0 ? s : 0.f; }
    }
    { const u32x4 z = {0u, 0u, 0u, 0u}; const int nchunk = PPAD * DM * 2 / 16;
        for (int i = gw * 64 + lane; i < nchunk; i += NGW * 64) { *(u32x4*)(ws + WS_KB - (size_t)PPAD * DM * 2 + (size_t)i * 16) = z; *(u32x4*)(ws + WS_VB - (size_t)PPAD * DM * 2 + (size_t)i * 16) = z; }
        const int nch2 = (MPAD - MTOT) * DM * 2 / 16;
        for (int i = gw * 64 + lane; i < nch2; i += NGW * 64) { *(u32x4*)(ws + WS_OB + (size_t)MTOT * DM * 2 + (size_t)i * 16) = z; *(u32x4*)(ws + WS_MH + (size_t)MTOT * DM * 2 + (size_t)i * 16) = z; } }
}

__device__ __forceinline__ float wave_scan_add(float v, int lane) {
#pragma unroll
    for (int o = 1; o < 64; o <<= 1) { const float t = __shfl_up(v, o); if (lane >= o) v += t; }
    return v;
}
__device__ __forceinline__ float wave_scan_max(float v, int lane) {
#pragma unroll
    for (int o = 1; o < 64; o <<= 1) { const float t = __shfl_up(v, o); if (lane >= o) v = fmaxf(v, t); }
    return v;
}
__device__ __forceinline__ void p2_cumsum(const Args& A, int gw, int NGW, int lane) {
    float* G = (float*)(A.ws + WS_G); float* GS = (float*)(A.ws + WS_GS);
    const float* lp = A.out + O_FLP; const float* lsn = A.out + O_FLS; const float* lc = A.in[4];
    for (int it = gw; it < NB * 16 + DB * 16; it += NGW) {
        if (it < NB * 16) { const int b = it >> 4, h = it & 15; float* g = G + (size_t)it * PLEN;
            for (int i = lane; i < PPAD; i += 64) g[i] = 0.f;
            float carry = 0.f;
#pragma unroll 1
            for (int c0 = 0; c0 < 65; c0 += 13) { float v[13];
#pragma unroll
                for (int c = 0; c < 13; ++c) { const int t = 64 * (c0 + c) + lane; v[c] = t < TP ? lp[((size_t)b * TP + t) * 16 + h] : 0.f; }
#pragma unroll
                for (int c = 0; c < 13; ++c) { const int t = 64 * (c0 + c) + lane; const float x = wave_scan_add(v[c], lane) + carry; if (t < TP) g[PPAD + t] = -LOG2E * x; carry = __shfl(x, 63); } }
        } else { const int i2 = it - NB * 16, b = i2 >> 4, h = i2 & 15; float* g = GS + (size_t)i2 * GSLEN;
            float carry = 0.f;
#pragma unroll 1
            for (int c0 = 0; c0 < 33; c0 += 11) { float v[11];
#pragma unroll
                for (int c = 0; c < 11; ++c) { const int s = 64 * (c0 + c) + lane; v[c] = 0.f; if (s < PAST) v[c] = lc[((size_t)b * PAST + s) * 16 + h]; else if (s < PAST + DT) v[c] = lsn[((size_t)b * DT + (s - PAST)) * 16 + h]; }
#pragma unroll
                for (int c = 0; c < 11; ++c) { const int s = 64 * (c0 + c) + lane; const float x = wave_scan_add(v[c], lane) + carry; g[s] = s < PAST + DT ? -LOG2E * x : 0.f; carry = __shfl(x, 63); } }
        }
    }
}

__device__ __forceinline__ int crow(int r, int hi) { return (r & 3) + 8 * (r >> 2) + 4 * hi; }
__device__ __forceinline__ v4i16_t vtr(clptr p) { return __builtin_amdgcn_ds_read_tr16_b64_v4i16((LAS v4i16_t*)p); }
constexpr int AT_KSTR = 144, AT_V = 9216, AT_B = 17408, AT_BUF = 17664;

template <bool MASK>
__device__ __forceinline__ void attn_tile(clptr Kt, clptr Vt, clptr Bt, const bf16x8 (&qr)[4], f32x16& o0, f32x16& o1, float& m, float& l, int qpos, int kpos0, int kmin, int lane) {
    const int r32 = lane & 31, hi = lane >> 5;
    f32x16 p0, p1;
#pragma unroll
    for (int r = 0; r < 16; ++r) { p0[r] = 0.f; p1[r] = 0.f; }
#pragma unroll
    for (int d0 = 0; d0 < 4; ++d0) {
        const bf16x8 a0 = *(const LAS bf16x8*)(Kt + r32 * AT_KSTR + d0 * 32 + hi * 16);
        const bf16x8 a1 = *(const LAS bf16x8*)(Kt + (32 + r32) * AT_KSTR + d0 * 32 + hi * 16);
        p0 = __builtin_amdgcn_mfma_f32_32x32x16_bf16(a0, qr[d0], p0, 0, 0, 0);
        p1 = __builtin_amdgcn_mfma_f32_32x32x16_bf16(a1, qr[d0], p1, 0, 0, 0);
    }
#pragma unroll
    for (int g = 0; g < 4; ++g) { const f32x4 b0 = *(const LAS f32x4*)(Bt + (8 * g + 4 * hi) * 4), b1 = *(const LAS f32x4*)(Bt + (32 + 8 * g + 4 * hi) * 4);
#pragma unroll
        for (int i = 0; i < 4; ++i) { p0[4 * g + i] += b0[i]; p1[4 * g + i] += b1[i]; } }
    if (MASK) {
#pragma unroll
        for (int r = 0; r < 16; ++r) { const int kp = kpos0 + crow(r, hi); if (kp > qpos || kp < kmin) p0[r] = -INFINITY; if (kp + 32 > qpos || kp + 32 < kmin) p1[r] = -INFINITY; }
    }
    float mx = fmaxf(p0[0], p1[0]);
#pragma unroll
    for (int r = 1; r < 16; ++r) mx = fmaxf(mx, fmaxf(p0[r], p1[r]));
    mx = fmaxf(mx, __shfl_xor(mx, 32));
    const float mnew = fmaxf(m, mx);
    if (__any(mnew > m)) {
        const float alpha = __builtin_amdgcn_exp2f(m - mnew); m = mnew; l *= alpha;
#pragma unroll
        for (int r = 0; r < 16; ++r) { o0[r] *= alpha; o1[r] *= alpha; } }
    float ls = 0.f;
#pragma unroll
    for (int r = 0; r < 16; ++r) { p0[r] = __builtin_amdgcn_exp2f(p0[r] - m); p1[r] = __builtin_amdgcn_exp2f(p1[r] - m); ls += p0[r] + p1[r]; }
    l += ls;
    u32x4 pw[4];
#pragma unroll
    for (int i = 0; i < 4; ++i) { pw[0][i] = pk2(p0[2 * i], p0[2 * i + 1]); pw[1][i] = pk2(p0[8 + 2 * i], p0[9 + 2 * i]); pw[2][i] = pk2(p1[2 * i], p1[2 * i + 1]); pw[3][i] = pk2(p1[8 + 2 * i], p1[9 + 2 * i]); }
    const clptr vb = Vt + ((lane >> 5) * 4 + ((lane & 15) >> 2)) * 64 + (((lane >> 4) & 1) * 16 + (lane & 3) * 4) * 2;
#pragma unroll
    for (int ks = 0; ks < 4; ++ks) {
        const v4i16_t l0 = vtr(vb + ks * 1024), h0 = vtr(vb + ks * 1024 + 512), l1 = vtr(vb + 4096 + ks * 1024), h1 = vtr(vb + 4096 + ks * 1024 + 512);
        const bf16x8 v0 = {l0[0], l0[1], l0[2], l0[3], h0[0], h0[1], h0[2], h0[3]}, v1 = {l1[0], l1[1], l1[2], l1[3], h1[0], h1[1], h1[2], h1[3]};
        const bf16x8 pb = __builtin_bit_cast(bf16x8, pw[ks]);
        o0 = __builtin_amdgcn_mfma_f32_32x32x16_bf16(v0, pb, o0, 0, 0, 0);
        o1 = __builtin_amdgcn_mfma_f32_32x32x16_bf16(v1, pb, o1, 0, 0, 0);
    }
}

__device__ __forceinline__ void kv_out_rows(const bf16* KB, const bf16* VB, float* outK, float* outV, size_t wsrow0, size_t outrow0, int nrows, int h, int tid) {
    const int ch = tid & 7, tsel = (tid >> 3) & 1, r0 = tid >> 4;
    const bf16* src = (tsel ? VB : KB) + h * 64 + ch * 8; float* dst = (tsel ? outV : outK) + h * 64 + ch * 8;
    asm volatile("" ::: "memory");
#pragma unroll 1
    for (int i0 = 0; i0 < 8; i0 += 4) { u32x4 v[4];
#pragma unroll
        for (int i = 0; i < 4; ++i) { const int r = r0 + 32 * (i0 + i); v[i] = r < nrows ? *(const u32x4*)(src + (wsrow0 + r) * DM) : (u32x4){0u, 0u, 0u, 0u}; }
#pragma unroll
        for (int i = 0; i < 4; ++i) { const int r = r0 + 32 * (i0 + i); if (r < nrows) { f32x4 a, b;
            a[0] = bf2f((unsigned short)(v[i].x & 0xffffu)); a[1] = bf2f((unsigned short)(v[i].x >> 16)); a[2] = bf2f((unsigned short)(v[i].y & 0xffffu)); a[3] = bf2f((unsigned short)(v[i].y >> 16));
            b[0] = bf2f((unsigned short)(v[i].z & 0xffffu)); b[1] = bf2f((unsigned short)(v[i].z >> 16)); b[2] = bf2f((unsigned short)(v[i].w & 0xffffu)); b[3] = bf2f((unsigned short)(v[i].w >> 16));
            *(f32x4*)(dst + (outrow0 + r) * DM) = a; *(f32x4*)(dst + (outrow0 + r) * DM + 4) = b; } } }
}

constexpr float AT_SKIP_T = 40.0f;
__device__ __forceinline__ void attn_prompt_unit(int b, int h, int j, const bf16* QB, const bf16* KB, const bf16* VB, const float* G, bf16* OB, lptr lds, int tid, int w, int lane, float kb, float* outK, float* outV) {
    const int r32 = lane & 31, hi = lane >> 5;
    const int qp = 256 * j + 32 * w + r32, t = qp - PPAD; const bool qvalid = t >= 0; const bool wave_active = (256 * j + 32 * w + 31) >= PPAD;
    const size_t qrow = (size_t)b * TP + (t > 0 ? t : 0);
    bf16x8 qr[4];
#pragma unroll
    for (int d0 = 0; d0 < 4; ++d0) qr[d0] = *(const bf16x8*)(QB + qrow * DM + h * 64 + d0 * 16 + hi * 8);
    const int lrow = tid >> 3, lch = tid & 7;
    const long krow0 = (long)b * TP - PPAD + lrow;
    const bf16* kg = KB + krow0 * DM + h * 64 + lch * 8; const bf16* vg = VB + krow0 * DM + h * 64 + lch * 8; const float* gg = G + (size_t)(b * 16 + h) * PLEN;
    f32x16 o0, o1;
#pragma unroll
    for (int r = 0; r < 16; ++r) { o0[r] = 0.f; o1[r] = 0.f; }
    float m = -1e30f, l = 0.f;
    const int kt1 = 4 * j + 3, ktw = 4 * j + (w >> 1), kmin = qp >= PPAD ? PPAD : 0;
    int kt0 = 3;
    { const int ta = 3 + lane, tb = 67 + lane;
        const float g0 = gg[j == 0 ? PPAD : 256 * j], ga = ta < 4 * j ? gg[64 * ta + 63] : 3.0e38f, gb = tb < 4 * j ? gg[64 * tb + 63] : 3.0e38f;
        const float thr = g0 - 2.0f * kb - AT_SKIP_T;
        const bool sa = ga <= thr, sb = gb <= thr;
        kt0 = 3 + __popcll(__ballot(sa)) + __popcll(__ballot(sb)); }
    u32x4 kreg[2][2], vreg[2][2]; float breg[2] = {0.f, 0.f};
    LAS int* vote = (LAS int*)(lds + 4 * AT_BUF);
#define AT_LOADPAIR(S, KH) do { _Pragma("unroll") for (int i_ = 0; i_ < 2; ++i_) { const int kk_ = (KH) - i_ >= kt0 ? (KH) - i_ : kt0; kreg[S][i_] = *(const u32x4*)(kg + (size_t)kk_ * 64 * DM); vreg[S][i_] = *(const u32x4*)(vg + (size_t)kk_ * 64 * DM); } \
        if (tid < 128) { const int kk_ = (KH) - (tid >> 6) >= kt0 ? (KH) - (tid >> 6) : kt0; breg[S] = gg[kk_ * 64 + (tid & 63)]; } } while (0)
#define AT_STEP(S, KH, STEPI) { const int kh_ = (KH); const lptr base = lds + (S) * 2 * AT_BUF; \
        _Pragma("unroll") for (int i = 0; i < 2; ++i) { *(LAS u32x4*)(base + i * AT_BUF + lrow * AT_KSTR + lch * 16) = kreg[S][i]; *(LAS u32x4*)(base + i * AT_BUF + AT_V + (lch >> 2) * 4096 + lrow * 64 + (lch & 3) * 16) = vreg[S][i]; } \
        if (tid < 128) *(LAS float*)(base + (tid >> 6) * AT_BUF + AT_B + (tid & 63) * 4) = breg[S]; \
        LDS_BARRIER(); \
        if ((STEPI) > 0) { const LAS int* vp_ = vote + (((STEPI) - 1) & 1) * 8; int all_ = 1; _Pragma("unroll") for (int i = 0; i < 8; ++i) all_ &= vp_[i]; if (all_) break; } \
        if (kh_ - 4 >= kt0) AT_LOADPAIR(S, kh_ - 4); \
        int done_ = wave_active ? 0 : 1; \
        _Pragma("unroll") for (int i = 0; i < 2; ++i) { const int k2 = kh_ - i; const lptr b2 = base + i * AT_BUF; \
            if (wave_active && k2 <= ktw && k2 >= kt0) { \
                if (k2 == 3 || k2 == ktw) attn_tile<true>(b2, b2 + AT_V, b2 + AT_B, qr, o0, o1, m, l, qp, 64 * k2, kmin, lane); \
                else attn_tile<false>(b2, b2 + AT_V, b2 + AT_B, qr, o0, o1, m, l, qp, 64 * k2, kmin, lane); \
                done_ = k2 > kt0 ? (__all(kb + *(const LAS float*)(b2 + AT_B) <= m - AT_SKIP_T) ? 1 : 0) : 1; } } \
        if (lane == 0) vote[((STEPI) & 1) * 8 + w] = done_; }
    AT_LOADPAIR(0, kt1);
    if (kt1 - 2 >= kt0) AT_LOADPAIR(1, kt1 - 2);
    for (int kh = kt1, si = 0; kh >= kt0; kh -= 4, si += 2) { AT_STEP(0, kh, si) if (kh - 2 >= kt0) AT_STEP(1, kh - 2, si + 1) }
#undef AT_STEP
#undef AT_LOADPAIR
    const float lt = l + __shfl_xor(l, 32), inv = 1.0f / lt;
    if (wave_active && qvalid) { bf16* op = OB + qrow * DM + h * 64 + 4 * hi;
#pragma unroll
        for (int g = 0; g < 4; ++g) { u32x2 a, c; a.x = pk2(o0[4 * g] * inv, o0[4 * g + 1] * inv); a.y = pk2(o0[4 * g + 2] * inv, o0[4 * g + 3] * inv); c.x = pk2(o1[4 * g] * inv, o1[4 * g + 1] * inv); c.y = pk2(o1[4 * g + 2] * inv, o1[4 * g + 3] * inv);
            *(u32x2*)(op + 8 * g) = a; *(u32x2*)(op + 32 + 8 * g) = c; } }
    { const int t0 = j == 0 ? 0 : 256 * j - PPAD, nr = j == 0 ? 256 - PPAD : 256;
        kv_out_rows(KB, VB, outK, outV, (size_t)b * TP + t0, (size_t)b * TP + t0, nr, h, tid); }
    __syncthreads();
}

__device__ __forceinline__ void attn_sample_unit(int b, int h, const float* cK, const float* cV, const bf16* QB, const bf16* KB, const bf16* VB, const float* GS, bf16* OB, lptr lds, int tid, int w, int lane, float kb, float* outK, float* outV) {
    const int r32 = lane & 31, hi = lane >> 5;
    const lptr base = lds + w * AT_BUF;
    const size_t qrow = (size_t)MP + b * DT + r32;
    bf16x8 qr[4];
#pragma unroll
    for (int d0 = 0; d0 < 4; ++d0) qr[d0] = *(const bf16x8*)(QB + qrow * DM + h * 64 + d0 * 16 + hi * 8);
    f32x16 o0, o1;
#pragma unroll
    for (int r = 0; r < 16; ++r) { o0[r] = 0.f; o1[r] = 0.f; }
    float m = -1e30f, l = 0.f;
    const float* gs = GS + (size_t)(b * 16 + h) * GSLEN;
    int ti0 = 0;
    { const float thr = gs[PAST] - 2.0f * kb - AT_SKIP_T; const bool sk = lane < 32 && gs[64 * lane + 63] <= thr; ti0 = __popcll(__ballot(sk)); }
#pragma unroll 1
    for (int ti = ti0 + w; ti < 33; ti += 8) {
        const float bias_l = gs[64 * ti + lane];
        if (ti < 32) {
            const float* ck0 = cK + (((size_t)b * PAST + 64 * ti + (lane >> 4)) * 16 + h) * 64 + 4 * (lane & 15); const float* cv0 = cV + (ck0 - cK);
            const lptr kw0 = base + (lane >> 4) * AT_KSTR + (lane & 15) * 8, vw0 = base + AT_V + ((lane & 15) >> 3) * 4096 + (lane >> 4) * 64 + (lane & 7) * 8;
#pragma unroll
            for (int half = 0; half < 2; ++half) {
                f32x4 kv[8], vv[8];
#pragma unroll
                for (int i = 0; i < 8; ++i) { kv[i] = *(const f32x4*)(ck0 + (half * 32 + i * 4) * 1024); vv[i] = *(const f32x4*)(cv0 + (half * 32 + i * 4) * 1024); }
#pragma unroll
                for (int i = 0; i < 8; ++i) { u32x2 a, c; a.x = pk2(kv[i][0], kv[i][1]); a.y = pk2(kv[i][2], kv[i][3]); c.x = pk2(vv[i][0], vv[i][1]); c.y = pk2(vv[i][2], vv[i][3]);
                    *(LAS u32x2*)(kw0 + (half * 32 + i * 4) * AT_KSTR) = a; *(LAS u32x2*)(vw0 + (half * 32 + i * 4) * 64) = c; }
                asm volatile("" ::: "memory");
            }
        } else {
            const size_t off0 = ((size_t)MP + b * DT + (lane >> 3)) * DM + h * 64 + (lane & 7) * 8;
            const lptr kw0 = base + (lane >> 3) * AT_KSTR + (lane & 7) * 16, vw0 = base + AT_V + ((lane & 7) >> 2) * 4096 + (lane >> 3) * 64 + (lane & 3) * 16;
#pragma unroll
            for (int i = 0; i < 8; ++i) { const u32x4 a = *(const u32x4*)(KB + off0 + (size_t)i * 8 * DM), c = *(const u32x4*)(VB + off0 + (size_t)i * 8 * DM);
                *(LAS u32x4*)(kw0 + i * 8 * AT_KSTR) = a; *(LAS u32x4*)(vw0 + i * 8 * 64) = c; }
        }
        *(LAS float*)(base + AT_B + lane * 4) = bias_l;
        LDS_WAIT();
        if (ti < 32) attn_tile<false>(base, base + AT_V, base + AT_B, qr, o0, o1, m, l, 0, 0, 0, lane);
        else attn_tile<true>(base, base + AT_V, base + AT_B, qr, o0, o1, m, l, r32, 0, 0, lane);
        asm volatile("" ::: "memory");
    }
    const float lt = l + __shfl_xor(l, 32);
    LDS_WAIT();
    LAS float* of = (LAS float*)base;
#pragma unroll
    for (int r = 0; r < 16; ++r) { of[crow(r, hi) * 32 + r32] = o0[r]; of[(32 + crow(r, hi)) * 32 + r32] = o1[r]; }
    if (hi == 0) { of[2048 + r32] = m; of[2080 + r32] = lt; }
    __syncthreads();
    { const int q = tid & 31, dg = tid >> 5; float M = -1e30f;
#pragma unroll
        for (int ww = 0; ww < 8; ++ww) M = fmaxf(M, ((LAS float*)(lds + ww * AT_BUF))[2048 + q]);
        float L = 0.f, o[4] = {0.f, 0.f, 0.f, 0.f};
#pragma unroll
        for (int ww = 0; ww < 8; ++ww) { const LAS float* p = (LAS float*)(lds + ww * AT_BUF); const float f = __builtin_amdgcn_exp2f(p[2048 + q] - M); L += f * p[2080 + q];
#pragma unroll
            for (int i = 0; i < 4; ++i) o[i] += f * p[(4 * dg + i) * 32 + q]; }
        const float inv = 1.0f / L; u32x2 a; a.x = pk2(o[0] * inv, o[1] * inv); a.y = pk2(o[2] * inv, o[3] * inv);
        *(u32x2*)(OB + ((size_t)MP + b * DT + q) * DM + h * 64 + 4 * dg) = a; }
    kv_out_rows(KB, VB, outK, outV, (size_t)MP + b * DT, (size_t)b * DT, DT, h, tid);
    __syncthreads();
}

__device__ __forceinline__ void p3_attention(const Args& A, lptr lds, int tid, int w, int lane, int rep) {
    unsigned char* ws = A.ws;
    const bf16* QB = (const bf16*)(ws + WS_QB); const bf16* KB = (const bf16*)(ws + WS_KB); const bf16* VB = (const bf16*)(ws + WS_VB); bf16* OB = (bf16*)(ws + WS_OB);
    const float* G = (const float*)(ws + WS_G); const float* GS = (const float*)(ws + WS_GS);
    unsigned* ctr = (unsigned*)(ws + WS_CTL) + 64 * rep;
    LAS unsigned* su = (LAS unsigned*)(lds + LDS_BYTES - 64);
    constexpr int NPU = 17 * NB * 16, NSU = DB * 16, NU = NPU + NSU;
    float gqm = 0.f, gkm = 0.f;
    for (int i = 0; i < 64; ++i) { gqm = fmaxf(gqm, fabsf(A.in[13][i])); gkm = fmaxf(gkm, fabsf(A.in[14][i])); }
    const float kb = 8.0f * LOG2E * gqm * gkm * 1.02f;
    for (;;) {
        if (tid == 0) *su = atomicAdd(ctr, 1u);
        __syncthreads();
        const int u = (int)*su;
        __syncthreads();
        if (u >= NU) break;
        const bool is_s = (u % 5 == 4) && (u / 5 < NSU);
        if (is_s) { const int s = u / 5; attn_sample_unit(s >> 4, s & 15, A.in[2], A.in[3], QB, KB, VB, GS, OB, lds, tid, w, lane, kb, A.out + O_FKS, A.out + O_FVS); }
        else { const int k = u / 5, pidx = u - (k < NSU ? k : NSU); const int j = 16 - pidx / (NB * 16), bh = pidx % (NB * 16); attn_prompt_unit(bh >> 4, bh & 15, j, QB, KB, VB, G, OB, lds, tid, w, lane, kb, A.out + O_FKP, A.out + O_FVP); }
    }
#ifdef PROBE_SAMPLE
    for (;;) { if (tid == 0) *su = atomicAdd(ctr + 128, 1u); __syncthreads(); const int u = (int)*su; __syncthreads(); if (u >= NSU) break;
        attn_sample_unit(u >> 4, u & 15, A.in[2], A.in[3], QB, KB, VB, GS, OB, lds, tid, w, lane, kb, A.out + O_FKS, A.out + O_FVS); }
#endif
}

constexpr int ML_QS = 272, ML_TS = 144;
constexpr int MA_VS = 544;
constexpr int MA_Q = 0, MA_K = 17408, MA_KW = 34816, MA_V = 52224, MA_SP = 87040, MA_VEC = 96256;
__device__ __forceinline__ bf16x8 tr_frag(clptr p, int rowstride4) { const v4i16_t lo = vtr(p), hi = vtr(p + rowstride4); return (bf16x8){lo[0], lo[1], lo[2], lo[3], hi[0], hi[1], hi[2], hi[3]}; }
constexpr int NUA = NB * 4 * 65 + DB * 4;
__device__ __forceinline__ f32x4 mfma16(bf16x8 a, bf16x8 b, f32x4 c) { return __builtin_amdgcn_mfma_f32_16x16x32_bf16(a, b, c, 0, 0, 0); }

__device__ __forceinline__ void mlstm_a_phase(const Args& A, int first, int stride, lptr lds, int tid, int w, int lane) {
    unsigned char* ws = A.ws;
    u32x4 pq[2], pk[2], pv[4]; float pgi = -1e30f, pgf = 0.f;
#define MA_LOAD(UID) do { const int uid_ = (UID); const bool pr_ = uid_ < NB * 4 * 65; const int bh_ = pr_ ? uid_ / 65 : uid_ - NB * 4 * 65, c_ = pr_ ? uid_ - bh_ * 65 : 0, b_ = bh_ >> 2, h_ = bh_ & 3; \
        const size_t rb_ = pr_ ? (size_t)b_ * TP : (size_t)MP + (size_t)b_ * DT; const int t0_ = pr_ ? 64 * c_ - 48 : 0, tl_ = pr_ ? TP : DT; \
        { const int tk_ = t0_ + lane; pgi = -1e30f; pgf = 0.f; if (tk_ >= 0 && tk_ < tl_) { pgi = ((const float*)(ws + WS_GI))[(rb_ + tk_) * 4 + h_]; pgf = ((const float*)(ws + WS_GF))[(rb_ + tk_) * 4 + h_]; } } \
        _Pragma("unroll") for (int i_ = 0; i_ < 2; ++i_) { const int id_ = tid + 512 * i_, r_ = id_ >> 4, ch_ = id_ & 15; const int tk_ = t0_ + r_; pq[i_] = (u32x4){0u, 0u, 0u, 0u}; pk[i_] = (u32x4){0u, 0u, 0u, 0u}; \
            if (tk_ >= 0 && tk_ < tl_) { pq[i_] = *(const u32x4*)((const bf16*)(ws + WS_MQ) + (rb_ + tk_) * 512 + h_ * 128 + ch_ * 8); pk[i_] = *(const u32x4*)((const bf16*)(ws + WS_MK) + (rb_ + tk_) * 512 + h_ * 128 + ch_ * 8); } } \
        _Pragma("unroll") for (int i_ = 0; i_ < 4; ++i_) { const int id_ = tid + 512 * i_, r_ = id_ >> 5, ch_ = id_ & 31; const int tk_ = t0_ + r_; pv[i_] = (u32x4){0u, 0u, 0u, 0u}; \
            if (tk_ >= 0 && tk_ < tl_) pv[i_] = *(const u32x4*)((const bf16*)(ws + WS_MV) + (rb_ + tk_) * DM + h_ * 256 + ch_ * 8); } } while (0)
    if (first < NUA) MA_LOAD(first);
#pragma unroll 1
    for (int uid = first; uid < NUA; uid += stride) {
    bf16* MH = (bf16*)(ws + WS_MH);
    float* RS = (float*)(ws + WS_RS); float* NU = (float*)(ws + WS_NU); bf16* U = (bf16*)(ws + WS_U) + (size_t)uid * 32768;
    const bool prompt = uid < NB * 4 * 65; const int bh = prompt ? uid / 65 : uid - NB * 4 * 65, c = prompt ? uid - bh * 65 : 0, b = bh >> 2, h = bh & 3;
    const size_t row_base = prompt ? (size_t)b * TP : (size_t)MP + (size_t)b * DT; const int tok0 = prompt ? 64 * c - 48 : 0, tlim = prompt ? TP : DT;
    LAS float* vec = (LAS float*)(lds + MA_VEC); LAS float* v_b = vec, *v_a = vec + 64, *v_ml = vec + 128, *v_rs = vec + 192;
    const int l15 = lane & 15, lg = lane >> 4;
    const float gi = pgi, gf = pgf;
    const float bb = wave_scan_add(gf, lane), aa = gi - bb, pm = wave_scan_max(aa, lane), mloc = bb + pm;
    const float b_last = __shfl(bb, 63), ml_last = __shfl(mloc, 63), wgl = __expf(b_last + aa - ml_last);
    if (w == 0) { v_b[lane] = bb; v_a[lane] = aa; v_ml[lane] = mloc; }
    if (w == 0) { ((float*)(ws + WS_BBC))[(size_t)uid * 64 + lane] = bb; ((float*)(ws + WS_PMC))[(size_t)uid * 64 + lane] = pm; }
#pragma unroll
    for (int i = 0; i < 2; ++i) { const int id = tid + 512 * i, r = id >> 4, ch = id & 15; const int tk = tok0 + r; const bool ok = tk >= 0 && tk < tlim;
        const u32x4 q = pq[i], k = pk[i]; (void)ok;
        *(LAS u32x4*)(lds + MA_Q + r * ML_QS + ch * 16) = q; *(LAS u32x4*)(lds + MA_K + r * ML_QS + ch * 16) = k;
        const float wgr = __shfl(wgl, r); u32x4 kw;
#pragma unroll
        for (int e = 0; e < 4; ++e) kw[e] = pk2(bf2f((unsigned short)(k[e] & 0xffffu)) * wgr, bf2f((unsigned short)(k[e] >> 16)) * wgr);
        *(LAS u32x4*)(lds + MA_KW + r * ML_QS + ch * 16) = kw; }
#pragma unroll
    for (int i = 0; i < 4; ++i) { const int id = tid + 512 * i, r = id >> 5, ch = id & 31; const int tk = tok0 + r; const bool ok = tk >= 0 && tk < tlim;
        const u32x4 v = pv[i]; (void)ok;
        *(LAS u32x4*)(lds + MA_V + r * MA_VS + ch * 16) = v; }
    LDS_BARRIER();
    if (uid + stride < NUA) MA_LOAD(uid + stride);
    { const int tr = w >> 1; float rs[4] = {0.f, 0.f, 0.f, 0.f};
#pragma unroll
        for (int i = 0; i < 2; ++i) { const int tc = 2 * (w & 1) + i; f32x4 acc = {0.f, 0.f, 0.f, 0.f};
#pragma unroll
            for (int k0 = 0; k0 < 128; k0 += 32) { const bf16x8 a = *(const LAS bf16x8*)(lds + MA_Q + (16 * tr + l15) * ML_QS + (k0 + 8 * lg) * 2), bq = *(const LAS bf16x8*)(lds + MA_K + (16 * tc + l15) * ML_QS + (k0 + 8 * lg) * 2); acc = mfma16(a, bq, acc); }
            const int s = 16 * tc + l15; const float as = v_a[s];
#pragma unroll
            for (int r = 0; r < 4; ++r) { const int t = 16 * tr + 4 * lg + r; const float d = s <= t ? __expf(v_b[t] + as - v_ml[t]) : 0.f; const float sp = acc[r] * d; rs[r] += sp;
                *(LAS unsigned short*)(lds + MA_SP + t * ML_TS + s * 2) = (unsigned short)f2bf(sp); } }
#pragma unroll
        for (int r = 0; r < 4; ++r) { float x = rs[r]; x += __shfl_xor(x, 1); x += __shfl_xor(x, 2); x += __shfl_xor(x, 4); x += __shfl_xor(x, 8); if (l15 == 0) v_rs[(w & 1) * 64 + 16 * tr + 4 * lg + r] = x; } }
    const clptr vtb = lds + MA_V + (8 * lg + (l15 >> 2)) * MA_VS + (l15 & 3) * 8;
    {
        const clptr kwb = lds + MA_KW + (8 * lg + (l15 >> 2)) * ML_QS + (l15 & 3) * 8 + w * 32;
        const bf16x8 a0 = tr_frag(kwb, 4 * ML_QS), a1 = tr_frag(kwb + 32 * ML_QS, 4 * ML_QS);
#pragma unroll 4
        for (int dvt = 0; dvt < 16; ++dvt) { const bf16x8 b0 = tr_frag(vtb + dvt * 32, 4 * MA_VS), b1 = tr_frag(vtb + 32 * MA_VS + dvt * 32, 4 * MA_VS);
            f32x4 acc = {0.f, 0.f, 0.f, 0.f}; acc = mfma16(a0, b0, acc); acc = mfma16(a1, b1, acc);
            u32x2 o; o.x = pk2(acc[0], acc[1]); o.y = pk2(acc[2], acc[3]); *(u32x2*)(U + (size_t)(16 * dvt + l15) * 128 + 16 * w + 4 * lg) = o; } }
    if (tid < 128) { float x = 0.f;
#pragma unroll 8
        for (int s = 0; s < 64; ++s) x += bf2f(*(const LAS unsigned short*)(lds + MA_KW + s * ML_QS + tid * 2));
        NU[(size_t)uid * 128 + tid] = x; }
    LDS_BARRIER();
    if (tid < 64) { const int tk = tok0 + tid; if (tk >= 0 && tk < tlim) RS[(row_base + tk) * 4 + h] = v_rs[tid] + v_rs[64 + tid]; }
    {
        const int tt = w & 3; const bf16x8 b0 = *(const LAS bf16x8*)(lds + MA_SP + (16 * tt + l15) * ML_TS + (8 * lg) * 2), b1 = *(const LAS bf16x8*)(lds + MA_SP + (16 * tt + l15) * ML_TS + (32 + 8 * lg) * 2);
        const int tk = tok0 + 16 * tt + l15; const bool ok = tk >= 0 && tk < tlim; bf16* dst = MH + (row_base + (ok ? tk : 0)) * DM + h * 256 + 4 * lg;
#pragma unroll 4
        for (int i = 0; i < 8; ++i) { const int dvt = 8 * (w >> 2) + i; const bf16x8 a0 = tr_frag(vtb + dvt * 32, 4 * MA_VS), a1 = tr_frag(vtb + 32 * MA_VS + dvt * 32, 4 * MA_VS);
            f32x4 acc = {0.f, 0.f, 0.f, 0.f}; acc = mfma16(a0, b0, acc); acc = mfma16(a1, b1, acc);
            if (ok) { u32x2 o; o.x = pk2(acc[0], acc[1]); o.y = pk2(acc[2], acc[3]); *(u32x2*)(dst + 16 * dvt) = o; } } }
    LDS_BARRIER();
    }
#undef MA_LOAD
    __syncthreads();
}

constexpr int MB_QSZ = 17408, MB_CBSZ = 48 * ML_QS, MB_Q = 0, MB_CB = 2 * MB_QSZ, MB_END = MB_CB + 2 * MB_CBSZ;
__device__ __forceinline__ void mlstm_b_item(const Args& A, int it, lptr lds, int tid, int w, int lane) {
    unsigned char* ws = A.ws;
    const bf16* MQ = (const bf16*)(ws + WS_MQ); bf16* MH = (bf16*)(ws + WS_MH); const float* GI = (const float*)(ws + WS_GI); const float* GF = (const float*)(ws + WS_GF);
    const float* RS = (const float*)(ws + WS_RS); const float* NU = (const float*)(ws + WS_NU); float* HSSQ = (float*)(ws + WS_HSSQ);
    const bool prompt = it < 256; const int i2 = prompt ? it : it - 256; const int b = i2 >> 5, h = (i2 >> 3) & 3, sl = i2 & 7; const int nch = prompt ? 65 : 1;
    const int uid0 = prompt ? (b * 4 + h) * 65 : NB * 4 * 65 + (b * 4 + h);
    const size_t row_base = prompt ? (size_t)b * TP : (size_t)MP + (size_t)b * DT; const int tlim = prompt ? TP : DT;
    const bf16* Ub = (const bf16*)(ws + WS_U) + (size_t)uid0 * 32768 + (size_t)(sl * 32 + (tid >> 4)) * 128 + (tid & 15) * 8;
    const int l15 = lane & 15, lg = lane >> 4, tt = w & 3, dvt = w >> 2, cdv = tid >> 4, cdk = (tid & 15) * 8;
    float C[8]; float nreg = 0.f, m_run = 0.f;
    {
        if (prompt) {
#pragma unroll
            for (int i = 0; i < 8; ++i) C[i] = 0.f;
        } else { const float* C0 = A.in[5] + ((size_t)(b * 4 + h) * 256 + sl * 32 + cdv) * 128 + cdk; const f32x4 c0 = *(const f32x4*)C0, c1 = *(const f32x4*)(C0 + 4);
#pragma unroll
            for (int i = 0; i < 4; ++i) { C[i] = c0[i]; C[4 + i] = c1[i]; }
            if (tid < 128) nreg = A.in[6][(size_t)(b * 4 + h) * 128 + tid]; m_run = A.in[7][b * 4 + h]; }
        u32x4 o; o.x = pk2(C[0], C[1]); o.y = pk2(C[2], C[3]); o.z = pk2(C[4], C[5]); o.w = pk2(C[6], C[7]);
        *(LAS u32x4*)(lds + MB_CB + cdv * ML_QS + cdk * 2) = o;
        if (tid < 256) { const int r = 32 + (tid >> 4); const u32x4 z = {0u, 0u, 0u, 0u}; *(LAS u32x4*)(lds + MB_CB + r * ML_QS + (tid & 15) * 16) = z; *(LAS u32x4*)(lds + MB_CB + MB_CBSZ + r * ML_QS + (tid & 15) * 16) = z; }
    }
    __syncthreads();
    if (tid < 128) *(LAS unsigned short*)(lds + MB_CB + 32 * ML_QS + tid * 2) = (unsigned short)f2bf(nreg);
    u32x4 q0_[2], q1_[2], uc_[2]; u32x2 nl_[2]; float gi_[2], gf_[2], rs_[2], nu_[2];
#define MB_LOADQ(S, cc) do { const int tok0_ = prompt ? 64 * (cc) - 48 : 0; \
        { const int r_ = tid >> 4, tk_ = tok0_ + r_; const bool ok_ = tk_ >= 0 && tk_ < tlim; q0_[S] = (u32x4){0u, 0u, 0u, 0u}; if (ok_) q0_[S] = *(const u32x4*)(MQ + (row_base + tk_) * 512 + h * 128 + (tid & 15) * 8); } \
        { const int r_ = 32 + (tid >> 4), tk_ = tok0_ + r_; const bool ok_ = tk_ >= 0 && tk_ < tlim; q1_[S] = (u32x4){0u, 0u, 0u, 0u}; if (ok_) q1_[S] = *(const u32x4*)(MQ + (row_base + tk_) * 512 + h * 128 + (tid & 15) * 8); } } while (0)
#define MB_LOAD(S, cc) do { const int tok0_ = prompt ? 64 * (cc) - 48 : 0; \
        uc_[S] = *(const u32x4*)(Ub + (size_t)(cc) * 32768); \
        { const int tk_ = tok0_ + lane; gi_[S] = ((const float*)(ws + WS_PMC))[(size_t)(uid0 + (cc)) * 64 + lane]; gf_[S] = ((const float*)(ws + WS_BBC))[(size_t)(uid0 + (cc)) * 64 + lane]; rs_[S] = 0.f; if (tk_ >= 0 && tk_ < tlim) rs_[S] = RS[(row_base + tk_) * 4 + h]; } \
        nu_[S] = tid < 128 ? NU[(size_t)(uid0 + (cc)) * 128 + tid] : 0.f; \
        { const int tk_ = tok0_ + 16 * tt + l15; nl_[S] = (u32x2){0u, 0u}; if (tk_ >= 0 && tk_ < tlim) nl_[S] = *(const u32x2*)(MH + (row_base + tk_) * DM + h * 256 + sl * 32 + 16 * dvt + 4 * lg); } } while (0)
    MB_LOADQ(0, 0); MB_LOAD(0, 0);
    if (nch > 1) MB_LOAD(1, 1);
    *(LAS u32x4*)(lds + MB_Q + (tid >> 4) * ML_QS + (tid & 15) * 16) = q0_[0]; *(LAS u32x4*)(lds + MB_Q + (32 + (tid >> 4)) * ML_QS + (tid & 15) * 16) = q1_[0];
    __syncthreads();
    if (nch > 1) MB_LOADQ(1, 1);
    if (nch > 2) MB_LOADQ(0, 2);
#pragma unroll 1
    for (int c2 = 0; c2 < nch; c2 += 2) {
        { constexpr int S = 0; const int c = c2;
        const int tok0 = prompt ? 64 * c - 48 : 0;
        const float bb = gf_[S], pm = gi_[S];
        const float mx = fmaxf(m_run, pm), mt = bb + mx, win = __expf(m_run - mx), scl = __expf(pm - mx), einv = __expf(-mt);
        const float b_last = __shfl(bb, 63), m_new = __shfl(mt, 63), pm_last = __shfl(pm, 63), mx_last = fmaxf(m_run, pm_last);
        const float decay = __expf(m_run - mx_last), usc = __expf(pm_last - mx_last);
        (void)b_last;
        const u32x4 uc = uc_[S]; const u32x2 nlc = nl_[S]; const float rsc = rs_[S], nuc = nu_[S];
        f32x4 acc = {0.f, 0.f, 0.f, 0.f}, acc2 = {0.f, 0.f, 0.f, 0.f};
#pragma unroll
        for (int k0 = 0; k0 < 128; k0 += 32) { const bf16x8 bq = *(const LAS bf16x8*)(lds + MB_Q + S * MB_QSZ + (16 * tt + l15) * ML_QS + (k0 + 8 * lg) * 2);
            const bf16x8 a = *(const LAS bf16x8*)(lds + MB_CB + S * MB_CBSZ + (16 * dvt + l15) * ML_QS + (k0 + 8 * lg) * 2), an = *(const LAS bf16x8*)(lds + MB_CB + S * MB_CBSZ + (32 + l15) * ML_QS + (k0 + 8 * lg) * 2);
            acc = mfma16(a, bq, acc); acc2 = mfma16(an, bq, acc2); }
        {
            const int t = 16 * tt + l15; const int tk = tok0 + t; const bool ok = tk >= 0 && tk < tlim;
            const float qn = __shfl(acc2[0], l15), win_t = __shfl(win, t), scl_t = __shfl(scl, t), einv_t = __shfl(einv, t), rs_t = __shfl(rsc, t);
            const float den = win_t * qn + scl_t * rs_t, rden = 1.0f / fmaxf(fabsf(den), einv_t);
            const float n0 = bf2f((unsigned short)(nlc.x & 0xffffu)), n1 = bf2f((unsigned short)(nlc.x >> 16)), n2 = bf2f((unsigned short)(nlc.y & 0xffffu)), n3 = bf2f((unsigned short)(nlc.y >> 16));
            const float h0 = (win_t * acc[0] + scl_t * n0) * rden, h1 = (win_t * acc[1] + scl_t * n1) * rden, h2 = (win_t * acc[2] + scl_t * n2) * rden, h3 = (win_t * acc[3] + scl_t * n3) * rden;
            float x = (h0 * h0 + h1 * h1) + (h2 * h2 + h3 * h3); x += __shfl_xor(x, 16); x += __shfl_xor(x, 32);
            if (ok) { u32x2 o; o.x = pk2(h0, h1); o.y = pk2(h2, h3); *(u32x2*)(MH + (row_base + tk) * DM + h * 256 + sl * 32 + 16 * dvt + 4 * lg) = o; if (lg == 0) HSSQ[((row_base + tk) * 4 + h) * 16 + sl * 2 + dvt] = x; }
        }
        {
            C[0] = decay * C[0] + usc * bf2f((unsigned short)(uc.x & 0xffffu)); C[1] = decay * C[1] + usc * bf2f((unsigned short)(uc.x >> 16));
            C[2] = decay * C[2] + usc * bf2f((unsigned short)(uc.y & 0xffffu)); C[3] = decay * C[3] + usc * bf2f((unsigned short)(uc.y >> 16));
            C[4] = decay * C[4] + usc * bf2f((unsigned short)(uc.z & 0xffffu)); C[5] = decay * C[5] + usc * bf2f((unsigned short)(uc.z >> 16));
            C[6] = decay * C[6] + usc * bf2f((unsigned short)(uc.w & 0xffffu)); C[7] = decay * C[7] + usc * bf2f((unsigned short)(uc.w >> 16));
            u32x4 o; o.x = pk2(C[0], C[1]); o.y = pk2(C[2], C[3]); o.z = pk2(C[4], C[5]); o.w = pk2(C[6], C[7]);
            *(LAS u32x4*)(lds + MB_CB + (S ^ 1) * MB_CBSZ + cdv * ML_QS + cdk * 2) = o;
            if (tid < 128) { nreg = decay * nreg + usc * nuc; *(LAS unsigned short*)(lds + MB_CB + (S ^ 1) * MB_CBSZ + 32 * ML_QS + tid * 2) = (unsigned short)f2bf(nreg); }
            if (c + 1 < nch) { *(LAS u32x4*)(lds + MB_Q + (S ^ 1) * MB_QSZ + (tid >> 4) * ML_QS + (tid & 15) * 16) = q0_[S ^ 1]; *(LAS u32x4*)(lds + MB_Q + (S ^ 1) * MB_QSZ + (32 + (tid >> 4)) * ML_QS + (tid & 15) * 16) = q1_[S ^ 1]; }
        }
        m_run = m_new;
        LDS_BARRIER();
        if (c + 2 < nch) MB_LOAD(S, c + 2);
        if (c + 3 < nch) MB_LOADQ(S ^ 1, c + 3);
        }
        if (c2 + 1 < nch) { constexpr int S = 1; const int c = c2 + 1;
        const int tok0 = prompt ? 64 * c - 48 : 0;
        const float bb = gf_[S], pm = gi_[S];
        const float mx = fmaxf(m_run, pm), mt = bb + mx, win = __expf(m_run - mx), scl = __expf(pm - mx), einv = __expf(-mt);
        const float b_last = __shfl(bb, 63), m_new = __shfl(mt, 63), pm_last = __shfl(pm, 63), mx_last = fmaxf(m_run, pm_last);
        const float decay = __expf(m_run - mx_last), usc = __expf(pm_last - mx_last);
        (void)b_last;
        const u32x4 uc = uc_[S]; const u32x2 nlc = nl_[S]; const float rsc = rs_[S], nuc = nu_[S];
        f32x4 acc = {0.f, 0.f, 0.f, 0.f}, acc2 = {0.f, 0.f, 0.f, 0.f};
#pragma unroll
        for (int k0 = 0; k0 < 128; k0 += 32) { const bf16x8 bq = *(const LAS bf16x8*)(lds + MB_Q + S * MB_QSZ + (16 * tt + l15) * ML_QS + (k0 + 8 * lg) * 2);
            const bf16x8 a = *(const LAS bf16x8*)(lds + MB_CB + S * MB_CBSZ + (16 * dvt + l15) * ML_QS + (k0 + 8 * lg) * 2), an = *(const LAS bf16x8*)(lds + MB_CB + S * MB_CBSZ + (32 + l15) * ML_QS + (k0 + 8 * lg) * 2);
            acc = mfma16(a, bq, acc); acc2 = mfma16(an, bq, acc2); }
        {
            const int t = 16 * tt + l15; const int tk = tok0 + t; const bool ok = tk >= 0 && tk < tlim;
            const float qn = __shfl(acc2[0], l15), win_t = __shfl(win, t), scl_t = __shfl(scl, t), einv_t = __shfl(einv, t), rs_t = __shfl(rsc, t);
            const float den = win_t * qn + scl_t * rs_t, rden = 1.0f / fmaxf(fabsf(den), einv_t);
            const float n0 = bf2f((unsigned short)(nlc.x & 0xffffu)), n1 = bf2f((unsigned short)(nlc.x >> 16)), n2 = bf2f((unsigned short)(nlc.y & 0xffffu)), n3 = bf2f((unsigned short)(nlc.y >> 16));
            const float h0 = (win_t * acc[0] + scl_t * n0) * rden, h1 = (win_t * acc[1] + scl_t * n1) * rden, h2 = (win_t * acc[2] + scl_t * n2) * rden, h3 = (win_t * acc[3] + scl_t * n3) * rden;
            float x = (h0 * h0 + h1 * h1) + (h2 * h2 + h3 * h3); x += __shfl_xor(x, 16); x += __shfl_xor(x, 32);
            if (ok) { u32x2 o; o.x = pk2(h0, h1); o.y = pk2(h2, h3); *(u32x2*)(MH + (row_base + tk) * DM + h * 256 + sl * 32 + 16 * dvt + 4 * lg) = o; if (lg == 0) HSSQ[((row_base + tk) * 4 + h) * 16 + sl * 2 + dvt] = x; }
        }
        {
            C[0] = decay * C[0] + usc * bf2f((unsigned short)(uc.x & 0xffffu)); C[1] = decay * C[1] + usc * bf2f((unsigned short)(uc.x >> 16));
            C[2] = decay * C[2] + usc * bf2f((unsigned short)(uc.y & 0xffffu)); C[3] = decay * C[3] + usc * bf2f((unsigned short)(uc.y >> 16));
            C[4] = decay * C[4] + usc * bf2f((unsigned short)(uc.z & 0xffffu)); C[5] = decay * C[5] + usc * bf2f((unsigned short)(uc.z >> 16));
            C[6] = decay * C[6] + usc * bf2f((unsigned short)(uc.w & 0xffffu)); C[7] = decay * C[7] + usc * bf2f((unsigned short)(uc.w >> 16));
            u32x4 o; o.x = pk2(C[0], C[1]); o.y = pk2(C[2], C[3]); o.z = pk2(C[4], C[5]); o.w = pk2(C[6], C[7]);
            *(LAS u32x4*)(lds + MB_CB + (S ^ 1) * MB_CBSZ + cdv * ML_QS + cdk * 2) = o;
            if (tid < 128) { nreg = decay * nreg + usc * nuc; *(LAS unsigned short*)(lds + MB_CB + (S ^ 1) * MB_CBSZ + 32 * ML_QS + tid * 2) = (unsigned short)f2bf(nreg); }
            if (c + 1 < nch) { *(LAS u32x4*)(lds + MB_Q + (S ^ 1) * MB_QSZ + (tid >> 4) * ML_QS + (tid & 15) * 16) = q0_[S ^ 1]; *(LAS u32x4*)(lds + MB_Q + (S ^ 1) * MB_QSZ + (32 + (tid >> 4)) * ML_QS + (tid & 15) * 16) = q1_[S ^ 1]; }
        }
        m_run = m_new;
        LDS_BARRIER();
        if (c + 2 < nch) MB_LOAD(S, c + 2);
        if (c + 3 < nch) MB_LOADQ(S ^ 1, c + 3);
        }
    }
#undef MB_LOAD
#undef MB_LOADQ
    { float* Co = A.out + (prompt ? O_MCP : O_MCS) + ((size_t)(b * 4 + h) * 256 + sl * 32 + cdv) * 128 + cdk;
        *(f32x4*)Co = (f32x4){C[0], C[1], C[2], C[3]}; *(f32x4*)(Co + 4) = (f32x4){C[4], C[5], C[6], C[7]};
        if (sl == 0) { if (tid < 128) (A.out + (prompt ? O_MNP : O_MNS))[(size_t)(b * 4 + h) * 128 + tid] = nreg; if (tid == 0) (A.out + (prompt ? O_MMP : O_MMS))[b * 4 + h] = m_run; } }
    __syncthreads();
}

__device__ __forceinline__ void p9_gate(const Args& A, int gw, int NGW, int lane) {
    unsigned char* ws = A.ws; bf16* MH = (bf16*)(ws + WS_MH); const bf16* MO = (const bf16*)(ws + WS_MO); const float* HSSQ = (const float*)(ws + WS_HSSQ);
    const int hd = lane >> 4;
    for (int row0 = gw; row0 < MTOT; row0 += 4 * NGW) {
        f32x4 p[4][4]; u32x4 hv[4][2], ov[4][2];
#pragma unroll
        for (int u = 0; u < 4; ++u) { const int row = row0 + u * NGW < MTOT ? row0 + u * NGW : row0; const float* pp = HSSQ + ((size_t)row * 4 + hd) * 16;
#pragma unroll
            for (int i = 0; i < 4; ++i) p[u][i] = *(const f32x4*)(pp + 4 * i);
#pragma unroll
            for (int i = 0; i < 2; ++i) { const size_t off = (size_t)row * DM + lane * 16 + i * 8; hv[u][i] = *(const u32x4*)(MH + off); ov[u][i] = *(const u32x4*)(MO + off); } }
#pragma unroll
        for (int u = 0; u < 4; ++u) { const int row = row0 + u * NGW; if (row >= MTOT) break;
            float s = 0.f;
#pragma unroll
            for (int i = 0; i < 4; ++i) s += (p[u][i][0] + p[u][i][1]) + (p[u][i][2] + p[u][i][3]);
            const float rs = __builtin_amdgcn_rsqf(s * (1.0f / 256.0f) + EPSN);
#pragma unroll
            for (int i = 0; i < 2; ++i) { const size_t off = (size_t)row * DM + lane * 16 + i * 8; u32x4 o;
#pragma unroll
                for (int e2 = 0; e2 < 4; ++e2) { const float a = bf2f((unsigned short)(hv[u][i][e2] & 0xffffu)) * rs * bf2f((unsigned short)(ov[u][i][e2] & 0xffffu)), c = bf2f((unsigned short)(hv[u][i][e2] >> 16)) * rs * bf2f((unsigned short)(ov[u][i][e2] >> 16)); o[e2] = pk2(a, c); }
                *(u32x4*)(MH + off) = o; } }
    }
}

__device__ __forceinline__ void p13_final(const Args& A, int gw, int NGW, int lane) {
    unsigned char* ws = A.ws; const float* X = (const float*)(ws + WS_X); const float* ssq = (const float*)(ws + WS_SSQ); const float* g = A.in[23];
    f32x4 gg[4];
#pragma unroll
    for (int j = 0; j < 4; ++j) gg[j] = *(const f32x4*)(g + 256 * j + 4 * lane);
    for (int row0 = gw; row0 < MTOT; row0 += 4 * NGW) {
        f32x4 v[4][4]; float sq[4];
#pragma unroll
        for (int u = 0; u < 4; ++u) { const int row = row0 + u * NGW < MTOT ? row0 + u * NGW : row0; sq[u] = lane < 16 ? ssq[(size_t)row * 16 + lane] : 0.f;
#pragma unroll
            for (int j = 0; j < 4; ++j) v[u][j] = *(const f32x4*)(X + (size_t)row * DM + 256 * j + 4 * lane); }
#pragma unroll
        for (int u = 0; u < 4; ++u) { const int row = row0 + u * NGW; if (row >= MTOT) break;
            float* dst;
            if (row < MP) { const int b = row / TP, t = row - b * TP; if (t < NMETA) continue; dst = A.out + O_YP + ((size_t)b * SEQL + (t - NMETA)) * DM; }
            else dst = A.out + O_YS + (size_t)(row - MP) * DM;
            const float rs = __builtin_amdgcn_rsqf(wave_sum(sq[u]) * (1.0f / 1024.0f) + EPSN);
#pragma unroll
            for (int j = 0; j < 4; ++j) *(f32x4*)(dst + 256 * j + 4 * lane) = v[u][j] * rs * gg[j]; }
    }
}

template <bool FIRSTR> __device__ __forceinline__ void tail_finish(const float* P, unsigned* cnt, const pg8::StaticOrder& base, int first, int ntail, int slices, int c, float* X, bf16* XB, float* ssq, lptr lds, int tid, const float* xp, const float* xs, const float* meta) {
    const int tu = c / slices; if (tu >= ntail) return;
    asm volatile("s_waitcnt vmcnt(0)" ::: "memory"); __syncthreads();
    if (tid == 0) { __builtin_amdgcn_fence(__ATOMIC_RELEASE, "agent"); asm volatile("s_waitcnt vmcnt(0)" ::: "memory");
        (void)__hip_atomic_fetch_add(cnt + tu, 1u, __ATOMIC_RELAXED, __HIP_MEMORY_SCOPE_AGENT);
        while (__hip_atomic_load(cnt + tu, __ATOMIC_RELAXED, __HIP_MEMORY_SCOPE_AGENT) < (unsigned)slices) __builtin_amdgcn_s_sleep(2); }
    __syncthreads();
    __builtin_amdgcn_fence(__ATOMIC_ACQUIRE, "agent"); asm volatile("s_waitcnt vmcnt(0)" ::: "memory");
    pg8::Unit u; base.map(first + tu, u);
    const int nrow = 256 / slices, rbase = (c % slices) * nrow;
    const int cc = tid & 31, r0 = tid >> 5;
    const float* p0 = P + (size_t)(tu * slices) * 65536 + cc * 8;
#pragma unroll 2
    for (int rr = 0; rr < nrow; rr += 16) { const int row = rbase + rr + r0;
        const size_t xoff = (size_t)(u.pm * 256 + row) * DM + u.pn * 256 + cc * 8;
        f32x4 a, b;
        if (FIRSTR) pg8::first_resid(xp, xs, meta, u.pm * 256 + row, u.pn * 256 + cc * 8, a, b); else { a = *(const f32x4*)(X + xoff); b = *(const f32x4*)(X + xoff + 4); }
        for (int s = 0; s < slices; ++s) { a = a + *(const f32x4*)(p0 + (size_t)s * 65536 + row * 256); b = b + *(const f32x4*)(p0 + (size_t)s * 65536 + row * 256 + 4); }
        *(f32x4*)(X + xoff) = a; *(f32x4*)(X + xoff + 4) = b; *(u32x4*)(XB + xoff) = pg8::pack8(a, b);
        float q = (a[0] * a[0] + a[1] * a[1]) + (a[2] * a[2] + a[3] * a[3]) + (b[0] * b[0] + b[1] * b[1]) + (b[2] * b[2] + b[3] * b[3]);
        q += __shfl_xor(q, 1); q += __shfl_xor(q, 2); q += __shfl_xor(q, 4);
        if ((cc & 7) == 0) ssq[(size_t)(u.pm * 256 + row) * 16 + u.pn * 4 + (cc >> 3)] = q; }
}

#define XB_TMO      128
#define XB_XCNT(j)  (256  + 64 * (j))
#define XB_XSUB(j)  (1280 + 64 * (j))
#define XB_XGEN(j)  (2304 + 64 * (j))
#define XB_TOP      3328
#define XB_TOPGEN   3392
#define XCD_BAR_WORDS 3456
#define XB_SPIN_CAP (1u << 18)

__device__ __forceinline__ unsigned xb_ld(unsigned* p)              { return __hip_atomic_load(p, __ATOMIC_RELAXED, __HIP_MEMORY_SCOPE_AGENT); }
__device__ __forceinline__ unsigned xb_add(unsigned* p, unsigned v) { return __hip_atomic_fetch_add(p, v, __ATOMIC_RELAXED, __HIP_MEMORY_SCOPE_AGENT); }
__device__ __forceinline__ unsigned xb_xcc_id() { return (unsigned)__builtin_amdgcn_s_getreg((3 << 11) | 20) & 0xFu; }
#define XB_SPIN(cond, bar) do { unsigned _sp = 0; while (cond) { __builtin_amdgcn_s_sleep(1); \
    if ((++_sp & 255u) == 0u) { if (xb_ld(&(bar)[XB_TMO])) break; if (_sp > XB_SPIN_CAP) { atomicAdd(&(bar)[XB_TMO], 1u); break; } } } } while (0)

struct XcdBarrier {
    unsigned* bar; unsigned x;
    volatile LAS unsigned* st;
};

__device__ __forceinline__ XcdBarrier xcd_barrier_post(unsigned* bar, volatile LAS unsigned* st) {
    XcdBarrier b; b.bar = bar; b.x = xb_xcc_id(); b.st = st;
    if (threadIdx.x == 0) (void)xb_add(&bar[XB_XCNT(b.x)], 1u);
    return b;
}
__device__ __forceinline__ void xcd_barrier_complete(unsigned* bar, unsigned x, unsigned& nloc, unsigned& nx) {
    const unsigned G = gridDim.x * gridDim.y * gridDim.z;
    unsigned sum, cnt, mine, sp = 0u;
    for (;;) {
        sum = 0u; cnt = 0u; mine = 0u;
#pragma unroll
        for (unsigned j = 0; j < 16; ++j) { const unsigned c = xb_ld(&bar[XB_XCNT(j)]); sum += c; cnt += (c > 0u) ? 1u : 0u; mine = (j == x) ? c : mine; }
        if (sum == G) break;
        __builtin_amdgcn_s_sleep(1);
        if ((++sp & 255u) == 0u) { if (xb_ld(&bar[XB_TMO])) break; if (sp > XB_SPIN_CAP) { atomicAdd(&bar[XB_TMO], 1u); break; } }
    }
    nloc = mine > 0u ? mine : 1u; nx = cnt > 0u ? cnt : 1u;
}

__device__ __forceinline__ void xcd_barrier(const XcdBarrier& b) {
    asm volatile("s_waitcnt vmcnt(0)" ::: "memory");
    __syncthreads();
    if (threadIdx.x == 0) {
        unsigned* bar = b.bar;
        __builtin_amdgcn_s_waitcnt(0);
        unsigned nloc = b.st[0], nx = b.st[1];
        if (nloc == 0u) { xcd_barrier_complete(bar, b.x, nloc, nx); b.st[0] = nloc; b.st[1] = nx; }
        const unsigned old = xb_add(&bar[XB_XSUB(b.x)], 1u);
        const unsigned gen = old / nloc;
        if (old + 1u == (gen + 1u) * nloc) {
            __builtin_amdgcn_fence(__ATOMIC_RELEASE, "agent");
            asm volatile("s_waitcnt vmcnt(0)" ::: "memory");
            const unsigned og = xb_add(&bar[XB_TOP], 1u);
            const unsigned tg = og / nx;
            if (og + 1u == (tg + 1u) * nx) xb_add(&bar[XB_TOPGEN], 1u);
            else XB_SPIN(xb_ld(&bar[XB_TOPGEN]) == tg, bar);
            __builtin_amdgcn_fence(__ATOMIC_ACQUIRE, "agent");
            xb_add(&bar[XB_XGEN(b.x)], 1u);
            asm volatile("s_waitcnt vmcnt(0)" ::: "memory");
        } else {
            XB_SPIN(xb_ld(&bar[XB_XGEN(b.x)]) == gen, bar);
            __builtin_amdgcn_fence(__ATOMIC_ACQUIRE, "agent");
            asm volatile("s_waitcnt vmcnt(0)" ::: "memory");
        }
    }
    __syncthreads();
}

__global__ void __launch_bounds__(NTHR, 2) fwd_megakernel(Args args) {
    extern __shared__ __attribute__((aligned(16))) unsigned char lds_raw[];
    cg::grid_group grid = cg::this_grid();
    { LAS unsigned* misc_ = (LAS unsigned*)(lds_raw) ; (void)misc_; }
#define GRID_SYNC() do { asm volatile("s_waitcnt vmcnt(0) lgkmcnt(0)" ::: "memory"); __syncthreads(); \
        if (threadIdx.x == 0) { __builtin_amdgcn_fence(__ATOMIC_RELEASE, "agent"); asm volatile("s_waitcnt vmcnt(0)" ::: "memory"); } \
        GSYNC(); \
        __builtin_amdgcn_fence(__ATOMIC_ACQUIRE, "agent"); asm volatile("s_waitcnt vmcnt(0)" ::: "memory"); __syncthreads(); } while (0)
    const lptr lds = (lptr)lds_raw;
    const int G = gridDim.x, bx = blockIdx.x, NGW = G * NWAVES;
#define TIDS int tid = threadIdx.x; asm volatile("" : "+v"(tid)); const int lane = tid & 63, w = __builtin_amdgcn_readfirstlane(tid >> 6), gw = bx * NWAVES + w; (void)gw; (void)lane
    unsigned char* ws = args.ws;
    bf16* XB = (bf16*)(ws + WS_XB); float* X = (float*)(ws + WS_X); float* ssq = (float*)(ws + WS_SSQ);
    volatile LAS unsigned* xb_st = (volatile LAS unsigned*)(lds + LDS_BYTES - 256);
    if (threadIdx.x < 2) xb_st[threadIdx.x] = 0u;
    __syncthreads();
    const XcdBarrier xbar = xcd_barrier_post((unsigned*)(ws + WS_CTL) + 4096, xb_st);
#ifndef USE_CG_SYNC
#define GSYNC() xcd_barrier(xbar)
#else
#define GSYNC() grid.sync()
#endif

#ifndef SKIP_P0
    { TIDS; p0_prologue(args, lds, gw, NGW, w, lane); }
#endif
#ifdef PROBE_P0
    { TIDS; p0_prologue(args, lds, gw, NGW, w, lane); }
#endif
    grid.sync();
    xcd_barrier(xbar);
#ifdef PROBE_P1
    { pg8::Gemm g{XB, (const bf16*)(ws + WS_WFIN), MPAD, NIN, DM}; pg8::StaticOrder S; S.init(MPAD, NIN, G, bx); pg8::EpiFoxIn E{ssq, args.in[13], args.in[14], args.in[12], ws, args.out};
      pg8::gemm_phase<pg8::EpiFoxIn, pg8::StaticOrder, PG8_ALIGN, PG8_SP2>(lds, g, S, E); }
    GSYNC();
#endif
#ifndef SKIP_P1
    {
        pg8::Gemm g{XB, (const bf16*)(ws + WS_WFIN), MPAD, NIN, DM}; pg8::StaticOrder S; S.init(MPAD, NIN, G, bx);
        pg8::EpiFoxIn E{ssq, args.in[13], args.in[14], args.in[12], ws, args.out};
        pg8::gemm_phase<pg8::EpiFoxIn, pg8::StaticOrder, PG8_ALIGN, PG8_SP2>(lds, g, S, E);
    }
#endif
    GSYNC();
#ifndef SKIP_P2
    { TIDS; p2_cumsum(args, gw, NGW, lane); }
#endif
    GSYNC();
#ifndef SKIP_P3
    { TIDS; p3_attention(args, lds, tid, w, lane, 0); }
#ifdef PROBE_P3
    GSYNC();
    { TIDS; p3_attention(args, lds, tid, w, lane, 1); }
#endif
#endif
    GSYNC();
#define RESID_GEMM(Ap, Wp, KK, CNTI, FIRSTF) do { \
    pg8::StaticOrder S; S.init(MPAD, DM, G, bx); const int full_ = (S.nwg / G) * G, ntail_ = S.nwg - full_; S.lim = full_; \
    { pg8::Gemm g{(Ap), (Wp), MPAD, DM, (KK), (KK)}; pg8::EpiResidT<FIRSTF> E{X, XB, ssq, args.in[0], args.in[1], args.in[8]}; pg8::gemm_phase<pg8::EpiResidT<FIRSTF>, pg8::StaticOrder, PG8_ALIGN, PG8_SP2>(lds, g, S, E); } \
    if (ntail_ > 0) { const int sl_ = ntail_ * 8 <= G ? 8 : (ntail_ * 4 <= G ? 4 : (ntail_ * 2 <= G ? 2 : 1)); const int ks_ = (KK) / sl_; \
        pg8::TailOrder T{S, full_, ntail_, sl_, bx}; pg8::Gemm g{(Ap) + (bx % sl_) * ks_, (Wp) + (bx % sl_) * ks_, MPAD, DM, ks_, (KK)}; pg8::EpiPartial E{(float*)(ws + WS_P)}; \
        pg8::gemm_phase<pg8::EpiPartial, pg8::TailOrder, false, PG8_SP2>(lds, g, T, E); \
        { int tid_ = threadIdx.x; asm volatile("" : "+v"(tid_)); tail_finish<FIRSTF>((const float*)(ws + WS_P), (unsigned*)(ws + WS_CTL) + 256 + (CNTI), S, full_, ntail_, sl_, bx, X, XB, ssq, lds, tid_, args.in[0], args.in[1], args.in[8]); } } } while (0)
#ifdef PROBE_UP
#define PROBE_UP_BODY(WUP) { pg8::Gemm g{XB, (const bf16*)(ws + (WUP)), MPAD, DFF, DM}; pg8::StaticOrder S; S.init(MPAD, DFF, G, bx); pg8::EpiUp E{ssq, (bf16*)(ws + WS_H)}; \
      pg8::gemm_phase<pg8::EpiUp, pg8::StaticOrder, PG8_ALIGN, PG8_SP2>(lds, g, S, E); } GSYNC();
#else
#define PROBE_UP_BODY(WUP)
#endif
#define LAYER_TAIL(AOP, WOUT, WUP, WDN, CNT0, FIRSTL) do { \
    RESID_GEMM((const bf16*)(AOP), (const bf16*)(ws + (WOUT)), DM, CNT0, FIRSTL); \
    GSYNC(); \
    { pg8::Gemm g{XB, (const bf16*)(ws + (WUP)), MPAD, DFF, DM}; pg8::StaticOrder S; S.init(MPAD, DFF, G, bx); pg8::EpiUp E{ssq, (bf16*)(ws + WS_H)}; \
      pg8::gemm_phase<pg8::EpiUp, pg8::StaticOrder, PG8_ALIGN, PG8_SP2>(lds, g, S, E); } \
    GSYNC(); \
    PROBE_UP_BODY(WUP) \
    RESID_GEMM((const bf16*)(ws + WS_H), (const bf16*)(ws + (WDN)), DFF, CNT0 + 32, false); \
    GSYNC(); } while (0)
#ifndef SKIP_L0
    LAYER_TAIL(ws + WS_OB, WS_WFOUT, WS_WUP0, WS_WDN0, 0, true);
#endif
#ifndef SKIP_P7
    {
        pg8::Gemm g{XB, (const bf16*)(ws + WS_WMIN), MPAD, NIN, DM}; pg8::StaticOrder S; S.init(MPAD, NIN, G, bx);
        pg8::EpiMlstmIn E{ssq, args.in[17], args.in[18], (bf16*)(ws + WS_MQ), (bf16*)(ws + WS_MK), (bf16*)(ws + WS_MV), (bf16*)(ws + WS_MO), (float*)(ws + WS_GI), (float*)(ws + WS_GF)};
        pg8::gemm_phase<pg8::EpiMlstmIn, pg8::StaticOrder, PG8_ALIGN, PG8_SP2>(lds, g, S, E);
    }
#endif
    GSYNC();
#ifndef SKIP_P8
    { TIDS; mlstm_a_phase(args, bx, G, lds, tid, w, lane); }
    GSYNC();
#ifdef PROBE_MA
    { TIDS; mlstm_a_phase(args, bx, G, lds, tid, w, lane); }
    GSYNC();
#endif
    { TIDS; for (int it = bx; it < 256 + 1024; it += G) mlstm_b_item(args, it, lds, tid, w, lane); }
#ifdef PROBE_MAB
    GSYNC();
    { TIDS; mlstm_a_phase(args, bx, G, lds, tid, w, lane); }
    GSYNC();
    { TIDS; for (int it = bx; it < 256 + 1024; it += G) mlstm_b_item(args, it, lds, tid, w, lane); }
#endif
#endif
    GSYNC();
#ifndef SKIP_P9
    { TIDS; p9_gate(args, gw, NGW, lane); }
#endif
    GSYNC();
#ifndef SKIP_L1
    LAYER_TAIL(ws + WS_MH, WS_WMOUT, WS_WUP1, WS_WDN1, 64, false);
#endif
#ifndef SKIP_P13
    { TIDS; p13_final(args, gw, NGW, lane); }
#ifdef PROBE_SYNC
    for (int i_ = 0; i_ < 16; ++i_) grid.sync();
#endif
#endif
}

extern "C" void kernel_launch(void* const* d_in, const int* in_sizes, int n_in, void* d_out, int out_size, void* d_ws, size_t ws_size, hipStream_t stream) {
    static int grid = 0;
    if (grid == 0) {
        if (n_in != 24 || (size_t)out_size != O_END || ws_size < WS_END) { fprintf(stderr, "kernel_launch: unexpected shapes: n_in %d out %d (want %zu) ws %zu (want >= %zu)\n", n_in, out_size, (size_t)O_END, ws_size, (size_t)WS_END); grid = -1; return; }
        int dev = 0, cus = 0, per_cu = 0;
        if (hipGetDevice(&dev) != hipSuccess || hipDeviceGetAttribute(&cus, hipDeviceAttributeMultiprocessorCount, dev) != hipSuccess) { grid = -1; return; }
        if (hipFuncSetAttribute((const void*)fwd_megakernel, hipFuncAttributeMaxDynamicSharedMemorySize, LDS_BYTES) != hipSuccess) { fprintf(stderr, "kernel_launch: hipFuncSetAttribute failed\n"); grid = -1; return; }
        if (hipOccupancyMaxActiveBlocksPerMultiprocessor(&per_cu, (const void*)fwd_megakernel, NTHR, LDS_BYTES) != hipSuccess || per_cu < 1) { fprintf(stderr, "kernel_launch: occupancy query says %d blocks per CU\n", per_cu); grid = -1; return; }
        grid = cus;
    }
    if (grid < 0) return;
    (void)hipMemsetAsync((char*)d_ws + WS_CTL, 0, 65536, stream);
    Args a{};
    for (int i = 0; i < 24; ++i) a.in[i] = (const float*)d_in[i];
    a.out = (float*)d_out; a.ws = (unsigned char*)d_ws;
    void* kargs[] = {&a};
    const hipError_t e = hipLaunchCooperativeKernel((const void*)fwd_megakernel, dim3(grid), dim3(NTHR), kargs, LDS_BYTES, stream);
    if (e != hipSuccess) fprintf(stderr, "kernel_launch: cooperative launch failed: %s (grid %d)\n", hipGetErrorString(e), grid);
}
```

```cpp
#include <hip/hip_runtime.h>
#include <hip/hip_cooperative_groups.h>
#include <cstdio>
#include <cstdint>
namespace cg = cooperative_groups;

constexpr int DM = 1024, TP = 4112, NB = 8, SEQL = 4096, NMETA = 16, DB = 32, DT = 32, PAST = 2048, DFF = 4096;
constexpr int MP = NB * TP;
constexpr int MTOT = MP + DB * DT;
constexpr int MPAD = 34048;
constexpr int NIN = 3328;
constexpr int PPAD = 240;
constexpr int PLEN = 4352;
constexpr int GSLEN = 2112;
constexpr float EPSN = 1e-6f;
constexpr float LOG2E = 1.4426950408889634f;
constexpr float QSCALE = 0.125f * LOG2E;

constexpr int NWAVES = 8, NTHR = 512;
constexpr int LDS_BYTES = 147456;
constexpr size_t MiB = 1u << 20;
constexpr size_t WS_CTL = 0;
constexpr size_t WS_WFIN = 1 * MiB, WS_WFOUT = 8 * MiB, WS_WMIN = 10 * MiB, WS_WMOUT = 17 * MiB, WS_WUP0 = 19 * MiB, WS_WUP1 = 27 * MiB, WS_WDN0 = 35 * MiB, WS_WDN1 = 43 * MiB;
constexpr size_t WS_SSQ = 51 * MiB, WS_G = 54 * MiB, WS_GS = 57 * MiB, WS_GI = 62 * MiB, WS_GF = 63 * MiB, WS_HSSQ = 64 * MiB;
constexpr size_t WS_X = 74 * MiB, WS_XB = 207 * MiB;
constexpr size_t WS_QB = 274 * MiB, WS_KB = 343 * MiB, WS_VB = 411 * MiB, WS_OB = 478 * MiB, WS_H = 274 * MiB;
constexpr size_t WS_MQ = 546 * MiB, WS_MK = 580 * MiB, WS_MV = 614 * MiB, WS_MO = 682 * MiB, WS_MH = 750 * MiB, WS_U = 818 * MiB, WS_RS = 958 * MiB, WS_NU = 959 * MiB, WS_P = 961 * MiB, WS_BBC = 1001 * MiB, WS_PMC = 1002 * MiB, WS_END = 1003 * MiB;
static_assert(WS_H + (size_t)MPAD * DFF * 2 <= WS_MQ && WS_OB + (size_t)MPAD * DM * 2 <= WS_MQ && WS_VB + (size_t)MPAD * DM * 2 <= WS_OB && WS_KB + (size_t)MPAD * DM * 2 <= WS_VB - MiB && WS_QB + (size_t)MPAD * DM * 2 <= WS_KB - MiB, "ws map");
static_assert(WS_G + (size_t)NB * 16 * PLEN * 4 <= WS_GS && WS_GS + (size_t)DB * 16 * GSLEN * 4 <= WS_GI && WS_HSSQ + (size_t)MPAD * 64 * 4 <= WS_X && WS_SSQ + (size_t)MPAD * 64 <= WS_G, "ws map 2");

struct Args { const float* in[24]; float* out; unsigned char* ws; };

constexpr size_t O_YP = 0, O_YS = O_YP + (size_t)NB * SEQL * DM, O_FKP = O_YS + (size_t)DB * DT * DM, O_FVP = O_FKP + (size_t)MP * DM, O_FLP = O_FVP + (size_t)MP * DM,
    O_MCP = O_FLP + (size_t)MP * 16, O_MNP = O_MCP + (size_t)NB * 4 * 256 * 128, O_MMP = O_MNP + (size_t)NB * 4 * 128, O_FKS = O_MMP + (size_t)NB * 4,
    O_FVS = O_FKS + (size_t)DB * DT * DM, O_FLS = O_FVS + (size_t)DB * DT * DM, O_MCS = O_FLS + (size_t)DB * DT * 16, O_MNS = O_MCS + (size_t)DB * 4 * 256 * 128,
    O_MMS = O_MNS + (size_t)DB * 4 * 128, O_END = O_MMS + (size_t)DB * 4;

namespace pg8 {
#define PG8_LAS __attribute__((address_space(3)))
typedef unsigned short bf16_t;
typedef short bf16x8 __attribute__((ext_vector_type(8)));
typedef float f32x4 __attribute__((ext_vector_type(4)));
typedef unsigned u32x4 __attribute__((ext_vector_type(4)));
constexpr int BM = 256, BK = 64, HALF = 128, HTB = HALF * BK * 2  , STAGE_BYTES = 8 * HTB, NXCD = 8, WGM = 8;

__host__ __device__ __forceinline__ int lds_byte(int r, int c) { const int st = (r >> 4) * 2 + (c >> 5), rr = r & 15, cc = c & 31, ob = rr * 64 + cc * 2; return st * 1024 + (ob ^ (((ob >> 9) & 1) << 5)); }
__host__ __device__ __forceinline__ void stage_rc(int b, int& R, int& C) { const int st = b / 1024, sb = b % 1024, swz = sb ^ (((sb >> 9) & 1) << 5); R = (st >> 1) * 16 + swz / 64; C = (st & 1) * 32 + (swz % 64) / 2; }
__host__ __device__ __forceinline__ int perm32(int rho) { const int n = rho >> 4, i = rho & 15; return 8 * (i >> 2) + 4 * n + (i & 3); }

struct Unit { int pm, pn, aux; };
struct Gemm { const bf16_t* A; const bf16_t* Bt; int M, N, K, ld; };

struct StaticOrder {
    int nM, nN, nwg, G, c, lim;
    __host__ __device__ void init(int M, int N, int G_, int c_) { nM = M / BM; nN = N / BM; nwg = nM * nN; G = G_; c = c_; lim = nwg; }
    __host__ __device__ bool next(int i, Unit& u) const { const long L = (long)i * G + c; if (L >= lim) return false; map((int)L, u); return true; }
    __host__ __device__ void map(int L, Unit& u) const {
        int wgid = L; { const int q = nwg / NXCD, r = nwg % NXCD, xcd = wgid % NXCD, off = wgid / NXCD; wgid = (xcd < r ? xcd * (q + 1) : r * (q + 1) + (xcd - r) * q) + off; }
        const int nig = WGM * nN, gid = wgid / nig, fm = gid * WGM, gsz = (nM - fm) < WGM ? (nM - fm) : WGM;
        u.pm = fm + ((wgid % nig) % gsz); u.pn = (wgid % nig) / gsz;
    }
    __device__ __forceinline__ void a_ready(const Unit&) const {}
    __device__ __forceinline__ void done(const Unit&) const {}
};


struct TailOrder {
    StaticOrder base; int first, ntail, slices, c;
    __device__ bool next(int i, Unit& u) const { if (i > 0) return false; const int tu = c / slices; if (tu >= ntail) return false; base.map(first + tu, u); u.aux = c; return true; }
    __device__ __forceinline__ void a_ready(const Unit&) const {}
    __device__ __forceinline__ void done(const Unit&) const {}
};

typedef float f32x2_cv __attribute__((ext_vector_type(2))); typedef __bf16 bf16x2_cv __attribute__((ext_vector_type(2)));
__device__ __forceinline__ unsigned cvt_pk_bf16(float lo, float hi) { const f32x2_cv v = {lo, hi}; const bf16x2_cv b = __builtin_convertvector(v, bf16x2_cv); return __builtin_bit_cast(unsigned, b); }
__device__ __forceinline__ u32x4 pack8(const f32x4 a, const f32x4 b) { u32x4 w; w.x = cvt_pk_bf16(a[0], a[1]); w.y = cvt_pk_bf16(a[2], a[3]); w.z = cvt_pk_bf16(b[0], b[1]); w.w = cvt_pk_bf16(b[2], b[3]); return w; }
__device__ __forceinline__ float row_rstd(const float* ssq, int row, int fq) {
    const f32x4 v = *(const f32x4*)(ssq + (size_t)row * 16 + 4 * fq);
    float s = (v[0] + v[1]) + (v[2] + v[3]);
    s += __shfl_xor(s, 16); s += __shfl_xor(s, 32);
    return __builtin_amdgcn_rsqf(s * (1.0f / 1024.0f) + EPSN);
}
__device__ __forceinline__ float log_sigmoid_f(float x) { return fminf(x, 0.f) - log1pf(__expf(-fabsf(x))); }

struct EpiFoxIn {
    static constexpr bool PERM = true, AFTER_DRAIN = false;
    const float* ssq; const float* gq; const float* gk; const float* bfv;
    unsigned char* ws; float* out;
    __device__ __forceinline__ void operator()(const f32x4 (&acc)[2][2][4][2], const Unit& u, int wr, int wc, int fr, int fq) const {
        const int pn = u.pn, sect = pn >> 2;
        f32x4 gv[2][2];
        if (sect < 2) {
#pragma unroll
            for (int bj = 0; bj < 2; ++bj)
#pragma unroll
                for (int n = 0; n < 2; ++n) { const f32x4 a = *(const f32x4*)(gq + 32 * bj + 8 * fq + 4 * n) * QSCALE, b = *(const f32x4*)(gk + 32 * bj + 8 * fq + 4 * n); gv[bj][n] = sect == 0 ? a : b; } }
        const int cb = (pn & 3) * 256 + wc * 64 + 8 * fq;
        float rsv[2][4];
#pragma unroll
        for (int ai = 0; ai < 2; ++ai)
#pragma unroll
            for (int m = 0; m < 4; ++m) rsv[ai][m] = row_rstd(ssq, u.pm * BM + ai * HALF + wr * 64 + m * 16 + fr, fq);
#pragma unroll
        for (int ai = 0; ai < 2; ++ai)
#pragma unroll
            for (int m = 0; m < 4; ++m) {
                const int row = u.pm * BM + ai * HALF + wr * 64 + m * 16 + fr;
                const float rs = rsv[ai][m];
                f32x4 v[2][2];
#pragma unroll
                for (int bj = 0; bj < 2; ++bj)
#pragma unroll
                    for (int n = 0; n < 2; ++n) v[bj][n] = acc[ai][bj][m][n] * rs;
                if (sect < 2) {
                    float ss = 0.f;
#pragma unroll
                    for (int bj = 0; bj < 2; ++bj)
#pragma unroll
                        for (int n = 0; n < 2; ++n) { const f32x4 x = v[bj][n]; ss += (x[0] * x[0] + x[1] * x[1]) + (x[2] * x[2] + x[3] * x[3]); }
                    ss += __shfl_xor(ss, 16); ss += __shfl_xor(ss, 32);
                    const float hr = __builtin_amdgcn_rsqf(ss * (1.0f / 64.0f) + EPSN);
#pragma unroll
                    for (int bj = 0; bj < 2; ++bj)
#pragma unroll
                        for (int n = 0; n < 2; ++n) v[bj][n] = v[bj][n] * hr * gv[bj][n];
                }
                const bool real = row < MTOT; const int grp = row < MP ? 0 : 1; const size_t orow = grp == 0 ? (size_t)row : (size_t)(row - MP);
                if (sect == 0) {
#pragma unroll
                    for (int bj = 0; bj < 2; ++bj) *(u32x4*)((bf16_t*)(ws + WS_QB) + (size_t)row * DM + cb + 32 * bj) = pack8(v[bj][0], v[bj][1]);
                } else if (sect < 3) {
                    bf16_t* B16 = (bf16_t*)(ws + (sect == 1 ? WS_KB : WS_VB)); float* of = out + (sect == 1 ? (grp == 0 ? O_FKP : O_FKS) : (grp == 0 ? O_FVP : O_FVS));
#pragma unroll
                    for (int bj = 0; bj < 2; ++bj) *(u32x4*)(B16 + (size_t)row * DM + cb + 32 * bj) = pack8(v[bj][0], v[bj][1]);
                    (void)of; (void)real;
                } else if (pn == 12 && wc == 0 && fq < 2 && real) {
#pragma unroll
                    for (int n = 0; n < 2; ++n) { const int h0 = 8 * fq + 4 * n; const f32x4 bb = *(const f32x4*)(bfv + h0); f32x4 o;
#pragma unroll
                        for (int j = 0; j < 4; ++j) o[j] = log_sigmoid_f(v[0][n][j] + bb[j]);
                        *(f32x4*)(out + (grp == 0 ? O_FLP : O_FLS) + orow * 16 + h0) = o; }
                }
            }
    }
};

__device__ __forceinline__ void first_resid(const float* xp, const float* xs, const float* meta, int row, int col, f32x4& x0, f32x4& x1) {
    x0 = (f32x4){0.f, 0.f, 0.f, 0.f}; x1 = x0;
    if (row < MP) { const int b = row / TP, t = row - b * TP;
        if (t < NMETA) { const float* p = meta + (size_t)t * DM + col; x0 = *(const f32x4*)p; x1 = *(const f32x4*)(p + 4); }
        else { const float* p = xp + ((size_t)b * SEQL + (t - NMETA)) * DM + col; x0 = *(const f32x4*)p; x1 = *(const f32x4*)(p + 4); } }
    else if (row < MTOT) { const float* p = xs + (size_t)(row - MP) * DM + col; x0 = *(const f32x4*)p; x1 = *(const f32x4*)(p + 4); }
}
template <bool FIRST, bool LAST = false> struct EpiResidT {
    static constexpr bool PERM = true, AFTER_DRAIN = false;
    float* X; bf16_t* XB; float* ssq; const float* xp; const float* xs; const float* meta;
    __device__ __forceinline__ void operator()(const f32x4 (&acc)[2][2][4][2], const Unit& u, int wr, int wc, int fr, int fq) const {
#pragma unroll
        for (int ai = 0; ai < 2; ++ai)
#pragma unroll
            for (int m = 0; m < 4; ++m) {
                const int row = u.pm * BM + ai * HALF + wr * 64 + m * 16 + fr; float ss = 0.f;
#pragma unroll
                for (int bj = 0; bj < 2; ++bj) { const size_t off = (size_t)row * DM + u.pn * BM + bj * HALF + wc * 32 + 8 * fq;
                    f32x4 x0, x1;
                    if (FIRST) first_resid(xp, xs, meta, row, u.pn * BM + bj * HALF + wc * 32 + 8 * fq, x0, x1); else { x0 = *(const f32x4*)(X + off); x1 = *(const f32x4*)(X + off + 4); }
                    x0 = x0 + acc[ai][bj][m][0]; x1 = x1 + acc[ai][bj][m][1];
                    if (!LAST) { *(f32x4*)(X + off) = x0; *(f32x4*)(X + off + 4) = x1; } *(u32x4*)(XB + off) = pack8(x0, x1);
                    ss += (x0[0] * x0[0] + x0[1] * x0[1]) + (x0[2] * x0[2] + x0[3] * x0[3]) + (x1[0] * x1[0] + x1[1] * x1[1]) + (x1[2] * x1[2] + x1[3] * x1[3]); }
                ss += __shfl_xor(ss, 16); ss += __shfl_xor(ss, 32);
                if (fq == 0) ssq[(size_t)row * 16 + u.pn * 4 + wc] = ss;
                if (m & 1) asm volatile("" ::: "memory");
            }
    }
};

struct EpiUp {
    static constexpr bool PERM = true, AFTER_DRAIN = false;
    const float* ssq; bf16_t* H;
    __device__ __forceinline__ void operator()(const f32x4 (&acc)[2][2][4][2], const Unit& u, int wr, int wc, int fr, int fq) const {
#pragma unroll
        for (int ai = 0; ai < 2; ++ai)
#pragma unroll
            for (int m = 0; m < 4; ++m) {
                const int row = u.pm * BM + ai * HALF + wr * 64 + m * 16 + fr; const float rs = row_rstd(ssq, row, fq);
#pragma unroll
                for (int bj = 0; bj < 2; ++bj) { f32x4 a = acc[ai][bj][m][0] * rs, b = acc[ai][bj][m][1] * rs;
#pragma unroll
                    for (int j = 0; j < 4; ++j) { a[j] = fmaxf(a[j], 0.f); a[j] *= a[j]; b[j] = fmaxf(b[j], 0.f); b[j] *= b[j]; }
                    *(u32x4*)(H + (size_t)row * DFF + u.pn * BM + bj * HALF + wc * 32 + 8 * fq) = pack8(a, b); }
            }
    }
};

struct EpiMlstmIn {
    static constexpr bool PERM = true, AFTER_DRAIN = false;
    const float* ssq; const float* bi; const float* bfv;
    bf16_t* MQ; bf16_t* MK; bf16_t* MV; bf16_t* MO; float* GI; float* GF;
    __device__ __forceinline__ void operator()(const f32x4 (&acc)[2][2][4][2], const Unit& u, int wr, int wc, int fr, int fq) const {
        const int pn = u.pn;
#pragma unroll
        for (int ai = 0; ai < 2; ++ai)
#pragma unroll
            for (int m = 0; m < 4; ++m) {
                const int row = u.pm * BM + ai * HALF + wr * 64 + m * 16 + fr; const float rs = row_rstd(ssq, row, fq);
                if (pn < 12) {
#pragma unroll
                    for (int bj = 0; bj < 2; ++bj) { f32x4 a = acc[ai][bj][m][0] * rs, b = acc[ai][bj][m][1] * rs; const int c = pn * BM + bj * HALF + wc * 32 + 8 * fq;
                        if (pn < 2) *(u32x4*)(MQ + (size_t)row * 512 + c) = pack8(a, b);
                        else if (pn < 4) { a = a * 0.08838834764831845f; b = b * 0.08838834764831845f; *(u32x4*)(MK + (size_t)row * 512 + (c - 512)) = pack8(a, b); }
                        else if (pn < 8) *(u32x4*)(MV + (size_t)row * DM + (c - 1024)) = pack8(a, b);
                        else {
#pragma unroll
                            for (int j = 0; j < 4; ++j) { a[j] = 1.0f / (1.0f + __expf(-a[j])); b[j] = 1.0f / (1.0f + __expf(-b[j])); }
                            *(u32x4*)(MO + (size_t)row * DM + (c - 2048)) = pack8(a, b); } }
                } else if (wc == 0 && fq == 0) {
                    const f32x4 a = acc[ai][0][m][0] * rs, b = acc[ai][0][m][1] * rs; const f32x4 vbi = *(const f32x4*)bi, vbf = *(const f32x4*)bfv; f32x4 oi, of;
#pragma unroll
                    for (int j = 0; j < 4; ++j) { oi[j] = a[j] + vbi[j]; of[j] = log_sigmoid_f(b[j] + vbf[j]); }
                    *(f32x4*)(GI + (size_t)row * 4) = oi; *(f32x4*)(GF + (size_t)row * 4) = of;
                }
            }
    }
};


struct EpiPartial {
    static constexpr bool PERM = true, AFTER_DRAIN = false;
    float* P;
    __device__ __forceinline__ void operator()(const f32x4 (&acc)[2][2][4][2], const Unit& u, int wr, int wc, int fr, int fq) const {
#pragma unroll
        for (int ai = 0; ai < 2; ++ai)
#pragma unroll
            for (int m = 0; m < 4; ++m)
#pragma unroll
                for (int bj = 0; bj < 2; ++bj) { float* p = P + (size_t)u.aux * 65536 + (size_t)(ai * HALF + wr * 64 + m * 16 + fr) * 256 + bj * HALF + wc * 32 + 8 * fq;
                    *(f32x4*)p = acc[ai][bj][m][0]; *(f32x4*)(p + 4) = acc[ai][bj][m][1]; }
    }
};
template <class Epi, class Sched, bool ALIGN_EPI = false, bool SP2 = false>
__device__ __forceinline__ void gemm_phase(PG8_LAS unsigned char* lds, const Gemm g, const Sched& S, const Epi& E) {
    int tid_o = threadIdx.x; asm volatile("" : "+v"(tid_o));
    const int tid = tid_o, wid = __builtin_amdgcn_readfirstlane(tid >> 6), lane = tid & 63, wr = wid >> 2, wc = wid & 3, fr = lane & 15, fq = lane >> 4;
    const int K = g.K, nt = K / BK, ld = g.ld ? g.ld : g.K;
    unsigned voffA[2], voffB[2];
#pragma unroll
    for (int i = 0; i < 2; ++i) { int R, C; stage_rc(tid * 16 + i * 8192, R, C); const int Rb = Epi::PERM ? ((R & ~31) + perm32(R & 31)) : R;
        voffA[i] = (unsigned)(R * ld + C) * 2u; voffB[i] = (unsigned)(Rb * ld + C) * 2u; }
    const size_t kstep = (size_t)(BK * 2);
    const size_t hstep = (size_t)HALF * ld * 2;
    const size_t tstep = 2 * hstep;
    const unsigned ldsw = (unsigned)wid * 1024u;
    const int aoff = lds_byte(wr * 64 + fr, fq * 8), boff = lds_byte(wc * 32 + fr, fq * 8);
#define PG8_SA(b, h) (((b) * 2 + (h)) * HTB)
#define PG8_SB(b, h) ((4 + (b) * 2 + (h)) * HTB)
#define PG8_STAGE(bufoff, gbase, voff) do { _Pragma("unroll") for (int _i = 0; _i < 2; ++_i) \
        __builtin_amdgcn_global_load_lds((const unsigned*)((const char*)(gbase) + (voff)[_i]), (PG8_LAS unsigned*)(lds + (bufoff) + ldsw + _i * 8192), 16, 0, 0); } while (0)
#define PG8_LDA(dst, b, h) do { _Pragma("unroll") for (int m = 0; m < 4; ++m) _Pragma("unroll") for (int k = 0; k < 2; ++k) dst[m][k] = *(const PG8_LAS bf16x8*)(lds + PG8_SA(b, h) + aoff + m * 2048 + k * 1024); } while (0)
#define PG8_LDB(dst, b, h) do { _Pragma("unroll") for (int n = 0; n < 2; ++n) _Pragma("unroll") for (int k = 0; k < 2; ++k) dst[n][k] = *(const PG8_LAS bf16x8*)(lds + PG8_SB(b, h) + boff + n * 2048 + k * 1024); } while (0)
#define PG8_MMA(ai, bj, At, Bt) do { __builtin_amdgcn_s_setprio(1); _Pragma("unroll") for (int m = 0; m < 4; ++m) _Pragma("unroll") for (int n = 0; n < 2; ++n) _Pragma("unroll") for (int k = 0; k < 2; ++k) \
        acc[ai][bj][m][n] = __builtin_amdgcn_mfma_f32_16x16x32_bf16(Bt[n][k], At[m][k], acc[ai][bj][m][n], 0, 0, 0); __builtin_amdgcn_s_setprio(0); } while (0)
#define PG8_WAIT_V(n) asm volatile("s_waitcnt vmcnt(" #n ")" ::: "memory")
#define PG8_WAIT_L(n) asm volatile("s_waitcnt lgkmcnt(" #n ")" ::: "memory")
#define PG8_BAR __builtin_amdgcn_s_barrier()
#define PG8_SCHED __builtin_amdgcn_sched_barrier(0)
    Unit cur, nxt; int ui = 0;
    if (!S.next(0, cur)) return;
    f32x4 acc[2][2][4][2];
#pragma unroll
    for (int a = 0; a < 2; ++a)
#pragma unroll
        for (int b = 0; b < 2; ++b)
#pragma unroll
            for (int m = 0; m < 4; ++m)
#pragma unroll
                for (int n = 0; n < 2; ++n) acc[a][b][m][n] = (f32x4){0.f, 0.f, 0.f, 0.f};
    bf16x8 At[4][2], B0[2][2], B1[2][2];
    const char* cA = (const char*)g.A + (size_t)cur.pm * tstep; const char* cB = (const char*)g.Bt + (size_t)cur.pn * tstep;
    S.a_ready(cur);
    if constexpr (SP2) {
        PG8_STAGE(PG8_SB(0, 0), cB, voffB); PG8_STAGE(PG8_SB(0, 1), cB + hstep, voffB); PG8_STAGE(PG8_SA(0, 0), cA, voffA); PG8_STAGE(PG8_SA(0, 1), cA + hstep, voffA);
        if (wr == 1) PG8_BAR;
        PG8_WAIT_V(2); PG8_BAR;
        PG8_STAGE(PG8_SB(1, 0), cB + kstep, voffB); PG8_STAGE(PG8_SA(1, 0), cA + kstep, voffA); PG8_STAGE(PG8_SB(1, 1), cB + hstep + kstep, voffB);
        PG8_WAIT_V(6); PG8_BAR;
    } else {
        PG8_STAGE(PG8_SB(0, 0), cB, voffB); PG8_STAGE(PG8_SA(0, 0), cA, voffA); PG8_STAGE(PG8_SB(0, 1), cB + hstep, voffB); PG8_STAGE(PG8_SA(0, 1), cA + hstep, voffA);
        if (wr == 1) PG8_BAR;
        PG8_WAIT_V(4); PG8_BAR;
        PG8_STAGE(PG8_SB(1, 0), cB + kstep, voffB); PG8_STAGE(PG8_SA(1, 0), cA + kstep, voffA); PG8_STAGE(PG8_SB(1, 1), cB + hstep + kstep, voffB);
        PG8_WAIT_V(6); PG8_BAR;
    }
    for (;;) {
        const bool has_next = S.next(ui + 1, nxt);
        const char* nA = has_next ? (const char*)g.A + (size_t)nxt.pm * tstep : cA; const char* nB = has_next ? (const char*)g.Bt + (size_t)nxt.pn * tstep : cB;
        for (int t = 0; t < nt; t += 2) {
            const bool last = (t == nt - 2);
            const char* a1 = cA + (size_t)(t + 1) * kstep;
            const char* a2 = last ? nA : cA + (size_t)(t + 2) * kstep; const char* b2 = last ? nB : cB + (size_t)(t + 2) * kstep;
            const char* a3 = a2 + kstep; const char* b3 = b2 + kstep;
            if (last && has_next) S.a_ready(nxt);
            if constexpr (SP2) {
            PG8_LDB(B0, 0, 0); PG8_LDB(B1, 0, 1); PG8_SCHED; PG8_LDA(At, 0, 0); PG8_STAGE(PG8_SA(1, 1), a1 + hstep, voffA);
            PG8_WAIT_V(8); PG8_WAIT_L(0); PG8_BAR; PG8_MMA(0, 0, At, B0); PG8_MMA(0, 1, At, B1); PG8_BAR; PG8_SCHED;
            PG8_LDA(At, 0, 1); PG8_STAGE(PG8_SB(0, 0), b2, voffB); PG8_STAGE(PG8_SB(0, 1), b2 + hstep, voffB); PG8_STAGE(PG8_SA(0, 0), a2, voffA);
            PG8_WAIT_V(8); PG8_WAIT_L(0); PG8_BAR; PG8_MMA(1, 0, At, B0); PG8_MMA(1, 1, At, B1); PG8_BAR; PG8_SCHED;
            PG8_LDB(B0, 1, 0); PG8_LDB(B1, 1, 1); PG8_SCHED; PG8_LDA(At, 1, 0); PG8_STAGE(PG8_SA(0, 1), a2 + hstep, voffA);
            PG8_WAIT_V(8); PG8_WAIT_L(0); PG8_BAR; PG8_MMA(0, 0, At, B0); PG8_MMA(0, 1, At, B1); PG8_BAR; PG8_SCHED;
            PG8_LDA(At, 1, 1); PG8_STAGE(PG8_SB(1, 0), b3, voffB); PG8_STAGE(PG8_SB(1, 1), b3 + hstep, voffB); PG8_STAGE(PG8_SA(1, 0), a3, voffA);
            PG8_WAIT_V(8); PG8_WAIT_L(0); PG8_BAR; PG8_MMA(1, 0, At, B0); PG8_MMA(1, 1, At, B1); PG8_BAR; PG8_SCHED;
            } else {
            PG8_LDB(B0, 0, 0); PG8_SCHED; PG8_LDA(At, 0, 0); PG8_STAGE(PG8_SA(1, 1), a1 + hstep, voffA);
            PG8_WAIT_L(8); PG8_BAR; PG8_WAIT_L(0); PG8_MMA(0, 0, At, B0); PG8_BAR; PG8_SCHED;
            PG8_LDB(B1, 0, 1); PG8_STAGE(PG8_SB(0, 0), b2, voffB);
            PG8_BAR; PG8_WAIT_L(0); PG8_MMA(0, 1, At, B1); PG8_BAR;
            PG8_LDA(At, 0, 1); PG8_STAGE(PG8_SA(0, 0), a2, voffA);
            PG8_BAR; PG8_WAIT_L(0); PG8_MMA(1, 0, At, B0); PG8_BAR; PG8_SCHED;
            PG8_STAGE(PG8_SB(0, 1), b2 + hstep, voffB);
            PG8_WAIT_V(6); PG8_BAR; PG8_MMA(1, 1, At, B1); PG8_BAR;
            PG8_LDB(B0, 1, 0); PG8_SCHED; PG8_LDA(At, 1, 0); PG8_STAGE(PG8_SA(0, 1), a2 + hstep, voffA);
            PG8_WAIT_L(8); PG8_BAR; PG8_WAIT_L(0); PG8_MMA(0, 0, At, B0); PG8_BAR; PG8_SCHED;
            PG8_LDB(B1, 1, 1); PG8_STAGE(PG8_SB(1, 0), b3, voffB);
            PG8_BAR; PG8_WAIT_L(0); PG8_MMA(0, 1, At, B1); PG8_BAR;
            PG8_LDA(At, 1, 1); PG8_STAGE(PG8_SA(1, 0), a3, voffA);
            PG8_BAR; PG8_WAIT_L(0); PG8_MMA(1, 0, At, B0); PG8_BAR; PG8_SCHED;
            PG8_STAGE(PG8_SB(1, 1), b3 + hstep, voffB);
            PG8_WAIT_V(6); PG8_BAR; PG8_MMA(1, 1, At, B1); PG8_BAR;
            }
        }
        if constexpr (ALIGN_EPI) { if (wr == 0) PG8_BAR; }
        if constexpr (!Epi::AFTER_DRAIN) { E(acc, cur, wr, wc, fr, fq); S.done(cur); }
        if (!has_next) break;
#pragma unroll
        for (int a = 0; a < 2; ++a)
#pragma unroll
            for (int b = 0; b < 2; ++b)
#pragma unroll
                for (int m = 0; m < 4; ++m)
#pragma unroll
                    for (int n = 0; n < 2; ++n) acc[a][b][m][n] = (f32x4){0.f, 0.f, 0.f, 0.f};
        cur = nxt; cA = nA; cB = nB; ++ui;
        if constexpr (ALIGN_EPI) { if (wr == 1) PG8_BAR; }
    }
    PG8_WAIT_V(0);
    if constexpr (!ALIGN_EPI) { if (wr == 0) PG8_BAR; }
    PG8_BAR;
    if constexpr (Epi::AFTER_DRAIN) { E.fused(acc, cur, wr, wc, fr, fq, lds, wid, lane); S.done(cur); }
#undef PG8_SA
#undef PG8_SB
#undef PG8_STAGE
#undef PG8_LDA
#undef PG8_LDB
#undef PG8_MMA
#undef PG8_WAIT_V
#undef PG8_WAIT_L
#undef PG8_BAR
#undef PG8_SCHED
}
}

#ifndef PG8_SP2
#define PG8_SP2 true
#endif
#ifndef PG8_ALIGN
#define PG8_ALIGN true
#endif

#define LAS __attribute__((address_space(3)))
typedef unsigned short bf16;
typedef unsigned u32x4 __attribute__((ext_vector_type(4)));
typedef unsigned u32x2 __attribute__((ext_vector_type(2)));
typedef float f32x4 __attribute__((ext_vector_type(4)));
typedef float f32x16 __attribute__((ext_vector_type(16)));
typedef short bf16x8 __attribute__((ext_vector_type(8)));
typedef short v4i16_t __attribute__((ext_vector_type(4)));
typedef LAS unsigned char* lptr;
typedef const LAS unsigned char* clptr;

__device__ __forceinline__ unsigned f2bf(float f) { unsigned u = __builtin_bit_cast(unsigned, f); return (u + 0x7fffu + ((u >> 16) & 1u)) >> 16; }
__device__ __forceinline__ unsigned pk2(float lo, float hi) { return pg8::cvt_pk_bf16(lo, hi); }
__device__ __forceinline__ float bf2f(unsigned short b) { return __builtin_bit_cast(float, (unsigned)b << 16); }
__device__ __forceinline__ float wave_sum(float v) {
#pragma unroll
    for (int o = 1; o < 64; o <<= 1) v += __shfl_xor(v, o);
    return v;
}
#define LDS_WAIT() asm volatile("s_waitcnt lgkmcnt(0)" ::: "memory")
#define LDS_BARRIER() asm volatile("s_waitcnt lgkmcnt(0)\n\ts_barrier" ::: "memory")

__device__ __forceinline__ void p0_transpose_item(const float* W, int K, int N, bf16* WT, const float* g, bool foxperm, LAS float* scr, int item, int nblk, int lane) {
    const int kb = item / nblk, nb = item % nblk, k0 = 64 * kb, n0 = 32 * nb;
#pragma unroll 8
    for (int i = 0; i < 32; ++i) { const int kk = 2 * i + (lane >> 5); const int n = n0 + (lane & 31); float v = n < N ? W[(size_t)(k0 + kk) * N + n] : 0.f; if (g) v *= g[k0 + kk]; scr[kk * 33 + (lane & 31)] = v; }
    LDS_WAIT(); asm volatile("" ::: "memory");
    const int c = lane & 7;
    int prow0 = n0;
    if (foxperm) { const int l = n0 & 255; prow0 = (n0 & ~255) + 128 * ((l >> 5) & 1) + 32 * ((l >> 6) & 3); }
#pragma unroll
    for (int j = 0; j < 4; ++j) { const int n = (lane >> 3) + 8 * j; const LAS float* s = scr + (8 * c) * 33 + n;
        u32x4 o; o.x = pk2(s[0 * 33], s[1 * 33]); o.y = pk2(s[2 * 33], s[3 * 33]); o.z = pk2(s[4 * 33], s[5 * 33]); o.w = pk2(s[6 * 33], s[7 * 33]);
        *(u32x4*)(WT + (size_t)(prow0 + n) * K + k0 + 8 * c) = o; }
    LDS_WAIT(); asm volatile("" ::: "memory");
}

__device__ __forceinline__ void p0_prologue(const Args& A, lptr lds, int gw, int NGW, int wave, int lane) {
    unsigned char* ws = A.ws;
    LAS float* scr = (LAS float*)(lds + wave * 16384);
    int base = 0;
#define WJOB(Wp, K_, N_, NP_, dst_, g_, perm_) do { const int nblk = (NP_) / 32, nitems = ((K_) / 64) * nblk; int first = (gw - base) % NGW; if (first < 0) first += NGW; \
        for (int it = first; it < nitems; it += NGW) p0_transpose_item((Wp), (K_), (N_), (bf16*)(ws + (dst_)), (g_), (perm_), scr, it, nblk, lane); base = (base + nitems) % NGW; } while (0)
    WJOB(A.in[11], DM, 3088, NIN, WS_WFIN, A.in[9], true);
    WJOB(A.in[15], DM, DM, DM, WS_WFOUT, (const float*)nullptr, false);
    WJOB(A.in[16], DM, 3080, NIN, WS_WMIN, A.in[9] + DM, false);
    WJOB(A.in[20], DM, DM, DM, WS_WMOUT, A.in[19], false);
    WJOB(A.in[21], DM, DFF, DFF, WS_WUP0, A.in[10], false);
    WJOB(A.in[21] + (size_t)DM * DFF, DM, DFF, DFF, WS_WUP1, A.in[10] + DM, false);
    WJOB(A.in[22], DFF, DM, DM, WS_WDN0, (const float*)nullptr, false);
    WJOB(A.in[22] + (size_t)DFF * DM, DFF, DM, DM, WS_WDN1, (const float*)nullptr, false);
#undef WJOB
    bf16* XB = (bf16*)(ws + WS_XB); float* ssq = (float*)(ws + WS_SSQ);
    for (int row0 = gw; row0 < MPAD; row0 += 4 * NGW) {
        f32x4 v[4][4];
#pragma unroll
        for (int u = 0; u < 4; ++u) { const int row = row0 + u * NGW; const float* src = nullptr;
            if (row < MP) { const int b = row / TP, t = row - b * TP; src = t < NMETA ? A.in[8] + (size_t)t * DM : A.in[0] + ((size_t)b * SEQL + (t - NMETA)) * DM; }
            else if (row < MTOT) src = A.in[1] + (size_t)(row - MP) * DM;
#pragma unroll
            for (int j = 0; j < 4; ++j) v[u][j] = src ? *(const f32x4*)(src + 256 * j + 4 * lane) : (f32x4){0.f, 0.f, 0.f, 0.f}; }
#pragma unroll
        for (int u = 0; u < 4; ++u) { const int row = row0 + u * NGW; if (row >= MPAD) break;
            float s = 0.f;
#pragma unroll
            for (int j = 0; j < 4; ++j) { const f32x4 x = v[u][j];
                u32x2 o;
                o.x = pk2(x[0], x[1]); o.y = pk2(x[2], x[3]); *(u32x2*)(XB + (size_t)row * DM + 256 * j + 4 * lane) = o;
                s += (x[0] * x[0] + x[1] * x[1]) + (x[2] * x[2] + x[3] * x[3]); }
            s = wave_sum(s);
            if (lane < 16) ssq[(size_t)row * 16 + lane] = lane == 0 ? s : 0.f; }
    }
    { const u32x4 z = {0u, 0u, 0u, 0u}; const int nchunk = PPAD * DM * 2 / 16;
        for (int i = gw * 64 + lane; i < nchunk; i += NGW * 64) { *(u32x4*)(ws + WS_KB - (size_t)PPAD * DM * 2 + (size_t)i * 16) = z; *(u32x4*)(ws + WS_VB - (size_t)PPAD * DM * 2 + (size_t)i * 16) = z; }
        const int nch2 = (MPAD - MTOT) * DM * 2 / 16;
        for (int i = gw * 64 + lane; i < nch2; i += NGW * 64) { *(u32x4*)(ws + WS_OB + (size_t)MTOT * DM * 2 + (size_t)i * 16) = z; *(u32x4*)(ws + WS_MH + (size_t)MTOT * DM * 2 + (size_t)i * 16) = z; } }
}

__device__ __forceinline__ float wave_scan_add(float v, int lane) {
#pragma unroll
    for (int o = 1; o < 64; o <<= 1) { const float t = __shfl_up(v, o); if (lane >= o) v += t; }
    return v;
}
__device__ __forceinline__ float wave_scan_max(float v, int lane) {
#pragma unroll
    for (int o = 1; o < 64; o <<= 1) { const float t = __shfl_up(v, o); if (lane >= o) v = fmaxf(v, t); }
    return v;
}
__device__ __forceinline__ void p2_cumsum(const Args& A, int gw, int NGW, int lane) {
    float* G = (float*)(A.ws + WS_G); float* GS = (float*)(A.ws + WS_GS);
    const float* lp = A.out + O_FLP; const float* lsn = A.out + O_FLS; const float* lc = A.in[4];
    for (int it = gw; it < NB * 16 + DB * 16; it += NGW) {
        if (it < NB * 16) { const int b = it >> 4, h = it & 15; float* g = G + (size_t)it * PLEN;
            for (int i = lane; i < PPAD; i += 64) g[i] = 0.f;
            float carry = 0.f;
#pragma unroll 1
            for (int c0 = 0; c0 < 65; c0 += 13) { float v[13];
#pragma unroll
                for (int c = 0; c < 13; ++c) { const int t = 64 * (c0 + c) + lane; v[c] = t < TP ? lp[((size_t)b * TP + t) * 16 + h] : 0.f; }
#pragma unroll
                for (int c = 0; c < 13; ++c) { const int t = 64 * (c0 + c) + lane; const float x = wave_scan_add(v[c], lane) + carry; if (t < TP) g[PPAD + t] = -LOG2E * x; carry = __shfl(x, 63); } }
        } else { const int i2 = it - NB * 16, b = i2 >> 4, h = i2 & 15; float* g = GS + (size_t)i2 * GSLEN;
            float carry = 0.f;
#pragma unroll 1
            for (int c0 = 0; c0 < 33; c0 += 11) { float v[11];
#pragma unroll
                for (int c = 0; c < 11; ++c) { const int s = 64 * (c0 + c) + lane; v[c] = 0.f; if (s < PAST) v[c] = lc[((size_t)b * PAST + s) * 16 + h]; else if (s < PAST + DT) v[c] = lsn[((size_t)b * DT + (s - PAST)) * 16 + h]; }
#pragma unroll
                for (int c = 0; c < 11; ++c) { const int s = 64 * (c0 + c) + lane; const float x = wave_scan_add(v[c], lane) + carry; g[s] = s < PAST + DT ? -LOG2E * x : 0.f; carry = __shfl(x, 63); } }
        }
    }
}

__device__ __forceinline__ int crow(int r, int hi) { return (r & 3) + 8 * (r >> 2) + 4 * hi; }
__device__ __forceinline__ v4i16_t vtr(clptr p) { return __builtin_amdgcn_ds_read_tr16_b64_v4i16((LAS v4i16_t*)p); }
constexpr int AT_KSTR = 144, AT_V = 9216, AT_B = 17408, AT_BUF = 17664;

template <bool MASK>
__device__ __forceinline__ void attn_tile(clptr Kt, clptr Vt, clptr Bt, const bf16x8 (&qr)[4], f32x16& o0, f32x16& o1, float& m, float& l, int qpos, int kpos0, int kmin, int lane) {
    const int r32 = lane & 31, hi = lane >> 5;
    f32x16 p0, p1;
#pragma unroll
    for (int r = 0; r < 16; ++r) { p0[r] = 0.f; p1[r] = 0.f; }
#pragma unroll
    for (int d0 = 0; d0 < 4; ++d0) {
        const bf16x8 a0 = *(const LAS bf16x8*)(Kt + r32 * AT_KSTR + d0 * 32 + hi * 16);
        const bf16x8 a1 = *(const LAS bf16x8*)(Kt + (32 + r32) * AT_KSTR + d0 * 32 + hi * 16);
        p0 = __builtin_amdgcn_mfma_f32_32x32x16_bf16(a0, qr[d0], p0, 0, 0, 0);
        p1 = __builtin_amdgcn_mfma_f32_32x32x16_bf16(a1, qr[d0], p1, 0, 0, 0);
    }
#pragma unroll
    for (int g = 0; g < 4; ++g) { const f32x4 b0 = *(const LAS f32x4*)(Bt + (8 * g + 4 * hi) * 4), b1 = *(const LAS f32x4*)(Bt + (32 + 8 * g + 4 * hi) * 4);
#pragma unroll
        for (int i = 0; i < 4; ++i) { p0[4 * g + i] += b0[i]; p1[4 * g + i] += b1[i]; } }
    if (MASK) {
#pragma unroll
        for (int r = 0; r < 16; ++r) { const int kp = kpos0 + crow(r, hi); if (kp > qpos || kp < kmin) p0[r] = -INFINITY; if (kp + 32 > qpos || kp + 32 < kmin) p1[r] = -INFINITY; }
    }
    float mx = fmaxf(p0[0], p1[0]);
#pragma unroll
    for (int r = 1; r < 16; ++r) mx = fmaxf(mx, fmaxf(p0[r], p1[r]));
    mx = fmaxf(mx, __shfl_xor(mx, 32));
    const float mnew = fmaxf(m, mx);
    if (__any(mnew > m)) {
        const float alpha = __builtin_amdgcn_exp2f(m - mnew); m = mnew; l *= alpha;
#pragma unroll
        for (int r = 0; r < 16; ++r) { o0[r] *= alpha; o1[r] *= alpha; } }
    float ls = 0.f;
#pragma unroll
    for (int r = 0; r < 16; ++r) { p0[r] = __builtin_amdgcn_exp2f(p0[r] - m); p1[r] = __builtin_amdgcn_exp2f(p1[r] - m); ls += p0[r] + p1[r]; }
    l += ls;
    u32x4 pw[4];
#pragma unroll
    for (int i = 0; i < 4; ++i) { pw[0][i] = pk2(p0[2 * i], p0[2 * i + 1]); pw[1][i] = pk2(p0[8 + 2 * i], p0[9 + 2 * i]); pw[2][i] = pk2(p1[2 * i], p1[2 * i + 1]); pw[3][i] = pk2(p1[8 + 2 * i], p1[9 + 2 * i]); }
    const clptr vb = Vt + ((lane >> 5) * 4 + ((lane & 15) >> 2)) * 64 + (((lane >> 4) & 1) * 16 + (lane & 3) * 4) * 2;
#pragma unroll
    for (int ks = 0; ks < 4; ++ks) {
        const v4i16_t l0 = vtr(vb + ks * 1024), h0 = vtr(vb + ks * 1024 + 512), l1 = vtr(vb + 4096 + ks * 1024), h1 = vtr(vb + 4096 + ks * 1024 + 512);
        const bf16x8 v0 = {l0[0], l0[1], l0[2], l0[3], h0[0], h0[1], h0[2], h0[3]}, v1 = {l1[0], l1[1], l1[2], l1[3], h1[0], h1[1], h1[2], h1[3]};
        const bf16x8 pb = __builtin_bit_cast(bf16x8, pw[ks]);
        o0 = __builtin_amdgcn_mfma_f32_32x32x16_bf16(v0, pb, o0, 0, 0, 0);
        o1 = __builtin_amdgcn_mfma_f32_32x32x16_bf16(v1, pb, o1, 0, 0, 0);
    }
}

__device__ __forceinline__ void kv_out_rows(const bf16* KB, const bf16* VB, float* outK, float* outV, size_t wsrow0, size_t outrow0, int nrows, int h, int tid) {
    const int ch = tid & 7, tsel = (tid >> 3) & 1, r0 = tid >> 4;
    const bf16* src = (tsel ? VB : KB) + h * 64 + ch * 8; float* dst = (tsel ? outV : outK) + h * 64 + ch * 8;
    asm volatile("" ::: "memory");
#pragma unroll 1
    for (int i0 = 0; i0 < 8; i0 += 4) { u32x4 v[4];
#pragma unroll
        for (int i = 0; i < 4; ++i) { const int r = r0 + 32 * (i0 + i); v[i] = r < nrows ? *(const u32x4*)(src + (wsrow0 + r) * DM) : (u32x4){0u, 0u, 0u, 0u}; }
#pragma unroll
        for (int i = 0; i < 4; ++i) { const int r = r0 + 32 * (i0 + i); if (r < nrows) { f32x4 a, b;
            a[0] = bf2f((unsigned short)(v[i].x & 0xffffu)); a[1] = bf2f((unsigned short)(v[i].x >> 16)); a[2] = bf2f((unsigned short)(v[i].y & 0xffffu)); a[3] = bf2f((unsigned short)(v[i].y >> 16));
            b[0] = bf2f((unsigned short)(v[i].z & 0xffffu)); b[1] = bf2f((unsigned short)(v[i].z >> 16)); b[2] = bf2f((unsigned short)(v[i].w & 0xffffu)); b[3] = bf2f((unsigned short)(v[i].w >> 16));
            *(f32x4*)(dst + (outrow0 + r) * DM) = a; *(f32x4*)(dst + (outrow0 + r) * DM + 4) = b; } } }
}

constexpr float AT_SKIP_T = 40.0f;
__device__ __forceinline__ void attn_prompt_unit(int b, int h, int j, const bf16* QB, const bf16* KB, const bf16* VB, const float* G, bf16* OB, lptr lds, int tid, int w, int lane, float kb, float* outK, float* outV) {
    const int r32 = lane & 31, hi = lane >> 5;
    const int qp = 256 * j + 32 * w + r32, t = qp - PPAD; const bool qvalid = t >= 0; const bool wave_active = (256 * j + 32 * w + 31) >= PPAD;
    const size_t qrow = (size_t)b * TP + (t > 0 ? t : 0);
    bf16x8 qr[4];
#pragma unroll
    for (int d0 = 0; d0 < 4; ++d0) qr[d0] = *(const bf16x8*)(QB + qrow * DM + h * 64 + d0 * 16 + hi * 8);
    const int lrow = tid >> 3, lch = tid & 7;
    const long krow0 = (long)b * TP - PPAD + lrow;
    const bf16* kg = KB + krow0 * DM + h * 64 + lch * 8; const bf16* vg = VB + krow0 * DM + h * 64 + lch * 8; const float* gg = G + (size_t)(b * 16 + h) * PLEN;
    f32x16 o0, o1;
#pragma unroll
    for (int r = 0; r < 16; ++r) { o0[r] = 0.f; o1[r] = 0.f; }
    float m = -1e30f, l = 0.f;
    const int kt1 = 4 * j + 3, ktw = 4 * j + (w >> 1), kmin = qp >= PPAD ? PPAD : 0;
    int kt0 = 3;
    { const int ta = 3 + lane, tb = 67 + lane;
        const float g0 = gg[j == 0 ? PPAD : 256 * j], ga = ta < 4 * j ? gg[64 * ta + 63] : 3.0e38f, gb = tb < 4 * j ? gg[64 * tb + 63] : 3.0e38f;
        const float thr = g0 - 2.0f * kb - AT_SKIP_T;
        const bool sa = ga <= thr, sb = gb <= thr;
        kt0 = 3 + __popcll(__ballot(sa)) + __popcll(__ballot(sb)); }
    u32x4 kreg[2][2], vreg[2][2]; float breg[2] = {0.f, 0.f};
    LAS int* vote = (LAS int*)(lds + 4 * AT_BUF);
#define AT_LOADPAIR(S, KH) do { _Pragma("unroll") for (int i_ = 0; i_ < 2; ++i_) { const int kk_ = (KH) - i_ >= kt0 ? (KH) - i_ : kt0; kreg[S][i_] = *(const u32x4*)(kg + (size_t)kk_ * 64 * DM); vreg[S][i_] = *(const u32x4*)(vg + (size_t)kk_ * 64 * DM); } \
        if (tid < 128) { const int kk_ = (KH) - (tid >> 6) >= kt0 ? (KH) - (tid >> 6) : kt0; breg[S] = gg[kk_ * 64 + (tid & 63)]; } } while (0)
#define AT_STEP(S, KH, STEPI) { const int kh_ = (KH); const lptr base = lds + (S) * 2 * AT_BUF; \
        _Pragma("unroll") for (int i = 0; i < 2; ++i) { *(LAS u32x4*)(base + i * AT_BUF + lrow * AT_KSTR + lch * 16) = kreg[S][i]; *(LAS u32x4*)(base + i * AT_BUF + AT_V + (lch >> 2) * 4096 + lrow * 64 + (lch & 3) * 16) = vreg[S][i]; } \
        if (tid < 128) *(LAS float*)(base + (tid >> 6) * AT_BUF + AT_B + (tid & 63) * 4) = breg[S]; \
        LDS_BARRIER(); \
        if ((STEPI) > 0) { const LAS int* vp_ = vote + (((STEPI) - 1) & 1) * 8; int all_ = 1; _Pragma("unroll") for (int i = 0; i < 8; ++i) all_ &= vp_[i]; if (all_) break; } \
        if (kh_ - 4 >= kt0) AT_LOADPAIR(S, kh_ - 4); \
        int done_ = wave_active ? 0 : 1; \
        _Pragma("unroll") for (int i = 0; i < 2; ++i) { const int k2 = kh_ - i; const lptr b2 = base + i * AT_BUF; \
            if (wave_active && k2 <= ktw && k2 >= kt0) { \
                if (k2 == 3 || k2 == ktw) attn_tile<true>(b2, b2 + AT_V, b2 + AT_B, qr, o0, o1, m, l, qp, 64 * k2, kmin, lane); \
                else attn_tile<false>(b2, b2 + AT_V, b2 + AT_B, qr, o0, o1, m, l, qp, 64 * k2, kmin, lane); \
                done_ = k2 > kt0 ? (__all(kb + *(const LAS float*)(b2 + AT_B) <= m - AT_SKIP_T) ? 1 : 0) : 1; } } \
        if (lane == 0) vote[((STEPI) & 1) * 8 + w] = done_; }
    AT_LOADPAIR(0, kt1);
    if (kt1 - 2 >= kt0) AT_LOADPAIR(1, kt1 - 2);
    for (int kh = kt1, si = 0; kh >= kt0; kh -= 4, si += 2) { AT_STEP(0, kh, si) if (kh - 2 >= kt0) AT_STEP(1, kh - 2, si + 1) }
#undef AT_STEP
#undef AT_LOADPAIR
    const float lt = l + __shfl_xor(l, 32), inv = 1.0f / lt;
    if (wave_active && qvalid) { bf16* op = OB + qrow * DM + h * 64 + 4 * hi;
#pragma unroll
        for (int g = 0; g < 4; ++g) { u32x2 a, c; a.x = pk2(o0[4 * g] * inv, o0[4 * g + 1] * inv); a.y = pk2(o0[4 * g + 2] * inv, o0[4 * g + 3] * inv); c.x = pk2(o1[4 * g] * inv, o1[4 * g + 1] * inv); c.y = pk2(o1[4 * g + 2] * inv, o1[4 * g + 3] * inv);
            *(u32x2*)(op + 8 * g) = a; *(u32x2*)(op + 32 + 8 * g) = c; } }
    { const int t0 = j == 0 ? 0 : 256 * j - PPAD, nr = j == 0 ? 256 - PPAD : 256;
        kv_out_rows(KB, VB, outK, outV, (size_t)b * TP + t0, (size_t)b * TP + t0, nr, h, tid); }
    __syncthreads();
}

__device__ __forceinline__ void attn_sample_unit(int b, int h, const float* cK, const float* cV, const bf16* QB, const bf16* KB, const bf16* VB, const float* GS, bf16* OB, lptr lds, int tid, int w, int lane, float kb, float* outK, float* outV) {
    const int r32 = lane & 31, hi = lane >> 5;
    const lptr base = lds + w * AT_BUF;
    const size_t qrow = (size_t)MP + b * DT + r32;
    bf16x8 qr[4];
#pragma unroll
    for (int d0 = 0; d0 < 4; ++d0) qr[d0] = *(const bf16x8*)(QB + qrow * DM + h * 64 + d0 * 16 + hi * 8);
    f32x16 o0, o1;
#pragma unroll
    for (int r = 0; r < 16; ++r) { o0[r] = 0.f; o1[r] = 0.f; }
    float m = -1e30f, l = 0.f;
    const float* gs = GS + (size_t)(b * 16 + h) * GSLEN;
    int ti0 = 0;
    { const float thr = gs[PAST] - 2.0f * kb - AT_SKIP_T; const bool sk = lane < 32 && gs[64 * lane + 63] <= thr; ti0 = __popcll(__ballot(sk)); }
#pragma unroll 1
    for (int ti = ti0 + w; ti < 33; ti += 8) {
        const float bias_l = gs[64 * ti + lane];
        if (ti < 32) {
            const float* ck0 = cK + (((size_t)b * PAST + 64 * ti + (lane >> 4)) * 16 + h) * 64 + 4 * (lane & 15); const float* cv0 = cV + (ck0 - cK);
            const lptr kw0 = base + (lane >> 4) * AT_KSTR + (lane & 15) * 8, vw0 = base + AT_V + ((lane & 15) >> 3) * 4096 + (lane >> 4) * 64 + (lane & 7) * 8;
#pragma unroll
            for (int half = 0; half < 2; ++half) {
                f32x4 kv[8], vv[8];
#pragma unroll
                for (int i = 0; i < 8; ++i) { kv[i] = *(const f32x4*)(ck0 + (half * 32 + i * 4) * 1024); vv[i] = *(const f32x4*)(cv0 + (half * 32 + i * 4) * 1024); }
#pragma unroll
                for (int i = 0; i < 8; ++i) { u32x2 a, c; a.x = pk2(kv[i][0], kv[i][1]); a.y = pk2(kv[i][2], kv[i][3]); c.x = pk2(vv[i][0], vv[i][1]); c.y = pk2(vv[i][2], vv[i][3]);
                    *(LAS u32x2*)(kw0 + (half * 32 + i * 4) * AT_KSTR) = a; *(LAS u32x2*)(vw0 + (half * 32 + i * 4) * 64) = c; }
                asm volatile("" ::: "memory");
            }
        } else {
            const size_t off0 = ((size_t)MP + b * DT + (lane >> 3)) * DM + h * 64 + (lane & 7) * 8;
            const lptr kw0 = base + (lane >> 3) * AT_KSTR + (lane & 7) * 16, vw0 = base + AT_V + ((lane & 7) >> 2) * 4096 + (lane >> 3) * 64 + (lane & 3) * 16;
#pragma unroll
            for (int i = 0; i < 8; ++i) { const u32x4 a = *(const u32x4*)(KB + off0 + (size_t)i * 8 * DM), c = *(const u32x4*)(VB + off0 + (size_t)i * 8 * DM);
                *(LAS u32x4*)(kw0 + i * 8 * AT_KSTR) = a; *(LAS u32x4*)(vw0 + i * 8 * 64) = c; }
        }
        *(LAS float*)(base + AT_B + lane * 4) = bias_l;
        LDS_WAIT();
        if (ti < 32) attn_tile<false>(base, base + AT_V, base + AT_B, qr, o0, o1, m, l, 0, 0, 0, lane);
        else attn_tile<true>(base, base + AT_V, base + AT_B, qr, o0, o1, m, l, r32, 0, 0, lane);
        asm volatile("" ::: "memory");
    }
    const float lt = l + __shfl_xor(l, 32);
    LDS_WAIT();
    LAS float* of = (LAS float*)base;
#pragma unroll
    for (int r = 0; r < 16; ++r) { of[crow(r, hi) * 32 + r32] = o0[r]; of[(32 + crow(r, hi)) * 32 + r32] = o1[r]; }
    if (hi == 0) { of[2048 + r32] = m; of[2080 + r32] = lt; }
    __syncthreads();
    { const int q = tid & 31, dg = tid >> 5; float M = -1e30f;
#pragma unroll
        for (int ww = 0; ww < 8; ++ww) M = fmaxf(M, ((LAS float*)(lds + ww * AT_BUF))[2048 + q]);
        float L = 0.f, o[4] = {0.f, 0.f, 0.f, 0.f};
#pragma unroll
        for (int ww = 0; ww < 8; ++ww) { const LAS float* p = (LAS float*)(lds + ww * AT_BUF); const float f = __builtin_amdgcn_exp2f(p[2048 + q] - M); L += f * p[2080 + q];
#pragma unroll
            for (int i = 0; i < 4; ++i) o[i] += f * p[(4 * dg + i) * 32 + q]; }
        const float inv = 1.0f / L; u32x2 a; a.x = pk2(o[0] * inv, o[1] * inv); a.y = pk2(o[2] * inv, o[3] * inv);
        *(u32x2*)(OB + ((size_t)MP + b * DT + q) * DM + h * 64 + 4 * dg) = a; }
    kv_out_rows(KB, VB, outK, outV, (size_t)MP + b * DT, (size_t)b * DT, DT, h, tid);
    __syncthreads();
}

__device__ __forceinline__ void p3_attention(const Args& A, lptr lds, int tid, int w, int lane, int rep) {
    unsigned char* ws = A.ws;
    const bf16* QB = (const bf16*)(ws + WS_QB); const bf16* KB = (const bf16*)(ws + WS_KB); const bf16* VB = (const bf16*)(ws + WS_VB); bf16* OB = (bf16*)(ws + WS_OB);
    const float* G = (const float*)(ws + WS_G); const float* GS = (const float*)(ws + WS_GS);
    unsigned* ctr = (unsigned*)(ws + WS_CTL) + 64 * rep;
    LAS unsigned* su = (LAS unsigned*)(lds + LDS_BYTES - 64);
    constexpr int NPU = 17 * NB * 16, NSU = DB * 16, NU = NPU + NSU;
    float gqm = 0.f, gkm = 0.f;
    for (int i = 0; i < 64; ++i) { gqm = fmaxf(gqm, fabsf(A.in[13][i])); gkm = fmaxf(gkm, fabsf(A.in[14][i])); }
    const float kb = 8.0f * LOG2E * gqm * gkm * 1.02f;
    for (;;) {
        if (tid == 0) *su = atomicAdd(ctr, 1u);
        __syncthreads();
        const int u = (int)*su;
        __syncthreads();
        if (u >= NU) break;
        const bool is_s = (u % 5 == 4) && (u / 5 < NSU);
        if (is_s) { const int s = u / 5; attn_sample_unit(s >> 4, s & 15, A.in[2], A.in[3], QB, KB, VB, GS, OB, lds, tid, w, lane, kb, A.out + O_FKS, A.out + O_FVS); }
        else { const int k = u / 5, pidx = u - (k < NSU ? k : NSU); const int j = 16 - pidx / (NB * 16), bh = pidx % (NB * 16); attn_prompt_unit(bh >> 4, bh & 15, j, QB, KB, VB, G, OB, lds, tid, w, lane, kb, A.out + O_FKP, A.out + O_FVP); }
    }
#ifdef PROBE_SAMPLE
    for (;;) { if (tid == 0) *su = atomicAdd(ctr + 128, 1u); __syncthreads(); const int u = (int)*su; __syncthreads(); if (u >= NSU) break;
        attn_sample_unit(u >> 4, u & 15, A.in[2], A.in[3], QB, KB, VB, GS, OB, lds, tid, w, lane, kb, A.out + O_FKS, A.out + O_FVS); }
#endif
}

constexpr int ML_QS = 272, ML_TS = 144;
constexpr int MA_VS = 544;
constexpr int MA_Q = 0, MA_K = 17408, MA_KW = 34816, MA_V = 52224, MA_SP = 87040, MA_VEC = 96256;
__device__ __forceinline__ bf16x8 tr_frag(clptr p, int rowstride4) { const v4i16_t lo = vtr(p), hi = vtr(p + rowstride4); return (bf16x8){lo[0], lo[1], lo[2], lo[3], hi[0], hi[1], hi[2], hi[3]}; }
constexpr int NUA = NB * 4 * 65 + DB * 4;
__device__ __forceinline__ f32x4 mfma16(bf16x8 a, bf16x8 b, f32x4 c) { return __builtin_amdgcn_mfma_f32_16x16x32_bf16(a, b, c, 0, 0, 0); }

__device__ __forceinline__ void mlstm_a_phase(const Args& A, int first, int stride, lptr lds, int tid, int w, int lane) {
    unsigned char* ws = A.ws;
    u32x4 pq[2], pk[2], pv[4]; float pgi = -1e30f, pgf = 0.f;
#define MA_LOAD(UID) do { const int uid_ = (UID); const bool pr_ = uid_ < NB * 4 * 65; const int bh_ = pr_ ? uid_ / 65 : uid_ - NB * 4 * 65, c_ = pr_ ? uid_ - bh_ * 65 : 0, b_ = bh_ >> 2, h_ = bh_ & 3; \
        const size_t rb_ = pr_ ? (size_t)b_ * TP : (size_t)MP + (size_t)b_ * DT; const int t0_ = pr_ ? 64 * c_ - 48 : 0, tl_ = pr_ ? TP : DT; \
        { const int tk_ = t0_ + lane; pgi = -1e30f; pgf = 0.f; if (tk_ >= 0 && tk_ < tl_) { pgi = ((const float*)(ws + WS_GI))[(rb_ + tk_) * 4 + h_]; pgf = ((const float*)(ws + WS_GF))[(rb_ + tk_) * 4 + h_]; } } \
        _Pragma("unroll") for (int i_ = 0; i_ < 2; ++i_) { const int id_ = tid + 512 * i_, r_ = id_ >> 4, ch_ = id_ & 15; const int tk_ = t0_ + r_; pq[i_] = (u32x4){0u, 0u, 0u, 0u}; pk[i_] = (u32x4){0u, 0u, 0u, 0u}; \
            if (tk_ >= 0 && tk_ < tl_) { pq[i_] = *(const u32x4*)((const bf16*)(ws + WS_MQ) + (rb_ + tk_) * 512 + h_ * 128 + ch_ * 8); pk[i_] = *(const u32x4*)((const bf16*)(ws + WS_MK) + (rb_ + tk_) * 512 + h_ * 128 + ch_ * 8); } } \
        _Pragma("unroll") for (int i_ = 0; i_ < 4; ++i_) { const int id_ = tid + 512 * i_, r_ = id_ >> 5, ch_ = id_ & 31; const int tk_ = t0_ + r_; pv[i_] = (u32x4){0u, 0u, 0u, 0u}; \
            if (tk_ >= 0 && tk_ < tl_) pv[i_] = *(const u32x4*)((const bf16*)(ws + WS_MV) + (rb_ + tk_) * DM + h_ * 256 + ch_ * 8); } } while (0)
    if (first < NUA) MA_LOAD(first);
#pragma unroll 1
    for (int uid = first; uid < NUA; uid += stride) {
    bf16* MH = (bf16*)(ws + WS_MH);
    float* RS = (float*)(ws + WS_RS); float* NU = (float*)(ws + WS_NU); bf16* U = (bf16*)(ws + WS_U) + (size_t)uid * 32768;
    const bool prompt = uid < NB * 4 * 65; const int bh = prompt ? uid / 65 : uid - NB * 4 * 65, c = prompt ? uid - bh * 65 : 0, b = bh >> 2, h = bh & 3;
    const size_t row_base = prompt ? (size_t)b * TP : (size_t)MP + (size_t)b * DT; const int tok0 = prompt ? 64 * c - 48 : 0, tlim = prompt ? TP : DT;
    LAS float* vec = (LAS float*)(lds + MA_VEC); LAS float* v_b = vec, *v_a = vec + 64, *v_ml = vec + 128, *v_rs = vec + 192;
    const int l15 = lane & 15, lg = lane >> 4;
    const float gi = pgi, gf = pgf;
    const float bb = wave_scan_add(gf, lane), aa = gi - bb, pm = wave_scan_max(aa, lane), mloc = bb + pm;
    const float b_last = __shfl(bb, 63), ml_last = __shfl(mloc, 63), wgl = __expf(b_last + aa - ml_last);
    if (w == 0) { v_b[lane] = bb; v_a[lane] = aa; v_ml[lane] = mloc; }
    if (w == 0) { ((float*)(ws + WS_BBC))[(size_t)uid * 64 + lane] = bb; ((float*)(ws + WS_PMC))[(size_t)uid * 64 + lane] = pm; }
#pragma unroll
    for (int i = 0; i < 2; ++i) { const int id = tid + 512 * i, r = id >> 4, ch = id & 15; const int tk = tok0 + r; const bool ok = tk >= 0 && tk < tlim;
        const u32x4 q = pq[i], k = pk[i]; (void)ok;
        *(LAS u32x4*)(lds + MA_Q + r * ML_QS + ch * 16) = q; *(LAS u32x4*)(lds + MA_K + r * ML_QS + ch * 16) = k;
        const float wgr = __shfl(wgl, r); u32x4 kw;
#pragma unroll
        for (int e = 0; e < 4; ++e) kw[e] = pk2(bf2f((unsigned short)(k[e] & 0xffffu)) * wgr, bf2f((unsigned short)(k[e] >> 16)) * wgr);
        *(LAS u32x4*)(lds + MA_KW + r * ML_QS + ch * 16) = kw; }
#pragma unroll
    for (int i = 0; i < 4; ++i) { const int id = tid + 512 * i, r = id >> 5, ch = id & 31; const int tk = tok0 + r; const bool ok = tk >= 0 && tk < tlim;
        const u32x4 v = pv[i]; (void)ok;
        *(LAS u32x4*)(lds + MA_V + r * MA_VS + ch * 16) = v; }
    LDS_BARRIER();
    if (uid + stride < NUA) MA_LOAD(uid + stride);
    { const int tr = w >> 1; float rs[4] = {0.f, 0.f, 0.f, 0.f};
#pragma unroll
        for (int i = 0; i < 2; ++i) { const int tc = 2 * (w & 1) + i; f32x4 acc = {0.f, 0.f, 0.f, 0.f};
#pragma unroll
            for (int k0 = 0; k0 < 128; k0 += 32) { const bf16x8 a = *(const LAS bf16x8*)(lds + MA_Q + (16 * tr + l15) * ML_QS + (k0 + 8 * lg) * 2), bq = *(const LAS bf16x8*)(lds + MA_K + (16 * tc + l15) * ML_QS + (k0 + 8 * lg) * 2); acc = mfma16(a, bq, acc); }
            const int s = 16 * tc + l15; const float as = v_a[s];
#pragma unroll
            for (int r = 0; r < 4; ++r) { const int t = 16 * tr + 4 * lg + r; const float d = s <= t ? __expf(v_b[t] + as - v_ml[t]) : 0.f; const float sp = acc[r] * d; rs[r] += sp;
                *(LAS unsigned short*)(lds + MA_SP + t * ML_TS + s * 2) = (unsigned short)f2bf(sp); } }
#pragma unroll
        for (int r = 0; r < 4; ++r) { float x = rs[r]; x += __shfl_xor(x, 1); x += __shfl_xor(x, 2); x += __shfl_xor(x, 4); x += __shfl_xor(x, 8); if (l15 == 0) v_rs[(w & 1) * 64 + 16 * tr + 4 * lg + r] = x; } }
    const clptr vtb = lds + MA_V + (8 * lg + (l15 >> 2)) * MA_VS + (l15 & 3) * 8;
    {
        const clptr kwb = lds + MA_KW + (8 * lg + (l15 >> 2)) * ML_QS + (l15 & 3) * 8 + w * 32;
        const bf16x8 a0 = tr_frag(kwb, 4 * ML_QS), a1 = tr_frag(kwb + 32 * ML_QS, 4 * ML_QS);
#pragma unroll 4
        for (int dvt = 0; dvt < 16; ++dvt) { const bf16x8 b0 = tr_frag(vtb + dvt * 32, 4 * MA_VS), b1 = tr_frag(vtb + 32 * MA_VS + dvt * 32, 4 * MA_VS);
            f32x4 acc = {0.f, 0.f, 0.f, 0.f}; acc = mfma16(a0, b0, acc); acc = mfma16(a1, b1, acc);
            u32x2 o; o.x = pk2(acc[0], acc[1]); o.y = pk2(acc[2], acc[3]); *(u32x2*)(U + (size_t)(16 * dvt + l15) * 128 + 16 * w + 4 * lg) = o; } }
    if (tid < 128) { float x = 0.f;
#pragma unroll 8
        for (int s = 0; s < 64; ++s) x += bf2f(*(const LAS unsigned short*)(lds + MA_KW + s * ML_QS + tid * 2));
        NU[(size_t)uid * 128 + tid] = x; }
    LDS_BARRIER();
    if (tid < 64) { const int tk = tok0 + tid; if (tk >= 0 && tk < tlim) RS[(row_base + tk) * 4 + h] = v_rs[tid] + v_rs[64 + tid]; }
    {
        const int tt = w & 3; const bf16x8 b0 = *(const LAS bf16x8*)(lds + MA_SP + (16 * tt + l15) * ML_TS + (8 * lg) * 2), b1 = *(const LAS bf16x8*)(lds + MA_SP + (16 * tt + l15) * ML_TS + (32 + 8 * lg) * 2);
        const int tk = tok0 + 16 * tt + l15; const bool ok = tk >= 0 && tk < tlim; bf16* dst = MH + (row_base + (ok ? tk : 0)) * DM + h * 256 + 4 * lg;
#pragma unroll 4
        for (int i = 0; i < 8; ++i) { const int dvt = 8 * (w >> 2) + i; const bf16x8 a0 = tr_frag(vtb + dvt * 32, 4 * MA_VS), a1 = tr_frag(vtb + 32 * MA_VS + dvt * 32, 4 * MA_VS);
            f32x4 acc = {0.f, 0.f, 0.f, 0.f}; acc = mfma16(a0, b0, acc); acc = mfma16(a1, b1, acc);
            if (ok) { u32x2 o; o.x = pk2(acc[0], acc[1]); o.y = pk2(acc[2], acc[3]); *(u32x2*)(dst + 16 * dvt) = o; } } }
    LDS_BARRIER();
    }
#undef MA_LOAD
    __syncthreads();
}

constexpr int MB_QSZ = 17408, MB_CBSZ = 48 * ML_QS, MB_Q = 0, MB_CB = 2 * MB_QSZ, MB_END = MB_CB + 2 * MB_CBSZ;
__device__ __forceinline__ void mlstm_b_item(const Args& A, int it, lptr lds, int tid, int w, int lane) {
    unsigned char* ws = A.ws;
    const bf16* MQ = (const bf16*)(ws + WS_MQ); bf16* MH = (bf16*)(ws + WS_MH); const float* GI = (const float*)(ws + WS_GI); const float* GF = (const float*)(ws + WS_GF);
    const float* RS = (const float*)(ws + WS_RS); const float* NU = (const float*)(ws + WS_NU); float* HSSQ = (float*)(ws + WS_HSSQ);
    const bool prompt = it < 256; const int i2 = prompt ? it : it - 256; const int b = i2 >> 5, h = (i2 >> 3) & 3, sl = i2 & 7; const int nch = prompt ? 65 : 1;
    const int uid0 = prompt ? (b * 4 + h) * 65 : NB * 4 * 65 + (b * 4 + h);
    const size_t row_base = prompt ? (size_t)b * TP : (size_t)MP + (size_t)b * DT; const int tlim = prompt ? TP : DT;
    const bf16* Ub = (const bf16*)(ws + WS_U) + (size_t)uid0 * 32768 + (size_t)(sl * 32 + (tid >> 4)) * 128 + (tid & 15) * 8;
    const int l15 = lane & 15, lg = lane >> 4, tt = w & 3, dvt = w >> 2, cdv = tid >> 4, cdk = (tid & 15) * 8;
    float C[8]; float nreg = 0.f, m_run = 0.f;
    {
        if (prompt) {
#pragma unroll
            for (int i = 0; i < 8; ++i) C[i] = 0.f;
        } else { const float* C0 = A.in[5] + ((size_t)(b * 4 + h) * 256 + sl * 32 + cdv) * 128 + cdk; const f32x4 c0 = *(const f32x4*)C0, c1 = *(const f32x4*)(C0 + 4);
#pragma unroll
            for (int i = 0; i < 4; ++i) { C[i] = c0[i]; C[4 + i] = c1[i]; }
            if (tid < 128) nreg = A.in[6][(size_t)(b * 4 + h) * 128 + tid]; m_run = A.in[7][b * 4 + h]; }
        u32x4 o; o.x = pk2(C[0], C[1]); o.y = pk2(C[2], C[3]); o.z = pk2(C[4], C[5]); o.w = pk2(C[6], C[7]);
        *(LAS u32x4*)(lds + MB_CB + cdv * ML_QS + cdk * 2) = o;
        if (tid < 256) { const int r = 32 + (tid >> 4); const u32x4 z = {0u, 0u, 0u, 0u}; *(LAS u32x4*)(lds + MB_CB + r * ML_QS + (tid & 15) * 16) = z; *(LAS u32x4*)(lds + MB_CB + MB_CBSZ + r * ML_QS + (tid & 15) * 16) = z; }
    }
    __syncthreads();
    if (tid < 128) *(LAS unsigned short*)(lds + MB_CB + 32 * ML_QS + tid * 2) = (unsigned short)f2bf(nreg);
    u32x4 q0_[2], q1_[2], uc_[2]; u32x2 nl_[2]; float gi_[2], gf_[2], rs_[2], nu_[2];
#define MB_LOADQ(S, cc) do { const int tok0_ = prompt ? 64 * (cc) - 48 : 0; \
        { const int r_ = tid >> 4, tk_ = tok0_ + r_; const bool ok_ = tk_ >= 0 && tk_ < tlim; q0_[S] = (u32x4){0u, 0u, 0u, 0u}; if (ok_) q0_[S] = *(const u32x4*)(MQ + (row_base + tk_) * 512 + h * 128 + (tid & 15) * 8); } \
        { const int r_ = 32 + (tid >> 4), tk_ = tok0_ + r_; const bool ok_ = tk_ >= 0 && tk_ < tlim; q1_[S] = (u32x4){0u, 0u, 0u, 0u}; if (ok_) q1_[S] = *(const u32x4*)(MQ + (row_base + tk_) * 512 + h * 128 + (tid & 15) * 8); } } while (0)
#define MB_LOAD(S, cc) do { const int tok0_ = prompt ? 64 * (cc) - 48 : 0; \
        uc_[S] = *(const u32x4*)(Ub + (size_t)(cc) * 32768); \
        { const int tk_ = tok0_ + lane; gi_[S] = ((const float*)(ws + WS_PMC))[(size_t)(uid0 + (cc)) * 64 + lane]; gf_[S] = ((const float*)(ws + WS_BBC))[(size_t)(uid0 + (cc)) * 64 + lane]; rs_[S] = 0.f; if (tk_ >= 0 && tk_ < tlim) rs_[S] = RS[(row_base + tk_) * 4 + h]; } \
        nu_[S] = tid < 128 ? NU[(size_t)(uid0 + (cc)) * 128 + tid] : 0.f; \
        { const int tk_ = tok0_ + 16 * tt + l15; nl_[S] = (u32x2){0u, 0u}; if (tk_ >= 0 && tk_ < tlim) nl_[S] = *(const u32x2*)(MH + (row_base + tk_) * DM + h * 256 + sl * 32 + 16 * dvt + 4 * lg); } } while (0)
    MB_LOADQ(0, 0); MB_LOAD(0, 0);
    if (nch > 1) MB_LOAD(1, 1);
    *(LAS u32x4*)(lds + MB_Q + (tid >> 4) * ML_QS + (tid & 15) * 16) = q0_[0]; *(LAS u32x4*)(lds + MB_Q + (32 + (tid >> 4)) * ML_QS + (tid & 15) * 16) = q1_[0];
    __syncthreads();
    if (nch > 1) MB_LOADQ(1, 1);
    if (nch > 2) MB_LOADQ(0, 2);
#pragma unroll 1
    for (int c2 = 0; c2 < nch; c2 += 2) {
        { constexpr int S = 0; const int c = c2;
        const int tok0 = prompt ? 64 * c - 48 : 0;
        const float bb = gf_[S], pm = gi_[S];
        const float mx = fmaxf(m_run, pm), mt = bb + mx, win = __expf(m_run - mx), scl = __expf(pm - mx), einv = __expf(-mt);
        const float b_last = __shfl(bb, 63), m_new = __shfl(mt, 63), pm_last = __shfl(pm, 63), mx_last = fmaxf(m_run, pm_last);
        const float decay = __expf(m_run - mx_last), usc = __expf(pm_last - mx_last);
        (void)b_last;
        const u32x4 uc = uc_[S]; const u32x2 nlc = nl_[S]; const float rsc = rs_[S], nuc = nu_[S];
        f32x4 acc = {0.f, 0.f, 0.f, 0.f}, acc2 = {0.f, 0.f, 0.f, 0.f};
#pragma unroll
        for (int k0 = 0; k0 < 128; k0 += 32) { const bf16x8 bq = *(const LAS bf16x8*)(lds + MB_Q + S * MB_QSZ + (16 * tt + l15) * ML_QS + (k0 + 8 * lg) * 2);
            const bf16x8 a = *(const LAS bf16x8*)(lds + MB_CB + S * MB_CBSZ + (16 * dvt + l15) * ML_QS + (k0 + 8 * lg) * 2), an = *(const LAS bf16x8*)(lds + MB_CB + S * MB_CBSZ + (32 + l15) * ML_QS + (k0 + 8 * lg) * 2);
            acc = mfma16(a, bq, acc); acc2 = mfma16(an, bq, acc2); }
        {
            const int t = 16 * tt + l15; const int tk = tok0 + t; const bool ok = tk >= 0 && tk < tlim;
            const float qn = __shfl(acc2[0], l15), win_t = __shfl(win, t), scl_t = __shfl(scl, t), einv_t = __shfl(einv, t), rs_t = __shfl(rsc, t);
            const float den = win_t * qn + scl_t * rs_t, rden = 1.0f / fmaxf(fabsf(den), einv_t);
            const float n0 = bf2f((unsigned short)(nlc.x & 0xffffu)), n1 = bf2f((unsigned short)(nlc.x >> 16)), n2 = bf2f((unsigned short)(nlc.y & 0xffffu)), n3 = bf2f((unsigned short)(nlc.y >> 16));
            const float h0 = (win_t * acc[0] + scl_t * n0) * rden, h1 = (win_t * acc[1] + scl_t * n1) * rden, h2 = (win_t * acc[2] + scl_t * n2) * rden, h3 = (win_t * acc[3] + scl_t * n3) * rden;
            float x = (h0 * h0 + h1 * h1) + (h2 * h2 + h3 * h3); x += __shfl_xor(x, 16); x += __shfl_xor(x, 32);
            if (ok) { u32x2 o; o.x = pk2(h0, h1); o.y = pk2(h2, h3); *(u32x2*)(MH + (row_base + tk) * DM + h * 256 + sl * 32 + 16 * dvt + 4 * lg) = o; if (lg == 0) HSSQ[((row_base + tk) * 4 + h) * 16 + sl * 2 + dvt] = x; }
        }
        {
            C[0] = decay * C[0] + usc * bf2f((unsigned short)(uc.x & 0xffffu)); C[1] = decay * C[1] + usc * bf2f((unsigned short)(uc.x >> 16));
            C[2] = decay * C[2] + usc * bf2f((unsigned short)(uc.y & 0xffffu)); C[3] = decay * C[3] + usc * bf2f((unsigned short)(uc.y >> 16));
            C[4] = decay * C[4] + usc * bf2f((unsigned short)(uc.z & 0xffffu)); C[5] = decay * C[5] + usc * bf2f((unsigned short)(uc.z >> 16));
            C[6] = decay * C[6] + usc * bf2f((unsigned short)(uc.w & 0xffffu)); C[7] = decay * C[7] + usc * bf2f((unsigned short)(uc.w >> 16));
            u32x4 o; o.x = pk2(C[0], C[1]); o.y = pk2(C[2], C[3]); o.z = pk2(C[4], C[5]); o.w = pk2(C[6], C[7]);
            *(LAS u32x4*)(lds + MB_CB + (S ^ 1) * MB_CBSZ + cdv * ML_QS + cdk * 2) = o;
            if (tid < 128) { nreg = decay * nreg + usc * nuc; *(LAS unsigned short*)(lds + MB_CB + (S ^ 1) * MB_CBSZ + 32 * ML_QS + tid * 2) = (unsigned short)f2bf(nreg); }
            if (c + 1 < nch) { *(LAS u32x4*)(lds + MB_Q + (S ^ 1) * MB_QSZ + (tid >> 4) * ML_QS + (tid & 15) * 16) = q0_[S ^ 1]; *(LAS u32x4*)(lds + MB_Q + (S ^ 1) * MB_QSZ + (32 + (tid >> 4)) * ML_QS + (tid & 15) * 16) = q1_[S ^ 1]; }
        }
        m_run = m_new;
        LDS_BARRIER();
        if (c + 2 < nch) MB_LOAD(S, c + 2);
        if (c + 3 < nch) MB_LOADQ(S ^ 1, c + 3);
        }
        if (c2 + 1 < nch) { constexpr int S = 1; const int c = c2 + 1;
        const int tok0 = prompt ? 64 * c - 48 : 0;
        const float bb = gf_[S], pm = gi_[S];
        const float mx = fmaxf(m_run, pm), mt = bb + mx, win = __expf(m_run - mx), scl = __expf(pm - mx), einv = __expf(-mt);
        const float b_last = __shfl(bb, 63), m_new = __shfl(mt, 63), pm_last = __shfl(pm, 63), mx_last = fmaxf(m_run, pm_last);
        const float decay = __expf(m_run - mx_last), usc = __expf(pm_last - mx_last);
        (void)b_last;
        const u32x4 uc = uc_[S]; const u32x2 nlc = nl_[S]; const float rsc = rs_[S], nuc = nu_[S];
        f32x4 acc = {0.f, 0.f, 0.f, 0.f}, acc2 = {0.f, 0.f, 0.f, 0.f};
#pragma unroll
        for (int k0 = 0; k0 < 128; k0 += 32) { const bf16x8 bq = *(const LAS bf16x8*)(lds + MB_Q + S * MB_QSZ + (16 * tt + l15) * ML_QS + (k0 + 8 * lg) * 2);
            const bf16x8 a = *(const LAS bf16x8*)(lds + MB_CB + S * MB_CBSZ + (16 * dvt + l15) * ML_QS + (k0 + 8 * lg) * 2), an = *(const LAS bf16x8*)(lds + MB_CB + S * MB_CBSZ + (32 + l15) * ML_QS + (k0 + 8 * lg) * 2);
            acc = mfma16(a, bq, acc); acc2 = mfma16(an, bq, acc2); }
        {
            const int t = 16 * tt + l15; const int tk = tok0 + t; const bool ok = tk >= 0 && tk < tlim;
            const float qn = __shfl(acc2[0], l15), win_t = __shfl(win, t), scl_t = __shfl(scl, t), einv_t = __shfl(einv, t), rs_t = __shfl(rsc, t);
            const float den = win_t * qn + scl_t * rs_t, rden = 1.0f / fmaxf(fabsf(den), einv_t);
            const float n0 = bf2f((unsigned short)(nlc.x & 0xffffu)), n1 = bf2f((unsigned short)(nlc.x >> 16)), n2 = bf2f((unsigned short)(nlc.y & 0xffffu)), n3 = bf2f((unsigned short)(nlc.y >> 16));
            const float h0 = (win_t * acc[0] + scl_t * n0) * rden, h1 = (win_t * acc[1] + scl_t * n1) * rden, h2 = (win_t * acc[2] + scl_t * n2) * rden, h3 = (win_t * acc[3] + scl_t * n3) * rden;
            float x = (h0 * h0 + h1 * h1) + (h2 * h2 + h3 * h3); x += __shfl_xor(x, 16); x += __shfl_xor(x, 32);
            if (ok) { u32x2 o; o.x = pk2(h0, h1); o.y = pk2(h2, h3); *(u32x2*)(MH + (row_base + tk) * DM + h * 256 + sl * 32 + 16 * dvt + 4 * lg) = o; if (lg == 0) HSSQ[((row_base + tk) * 4 + h) * 16 + sl * 2 + dvt] = x; }
        }
        {
            C[0] = decay * C[0] + usc * bf2f((unsigned short)(uc.x & 0xffffu)); C[1] = decay * C[1] + usc * bf2f((unsigned short)(uc.x >> 16));
            C[2] = decay * C[2] + usc * bf2f((unsigned short)(uc.y & 0xffffu)); C[3] = decay * C[3] + usc * bf2f((unsigned short)(uc.y >> 16));
            C[4] = decay * C[4] + usc * bf2f((unsigned short)(uc.z & 0xffffu)); C[5] = decay * C[5] + usc * bf2f((unsigned short)(uc.z >> 16));
            C[6] = decay * C[6] + usc * bf2f((unsigned short)(uc.w & 0xffffu)); C[7] = decay * C[7] + usc * bf2f((unsigned short)(uc.w >> 16));
            u32x4 o; o.x = pk2(C[0], C[1]); o.y = pk2(C[2], C[3]); o.z = pk2(C[4], C[5]); o.w = pk2(C[6], C[7]);
            *(LAS u32x4*)(lds + MB_CB + (S ^ 1) * MB_CBSZ + cdv * ML_QS + cdk * 2) = o;
            if (tid < 128) { nreg = decay * nreg + usc * nuc; *(LAS unsigned short*)(lds + MB_CB + (S ^ 1) * MB_CBSZ + 32 * ML_QS + tid * 2) = (unsigned short)f2bf(nreg); }
            if (c + 1 < nch) { *(LAS u32x4*)(lds + MB_Q + (S ^ 1) * MB_QSZ + (tid >> 4) * ML_QS + (tid & 15) * 16) = q0_[S ^ 1]; *(LAS u32x4*)(lds + MB_Q + (S ^ 1) * MB_QSZ + (32 + (tid >> 4)) * ML_QS + (tid & 15) * 16) = q1_[S ^ 1]; }
        }
        m_run = m_new;
        LDS_BARRIER();
        if (c + 2 < nch) MB_LOAD(S, c + 2);
        if (c + 3 < nch) MB_LOADQ(S ^ 1, c + 3);
        }
    }
#undef MB_LOAD
#undef MB_LOADQ
    { float* Co = A.out + (prompt ? O_MCP : O_MCS) + ((size_t)(b * 4 + h) * 256 + sl * 32 + cdv) * 128 + cdk;
        *(f32x4*)Co = (f32x4){C[0], C[1], C[2], C[3]}; *(f32x4*)(Co + 4) = (f32x4){C[4], C[5], C[6], C[7]};
        if (sl == 0) { if (tid < 128) (A.out + (prompt ? O_MNP : O_MNS))[(size_t)(b * 4 + h) * 128 + tid] = nreg; if (tid == 0) (A.out + (prompt ? O_MMP : O_MMS))[b * 4 + h] = m_run; } }
    __syncthreads();
}

__device__ __forceinline__ void p9_gate(const Args& A, int gw, int NGW, int lane) {
    unsigned char* ws = A.ws; bf16* MH = (bf16*)(ws + WS_MH); const bf16* MO = (const bf16*)(ws + WS_MO); const float* HSSQ = (const float*)(ws + WS_HSSQ);
    const int hd = lane >> 4;
    for (int row0 = gw; row0 < MTOT; row0 += 4 * NGW) {
        f32x4 p[4][4]; u32x4 hv[4][2], ov[4][2];
#pragma unroll
        for (int u = 0; u < 4; ++u) { const int row = row0 + u * NGW < MTOT ? row0 + u * NGW : row0; const float* pp = HSSQ + ((size_t)row * 4 + hd) * 16;
#pragma unroll
            for (int i = 0; i < 4; ++i) p[u][i] = *(const f32x4*)(pp + 4 * i);
#pragma unroll
            for (int i = 0; i < 2; ++i) { const size_t off = (size_t)row * DM + lane * 16 + i * 8; hv[u][i] = *(const u32x4*)(MH + off); ov[u][i] = *(const u32x4*)(MO + off); } }
#pragma unroll
        for (int u = 0; u < 4; ++u) { const int row = row0 + u * NGW; if (row >= MTOT) break;
            float s = 0.f;
#pragma unroll
            for (int i = 0; i < 4; ++i) s += (p[u][i][0] + p[u][i][1]) + (p[u][i][2] + p[u][i][3]);
            const float rs = __builtin_amdgcn_rsqf(s * (1.0f / 256.0f) + EPSN);
#pragma unroll
            for (int i = 0; i < 2; ++i) { const size_t off = (size_t)row * DM + lane * 16 + i * 8; u32x4 o;
#pragma unroll
                for (int e2 = 0; e2 < 4; ++e2) { const float a = bf2f((unsigned short)(hv[u][i][e2] & 0xffffu)) * rs * bf2f((unsigned short)(ov[u][i][e2] & 0xffffu)), c = bf2f((unsigned short)(hv[u][i][e2] >> 16)) * rs * bf2f((unsigned short)(ov[u][i][e2] >> 16)); o[e2] = pk2(a, c); }
                *(u32x4*)(MH + off) = o; } }
    }
}

__device__ __forceinline__ void p13_final(const Args& A, int gw, int NGW, int lane) {
    unsigned char* ws = A.ws; const bf16* XB = (const bf16*)(ws + WS_XB); const float* ssq = (const float*)(ws + WS_SSQ); const float* g = A.in[23];
    f32x4 gg[4];
#pragma unroll
    for (int j = 0; j < 4; ++j) gg[j] = *(const f32x4*)(g + 256 * j + 4 * lane);
    for (int row0 = gw; row0 < MTOT; row0 += 4 * NGW) {
        u32x2 v[4][4]; float sq[4];
#pragma unroll
        for (int u = 0; u < 4; ++u) { const int row = row0 + u * NGW < MTOT ? row0 + u * NGW : row0; sq[u] = lane < 16 ? ssq[(size_t)row * 16 + lane] : 0.f;
#pragma unroll
            for (int j = 0; j < 4; ++j) v[u][j] = *(const u32x2*)(XB + (size_t)row * DM + 256 * j + 4 * lane); }
#pragma unroll
        for (int u = 0; u < 4; ++u) { const int row = row0 + u * NGW; if (row >= MTOT) break;
            float* dst;
            if (row < MP) { const int b = row / TP, t = row - b * TP; if (t < NMETA) continue; dst = A.out + O_YP + ((size_t)b * SEQL + (t - NMETA)) * DM; }
            else dst = A.out + O_YS + (size_t)(row - MP) * DM;
            const float rs = __builtin_amdgcn_rsqf(wave_sum(sq[u]) * (1.0f / 1024.0f) + EPSN);
#pragma unroll
            for (int j = 0; j < 4; ++j) { const f32x4 x = {bf2f((unsigned short)(v[u][j].x & 0xffffu)), bf2f((unsigned short)(v[u][j].x >> 16)), bf2f((unsigned short)(v[u][j].y & 0xffffu)), bf2f((unsigned short)(v[u][j].y >> 16))};
                *(f32x4*)(dst + 256 * j + 4 * lane) = x * rs * gg[j]; } }
    }
}

template <bool FIRSTR, bool LASTR> __device__ __forceinline__ void tail_finish(const float* P, unsigned* cnt, const pg8::StaticOrder& base, int first, int ntail, int slices, int c, float* X, bf16* XB, float* ssq, lptr lds, int tid, const float* xp, const float* xs, const float* meta) {
    const int tu = c / slices; if (tu >= ntail) return;
    asm volatile("s_waitcnt vmcnt(0)" ::: "memory"); __syncthreads();
    if (tid == 0) { __builtin_amdgcn_fence(__ATOMIC_RELEASE, "agent"); asm volatile("s_waitcnt vmcnt(0)" ::: "memory");
        (void)__hip_atomic_fetch_add(cnt + tu, 1u, __ATOMIC_RELAXED, __HIP_MEMORY_SCOPE_AGENT);
        while (__hip_atomic_load(cnt + tu, __ATOMIC_RELAXED, __HIP_MEMORY_SCOPE_AGENT) < (unsigned)slices) __builtin_amdgcn_s_sleep(2); }
    __syncthreads();
    __builtin_amdgcn_fence(__ATOMIC_ACQUIRE, "agent"); asm volatile("s_waitcnt vmcnt(0)" ::: "memory");
    pg8::Unit u; base.map(first + tu, u);
    const int nrow = 256 / slices, rbase = (c % slices) * nrow;
    const int cc = tid & 31, r0 = tid >> 5;
    const float* p0 = P + (size_t)(tu * slices) * 65536 + cc * 8;
#pragma unroll 2
    for (int rr = 0; rr < nrow; rr += 16) { const int row = rbase + rr + r0;
        const size_t xoff = (size_t)(u.pm * 256 + row) * DM + u.pn * 256 + cc * 8;
        f32x4 a, b;
        if (FIRSTR) pg8::first_resid(xp, xs, meta, u.pm * 256 + row, u.pn * 256 + cc * 8, a, b); else { a = *(const f32x4*)(X + xoff); b = *(const f32x4*)(X + xoff + 4); }
        for (int s = 0; s < slices; ++s) { a = a + *(const f32x4*)(p0 + (size_t)s * 65536 + row * 256); b = b + *(const f32x4*)(p0 + (size_t)s * 65536 + row * 256 + 4); }
        if (!LASTR) { *(f32x4*)(X + xoff) = a; *(f32x4*)(X + xoff + 4) = b; } *(u32x4*)(XB + xoff) = pg8::pack8(a, b);
        float q = (a[0] * a[0] + a[1] * a[1]) + (a[2] * a[2] + a[3] * a[3]) + (b[0] * b[0] + b[1] * b[1]) + (b[2] * b[2] + b[3] * b[3]);
        q += __shfl_xor(q, 1); q += __shfl_xor(q, 2); q += __shfl_xor(q, 4);
        if ((cc & 7) == 0) ssq[(size_t)(u.pm * 256 + row) * 16 + u.pn * 4 + (cc >> 3)] = q; }
}

#define XB_TMO      128
#define XB_XCNT(j)  (256  + 64 * (j))
#define XB_XSUB(j)  (1280 + 64 * (j))
#define XB_XGEN(j)  (2304 + 64 * (j))
#define XB_TOP      3328
#define XB_TOPGEN   3392
#define XCD_BAR_WORDS 3456
#define XB_SPIN_CAP (1u << 18)

__device__ __forceinline__ unsigned xb_ld(unsigned* p)              { return __hip_atomic_load(p, __ATOMIC_RELAXED, __HIP_MEMORY_SCOPE_AGENT); }
__device__ __forceinline__ unsigned xb_add(unsigned* p, unsigned v) { return __hip_atomic_fetch_add(p, v, __ATOMIC_RELAXED, __HIP_MEMORY_SCOPE_AGENT); }
__device__ __forceinline__ unsigned xb_xcc_id() { return (unsigned)__builtin_amdgcn_s_getreg((3 << 11) | 20) & 0xFu; }
#define XB_SPIN(cond, bar) do { unsigned _sp = 0; while (cond) { __builtin_amdgcn_s_sleep(1); \
    if ((++_sp & 255u) == 0u) { if (xb_ld(&(bar)[XB_TMO])) break; if (_sp > XB_SPIN_CAP) { atomicAdd(&(bar)[XB_TMO], 1u); break; } } } } while (0)

struct XcdBarrier {
    unsigned* bar; unsigned x;
    volatile LAS unsigned* st;
};

__device__ __forceinline__ XcdBarrier xcd_barrier_post(unsigned* bar, volatile LAS unsigned* st) {
    XcdBarrier b; b.bar = bar; b.x = xb_xcc_id(); b.st = st;
    if (threadIdx.x == 0) (void)xb_add(&bar[XB_XCNT(b.x)], 1u);
    return b;
}
__device__ __forceinline__ void xcd_barrier_complete(unsigned* bar, unsigned x, unsigned& nloc, unsigned& nx) {
    const unsigned G = gridDim.x * gridDim.y * gridDim.z;
    unsigned sum, cnt, mine, sp = 0u;
    for (;;) {
        sum = 0u; cnt = 0u; mine = 0u;
#pragma unroll
        for (unsigned j = 0; j < 16; ++j) { const unsigned c = xb_ld(&bar[XB_XCNT(j)]); sum += c; cnt += (c > 0u) ? 1u : 0u; mine = (j == x) ? c : mine; }
        if (sum == G) break;
        __builtin_amdgcn_s_sleep(1);
        if ((++sp & 255u) == 0u) { if (xb_ld(&bar[XB_TMO])) break; if (sp > XB_SPIN_CAP) { atomicAdd(&bar[XB_TMO], 1u); break; } }
    }
    nloc = mine > 0u ? mine : 1u; nx = cnt > 0u ? cnt : 1u;
}

__device__ __forceinline__ void xcd_barrier(const XcdBarrier& b) {
    asm volatile("s_waitcnt vmcnt(0)" ::: "memory");
    __syncthreads();
    if (threadIdx.x == 0) {
        unsigned* bar = b.bar;
        __builtin_amdgcn_s_waitcnt(0);
        unsigned nloc = b.st[0], nx = b.st[1];
        if (nloc == 0u) { xcd_barrier_complete(bar, b.x, nloc, nx); b.st[0] = nloc; b.st[1] = nx; }
        const unsigned old = xb_add(&bar[XB_XSUB(b.x)], 1u);
        const unsigned gen = old / nloc;
        if (old + 1u == (gen + 1u) * nloc) {
            __builtin_amdgcn_fence(__ATOMIC_RELEASE, "agent");
            asm volatile("s_waitcnt vmcnt(0)" ::: "memory");
            const unsigned og = xb_add(&bar[XB_TOP], 1u);
            const unsigned tg = og / nx;
            if (og + 1u == (tg + 1u) * nx) xb_add(&bar[XB_TOPGEN], 1u);
            else XB_SPIN(xb_ld(&bar[XB_TOPGEN]) == tg, bar);
            __builtin_amdgcn_fence(__ATOMIC_ACQUIRE, "agent");
            xb_add(&bar[XB_XGEN(b.x)], 1u);
            asm volatile("s_waitcnt vmcnt(0)" ::: "memory");
        } else {
            XB_SPIN(xb_ld(&bar[XB_XGEN(b.x)]) == gen, bar);
            __builtin_amdgcn_fence(__ATOMIC_ACQUIRE, "agent");
            asm volatile("s_waitcnt vmcnt(0)" ::: "memory");
        }
    }
    __syncthreads();
}

__global__ void __launch_bounds__(NTHR, 2) fwd_megakernel(Args args) {
    extern __shared__ __attribute__((aligned(16))) unsigned char lds_raw[];
    cg::grid_group grid = cg::this_grid();
    { LAS unsigned* misc_ = (LAS unsigned*)(lds_raw) ; (void)misc_; }
#define GRID_SYNC() do { asm volatile("s_waitcnt vmcnt(0) lgkmcnt(0)" ::: "memory"); __syncthreads(); \
        if (threadIdx.x == 0) { __builtin_amdgcn_fence(__ATOMIC_RELEASE, "agent"); asm volatile("s_waitcnt vmcnt(0)" ::: "memory"); } \
        GSYNC(); \
        __builtin_amdgcn_fence(__ATOMIC_ACQUIRE, "agent"); asm volatile("s_waitcnt vmcnt(0)" ::: "memory"); __syncthreads(); } while (0)
    const lptr lds = (lptr)lds_raw;
    const int G = gridDim.x, bx = blockIdx.x, NGW = G * NWAVES;
#define TIDS int tid = threadIdx.x; asm volatile("" : "+v"(tid)); const int lane = tid & 63, w = __builtin_amdgcn_readfirstlane(tid >> 6), gw = bx * NWAVES + w; (void)gw; (void)lane
    unsigned char* ws = args.ws;
    bf16* XB = (bf16*)(ws + WS_XB); float* X = (float*)(ws + WS_X); float* ssq = (float*)(ws + WS_SSQ);
    volatile LAS unsigned* xb_st = (volatile LAS unsigned*)(lds + LDS_BYTES - 256);
    if (threadIdx.x < 2) xb_st[threadIdx.x] = 0u;
    __syncthreads();
    const XcdBarrier xbar = xcd_barrier_post((unsigned*)(ws + WS_CTL) + 4096, xb_st);
#ifndef USE_CG_SYNC
#define GSYNC() xcd_barrier(xbar)
#else
#define GSYNC() grid.sync()
#endif

#ifndef SKIP_P0
    { TIDS; p0_prologue(args, lds, gw, NGW, w, lane); }
#endif
#ifdef PROBE_P0
    { TIDS; p0_prologue(args, lds, gw, NGW, w, lane); }
#endif
    grid.sync();
    xcd_barrier(xbar);
#ifdef PROBE_P1
    { pg8::Gemm g{XB, (const bf16*)(ws + WS_WFIN), MPAD, NIN, DM}; pg8::StaticOrder S; S.init(MPAD, NIN, G, bx); pg8::EpiFoxIn E{ssq, args.in[13], args.in[14], args.in[12], ws, args.out};
      pg8::gemm_phase<pg8::EpiFoxIn, pg8::StaticOrder, PG8_ALIGN, PG8_SP2>(lds, g, S, E); }
    GSYNC();
#endif
#ifndef SKIP_P1
    {
        pg8::Gemm g{XB, (const bf16*)(ws + WS_WFIN), MPAD, NIN, DM}; pg8::StaticOrder S; S.init(MPAD, NIN, G, bx);
        pg8::EpiFoxIn E{ssq, args.in[13], args.in[14], args.in[12], ws, args.out};
        pg8::gemm_phase<pg8::EpiFoxIn, pg8::StaticOrder, PG8_ALIGN, PG8_SP2>(lds, g, S, E);
    }
#endif
    GSYNC();
#ifndef SKIP_P2
    { TIDS; p2_cumsum(args, gw, NGW, lane); }
#endif
    GSYNC();
#ifndef SKIP_P3
    { TIDS; p3_attention(args, lds, tid, w, lane, 0); }
#ifdef PROBE_P3
    GSYNC();
    { TIDS; p3_attention(args, lds, tid, w, lane, 1); }
#endif
#endif
    GSYNC();
#define RESID_GEMM(Ap, Wp, KK, CNTI, FIRSTF, LASTF) do { \
    pg8::StaticOrder S; S.init(MPAD, DM, G, bx); const int full_ = (S.nwg / G) * G, ntail_ = S.nwg - full_; S.lim = full_; \
    { pg8::Gemm g{(Ap), (Wp), MPAD, DM, (KK), (KK)}; pg8::EpiResidT<FIRSTF, LASTF> E{X, XB, ssq, args.in[0], args.in[1], args.in[8]}; pg8::gemm_phase<pg8::EpiResidT<FIRSTF, LASTF>, pg8::StaticOrder, PG8_ALIGN, PG8_SP2>(lds, g, S, E); } \
    if (ntail_ > 0) { const int sl_ = ntail_ * 8 <= G ? 8 : (ntail_ * 4 <= G ? 4 : (ntail_ * 2 <= G ? 2 : 1)); const int ks_ = (KK) / sl_; \
        pg8::TailOrder T{S, full_, ntail_, sl_, bx}; pg8::Gemm g{(Ap) + (bx % sl_) * ks_, (Wp) + (bx % sl_) * ks_, MPAD, DM, ks_, (KK)}; pg8::EpiPartial E{(float*)(ws + WS_P)}; \
        pg8::gemm_phase<pg8::EpiPartial, pg8::TailOrder, false, PG8_SP2>(lds, g, T, E); \
        { int tid_ = threadIdx.x; asm volatile("" : "+v"(tid_)); tail_finish<FIRSTF, LASTF>((const float*)(ws + WS_P), (unsigned*)(ws + WS_CTL) + 256 + (CNTI), S, full_, ntail_, sl_, bx, X, XB, ssq, lds, tid_, args.in[0], args.in[1], args.in[8]); } } } while (0)
#ifdef PROBE_UP
#define PROBE_UP_BODY(WUP) { pg8::Gemm g{XB, (const bf16*)(ws + (WUP)), MPAD, DFF, DM}; pg8::StaticOrder S; S.init(MPAD, DFF, G, bx); pg8::EpiUp E{ssq, (bf16*)(ws + WS_H)}; \
      pg8::gemm_phase<pg8::EpiUp, pg8::StaticOrder, PG8_ALIGN, PG8_SP2>(lds, g, S, E); } GSYNC();
#else
#define PROBE_UP_BODY(WUP)
#endif
#define LAYER_TAIL(AOP, WOUT, WUP, WDN, CNT0, FIRSTL, LASTL) do { \
    RESID_GEMM((const bf16*)(AOP), (const bf16*)(ws + (WOUT)), DM, CNT0, FIRSTL, false); \
    GSYNC(); \
    { pg8::Gemm g{XB, (const bf16*)(ws + (WUP)), MPAD, DFF, DM}; pg8::StaticOrder S; S.init(MPAD, DFF, G, bx); pg8::EpiUp E{ssq, (bf16*)(ws + WS_H)}; \
      pg8::gemm_phase<pg8::EpiUp, pg8::StaticOrder, PG8_ALIGN, PG8_SP2>(lds, g, S, E); } \
    GSYNC(); \
    PROBE_UP_BODY(WUP) \
    RESID_GEMM((const bf16*)(ws + WS_H), (const bf16*)(ws + (WDN)), DFF, CNT0 + 32, false, LASTL); \
    GSYNC(); } while (0)
#ifndef SKIP_L0
    LAYER_TAIL(ws + WS_OB, WS_WFOUT, WS_WUP0, WS_WDN0, 0, true, false);
#endif
#ifndef SKIP_P7
    {
        pg8::Gemm g{XB, (const bf16*)(ws + WS_WMIN), MPAD, NIN, DM}; pg8::StaticOrder S; S.init(MPAD, NIN, G, bx);
        pg8::EpiMlstmIn E{ssq, args.in[17], args.in[18], (bf16*)(ws + WS_MQ), (bf16*)(ws + WS_MK), (bf16*)(ws + WS_MV), (bf16*)(ws + WS_MO), (float*)(ws + WS_GI), (float*)(ws + WS_GF)};
        pg8::gemm_phase<pg8::EpiMlstmIn, pg8::StaticOrder, PG8_ALIGN, PG8_SP2>(lds, g, S, E);
    }
#endif
    GSYNC();
#ifndef SKIP_P8
    { TIDS; mlstm_a_phase(args, bx, G, lds, tid, w, lane); }
    GSYNC();
#ifdef PROBE_MA
    { TIDS; mlstm_a_phase(args, bx, G, lds, tid, w, lane); }
    GSYNC();
#endif
    { TIDS; for (int it = bx; it < 256 + 1024; it += G) mlstm_b_item(args, it, lds, tid, w, lane); }
#ifdef PROBE_MAB
    GSYNC();
    { TIDS; mlstm_a_phase(args, bx, G, lds, tid, w, lane); }
    GSYNC();
    { TIDS; for (int it = bx; it < 256 + 1024; it += G) mlstm_b_item(args, it, lds, tid, w, lane); }
#endif
#endif
    GSYNC();
#ifndef SKIP_P9
    { TIDS; p9_gate(args, gw, NGW, lane); }
#endif
    GSYNC();
#ifndef SKIP_L1
    LAYER_TAIL(ws + WS_MH, WS_WMOUT, WS_WUP1, WS_WDN1, 64, false, true);
#endif
#ifndef SKIP_P13
    { TIDS; p13_final(args, gw, NGW, lane); }
#ifdef PROBE_SYNC
    for (int i_ = 0; i_ < 16; ++i_) grid.sync();
#endif
#endif
}

extern "C" void kernel_launch(void* const* d_in, const int* in_sizes, int n_in, void* d_out, int out_size, void* d_ws, size_t ws_size, hipStream_t stream) {
    static int grid = 0;
    if (grid == 0) {
        if (n_in != 24 || (size_t)out_size != O_END || ws_size < WS_END) { fprintf(stderr, "kernel_launch: unexpected shapes: n_in %d out %d (want %zu) ws %zu (want >= %zu)\n", n_in, out_size, (size_t)O_END, ws_size, (size_t)WS_END); grid = -1; return; }
        int dev = 0, cus = 0, per_cu = 0;
        if (hipGetDevice(&dev) != hipSuccess || hipDeviceGetAttribute(&cus, hipDeviceAttributeMultiprocessorCount, dev) != hipSuccess) { grid = -1; return; }
        if (hipFuncSetAttribute((const void*)fwd_megakernel, hipFuncAttributeMaxDynamicSharedMemorySize, LDS_BYTES) != hipSuccess) { fprintf(stderr, "kernel_launch: hipFuncSetAttribute failed\n"); grid = -1; return; }
        if (hipOccupancyMaxActiveBlocksPerMultiprocessor(&per_cu, (const void*)fwd_megakernel, NTHR, LDS_BYTES) != hipSuccess || per_cu < 1) { fprintf(stderr, "kernel_launch: occupancy query says %d blocks per CU\n", per_cu); grid = -1; return; }
        grid = cus;
    }
    if (grid < 0) return;
    (void)hipMemsetAsync((char*)d_ws + WS_CTL, 0, 65536, stream);
    Args a{};
    for (int i = 0; i < 24; ++i) a.in[i] = (const float*)d_in[i];
    a.out = (float*)d_out; a.ws = (unsigned char*)d_ws;
    void* kargs[] = {&a};
    const hipError_t e = hipLaunchCooperativeKernel((const void*)fwd_megakernel, dim3(grid), dim3(NTHR), kargs, LDS_BYTES, stream);
    if (e != hipSuccess) fprintf(stderr, "kernel_launch: cooperative launch failed: %s (grid %d)\n", hipGetErrorString(e), grid);
}
```

```cpp
#include <hip/hip_runtime.h>
#include <hip/hip_cooperative_groups.h>
#include <cstdio>
#include <cstdint>
namespace cg = cooperative_groups;

constexpr int DM = 1024, TP = 4112, NB = 8, SEQL = 4096, NMETA = 16, DB = 32, DT = 32, PAST = 2048, DFF = 4096;
constexpr int MP = NB * TP;
constexpr int MTOT = MP + DB * DT;
constexpr int MPAD = 34048;
constexpr int NIN = 3328;
constexpr int PPAD = 240;
constexpr int PLEN = 4352;
constexpr int GSLEN = 2112;
constexpr float EPSN = 1e-6f;
constexpr float LOG2E = 1.4426950408889634f;
constexpr float QSCALE = 0.125f * LOG2E;

constexpr int NWAVES = 8, NTHR = 512;
constexpr int LDS_BYTES = 147456;
constexpr size_t MiB = 1u << 20;
constexpr size_t WS_CTL = 0;
constexpr size_t WS_WFIN = 1 * MiB, WS_WFOUT = 8 * MiB, WS_WMIN = 10 * MiB, WS_WMOUT = 17 * MiB, WS_WUP0 = 19 * MiB, WS_WUP1 = 27 * MiB, WS_WDN0 = 35 * MiB, WS_WDN1 = 43 * MiB;
constexpr size_t WS_SSQ = 51 * MiB, WS_G = 54 * MiB, WS_GS = 57 * MiB, WS_GI = 62 * MiB, WS_GF = 63 * MiB, WS_HSSQ = 64 * MiB;
constexpr size_t WS_X = 74 * MiB, WS_XB = 207 * MiB;
constexpr size_t WS_QB = 274 * MiB, WS_KB = 343 * MiB, WS_VB = 411 * MiB, WS_OB = 478 * MiB, WS_H = 274 * MiB;
constexpr size_t WS_MQ = 546 * MiB, WS_MK = 580 * MiB, WS_MV = 614 * MiB, WS_MO = 682 * MiB, WS_MH = 750 * MiB, WS_U = 818 * MiB, WS_RS = 958 * MiB, WS_NU = 959 * MiB, WS_P = 961 * MiB, WS_BBC = 1001 * MiB, WS_PMC = 1002 * MiB, WS_END = 1003 * MiB;
static_assert(WS_H + (size_t)MPAD * DFF * 2 <= WS_MQ && WS_OB + (size_t)MPAD * DM * 2 <= WS_MQ && WS_VB + (size_t)MPAD * DM * 2 <= WS_OB && WS_KB + (size_t)MPAD * DM * 2 <= WS_VB - MiB && WS_QB + (size_t)MPAD * DM * 2 <= WS_KB - MiB, "ws map");
static_assert(WS_G + (size_t)NB * 16 * PLEN * 4 <= WS_GS && WS_GS + (size_t)DB * 16 * GSLEN * 4 <= WS_GI && WS_HSSQ + (size_t)MPAD * 64 * 4 <= WS_X && WS_SSQ + (size_t)MPAD * 64 <= WS_G, "ws map 2");

struct Args { const float* in[24]; float* out; unsigned char* ws; };

constexpr size_t O_YP = 0, O_YS = O_YP + (size_t)NB * SEQL * DM, O_FKP = O_YS + (size_t)DB * DT * DM, O_FVP = O_FKP + (size_t)MP * DM, O_FLP = O_FVP + (size_t)MP * DM,
    O_MCP = O_FLP + (size_t)MP * 16, O_MNP = O_MCP + (size_t)NB * 4 * 256 * 128, O_MMP = O_MNP + (size_t)NB * 4 * 128, O_FKS = O_MMP + (size_t)NB * 4,
    O_FVS = O_FKS + (size_t)DB * DT * DM, O_FLS = O_FVS + (size_t)DB * DT * DM, O_MCS = O_FLS + (size_t)DB * DT * 16, O_MNS = O_MCS + (size_t)DB * 4 * 256 * 128,
    O_MMS = O_MNS + (size_t)DB * 4 * 128, O_END = O_MMS + (size_t)DB * 4;

namespace pg8 {
#define PG8_LAS __attribute__((address_space(3)))
typedef unsigned short bf16_t;
typedef short bf16x8 __attribute__((ext_vector_type(8)));
typedef float f32x4 __attribute__((ext_vector_type(4)));
typedef unsigned u32x4 __attribute__((ext_vector_type(4)));
constexpr int BM = 256, BK = 64, HALF = 128, HTB = HALF * BK * 2  , STAGE_BYTES = 8 * HTB, NXCD = 8, WGM = 8;

__host__ __device__ __forceinline__ int lds_byte(int r, int c) { const int st = (r >> 4) * 2 + (c >> 5), rr = r & 15, cc = c & 31, ob = rr * 64 + cc * 2; return st * 1024 + (ob ^ (((ob >> 9) & 1) << 5)); }
__host__ __device__ __forceinline__ void stage_rc(int b, int& R, int& C) { const int st = b / 1024, sb = b % 1024, swz = sb ^ (((sb >> 9) & 1) << 5); R = (st >> 1) * 16 + swz / 64; C = (st & 1) * 32 + (swz % 64) / 2; }
__host__ __device__ __forceinline__ int perm32(int rho) { const int n = rho >> 4, i = rho & 15; return 8 * (i >> 2) + 4 * n + (i & 3); }

struct Unit { int pm, pn, aux; };
struct Gemm { const bf16_t* A; const bf16_t* Bt; int M, N, K, ld; };

struct StaticOrder {
    int nM, nN, nwg, G, c, lim;
    __host__ __device__ void init(int M, int N, int G_, int c_) { nM = M / BM; nN = N / BM; nwg = nM * nN; G = G_; c = c_; lim = nwg; }
    __host__ __device__ bool next(int i, Unit& u) const { const long L = (long)i * G + c; if (L >= lim) return false; map((int)L, u); return true; }
    __host__ __device__ void map(int L, Unit& u) const {
        int wgid = L; { const int q = nwg / NXCD, r = nwg % NXCD, xcd = wgid % NXCD, off = wgid / NXCD; wgid = (xcd < r ? xcd * (q + 1) : r * (q + 1) + (xcd - r) * q) + off; }
        const int nig = WGM * nN, gid = wgid / nig, fm = gid * WGM, gsz = (nM - fm) < WGM ? (nM - fm) : WGM;
        u.pm = fm + ((wgid % nig) % gsz); u.pn = (wgid % nig) / gsz;
    }
    __device__ __forceinline__ void a_ready(const Unit&) const {}
    __device__ __forceinline__ void done(const Unit&) const {}
};


struct TailOrder {
    StaticOrder base; int first, ntail, slices, c;
    __device__ bool next(int i, Unit& u) const { if (i > 0) return false; const int tu = c / slices; if (tu >= ntail) return false; base.map(first + tu, u); u.aux = c; return true; }
    __device__ __forceinline__ void a_ready(const Unit&) const {}
    __device__ __forceinline__ void done(const Unit&) const {}
};

typedef float f32x2_cv __attribute__((ext_vector_type(2))); typedef __bf16 bf16x2_cv __attribute__((ext_vector_type(2)));
__device__ __forceinline__ unsigned cvt_pk_bf16(float lo, float hi) { const f32x2_cv v = {lo, hi}; const bf16x2_cv b = __builtin_convertvector(v, bf16x2_cv); return __builtin_bit_cast(unsigned, b); }
__device__ __forceinline__ u32x4 pack8(const f32x4 a, const f32x4 b) { u32x4 w; w.x = cvt_pk_bf16(a[0], a[1]); w.y = cvt_pk_bf16(a[2], a[3]); w.z = cvt_pk_bf16(b[0], b[1]); w.w = cvt_pk_bf16(b[2], b[3]); return w; }
__device__ __forceinline__ float row_rstd(const float* ssq, int row, int fq) {
    const f32x4 v = *(const f32x4*)(ssq + (size_t)row * 16 + 4 * fq);
    float s = (v[0] + v[1]) + (v[2] + v[3]);
    s += __shfl_xor(s, 16); s += __shfl_xor(s, 32);
    return __builtin_amdgcn_rsqf(s * (1.0f / 1024.0f) + EPSN);
}
__device__ __forceinline__ float log_sigmoid_f(float x) { return fminf(x, 0.f) - log1pf(__expf(-fabsf(x))); }

struct EpiFoxIn {
    static constexpr bool PERM = true, AFTER_DRAIN = false;
    const float* ssq; const float* gq; const float* gk; const float* bfv;
    unsigned char* ws; float* out;
    __device__ __forceinline__ void operator()(const f32x4 (&acc)[2][2][4][2], const Unit& u, int wr, int wc, int fr, int fq) const {
        const int pn = u.pn, sect = pn >> 2;
        f32x4 gv[2][2];
        if (sect < 2) {
#pragma unroll
            for (int bj = 0; bj < 2; ++bj)
#pragma unroll
                for (int n = 0; n < 2; ++n) { const f32x4 a = *(const f32x4*)(gq + 32 * bj + 8 * fq + 4 * n) * QSCALE, b = *(const f32x4*)(gk + 32 * bj + 8 * fq + 4 * n); gv[bj][n] = sect == 0 ? a : b; } }
        const int cb = (pn & 3) * 256 + wc * 64 + 8 * fq;
        float rsv[2][4];
#pragma unroll
        for (int ai = 0; ai < 2; ++ai)
#pragma unroll
            for (int m = 0; m < 4; ++m) rsv[ai][m] = row_rstd(ssq, u.pm * BM + ai * HALF + wr * 64 + m * 16 + fr, fq);
#pragma unroll
        for (int ai = 0; ai < 2; ++ai)
#pragma unroll
            for (int m = 0; m < 4; ++m) {
                const int row = u.pm * BM + ai * HALF + wr * 64 + m * 16 + fr;
                const float rs = rsv[ai][m];
                f32x4 v[2][2];
#pragma unroll
                for (int bj = 0; bj < 2; ++bj)
#pragma unroll
                    for (int n = 0; n < 2; ++n) v[bj][n] = acc[ai][bj][m][n] * rs;
                if (sect < 2) {
                    float ss = 0.f;
#pragma unroll
                    for (int bj = 0; bj < 2; ++bj)
#pragma unroll
                        for (int n = 0; n < 2; ++n) { const f32x4 x = v[bj][n]; ss += (x[0] * x[0] + x[1] * x[1]) + (x[2] * x[2] + x[3] * x[3]); }
                    ss += __shfl_xor(ss, 16); ss += __shfl_xor(ss, 32);
                    const float hr = __builtin_amdgcn_rsqf(ss * (1.0f / 64.0f) + EPSN);
#pragma unroll
                    for (int bj = 0; bj < 2; ++bj)
#pragma unroll
                        for (int n = 0; n < 2; ++n) v[bj][n] = v[bj][n] * hr * gv[bj][n];
                }
                const bool real = row < MTOT; const int grp = row < MP ? 0 : 1; const size_t orow = grp == 0 ? (size_t)row : (size_t)(row - MP);
                if (sect == 0) {
#pragma unroll
                    for (int bj = 0; bj < 2; ++bj) *(u32x4*)((bf16_t*)(ws + WS_QB) + (size_t)row * DM + cb + 32 * bj) = pack8(v[bj][0], v[bj][1]);
                } else if (sect < 3) {
                    bf16_t* B16 = (bf16_t*)(ws + (sect == 1 ? WS_KB : WS_VB)); float* of = out + (sect == 1 ? (grp == 0 ? O_FKP : O_FKS) : (grp == 0 ? O_FVP : O_FVS));
#pragma unroll
                    for (int bj = 0; bj < 2; ++bj) *(u32x4*)(B16 + (size_t)row * DM + cb + 32 * bj) = pack8(v[bj][0], v[bj][1]);
                    (void)of; (void)real;
                } else if (pn == 12 && wc == 0 && fq < 2 && real) {
#pragma unroll
                    for (int n = 0; n < 2; ++n) { const int h0 = 8 * fq + 4 * n; const f32x4 bb = *(const f32x4*)(bfv + h0); f32x4 o;
#pragma unroll
                        for (int j = 0; j < 4; ++j) o[j] = log_sigmoid_f(v[0][n][j] + bb[j]);
                        *(f32x4*)(out + (grp == 0 ? O_FLP : O_FLS) + orow * 16 + h0) = o; }
                }
            }
    }
};

__device__ __forceinline__ void first_resid(const float* xp, const float* xs, const float* meta, int row, int col, f32x4& x0, f32x4& x1) {
    x0 = (f32x4){0.f, 0.f, 0.f, 0.f}; x1 = x0;
    if (row < MP) { const int b = row / TP, t = row - b * TP;
        if (t < NMETA) { const float* p = meta + (size_t)t * DM + col; x0 = *(const f32x4*)p; x1 = *(const f32x4*)(p + 4); }
        else { const float* p = xp + ((size_t)b * SEQL + (t - NMETA)) * DM + col; x0 = *(const f32x4*)p; x1 = *(const f32x4*)(p + 4); } }
    else if (row < MTOT) { const float* p = xs + (size_t)(row - MP) * DM + col; x0 = *(const f32x4*)p; x1 = *(const f32x4*)(p + 4); }
}
template <bool FIRST, bool LAST = false> struct EpiResidT {
    static constexpr bool PERM = true, AFTER_DRAIN = false;
    float* X; bf16_t* XB; float* ssq; const float* xp; const float* xs; const float* meta;
    __device__ __forceinline__ void operator()(const f32x4 (&acc)[2][2][4][2], const Unit& u, int wr, int wc, int fr, int fq) const {
#pragma unroll
        for (int ai = 0; ai < 2; ++ai)
#pragma unroll
            for (int m = 0; m < 4; ++m) {
                const int row = u.pm * BM + ai * HALF + wr * 64 + m * 16 + fr; float ss = 0.f;
#pragma unroll
                for (int bj = 0; bj < 2; ++bj) { const size_t off = (size_t)row * DM + u.pn * BM + bj * HALF + wc * 32 + 8 * fq;
                    f32x4 x0, x1;
                    if (FIRST) first_resid(xp, xs, meta, row, u.pn * BM + bj * HALF + wc * 32 + 8 * fq, x0, x1);
                    else { const u32x4 r = *(const u32x4*)(XB + off);
                        x0 = (f32x4){__builtin_bit_cast(float, r.x << 16), __builtin_bit_cast(float, r.x & 0xffff0000u), __builtin_bit_cast(float, r.y << 16), __builtin_bit_cast(float, r.y & 0xffff0000u)};
                        x1 = (f32x4){__builtin_bit_cast(float, r.z << 16), __builtin_bit_cast(float, r.z & 0xffff0000u), __builtin_bit_cast(float, r.w << 16), __builtin_bit_cast(float, r.w & 0xffff0000u)}; }
                    x0 = x0 + acc[ai][bj][m][0]; x1 = x1 + acc[ai][bj][m][1];
                    *(u32x4*)(XB + off) = pack8(x0, x1);
                    ss += (x0[0] * x0[0] + x0[1] * x0[1]) + (x0[2] * x0[2] + x0[3] * x0[3]) + (x1[0] * x1[0] + x1[1] * x1[1]) + (x1[2] * x1[2] + x1[3] * x1[3]); }
                ss += __shfl_xor(ss, 16); ss += __shfl_xor(ss, 32);
                if (fq == 0) ssq[(size_t)row * 16 + u.pn * 4 + wc] = ss;
                if (m & 1) asm volatile("" ::: "memory");
            }
    }
};

struct EpiUp {
    static constexpr bool PERM = true, AFTER_DRAIN = false;
    const float* ssq; bf16_t* H;
    __device__ __forceinline__ void operator()(const f32x4 (&acc)[2][2][4][2], const Unit& u, int wr, int wc, int fr, int fq) const {
#pragma unroll
        for (int ai = 0; ai < 2; ++ai)
#pragma unroll
            for (int m = 0; m < 4; ++m) {
                const int row = u.pm * BM + ai * HALF + wr * 64 + m * 16 + fr; const float rs = row_rstd(ssq, row, fq);
#pragma unroll
                for (int bj = 0; bj < 2; ++bj) { f32x4 a = acc[ai][bj][m][0] * rs, b = acc[ai][bj][m][1] * rs;
#pragma unroll
                    for (int j = 0; j < 4; ++j) { a[j] = fmaxf(a[j], 0.f); a[j] *= a[j]; b[j] = fmaxf(b[j], 0.f); b[j] *= b[j]; }
                    *(u32x4*)(H + (size_t)row * DFF + u.pn * BM + bj * HALF + wc * 32 + 8 * fq) = pack8(a, b); }
            }
    }
};

struct EpiMlstmIn {
    static constexpr bool PERM = true, AFTER_DRAIN = false;
    const float* ssq; const float* bi; const float* bfv;
    bf16_t* MQ; bf16_t* MK; bf16_t* MV; bf16_t* MO; float* GI; float* GF;
    __device__ __forceinline__ void operator()(const f32x4 (&acc)[2][2][4][2], const Unit& u, int wr, int wc, int fr, int fq) const {
        const int pn = u.pn;
#pragma unroll
        for (int ai = 0; ai < 2; ++ai)
#pragma unroll
            for (int m = 0; m < 4; ++m) {
                const int row = u.pm * BM + ai * HALF + wr * 64 + m * 16 + fr; const float rs = row_rstd(ssq, row, fq);
                if (pn < 12) {
#pragma unroll
                    for (int bj = 0; bj < 2; ++bj) { f32x4 a = acc[ai][bj][m][0] * rs, b = acc[ai][bj][m][1] * rs; const int c = pn * BM + bj * HALF + wc * 32 + 8 * fq;
                        if (pn < 2) *(u32x4*)(MQ + (size_t)row * 512 + c) = pack8(a, b);
                        else if (pn < 4) { a = a * 0.08838834764831845f; b = b * 0.08838834764831845f; *(u32x4*)(MK + (size_t)row * 512 + (c - 512)) = pack8(a, b); }
                        else if (pn < 8) *(u32x4*)(MV + (size_t)row * DM + (c - 1024)) = pack8(a, b);
                        else {
#pragma unroll
                            for (int j = 0; j < 4; ++j) { a[j] = 1.0f / (1.0f + __expf(-a[j])); b[j] = 1.0f / (1.0f + __expf(-b[j])); }
                            *(u32x4*)(MO + (size_t)row * DM + (c - 2048)) = pack8(a, b); } }
                } else if (wc == 0 && fq == 0) {
                    const f32x4 a = acc[ai][0][m][0] * rs, b = acc[ai][0][m][1] * rs; const f32x4 vbi = *(const f32x4*)bi, vbf = *(const f32x4*)bfv; f32x4 oi, of;
#pragma unroll
                    for (int j = 0; j < 4; ++j) { oi[j] = a[j] + vbi[j]; of[j] = log_sigmoid_f(b[j] + vbf[j]); }
                    *(f32x4*)(GI + (size_t)row * 4) = oi; *(f32x4*)(GF + (size_t)row * 4) = of;
                }
            }
    }
};


struct EpiPartial {
    static constexpr bool PERM = true, AFTER_DRAIN = false;
    float* P;
    __device__ __forceinline__ void operator()(const f32x4 (&acc)[2][2][4][2], const Unit& u, int wr, int wc, int fr, int fq) const {
#pragma unroll
        for (int ai = 0; ai < 2; ++ai)
#pragma unroll
            for (int m = 0; m < 4; ++m)
#pragma unroll
                for (int bj = 0; bj < 2; ++bj) { float* p = P + (size_t)u.aux * 65536 + (size_t)(ai * HALF + wr * 64 + m * 16 + fr) * 256 + bj * HALF + wc * 32 + 8 * fq;
                    *(f32x4*)p = acc[ai][bj][m][0]; *(f32x4*)(p + 4) = acc[ai][bj][m][1]; }
    }
};
template <class Epi, class Sched, bool ALIGN_EPI = false, bool SP2 = false>
__device__ __forceinline__ void gemm_phase(PG8_LAS unsigned char* lds, const Gemm g, const Sched& S, const Epi& E) {
    int tid_o = threadIdx.x; asm volatile("" : "+v"(tid_o));
    const int tid = tid_o, wid = __builtin_amdgcn_readfirstlane(tid >> 6), lane = tid & 63, wr = wid >> 2, wc = wid & 3, fr = lane & 15, fq = lane >> 4;
    const int K = g.K, nt = K / BK, ld = g.ld ? g.ld : g.K;
    unsigned voffA[2], voffB[2];
#pragma unroll
    for (int i = 0; i < 2; ++i) { int R, C; stage_rc(tid * 16 + i * 8192, R, C); const int Rb = Epi::PERM ? ((R & ~31) + perm32(R & 31)) : R;
        voffA[i] = (unsigned)(R * ld + C) * 2u; voffB[i] = (unsigned)(Rb * ld + C) * 2u; }
    const size_t kstep = (size_t)(BK * 2);
    const size_t hstep = (size_t)HALF * ld * 2;
    const size_t tstep = 2 * hstep;
    const unsigned ldsw = (unsigned)wid * 1024u;
    const int aoff = lds_byte(wr * 64 + fr, fq * 8), boff = lds_byte(wc * 32 + fr, fq * 8);
#define PG8_SA(b, h) (((b) * 2 + (h)) * HTB)
#define PG8_SB(b, h) ((4 + (b) * 2 + (h)) * HTB)
#define PG8_STAGE(bufoff, gbase, voff) do { _Pragma("unroll") for (int _i = 0; _i < 2; ++_i) \
        __builtin_amdgcn_global_load_lds((const unsigned*)((const char*)(gbase) + (voff)[_i]), (PG8_LAS unsigned*)(lds + (bufoff) + ldsw + _i * 8192), 16, 0, 0); } while (0)
#define PG8_LDA(dst, b, h) do { _Pragma("unroll") for (int m = 0; m < 4; ++m) _Pragma("unroll") for (int k = 0; k < 2; ++k) dst[m][k] = *(const PG8_LAS bf16x8*)(lds + PG8_SA(b, h) + aoff + m * 2048 + k * 1024); } while (0)
#define PG8_LDB(dst, b, h) do { _Pragma("unroll") for (int n = 0; n < 2; ++n) _Pragma("unroll") for (int k = 0; k < 2; ++k) dst[n][k] = *(const PG8_LAS bf16x8*)(lds + PG8_SB(b, h) + boff + n * 2048 + k * 1024); } while (0)
#define PG8_MMA(ai, bj, At, Bt) do { __builtin_amdgcn_s_setprio(1); _Pragma("unroll") for (int m = 0; m < 4; ++m) _Pragma("unroll") for (int n = 0; n < 2; ++n) _Pragma("unroll") for (int k = 0; k < 2; ++k) \
        acc[ai][bj][m][n] = __builtin_amdgcn_mfma_f32_16x16x32_bf16(Bt[n][k], At[m][k], acc[ai][bj][m][n], 0, 0, 0); __builtin_amdgcn_s_setprio(0); } while (0)
#define PG8_WAIT_V(n) asm volatile("s_waitcnt vmcnt(" #n ")" ::: "memory")
#define PG8_WAIT_L(n) asm volatile("s_waitcnt lgkmcnt(" #n ")" ::: "memory")
#define PG8_BAR __builtin_amdgcn_s_barrier()
#define PG8_SCHED __builtin_amdgcn_sched_barrier(0)
    Unit cur, nxt; int ui = 0;
    if (!S.next(0, cur)) return;
    f32x4 acc[2][2][4][2];
#pragma unroll
    for (int a = 0; a < 2; ++a)
#pragma unroll
        for (int b = 0; b < 2; ++b)
#pragma unroll
            for (int m = 0; m < 4; ++m)
#pragma unroll
                for (int n = 0; n < 2; ++n) acc[a][b][m][n] = (f32x4){0.f, 0.f, 0.f, 0.f};
    bf16x8 At[4][2], B0[2][2], B1[2][2];
    const char* cA = (const char*)g.A + (size_t)cur.pm * tstep; const char* cB = (const char*)g.Bt + (size_t)cur.pn * tstep;
    S.a_ready(cur);
    if constexpr (SP2) {
        PG8_STAGE(PG8_SB(0, 0), cB, voffB); PG8_STAGE(PG8_SB(0, 1), cB + hstep, voffB); PG8_STAGE(PG8_SA(0, 0), cA, voffA); PG8_STAGE(PG8_SA(0, 1), cA + hstep, voffA);
        if (wr == 1) PG8_BAR;
        PG8_WAIT_V(2); PG8_BAR;
        PG8_STAGE(PG8_SB(1, 0), cB + kstep, voffB); PG8_STAGE(PG8_SA(1, 0), cA + kstep, voffA); PG8_STAGE(PG8_SB(1, 1), cB + hstep + kstep, voffB);
        PG8_WAIT_V(6); PG8_BAR;
    } else {
        PG8_STAGE(PG8_SB(0, 0), cB, voffB); PG8_STAGE(PG8_SA(0, 0), cA, voffA); PG8_STAGE(PG8_SB(0, 1), cB + hstep, voffB); PG8_STAGE(PG8_SA(0, 1), cA + hstep, voffA);
        if (wr == 1) PG8_BAR;
        PG8_WAIT_V(4); PG8_BAR;
        PG8_STAGE(PG8_SB(1, 0), cB + kstep, voffB); PG8_STAGE(PG8_SA(1, 0), cA + kstep, voffA); PG8_STAGE(PG8_SB(1, 1), cB + hstep + kstep, voffB);
        PG8_WAIT_V(6); PG8_BAR;
    }
    for (;;) {
        const bool has_next = S.next(ui + 1, nxt);
        const char* nA = has_next ? (const char*)g.A + (size_t)nxt.pm * tstep : cA; const char* nB = has_next ? (const char*)g.Bt + (size_t)nxt.pn * tstep : cB;
        for (int t = 0; t < nt; t += 2) {
            const bool last = (t == nt - 2);
            const char* a1 = cA + (size_t)(t + 1) * kstep;
            const char* a2 = last ? nA : cA + (size_t)(t + 2) * kstep; const char* b2 = last ? nB : cB + (size_t)(t + 2) * kstep;
            const char* a3 = a2 + kstep; const char* b3 = b2 + kstep;
            if (last && has_next) S.a_ready(nxt);
            if constexpr (SP2) {
            PG8_LDB(B0, 0, 0); PG8_LDB(B1, 0, 1); PG8_SCHED; PG8_LDA(At, 0, 0); PG8_STAGE(PG8_SA(1, 1), a1 + hstep, voffA);
            PG8_WAIT_V(8); PG8_WAIT_L(0); PG8_BAR; PG8_MMA(0, 0, At, B0); PG8_MMA(0, 1, At, B1); PG8_BAR; PG8_SCHED;
            PG8_LDA(At, 0, 1); PG8_STAGE(PG8_SB(0, 0), b2, voffB); PG8_STAGE(PG8_SB(0, 1), b2 + hstep, voffB); PG8_STAGE(PG8_SA(0, 0), a2, voffA);
            PG8_WAIT_V(8); PG8_WAIT_L(0); PG8_BAR; PG8_MMA(1, 0, At, B0); PG8_MMA(1, 1, At, B1); PG8_BAR; PG8_SCHED;
            PG8_LDB(B0, 1, 0); PG8_LDB(B1, 1, 1); PG8_SCHED; PG8_LDA(At, 1, 0); PG8_STAGE(PG8_SA(0, 1), a2 + hstep, voffA);
            PG8_WAIT_V(8); PG8_WAIT_L(0); PG8_BAR; PG8_MMA(0, 0, At, B0); PG8_MMA(0, 1, At, B1); PG8_BAR; PG8_SCHED;
            PG8_LDA(At, 1, 1); PG8_STAGE(PG8_SB(1, 0), b3, voffB); PG8_STAGE(PG8_SB(1, 1), b3 + hstep, voffB); PG8_STAGE(PG8_SA(1, 0), a3, voffA);
            PG8_WAIT_V(8); PG8_WAIT_L(0); PG8_BAR; PG8_MMA(1, 0, At, B0); PG8_MMA(1, 1, At, B1); PG8_BAR; PG8_SCHED;
            } else {
            PG8_LDB(B0, 0, 0); PG8_SCHED; PG8_LDA(At, 0, 0); PG8_STAGE(PG8_SA(1, 1), a1 + hstep, voffA);
            PG8_WAIT_L(8); PG8_BAR; PG8_WAIT_L(0); PG8_MMA(0, 0, At, B0); PG8_BAR; PG8_SCHED;
            PG8_LDB(B1, 0, 1); PG8_STAGE(PG8_SB(0, 0), b2, voffB);
            PG8_BAR; PG8_WAIT_L(0); PG8_MMA(0, 1, At, B1); PG8_BAR;
            PG8_LDA(At, 0, 1); PG8_STAGE(PG8_SA(0, 0), a2, voffA);
            PG8_BAR; PG8_WAIT_L(0); PG8_MMA(1, 0, At, B0); PG8_BAR; PG8_SCHED;
            PG8_STAGE(PG8_SB(0, 1), b2 + hstep, voffB);
            PG8_WAIT_V(6); PG8_BAR; PG8_MMA(1, 1, At, B1); PG8_BAR;
            PG8_LDB(B0, 1, 0); PG8_SCHED; PG8_LDA(At, 1, 0); PG8_STAGE(PG8_SA(0, 1), a2 + hstep, voffA);
            PG8_WAIT_L(8); PG8_BAR; PG8_WAIT_L(0); PG8_MMA(0, 0, At, B0); PG8_BAR; PG8_SCHED;
            PG8_LDB(B1, 1, 1); PG8_STAGE(PG8_SB(1, 0), b3, voffB);
            PG8_BAR; PG8_WAIT_L(0); PG8_MMA(0, 1, At, B1); PG8_BAR;
            PG8_LDA(At, 1, 1); PG8_STAGE(PG8_SA(1, 0), a3, voffA);
            PG8_BAR; PG8_WAIT_L(0); PG8_MMA(1, 0, At, B0); PG8_BAR; PG8_SCHED;
            PG8_STAGE(PG8_SB(1, 1), b3 + hstep, voffB);
            PG8_WAIT_V(6); PG8_BAR; PG8_MMA(1, 1, At, B1); PG8_BAR;
            }
        }
        if constexpr (ALIGN_EPI) { if (wr == 0) PG8_BAR; }
        if constexpr (!Epi::AFTER_DRAIN) { E(acc, cur, wr, wc, fr, fq); S.done(cur); }
        if (!has_next) break;
#pragma unroll
        for (int a = 0; a < 2; ++a)
#pragma unroll
            for (int b = 0; b < 2; ++b)
#pragma unroll
                for (int m = 0; m < 4; ++m)
#pragma unroll
                    for (int n = 0; n < 2; ++n) acc[a][b][m][n] = (f32x4){0.f, 0.f, 0.f, 0.f};
        cur = nxt; cA = nA; cB = nB; ++ui;
        if constexpr (ALIGN_EPI) { if (wr == 1) PG8_BAR; }
    }
    PG8_WAIT_V(0);
    if constexpr (!ALIGN_EPI) { if (wr == 0) PG8_BAR; }
    PG8_BAR;
    if constexpr (Epi::AFTER_DRAIN) { E.fused(acc, cur, wr, wc, fr, fq, lds, wid, lane); S.done(cur); }
#undef PG8_SA
#undef PG8_SB
#undef PG8_STAGE
#undef PG8_LDA
#undef PG8_LDB
#undef PG8_MMA
#undef PG8_WAIT_V
#undef PG8_WAIT_L
#undef PG8_BAR
#undef PG8_SCHED
}
}

#ifndef PG8_SP2
#define PG8_SP2 true
#endif
#ifndef PG8_ALIGN
#define PG8_ALIGN true
#endif

#define LAS __attribute__((address_space(3)))
typedef unsigned short bf16;
typedef unsigned u32x4 __attribute__((ext_vector_type(4)));
typedef unsigned u32x2 __attribute__((ext_vector_type(2)));
typedef float f32x4 __attribute__((ext_vector_type(4)));
typedef float f32x16 __attribute__((ext_vector_type(16)));
typedef short bf16x8 __attribute__((ext_vector_type(8)));
typedef short v4i16_t __attribute__((ext_vector_type(4)));
typedef LAS unsigned char* lptr;
typedef const LAS unsigned char* clptr;

__device__ __forceinline__ unsigned f2bf(float f) { unsigned u = __builtin_bit_cast(unsigned, f); return (u + 0x7fffu + ((u >> 16) & 1u)) >> 16; }
__device__ __forceinline__ unsigned pk2(float lo, float hi) { return pg8::cvt_pk_bf16(lo, hi); }
__device__ __forceinline__ float bf2f(unsigned short b) { return __builtin_bit_cast(float, (unsigned)b << 16); }
__device__ __forceinline__ float wave_sum(float v) {
#pragma unroll
    for (int o = 1; o < 64; o <<= 1) v += __shfl_xor(v, o);
    return v;
}
#define LDS_WAIT() asm volatile("s_waitcnt lgkmcnt(0)" ::: "memory")
#define LDS_BARRIER() asm volatile("s_waitcnt lgkmcnt(0)\n\ts_barrier" ::: "memory")

__device__ __forceinline__ void p0_transpose_item(const float* W, int K, int N, bf16* WT, const float* g, bool foxperm, LAS float* scr, int item, int nblk, int lane) {
    const int kb = item / nblk, nb = item % nblk, k0 = 64 * kb, n0 = 32 * nb;
#pragma unroll 8
    for (int i = 0; i < 32; ++i) { const int kk = 2 * i + (lane >> 5); const int n = n0 + (lane & 31); float v = n < N ? W[(size_t)(k0 + kk) * N + n] : 0.f; if (g) v *= g[k0 + kk]; scr[kk * 33 + (lane & 31)] = v; }
    LDS_WAIT(); asm volatile("" ::: "memory");
    const int c = lane & 7;
    int prow0 = n0;
    if (foxperm) { const int l = n0 & 255; prow0 = (n0 & ~255) + 128 * ((l >> 5) & 1) + 32 * ((l >> 6) & 3); }
#pragma unroll
    for (int j = 0; j < 4; ++j) { const int n = (lane >> 3) + 8 * j; const LAS float* s = scr + (8 * c) * 33 + n;
        u32x4 o; o.x = pk2(s[0 * 33], s[1 * 33]); o.y = pk2(s[2 * 33], s[3 * 33]); o.z = pk2(s[4 * 33], s[5 * 33]); o.w = pk2(s[6 * 33], s[7 * 33]);
        *(u32x4*)(WT + (size_t)(prow0 + n) * K + k0 + 8 * c) = o; }
    LDS_WAIT(); asm volatile("" ::: "memory");
}

__device__ __forceinline__ void p0_prologue(const Args& A, lptr lds, int gw, int NGW, int wave, int lane) {
    unsigned char* ws = A.ws;
    LAS float* scr = (LAS float*)(lds + wave * 16384);
    int base = 0;
#define WJOB(Wp, K_, N_, NP_, dst_, g_, perm_) do { const int nblk = (NP_) / 32, nitems = ((K_) / 64) * nblk; int first = (gw - base) % NGW; if (first < 0) first += NGW; \
        for (int it = first; it < nitems; it += NGW) p0_transpose_item((Wp), (K_), (N_), (bf16*)(ws + (dst_)), (g_), (perm_), scr, it, nblk, lane); base = (base + nitems) % NGW; } while (0)
    WJOB(A.in[11], DM, 3088, NIN, WS_WFIN, A.in[9], true);
    WJOB(A.in[15], DM, DM, DM, WS_WFOUT, (const float*)nullptr, false);
    WJOB(A.in[16], DM, 3080, NIN, WS_WMIN, A.in[9] + DM, false);
    WJOB(A.in[20], DM, DM, DM, WS_WMOUT, A.in[19], false);
    WJOB(A.in[21], DM, DFF, DFF, WS_WUP0, A.in[10], false);
    WJOB(A.in[21] + (size_t)DM * DFF, DM, DFF, DFF, WS_WUP1, A.in[10] + DM, false);
    WJOB(A.in[22], DFF, DM, DM, WS_WDN0, (const float*)nullptr, false);
    WJOB(A.in[22] + (size_t)DFF * DM, DFF, DM, DM, WS_WDN1, (const float*)nullptr, false);
#undef WJOB
    bf16* XB = (bf16*)(ws + WS_XB); float* ssq = (float*)(ws + WS_SSQ);
    for (int row0 = gw; row0 < MPAD; row0 += 4 * NGW) {
        f32x4 v[4][4];
#pragma unroll
        for (int u = 0; u < 4; ++u) { const int row = row0 + u * NGW; const float* src = nullptr;
            if (row < MP) { const int b = row / TP, t = row - b * TP; src = t < NMETA ? A.in[8] + (size_t)t * DM : A.in[0] + ((size_t)b * SEQL + (t - NMETA)) * DM; }
            else if (row < MTOT) src = A.in[1] + (size_t)(row - MP) * DM;
#pragma unroll
            for (int j = 0; j < 4; ++j) v[u][j] = src ? *(const f32x4*)(src + 256 * j + 4 * lane) : (f32x4){0.f, 0.f, 0.f, 0.f}; }
#pragma unroll
        for (int u = 0; u < 4; ++u) { const int row = row0 + u * NGW; if (row >= MPAD) break;
            float s = 0.f;
#pragma unroll
            for (int j = 0; j < 4; ++j) { const f32x4 x = v[u][j];
                u32x2 o;
                o.x = pk2(x[0], x[1]); o.y = pk2(x[2], x[3]); *(u32x2*)(XB + (size_t)row * DM + 256 * j + 4 * lane) = o;
                s += (x[0] * x[0] + x[1] * x[1]) + (x[2] * x[2] + x[3] * x[3]); }
            s = wave_sum(s);
            if (lane < 16) ssq[(size_t)row * 16 + lane] = lane == 0 ? s : 0.f; }
    }
    { const u32x4 z = {0u, 0u, 0u, 0u}; const int nchunk = PPAD * DM * 2 / 16;
        for (int i = gw * 64 + lane; i < nchunk; i += NGW * 64) { *(u32x4*)(ws + WS_KB - (size_t)PPAD * DM * 2 + (size_t)i * 16) = z; *(u32x4*)(ws + WS_VB - (size_t)PPAD * DM * 2 + (size_t)i * 16) = z; }
        const int nch2 = (MPAD - MTOT) * DM * 2 / 16;
        for (int i = gw * 64 + lane; i < nch2; i += NGW * 64) { *(u32x4*)(ws + WS_OB + (size_t)MTOT * DM * 2 + (size_t)i * 16) = z; *(u32x4*)(ws + WS_MH + (size_t)MTOT * DM * 2 + (size_t)i * 16) = z; } }
}

__device__ __forceinline__ float wave_scan_add(float v, int lane) {
#pragma unroll
    for (int o = 1; o < 64; o <<= 1) { const float t = __shfl_up(v, o); if (lane >= o) v += t; }
    return v;
}
__device__ __forceinline__ float wave_scan_max(float v, int lane) {
#pragma unroll
    for (int o = 1; o < 64; o <<= 1) { const float t = __shfl_up(v, o); if (lane >= o) v = fmaxf(v, t); }
    return v;
}
__device__ __forceinline__ void p2_cumsum(const Args& A, int gw, int NGW, int lane) {
    float* G = (float*)(A.ws + WS_G); float* GS = (float*)(A.ws + WS_GS);
    const float* lp = A.out + O_FLP; const float* lsn = A.out + O_FLS; const float* lc = A.in[4];
    for (int it = gw; it < NB * 16 + DB * 16; it += NGW) {
        if (it < NB * 16) { const int b = it >> 4, h = it & 15; float* g = G + (size_t)it * PLEN;
            for (int i = lane; i < PPAD; i += 64) g[i] = 0.f;
            float carry = 0.f;
#pragma unroll 1
            for (int c0 = 0; c0 < 65; c0 += 13) { float v[13];
#pragma unroll
                for (int c = 0; c < 13; ++c) { const int t = 64 * (c0 + c) + lane; v[c] = t < TP ? lp[((size_t)b * TP + t) * 16 + h] : 0.f; }
#pragma unroll
                for (int c = 0; c < 13; ++c) { const int t = 64 * (c0 + c) + lane; const float x = wave_scan_add(v[c], lane) + carry; if (t < TP) g[PPAD + t] = -LOG2E * x; carry = __shfl(x, 63); } }
        } else { const int i2 = it - NB * 16, b = i2 >> 4, h = i2 & 15; float* g = GS + (size_t)i2 * GSLEN;
            float carry = 0.f;
#pragma unroll 1
            for (int c0 = 0; c0 < 33; c0 += 11) { float v[11];
#pragma unroll
                for (int c = 0; c < 11; ++c) { const int s = 64 * (c0 + c) + lane; v[c] = 0.f; if (s < PAST) v[c] = lc[((size_t)b * PAST + s) * 16 + h]; else if (s < PAST + DT) v[c] = lsn[((size_t)b * DT + (s - PAST)) * 16 + h]; }
#pragma unroll
                for (int c = 0; c < 11; ++c) { const int s = 64 * (c0 + c) + lane; const float x = wave_scan_add(v[c], lane) + carry; g[s] = s < PAST + DT ? -LOG2E * x : 0.f; carry = __shfl(x, 63); } }
        }
    }
}

__device__ __forceinline__ int crow(int r, int hi) { return (r & 3) + 8 * (r >> 2) + 4 * hi; }
__device__ __forceinline__ v4i16_t vtr(clptr p) { return __builtin_amdgcn_ds_read_tr16_b64_v4i16((LAS v4i16_t*)p); }
constexpr int AT_KSTR = 144, AT_V = 9216, AT_B = 17408, AT_BUF = 17664;

template <bool MASK>
__device__ __forceinline__ void attn_tile(clptr Kt, clptr Vt, clptr Bt, const bf16x8 (&qr)[4], f32x16& o0, f32x16& o1, float& m, float& l, int qpos, int kpos0, int kmin, int lane) {
    const int r32 = lane & 31, hi = lane >> 5;
    f32x16 p0, p1;
#pragma unroll
    for (int r = 0; r < 16; ++r) { p0[r] = 0.f; p1[r] = 0.f; }
#pragma unroll
    for (int d0 = 0; d0 < 4; ++d0) {
        const bf16x8 a0 = *(const LAS bf16x8*)(Kt + r32 * AT_KSTR + d0 * 32 + hi * 16);
        const bf16x8 a1 = *(const LAS bf16x8*)(Kt + (32 + r32) * AT_KSTR + d0 * 32 + hi * 16);
        p0 = __builtin_amdgcn_mfma_f32_32x32x16_bf16(a0, qr[d0], p0, 0, 0, 0);
        p1 = __builtin_amdgcn_mfma_f32_32x32x16_bf16(a1, qr[d0], p1, 0, 0, 0);
    }
#pragma unroll
    for (int g = 0; g < 4; ++g) { const f32x4 b0 = *(const LAS f32x4*)(Bt + (8 * g + 4 * hi) * 4), b1 = *(const LAS f32x4*)(Bt + (32 + 8 * g + 4 * hi) * 4);
#pragma unroll
        for (int i = 0; i < 4; ++i) { p0[4 * g + i] += b0[i]; p1[4 * g + i] += b1[i]; } }
    if (MASK) {
#pragma unroll
        for (int r = 0; r < 16; ++r) { const int kp = kpos0 + crow(r, hi); if (kp > qpos || kp < kmin) p0[r] = -INFINITY; if (kp + 32 > qpos || kp + 32 < kmin) p1[r] = -INFINITY; }
    }
    float mx = fmaxf(p0[0], p1[0]);
#pragma unroll
    for (int r = 1; r < 16; ++r) mx = fmaxf(mx, fmaxf(p0[r], p1[r]));
    mx = fmaxf(mx, __shfl_xor(mx, 32));
    const float mnew = fmaxf(m, mx);
    if (__any(mnew > m)) {
        const float alpha = __builtin_amdgcn_exp2f(m - mnew); m = mnew; l *= alpha;
#pragma unroll
        for (int r = 0; r < 16; ++r) { o0[r] *= alpha; o1[r] *= alpha; } }
    float ls = 0.f;
#pragma unroll
    for (int r = 0; r < 16; ++r) { p0[r] = __builtin_amdgcn_exp2f(p0[r] - m); p1[r] = __builtin_amdgcn_exp2f(p1[r] - m); ls += p0[r] + p1[r]; }
    l += ls;
    u32x4 pw[4];
#pragma unroll
    for (int i = 0; i < 4; ++i) { pw[0][i] = pk2(p0[2 * i], p0[2 * i + 1]); pw[1][i] = pk2(p0[8 + 2 * i], p0[9 + 2 * i]); pw[2][i] = pk2(p1[2 * i], p1[2 * i + 1]); pw[3][i] = pk2(p1[8 + 2 * i], p1[9 + 2 * i]); }
    const clptr vb = Vt + ((lane >> 5) * 4 + ((lane & 15) >> 2)) * 64 + (((lane >> 4) & 1) * 16 + (lane & 3) * 4) * 2;
#pragma unroll
    for (int ks = 0; ks < 4; ++ks) {
        const v4i16_t l0 = vtr(vb + ks * 1024), h0 = vtr(vb + ks * 1024 + 512), l1 = vtr(vb + 4096 + ks * 1024), h1 = vtr(vb + 4096 + ks * 1024 + 512);
        const bf16x8 v0 = {l0[0], l0[1], l0[2], l0[3], h0[0], h0[1], h0[2], h0[3]}, v1 = {l1[0], l1[1], l1[2], l1[3], h1[0], h1[1], h1[2], h1[3]};
        const bf16x8 pb = __builtin_bit_cast(bf16x8, pw[ks]);
        o0 = __builtin_amdgcn_mfma_f32_32x32x16_bf16(v0, pb, o0, 0, 0, 0);
        o1 = __builtin_amdgcn_mfma_f32_32x32x16_bf16(v1, pb, o1, 0, 0, 0);
    }
}

__device__ __forceinline__ void kv_out_rows(const bf16* KB, const bf16* VB, float* outK, float* outV, size_t wsrow0, size_t outrow0, int nrows, int h, int tid) {
    const int ch = tid & 7, tsel = (tid >> 3) & 1, r0 = tid >> 4;
    const bf16* src = (tsel ? VB : KB) + h * 64 + ch * 8; float* dst = (tsel ? outV : outK) + h * 64 + ch * 8;
    asm volatile("" ::: "memory");
#pragma unroll 1
    for (int i0 = 0; i0 < 8; i0 += 4) { u32x4 v[4];
#pragma unroll
        for (int i = 0; i < 4; ++i) { const int r = r0 + 32 * (i0 + i); v[i] = r < nrows ? *(const u32x4*)(src + (wsrow0 + r) * DM) : (u32x4){0u, 0u, 0u, 0u}; }
#pragma unroll
        for (int i = 0; i < 4; ++i) { const int r = r0 + 32 * (i0 + i); if (r < nrows) { f32x4 a, b;
            a[0] = bf2f((unsigned short)(v[i].x & 0xffffu)); a[1] = bf2f((unsigned short)(v[i].x >> 16)); a[2] = bf2f((unsigned short)(v[i].y & 0xffffu)); a[3] = bf2f((unsigned short)(v[i].y >> 16));
            b[0] = bf2f((unsigned short)(v[i].z & 0xffffu)); b[1] = bf2f((unsigned short)(v[i].z >> 16)); b[2] = bf2f((unsigned short)(v[i].w & 0xffffu)); b[3] = bf2f((unsigned short)(v[i].w >> 16));
            *(f32x4*)(dst + (outrow0 + r) * DM) = a; *(f32x4*)(dst + (outrow0 + r) * DM + 4) = b; } } }
}

constexpr float AT_SKIP_T = 40.0f;
__device__ __forceinline__ void attn_prompt_unit(int b, int h, int j, const bf16* QB, const bf16* KB, const bf16* VB, const float* G, bf16* OB, lptr lds, int tid, int w, int lane, float kb, float* outK, float* outV) {
    const int r32 = lane & 31, hi = lane >> 5;
    const int qp = 256 * j + 32 * w + r32, t = qp - PPAD; const bool qvalid = t >= 0; const bool wave_active = (256 * j + 32 * w + 31) >= PPAD;
    const size_t qrow = (size_t)b * TP + (t > 0 ? t : 0);
    bf16x8 qr[4];
#pragma unroll
    for (int d0 = 0; d0 < 4; ++d0) qr[d0] = *(const bf16x8*)(QB + qrow * DM + h * 64 + d0 * 16 + hi * 8);
    const int lrow = tid >> 3, lch = tid & 7;
    const long krow0 = (long)b * TP - PPAD + lrow;
    const bf16* kg = KB + krow0 * DM + h * 64 + lch * 8; const bf16* vg = VB + krow0 * DM + h * 64 + lch * 8; const float* gg = G + (size_t)(b * 16 + h) * PLEN;
    f32x16 o0, o1;
#pragma unroll
    for (int r = 0; r < 16; ++r) { o0[r] = 0.f; o1[r] = 0.f; }
    float m = -1e30f, l = 0.f;
    const int kt1 = 4 * j + 3, ktw = 4 * j + (w >> 1), kmin = qp >= PPAD ? PPAD : 0;
    int kt0 = 3;
    { const int ta = 3 + lane, tb = 67 + lane;
        const float g0 = gg[j == 0 ? PPAD : 256 * j], ga = ta < 4 * j ? gg[64 * ta + 63] : 3.0e38f, gb = tb < 4 * j ? gg[64 * tb + 63] : 3.0e38f;
        const float thr = g0 - 2.0f * kb - AT_SKIP_T;
        const bool sa = ga <= thr, sb = gb <= thr;
        kt0 = 3 + __popcll(__ballot(sa)) + __popcll(__ballot(sb)); }
    u32x4 kreg[2][2], vreg[2][2]; float breg[2] = {0.f, 0.f};
    LAS int* vote = (LAS int*)(lds + 4 * AT_BUF);
#define AT_LOADPAIR(S, KH) do { _Pragma("unroll") for (int i_ = 0; i_ < 2; ++i_) { const int kk_ = (KH) - i_ >= kt0 ? (KH) - i_ : kt0; kreg[S][i_] = *(const u32x4*)(kg + (size_t)kk_ * 64 * DM); vreg[S][i_] = *(const u32x4*)(vg + (size_t)kk_ * 64 * DM); } \
        if (tid < 128) { const int kk_ = (KH) - (tid >> 6) >= kt0 ? (KH) - (tid >> 6) : kt0; breg[S] = gg[kk_ * 64 + (tid & 63)]; } } while (0)
#define AT_STEP(S, KH, STEPI) { const int kh_ = (KH); const lptr base = lds + (S) * 2 * AT_BUF; \
        _Pragma("unroll") for (int i = 0; i < 2; ++i) { *(LAS u32x4*)(base + i * AT_BUF + lrow * AT_KSTR + lch * 16) = kreg[S][i]; *(LAS u32x4*)(base + i * AT_BUF + AT_V + (lch >> 2) * 4096 + lrow * 64 + (lch & 3) * 16) = vreg[S][i]; } \
        if (tid < 128) *(LAS float*)(base + (tid >> 6) * AT_BUF + AT_B + (tid & 63) * 4) = breg[S]; \
        LDS_BARRIER(); \
        if ((STEPI) > 0) { const LAS int* vp_ = vote + (((STEPI) - 1) & 1) * 8; int all_ = 1; _Pragma("unroll") for (int i = 0; i < 8; ++i) all_ &= vp_[i]; if (all_) break; } \
        if (kh_ - 4 >= kt0) AT_LOADPAIR(S, kh_ - 4); \
        int done_ = wave_active ? 0 : 1; \
        _Pragma("unroll") for (int i = 0; i < 2; ++i) { const int k2 = kh_ - i; const lptr b2 = base + i * AT_BUF; \
            if (wave_active && k2 <= ktw && k2 >= kt0) { \
                if (k2 == 3 || k2 == ktw) attn_tile<true>(b2, b2 + AT_V, b2 + AT_B, qr, o0, o1, m, l, qp, 64 * k2, kmin, lane); \
                else attn_tile<false>(b2, b2 + AT_V, b2 + AT_B, qr, o0, o1, m, l, qp, 64 * k2, kmin, lane); \
                done_ = k2 > kt0 ? (__all(kb + *(const LAS float*)(b2 + AT_B) <= m - AT_SKIP_T) ? 1 : 0) : 1; } } \
        if (lane == 0) vote[((STEPI) & 1) * 8 + w] = done_; }
    AT_LOADPAIR(0, kt1);
    if (kt1 - 2 >= kt0) AT_LOADPAIR(1, kt1 - 2);
    for (int kh = kt1, si = 0; kh >= kt0; kh -= 4, si += 2) { AT_STEP(0, kh, si) if (kh - 2 >= kt0) AT_STEP(1, kh - 2, si + 1) }
#undef AT_STEP
#undef AT_LOADPAIR
    const float lt = l + __shfl_xor(l, 32), inv = 1.0f / lt;
    if (wave_active && qvalid) { bf16* op = OB + qrow * DM + h * 64 + 4 * hi;
#pragma unroll
        for (int g = 0; g < 4; ++g) { u32x2 a, c; a.x = pk2(o0[4 * g] * inv, o0[4 * g + 1] * inv); a.y = pk2(o0[4 * g + 2] * inv, o0[4 * g + 3] * inv); c.x = pk2(o1[4 * g] * inv, o1[4 * g + 1] * inv); c.y = pk2(o1[4 * g + 2] * inv, o1[4 * g + 3] * inv);
            *(u32x2*)(op + 8 * g) = a; *(u32x2*)(op + 32 + 8 * g) = c; } }
    { const int t0 = j == 0 ? 0 : 256 * j - PPAD, nr = j == 0 ? 256 - PPAD : 256;
        kv_out_rows(KB, VB, outK, outV, (size_t)b * TP + t0, (size_t)b * TP + t0, nr, h, tid); }
    __syncthreads();
}

__device__ __forceinline__ void attn_sample_unit(int b, int h, const float* cK, const float* cV, const bf16* QB, const bf16* KB, const bf16* VB, const float* GS, bf16* OB, lptr lds, int tid, int w, int lane, float kb, float* outK, float* outV) {
    const int r32 = lane & 31, hi = lane >> 5;
    const lptr base = lds + w * AT_BUF;
    const size_t qrow = (size_t)MP + b * DT + r32;
    bf16x8 qr[4];
#pragma unroll
    for (int d0 = 0; d0 < 4; ++d0) qr[d0] = *(const bf16x8*)(QB + qrow * DM + h * 64 + d0 * 16 + hi * 8);
    f32x16 o0, o1;
#pragma unroll
    for (int r = 0; r < 16; ++r) { o0[r] = 0.f; o1[r] = 0.f; }
    float m = -1e30f, l = 0.f;
    const float* gs = GS + (size_t)(b * 16 + h) * GSLEN;
    int ti0 = 0;
    { const float thr = gs[PAST] - 2.0f * kb - AT_SKIP_T; const bool sk = lane < 32 && gs[64 * lane + 63] <= thr; ti0 = __popcll(__ballot(sk)); }
#pragma unroll 1
    for (int ti = ti0 + w; ti < 33; ti += 8) {
        const float bias_l = gs[64 * ti + lane];
        if (ti < 32) {
            const float* ck0 = cK + (((size_t)b * PAST + 64 * ti + (lane >> 4)) * 16 + h) * 64 + 4 * (lane & 15); const float* cv0 = cV + (ck0 - cK);
            const lptr kw0 = base + (lane >> 4) * AT_KSTR + (lane & 15) * 8, vw0 = base + AT_V + ((lane & 15) >> 3) * 4096 + (lane >> 4) * 64 + (lane & 7) * 8;
#pragma unroll
            for (int half = 0; half < 2; ++half) {
                f32x4 kv[8], vv[8];
#pragma unroll
                for (int i = 0; i < 8; ++i) { kv[i] = *(const f32x4*)(ck0 + (half * 32 + i * 4) * 1024); vv[i] = *(const f32x4*)(cv0 + (half * 32 + i * 4) * 1024); }
#pragma unroll
                for (int i = 0; i < 8; ++i) { u32x2 a, c; a.x = pk2(kv[i][0], kv[i][1]); a.y = pk2(kv[i][2], kv[i][3]); c.x = pk2(vv[i][0], vv[i][1]); c.y = pk2(vv[i][2], vv[i][3]);
                    *(LAS u32x2*)(kw0 + (half * 32 + i * 4) * AT_KSTR) = a; *(LAS u32x2*)(vw0 + (half * 32 + i * 4) * 64) = c; }
                asm volatile("" ::: "memory");
            }
        } else {
            const size_t off0 = ((size_t)MP + b * DT + (lane >> 3)) * DM + h * 64 + (lane & 7) * 8;
            const lptr kw0 = base + (lane >> 3) * AT_KSTR + (lane & 7) * 16, vw0 = base + AT_V + ((lane & 7) >> 2) * 4096 + (lane >> 3) * 64 + (lane & 3) * 16;
#pragma unroll
            for (int i = 0; i < 8; ++i) { const u32x4 a = *(const u32x4*)(KB + off0 + (size_t)i * 8 * DM), c = *(const u32x4*)(VB + off0 + (size_t)i * 8 * DM);
                *(LAS u32x4*)(kw0 + i * 8 * AT_KSTR) = a; *(LAS u32x4*)(vw0 + i * 8 * 64) = c; }
        }
        *(LAS float*)(base + AT_B + lane * 4) = bias_l;
        LDS_WAIT();
        if (ti < 32) attn_tile<false>(base, base + AT_V, base + AT_B, qr, o0, o1, m, l, 0, 0, 0, lane);
        else attn_tile<true>(base, base + AT_V, base + AT_B, qr, o0, o1, m, l, r32, 0, 0, lane);
        asm volatile("" ::: "memory");
    }
    const float lt = l + __shfl_xor(l, 32);
    LDS_WAIT();
    LAS float* of = (LAS float*)base;
#pragma unroll
    for (int r = 0; r < 16; ++r) { of[crow(r, hi) * 32 + r32] = o0[r]; of[(32 + crow(r, hi)) * 32 + r32] = o1[r]; }
    if (hi == 0) { of[2048 + r32] = m; of[2080 + r32] = lt; }
    __syncthreads();
    { const int q = tid & 31, dg = tid >> 5; float M = -1e30f;
#pragma unroll
        for (int ww = 0; ww < 8; ++ww) M = fmaxf(M, ((LAS float*)(lds + ww * AT_BUF))[2048 + q]);
        float L = 0.f, o[4] = {0.f, 0.f, 0.f, 0.f};
#pragma unroll
        for (int ww = 0; ww < 8; ++ww) { const LAS float* p = (LAS float*)(lds + ww * AT_BUF); const float f = __builtin_amdgcn_exp2f(p[2048 + q] - M); L += f * p[2080 + q];
#pragma unroll
            for (int i = 0; i < 4; ++i) o[i] += f * p[(4 * dg + i) * 32 + q]; }
        const float inv = 1.0f / L; u32x2 a; a.x = pk2(o[0] * inv, o[1] * inv); a.y = pk2(o[2] * inv, o[3] * inv);
        *(u32x2*)(OB + ((size_t)MP + b * DT + q) * DM + h * 64 + 4 * dg) = a; }
    kv_out_rows(KB, VB, outK, outV, (size_t)MP + b * DT, (size_t)b * DT, DT, h, tid);
    __syncthreads();
}

__device__ __forceinline__ void p3_attention(const Args& A, lptr lds, int tid, int w, int lane, int rep) {
    unsigned char* ws = A.ws;
    const bf16* QB = (const bf16*)(ws + WS_QB); const bf16* KB = (const bf16*)(ws + WS_KB); const bf16* VB = (const bf16*)(ws + WS_VB); bf16* OB = (bf16*)(ws + WS_OB);
    const float* G = (const float*)(ws + WS_G); const float* GS = (const float*)(ws + WS_GS);
    unsigned* ctr = (unsigned*)(ws + WS_CTL) + 64 * rep;
    LAS unsigned* su = (LAS unsigned*)(lds + LDS_BYTES - 64);
    constexpr int NPU = 17 * NB * 16, NSU = DB * 16, NU = NPU + NSU;
    float gqm = 0.f, gkm = 0.f;
    for (int i = 0; i < 64; ++i) { gqm = fmaxf(gqm, fabsf(A.in[13][i])); gkm = fmaxf(gkm, fabsf(A.in[14][i])); }
    const float kb = 8.0f * LOG2E * gqm * gkm * 1.02f;
    for (;;) {
        if (tid == 0) *su = atomicAdd(ctr, 1u);
        __syncthreads();
        const int u = (int)*su;
        __syncthreads();
        if (u >= NU) break;
        const bool is_s = (u % 5 == 4) && (u / 5 < NSU);
        if (is_s) { const int s = u / 5; attn_sample_unit(s >> 4, s & 15, A.in[2], A.in[3], QB, KB, VB, GS, OB, lds, tid, w, lane, kb, A.out + O_FKS, A.out + O_FVS); }
        else { const int k = u / 5, pidx = u - (k < NSU ? k : NSU); const int j = 16 - pidx / (NB * 16), bh = pidx % (NB * 16); attn_prompt_unit(bh >> 4, bh & 15, j, QB, KB, VB, G, OB, lds, tid, w, lane, kb, A.out + O_FKP, A.out + O_FVP); }
    }
#ifdef PROBE_SAMPLE
    for (;;) { if (tid == 0) *su = atomicAdd(ctr + 128, 1u); __syncthreads(); const int u = (int)*su; __syncthreads(); if (u >= NSU) break;
        attn_sample_unit(u >> 4, u & 15, A.in[2], A.in[3], QB, KB, VB, GS, OB, lds, tid, w, lane, kb, A.out + O_FKS, A.out + O_FVS); }
#endif
}

constexpr int ML_QS = 272, ML_TS = 144;
constexpr int MA_VS = 544;
constexpr int MA_Q = 0, MA_K = 17408, MA_KW = 34816, MA_V = 52224, MA_SP = 87040, MA_VEC = 96256;
__device__ __forceinline__ bf16x8 tr_frag(clptr p, int rowstride4) { const v4i16_t lo = vtr(p), hi = vtr(p + rowstride4); return (bf16x8){lo[0], lo[1], lo[2], lo[3], hi[0], hi[1], hi[2], hi[3]}; }
constexpr int NUA = NB * 4 * 65 + DB * 4;
__device__ __forceinline__ f32x4 mfma16(bf16x8 a, bf16x8 b, f32x4 c) { return __builtin_amdgcn_mfma_f32_16x16x32_bf16(a, b, c, 0, 0, 0); }

__device__ __forceinline__ void mlstm_a_phase(const Args& A, int first, int stride, lptr lds, int tid, int w, int lane) {
    unsigned char* ws = A.ws;
    u32x4 pq[2], pk[2], pv[4]; float pgi = -1e30f, pgf = 0.f;
#define MA_LOAD(UID) do { const int uid_ = (UID); const bool pr_ = uid_ < NB * 4 * 65; const int bh_ = pr_ ? uid_ / 65 : uid_ - NB * 4 * 65, c_ = pr_ ? uid_ - bh_ * 65 : 0, b_ = bh_ >> 2, h_ = bh_ & 3; \
        const size_t rb_ = pr_ ? (size_t)b_ * TP : (size_t)MP + (size_t)b_ * DT; const int t0_ = pr_ ? 64 * c_ - 48 : 0, tl_ = pr_ ? TP : DT; \
        { const int tk_ = t0_ + lane; pgi = -1e30f; pgf = 0.f; if (tk_ >= 0 && tk_ < tl_) { pgi = ((const float*)(ws + WS_GI))[(rb_ + tk_) * 4 + h_]; pgf = ((const float*)(ws + WS_GF))[(rb_ + tk_) * 4 + h_]; } } \
        _Pragma("unroll") for (int i_ = 0; i_ < 2; ++i_) { const int id_ = tid + 512 * i_, r_ = id_ >> 4, ch_ = id_ & 15; const int tk_ = t0_ + r_; pq[i_] = (u32x4){0u, 0u, 0u, 0u}; pk[i_] = (u32x4){0u, 0u, 0u, 0u}; \
            if (tk_ >= 0 && tk_ < tl_) { pq[i_] = *(const u32x4*)((const bf16*)(ws + WS_MQ) + (rb_ + tk_) * 512 + h_ * 128 + ch_ * 8); pk[i_] = *(const u32x4*)((const bf16*)(ws + WS_MK) + (rb_ + tk_) * 512 + h_ * 128 + ch_ * 8); } } \
        _Pragma("unroll") for (int i_ = 0; i_ < 4; ++i_) { const int id_ = tid + 512 * i_, r_ = id_ >> 5, ch_ = id_ & 31; const int tk_ = t0_ + r_; pv[i_] = (u32x4){0u, 0u, 0u, 0u}; \
            if (tk_ >= 0 && tk_ < tl_) pv[i_] = *(const u32x4*)((const bf16*)(ws + WS_MV) + (rb_ + tk_) * DM + h_ * 256 + ch_ * 8); } } while (0)
    if (first < NUA) MA_LOAD(first);
#pragma unroll 1
    for (int uid = first; uid < NUA; uid += stride) {
    bf16* MH = (bf16*)(ws + WS_MH);
    float* RS = (float*)(ws + WS_RS); float* NU = (float*)(ws + WS_NU); bf16* U = (bf16*)(ws + WS_U) + (size_t)uid * 32768;
    const bool prompt = uid < NB * 4 * 65; const int bh = prompt ? uid / 65 : uid - NB * 4 * 65, c = prompt ? uid - bh * 65 : 0, b = bh >> 2, h = bh & 3;
    const size_t row_base = prompt ? (size_t)b * TP : (size_t)MP + (size_t)b * DT; const int tok0 = prompt ? 64 * c - 48 : 0, tlim = prompt ? TP : DT;
    LAS float* vec = (LAS float*)(lds + MA_VEC); LAS float* v_b = vec, *v_a = vec + 64, *v_ml = vec + 128, *v_rs = vec + 192;
    const int l15 = lane & 15, lg = lane >> 4;
    const float gi = pgi, gf = pgf;
    const float bb = wave_scan_add(gf, lane), aa = gi - bb, pm = wave_scan_max(aa, lane), mloc = bb + pm;
    const float b_last = __shfl(bb, 63), ml_last = __shfl(mloc, 63), wgl = __expf(b_last + aa - ml_last);
    if (w == 0) { v_b[lane] = bb; v_a[lane] = aa; v_ml[lane] = mloc; }
    if (w == 0) { ((float*)(ws + WS_BBC))[(size_t)uid * 64 + lane] = bb; ((float*)(ws + WS_PMC))[(size_t)uid * 64 + lane] = pm; }
#pragma unroll
    for (int i = 0; i < 2; ++i) { const int id = tid + 512 * i, r = id >> 4, ch = id & 15; const int tk = tok0 + r; const bool ok = tk >= 0 && tk < tlim;
        const u32x4 q = pq[i], k = pk[i]; (void)ok;
        *(LAS u32x4*)(lds + MA_Q + r * ML_QS + ch * 16) = q; *(LAS u32x4*)(lds + MA_K + r * ML_QS + ch * 16) = k;
        const float wgr = __shfl(wgl, r); u32x4 kw;
#pragma unroll
        for (int e = 0; e < 4; ++e) kw[e] = pk2(bf2f((unsigned short)(k[e] & 0xffffu)) * wgr, bf2f((unsigned short)(k[e] >> 16)) * wgr);
        *(LAS u32x4*)(lds + MA_KW + r * ML_QS + ch * 16) = kw; }
#pragma unroll
    for (int i = 0; i < 4; ++i) { const int id = tid + 512 * i, r = id >> 5, ch = id & 31; const int tk = tok0 + r; const bool ok = tk >= 0 && tk < tlim;
        const u32x4 v = pv[i]; (void)ok;
        *(LAS u32x4*)(lds + MA_V + r * MA_VS + ch * 16) = v; }
    LDS_BARRIER();
    if (uid + stride < NUA) MA_LOAD(uid + stride);
    { const int tr = w >> 1; float rs[4] = {0.f, 0.f, 0.f, 0.f};
#pragma unroll
        for (int i = 0; i < 2; ++i) { const int tc = 2 * (w & 1) + i; f32x4 acc = {0.f, 0.f, 0.f, 0.f};
#pragma unroll
            for (int k0 = 0; k0 < 128; k0 += 32) { const bf16x8 a = *(const LAS bf16x8*)(lds + MA_Q + (16 * tr + l15) * ML_QS + (k0 + 8 * lg) * 2), bq = *(const LAS bf16x8*)(lds + MA_K + (16 * tc + l15) * ML_QS + (k0 + 8 * lg) * 2); acc = mfma16(a, bq, acc); }
            const int s = 16 * tc + l15; const float as = v_a[s];
#pragma unroll
            for (int r = 0; r < 4; ++r) { const int t = 16 * tr + 4 * lg + r; const float d = s <= t ? __expf(v_b[t] + as - v_ml[t]) : 0.f; const float sp = acc[r] * d; rs[r] += sp;
                *(LAS unsigned short*)(lds + MA_SP + t * ML_TS + s * 2) = (unsigned short)f2bf(sp); } }
#pragma unroll
        for (int r = 0; r < 4; ++r) { float x = rs[r]; x += __shfl_xor(x, 1); x += __shfl_xor(x, 2); x += __shfl_xor(x, 4); x += __shfl_xor(x, 8); if (l15 == 0) v_rs[(w & 1) * 64 + 16 * tr + 4 * lg + r] = x; } }
    const clptr vtb = lds + MA_V + (8 * lg + (l15 >> 2)) * MA_VS + (l15 & 3) * 8;
    {
        const clptr kwb = lds + MA_KW + (8 * lg + (l15 >> 2)) * ML_QS + (l15 & 3) * 8 + w * 32;
        const bf16x8 a0 = tr_frag(kwb, 4 * ML_QS), a1 = tr_frag(kwb + 32 * ML_QS, 4 * ML_QS);
#pragma unroll 4
        for (int dvt = 0; dvt < 16; ++dvt) { const bf16x8 b0 = tr_frag(vtb + dvt * 32, 4 * MA_VS), b1 = tr_frag(vtb + 32 * MA_VS + dvt * 32, 4 * MA_VS);
            f32x4 acc = {0.f, 0.f, 0.f, 0.f}; acc = mfma16(a0, b0, acc); acc = mfma16(a1, b1, acc);
            u32x2 o; o.x = pk2(acc[0], acc[1]); o.y = pk2(acc[2], acc[3]); *(u32x2*)(U + (size_t)(16 * dvt + l15) * 128 + 16 * w + 4 * lg) = o; } }
    if (tid < 128) { float x = 0.f;
#pragma unroll 8
        for (int s = 0; s < 64; ++s) x += bf2f(*(const LAS unsigned short*)(lds + MA_KW + s * ML_QS + tid * 2));
        NU[(size_t)uid * 128 + tid] = x; }
    LDS_BARRIER();
    if (tid < 64) { const int tk = tok0 + tid; if (tk >= 0 && tk < tlim) RS[(row_base + tk) * 4 + h] = v_rs[tid] + v_rs[64 + tid]; }
    {
        const int tt = w & 3; const bf16x8 b0 = *(const LAS bf16x8*)(lds + MA_SP + (16 * tt + l15) * ML_TS + (8 * lg) * 2), b1 = *(const LAS bf16x8*)(lds + MA_SP + (16 * tt + l15) * ML_TS + (32 + 8 * lg) * 2);
        const int tk = tok0 + 16 * tt + l15; const bool ok = tk >= 0 && tk < tlim; bf16* dst = MH + (row_base + (ok ? tk : 0)) * DM + h * 256 + 4 * lg;
#pragma unroll 4
        for (int i = 0; i < 8; ++i) { const int dvt = 8 * (w >> 2) + i; const bf16x8 a0 = tr_frag(vtb + dvt * 32, 4 * MA_VS), a1 = tr_frag(vtb + 32 * MA_VS + dvt * 32, 4 * MA_VS);
            f32x4 acc = {0.f, 0.f, 0.f, 0.f}; acc = mfma16(a0, b0, acc); acc = mfma16(a1, b1, acc);
            if (ok) { u32x2 o; o.x = pk2(acc[0], acc[1]); o.y = pk2(acc[2], acc[3]); *(u32x2*)(dst + 16 * dvt) = o; } } }
    LDS_BARRIER();
    }
#undef MA_LOAD
    __syncthreads();
}

constexpr int MB_QSZ = 17408, MB_CBSZ = 48 * ML_QS, MB_Q = 0, MB_CB = 2 * MB_QSZ, MB_END = MB_CB + 2 * MB_CBSZ;
__device__ __forceinline__ void mlstm_b_item(const Args& A, int it, lptr lds, int tid, int w, int lane) {
    unsigned char* ws = A.ws;
    const bf16* MQ = (const bf16*)(ws + WS_MQ); bf16* MH = (bf16*)(ws + WS_MH); const float* GI = (const float*)(ws + WS_GI); const float* GF = (const float*)(ws + WS_GF);
    const float* RS = (const float*)(ws + WS_RS); const float* NU = (const float*)(ws + WS_NU); float* HSSQ = (float*)(ws + WS_HSSQ);
    const bool prompt = it < 256; const int i2 = prompt ? it : it - 256; const int b = i2 >> 5, h = (i2 >> 3) & 3, sl = i2 & 7; const int nch = prompt ? 65 : 1;
    const int uid0 = prompt ? (b * 4 + h) * 65 : NB * 4 * 65 + (b * 4 + h);
    const size_t row_base = prompt ? (size_t)b * TP : (size_t)MP + (size_t)b * DT; const int tlim = prompt ? TP : DT;
    const bf16* Ub = (const bf16*)(ws + WS_U) + (size_t)uid0 * 32768 + (size_t)(sl * 32 + (tid >> 4)) * 128 + (tid & 15) * 8;
    const int l15 = lane & 15, lg = lane >> 4, tt = w & 3, dvt = w >> 2, cdv = tid >> 4, cdk = (tid & 15) * 8;
    float C[8]; float nreg = 0.f, m_run = 0.f;
    {
        if (prompt) {
#pragma unroll
            for (int i = 0; i < 8; ++i) C[i] = 0.f;
        } else { const float* C0 = A.in[5] + ((size_t)(b * 4 + h) * 256 + sl * 32 + cdv) * 128 + cdk; const f32x4 c0 = *(const f32x4*)C0, c1 = *(const f32x4*)(C0 + 4);
#pragma unroll
            for (int i = 0; i < 4; ++i) { C[i] = c0[i]; C[4 + i] = c1[i]; }
            if (tid < 128) nreg = A.in[6][(size_t)(b * 4 + h) * 128 + tid]; m_run = A.in[7][b * 4 + h]; }
        u32x4 o; o.x = pk2(C[0], C[1]); o.y = pk2(C[2], C[3]); o.z = pk2(C[4], C[5]); o.w = pk2(C[6], C[7]);
        *(LAS u32x4*)(lds + MB_CB + cdv * ML_QS + cdk * 2) = o;
        if (tid < 256) { const int r = 32 + (tid >> 4); const u32x4 z = {0u, 0u, 0u, 0u}; *(LAS u32x4*)(lds + MB_CB + r * ML_QS + (tid & 15) * 16) = z; *(LAS u32x4*)(lds + MB_CB + MB_CBSZ + r * ML_QS + (tid & 15) * 16) = z; }
    }
    __syncthreads();
    if (tid < 128) *(LAS unsigned short*)(lds + MB_CB + 32 * ML_QS + tid * 2) = (unsigned short)f2bf(nreg);
    u32x4 q0_[2], q1_[2], uc_[2]; u32x2 nl_[2]; float gi_[2], gf_[2], rs_[2], nu_[2];
#define MB_LOADQ(S, cc) do { const int tok0_ = prompt ? 64 * (cc) - 48 : 0; \
        { const int r_ = tid >> 4, tk_ = tok0_ + r_; const bool ok_ = tk_ >= 0 && tk_ < tlim; q0_[S] = (u32x4){0u, 0u, 0u, 0u}; if (ok_) q0_[S] = *(const u32x4*)(MQ + (row_base + tk_) * 512 + h * 128 + (tid & 15) * 8); } \
        { const int r_ = 32 + (tid >> 4), tk_ = tok0_ + r_; const bool ok_ = tk_ >= 0 && tk_ < tlim; q1_[S] = (u32x4){0u, 0u, 0u, 0u}; if (ok_) q1_[S] = *(const u32x4*)(MQ + (row_base + tk_) * 512 + h * 128 + (tid & 15) * 8); } } while (0)
#define MB_LOAD(S, cc) do { const int tok0_ = prompt ? 64 * (cc) - 48 : 0; \
        uc_[S] = *(const u32x4*)(Ub + (size_t)(cc) * 32768); \
        { const int tk_ = tok0_ + lane; gi_[S] = ((const float*)(ws + WS_PMC))[(size_t)(uid0 + (cc)) * 64 + lane]; gf_[S] = ((const float*)(ws + WS_BBC))[(size_t)(uid0 + (cc)) * 64 + lane]; rs_[S] = 0.f; if (tk_ >= 0 && tk_ < tlim) rs_[S] = RS[(row_base + tk_) * 4 + h]; } \
        nu_[S] = tid < 128 ? NU[(size_t)(uid0 + (cc)) * 128 + tid] : 0.f; \
        { const int tk_ = tok0_ + 16 * tt + l15; nl_[S] = (u32x2){0u, 0u}; if (tk_ >= 0 && tk_ < tlim) nl_[S] = *(const u32x2*)(MH + (row_base + tk_) * DM + h * 256 + sl * 32 + 16 * dvt + 4 * lg); } } while (0)
    MB_LOADQ(0, 0); MB_LOAD(0, 0);
    if (nch > 1) MB_LOAD(1, 1);
    *(LAS u32x4*)(lds + MB_Q + (tid >> 4) * ML_QS + (tid & 15) * 16) = q0_[0]; *(LAS u32x4*)(lds + MB_Q + (32 + (tid >> 4)) * ML_QS + (tid & 15) * 16) = q1_[0];
    __syncthreads();
    if (nch > 1) MB_LOADQ(1, 1);
    if (nch > 2) MB_LOADQ(0, 2);
#pragma unroll 1
    for (int c2 = 0; c2 < nch; c2 += 2) {
        { constexpr int S = 0; const int c = c2;
        const int tok0 = prompt ? 64 * c - 48 : 0;
        const float bb = gf_[S], pm = gi_[S];
        const float mx = fmaxf(m_run, pm), mt = bb + mx, win = __expf(m_run - mx), scl = __expf(pm - mx), einv = __expf(-mt);
        const float b_last = __shfl(bb, 63), m_new = __shfl(mt, 63), pm_last = __shfl(pm, 63), mx_last = fmaxf(m_run, pm_last);
        const float decay = __expf(m_run - mx_last), usc = __expf(pm_last - mx_last);
        (void)b_last;
        const u32x4 uc = uc_[S]; const u32x2 nlc = nl_[S]; const float rsc = rs_[S], nuc = nu_[S];
        f32x4 acc = {0.f, 0.f, 0.f, 0.f}, acc2 = {0.f, 0.f, 0.f, 0.f};
#pragma unroll
        for (int k0 = 0; k0 < 128; k0 += 32) { const bf16x8 bq = *(const LAS bf16x8*)(lds + MB_Q + S * MB_QSZ + (16 * tt + l15) * ML_QS + (k0 + 8 * lg) * 2);
            const bf16x8 a = *(const LAS bf16x8*)(lds + MB_CB + S * MB_CBSZ + (16 * dvt + l15) * ML_QS + (k0 + 8 * lg) * 2), an = *(const LAS bf16x8*)(lds + MB_CB + S * MB_CBSZ + (32 + l15) * ML_QS + (k0 + 8 * lg) * 2);
            acc = mfma16(a, bq, acc); acc2 = mfma16(an, bq, acc2); }
        {
            const int t = 16 * tt + l15; const int tk = tok0 + t; const bool ok = tk >= 0 && tk < tlim;
            const float qn = __shfl(acc2[0], l15), win_t = __shfl(win, t), scl_t = __shfl(scl, t), einv_t = __shfl(einv, t), rs_t = __shfl(rsc, t);
            const float den = win_t * qn + scl_t * rs_t, rden = 1.0f / fmaxf(fabsf(den), einv_t);
            const float n0 = bf2f((unsigned short)(nlc.x & 0xffffu)), n1 = bf2f((unsigned short)(nlc.x >> 16)), n2 = bf2f((unsigned short)(nlc.y & 0xffffu)), n3 = bf2f((unsigned short)(nlc.y >> 16));
            const float h0 = (win_t * acc[0] + scl_t * n0) * rden, h1 = (win_t * acc[1] + scl_t * n1) * rden, h2 = (win_t * acc[2] + scl_t * n2) * rden, h3 = (win_t * acc[3] + scl_t * n3) * rden;
            float x = (h0 * h0 + h1 * h1) + (h2 * h2 + h3 * h3); x += __shfl_xor(x, 16); x += __shfl_xor(x, 32);
            if (ok) { u32x2 o; o.x = pk2(h0, h1); o.y = pk2(h2, h3); *(u32x2*)(MH + (row_base + tk) * DM + h * 256 + sl * 32 + 16 * dvt + 4 * lg) = o; if (lg == 0) HSSQ[((row_base + tk) * 4 + h) * 16 + sl * 2 + dvt] = x; }
        }
        {
            C[0] = decay * C[0] + usc * bf2f((unsigned short)(uc.x & 0xffffu)); C[1] = decay * C[1] + usc * bf2f((unsigned short)(uc.x >> 16));
            C[2] = decay * C[2] + usc * bf2f((unsigned short)(uc.y & 0xffffu)); C[3] = decay * C[3] + usc * bf2f((unsigned short)(uc.y >> 16));
            C[4] = decay * C[4] + usc * bf2f((unsigned short)(uc.z & 0xffffu)); C[5] = decay * C[5] + usc * bf2f((unsigned short)(uc.z >> 16));
            C[6] = decay * C[6] + usc * bf2f((unsigned short)(uc.w & 0xffffu)); C[7] = decay * C[7] + usc * bf2f((unsigned short)(uc.w >> 16));
            u32x4 o; o.x = pk2(C[0], C[1]); o.y = pk2(C[2], C[3]); o.z = pk2(C[4], C[5]); o.w = pk2(C[6], C[7]);
            *(LAS u32x4*)(lds + MB_CB + (S ^ 1) * MB_CBSZ + cdv * ML_QS + cdk * 2) = o;
            if (tid < 128) { nreg = decay * nreg + usc * nuc; *(LAS unsigned short*)(lds + MB_CB + (S ^ 1) * MB_CBSZ + 32 * ML_QS + tid * 2) = (unsigned short)f2bf(nreg); }
            if (c + 1 < nch) { *(LAS u32x4*)(lds + MB_Q + (S ^ 1) * MB_QSZ + (tid >> 4) * ML_QS + (tid & 15) * 16) = q0_[S ^ 1]; *(LAS u32x4*)(lds + MB_Q + (S ^ 1) * MB_QSZ + (32 + (tid >> 4)) * ML_QS + (tid & 15) * 16) = q1_[S ^ 1]; }
        }
        m_run = m_new;
        LDS_BARRIER();
        if (c + 2 < nch) MB_LOAD(S, c + 2);
        if (c + 3 < nch) MB_LOADQ(S ^ 1, c + 3);
        }
        if (c2 + 1 < nch) { constexpr int S = 1; const int c = c2 + 1;
        const int tok0 = prompt ? 64 * c - 48 : 0;
        const float bb = gf_[S], pm = gi_[S];
        const float mx = fmaxf(m_run, pm), mt = bb + mx, win = __expf(m_run - mx), scl = __expf(pm - mx), einv = __expf(-mt);
        const float b_last = __shfl(bb, 63), m_new = __shfl(mt, 63), pm_last = __shfl(pm, 63), mx_last = fmaxf(m_run, pm_last);
        const float decay = __expf(m_run - mx_last), usc = __expf(pm_last - mx_last);
        (void)b_last;
        const u32x4 uc = uc_[S]; const u32x2 nlc = nl_[S]; const float rsc = rs_[S], nuc = nu_[S];
        f32x4 acc = {0.f, 0.f, 0.f, 0.f}, acc2 = {0.f, 0.f, 0.f, 0.f};
#pragma unroll
        for (int k0 = 0; k0 < 128; k0 += 32) { const bf16x8 bq = *(const LAS bf16x8*)(lds + MB_Q + S * MB_QSZ + (16 * tt + l15) * ML_QS + (k0 + 8 * lg) * 2);
            const bf16x8 a = *(const LAS bf16x8*)(lds + MB_CB + S * MB_CBSZ + (16 * dvt + l15) * ML_QS + (k0 + 8 * lg) * 2), an = *(const LAS bf16x8*)(lds + MB_CB + S * MB_CBSZ + (32 + l15) * ML_QS + (k0 + 8 * lg) * 2);
            acc = mfma16(a, bq, acc); acc2 = mfma16(an, bq, acc2); }
        {
            const int t = 16 * tt + l15; const int tk = tok0 + t; const bool ok = tk >= 0 && tk < tlim;
            const float qn = __shfl(acc2[0], l15), win_t = __shfl(win, t), scl_t = __shfl(scl, t), einv_t = __shfl(einv, t), rs_t = __shfl(rsc, t);
            const float den = win_t * qn + scl_t * rs_t, rden = 1.0f / fmaxf(fabsf(den), einv_t);
            const float n0 = bf2f((unsigned short)(nlc.x & 0xffffu)), n1 = bf2f((unsigned short)(nlc.x >> 16)), n2 = bf2f((unsigned short)(nlc.y & 0xffffu)), n3 = bf2f((unsigned short)(nlc.y >> 16));
            const float h0 = (win_t * acc[0] + scl_t * n0) * rden, h1 = (win_t * acc[1] + scl_t * n1) * rden, h2 = (win_t * acc[2] + scl_t * n2) * rden, h3 = (win_t * acc[3] + scl_t * n3) * rden;
            float x = (h0 * h0 + h1 * h1) + (h2 * h2 + h3 * h3); x += __shfl_xor(x, 16); x += __shfl_xor(x, 32);
            if (ok) { u32x2 o; o.x = pk2(h0, h1); o.y = pk2(h2, h3); *(u32x2*)(MH + (row_base + tk) * DM + h * 256 + sl * 32 + 16 * dvt + 4 * lg) = o; if (lg == 0) HSSQ[((row_base + tk) * 4 + h) * 16 + sl * 2 + dvt] = x; }
        }
        {
            C[0] = decay * C[0] + usc * bf2f((unsigned short)(uc.x & 0xffffu)); C[1] = decay * C[1] + usc * bf2f((unsigned short)(uc.x >> 16));
            C[2] = decay * C[2] + usc * bf2f((unsigned short)(uc.y & 0xffffu)); C[3] = decay * C[3] + usc * bf2f((unsigned short)(uc.y >> 16));
            C[4] = decay * C[4] + usc * bf2f((unsigned short)(uc.z & 0xffffu)); C[5] = decay * C[5] + usc * bf2f((unsigned short)(uc.z >> 16));
            C[6] = decay * C[6] + usc * bf2f((unsigned short)(uc.w & 0xffffu)); C[7] = decay * C[7] + usc * bf2f((unsigned short)(uc.w >> 16));
            u32x4 o; o.x = pk2(C[0], C[1]); o.y = pk2(C[2], C[3]); o.z = pk2(C[4], C[5]); o.w = pk2(C[6], C[7]);
            *(LAS u32x4*)(lds + MB_CB + (S ^ 1) * MB_CBSZ + cdv * ML_QS + cdk * 2) = o;
            if (tid < 128) { nreg = decay * nreg + usc * nuc; *(LAS unsigned short*)(lds + MB_CB + (S ^ 1) * MB_CBSZ + 32 * ML_QS + tid * 2) = (unsigned short)f2bf(nreg); }
            if (c + 1 < nch) { *(LAS u32x4*)(lds + MB_Q + (S ^ 1) * MB_QSZ + (tid >> 4) * ML_QS + (tid & 15) * 16) = q0_[S ^ 1]; *(LAS u32x4*)(lds + MB_Q + (S ^ 1) * MB_QSZ + (32 + (tid >> 4)) * ML_QS + (tid & 15) * 16) = q1_[S ^ 1]; }
        }
        m_run = m_new;
        LDS_BARRIER();
        if (c + 2 < nch) MB_LOAD(S, c + 2);
        if (c + 3 < nch) MB_LOADQ(S ^ 1, c + 3);
        }
    }
#undef MB_LOAD
#undef MB_LOADQ
    { float* Co = A.out + (prompt ? O_MCP : O_MCS) + ((size_t)(b * 4 + h) * 256 + sl * 32 + cdv) * 128 + cdk;
        *(f32x4*)Co = (f32x4){C[0], C[1], C[2], C[3]}; *(f32x4*)(Co + 4) = (f32x4){C[4], C[5], C[6], C[7]};
        if (sl == 0) { if (tid < 128) (A.out + (prompt ? O_MNP : O_MNS))[(size_t)(b * 4 + h) * 128 + tid] = nreg; if (tid == 0) (A.out + (prompt ? O_MMP : O_MMS))[b * 4 + h] = m_run; } }
    __syncthreads();
}

__device__ __forceinline__ void p9_gate(const Args& A, int gw, int NGW, int lane) {
    unsigned char* ws = A.ws; bf16* MH = (bf16*)(ws + WS_MH); const bf16* MO = (const bf16*)(ws + WS_MO); const float* HSSQ = (const float*)(ws + WS_HSSQ);
    const int hd = lane >> 4;
    for (int row0 = gw; row0 < MTOT; row0 += 4 * NGW) {
        f32x4 p[4][4]; u32x4 hv[4][2], ov[4][2];
#pragma unroll
        for (int u = 0; u < 4; ++u) { const int row = row0 + u * NGW < MTOT ? row0 + u * NGW : row0; const float* pp = HSSQ + ((size_t)row * 4 + hd) * 16;
#pragma unroll
            for (int i = 0; i < 4; ++i) p[u][i] = *(const f32x4*)(pp + 4 * i);
#pragma unroll
            for (int i = 0; i < 2; ++i) { const size_t off = (size_t)row * DM + lane * 16 + i * 8; hv[u][i] = *(const u32x4*)(MH + off); ov[u][i] = *(const u32x4*)(MO + off); } }
#pragma unroll
        for (int u = 0; u < 4; ++u) { const int row = row0 + u * NGW; if (row >= MTOT) break;
            float s = 0.f;
#pragma unroll
            for (int i = 0; i < 4; ++i) s += (p[u][i][0] + p[u][i][1]) + (p[u][i][2] + p[u][i][3]);
            const float rs = __builtin_amdgcn_rsqf(s * (1.0f / 256.0f) + EPSN);
#pragma unroll
            for (int i = 0; i < 2; ++i) { const size_t off = (size_t)row * DM + lane * 16 + i * 8; u32x4 o;
#pragma unroll
                for (int e2 = 0; e2 < 4; ++e2) { const float a = bf2f((unsigned short)(hv[u][i][e2] & 0xffffu)) * rs * bf2f((unsigned short)(ov[u][i][e2] & 0xffffu)), c = bf2f((unsigned short)(hv[u][i][e2] >> 16)) * rs * bf2f((unsigned short)(ov[u][i][e2] >> 16)); o[e2] = pk2(a, c); }
                *(u32x4*)(MH + off) = o; } }
    }
}

__device__ __forceinline__ void p13_final(const Args& A, int gw, int NGW, int lane) {
    unsigned char* ws = A.ws; const bf16* XB = (const bf16*)(ws + WS_XB); const float* ssq = (const float*)(ws + WS_SSQ); const float* g = A.in[23];
    f32x4 gg[4];
#pragma unroll
    for (int j = 0; j < 4; ++j) gg[j] = *(const f32x4*)(g + 256 * j + 4 * lane);
    for (int row0 = gw; row0 < MTOT; row0 += 4 * NGW) {
        u32x2 v[4][4]; float sq[4];
#pragma unroll
        for (int u = 0; u < 4; ++u) { const int row = row0 + u * NGW < MTOT ? row0 + u * NGW : row0; sq[u] = lane < 16 ? ssq[(size_t)row * 16 + lane] : 0.f;
#pragma unroll
            for (int j = 0; j < 4; ++j) v[u][j] = *(const u32x2*)(XB + (size_t)row * DM + 256 * j + 4 * lane); }
#pragma unroll
        for (int u = 0; u < 4; ++u) { const int row = row0 + u * NGW; if (row >= MTOT) break;
            float* dst;
            if (row < MP) { const int b = row / TP, t = row - b * TP; if (t < NMETA) continue; dst = A.out + O_YP + ((size_t)b * SEQL + (t - NMETA)) * DM; }
            else dst = A.out + O_YS + (size_t)(row - MP) * DM;
            const float rs = __builtin_amdgcn_rsqf(wave_sum(sq[u]) * (1.0f / 1024.0f) + EPSN);
#pragma unroll
            for (int j = 0; j < 4; ++j) { const f32x4 x = {bf2f((unsigned short)(v[u][j].x & 0xffffu)), bf2f((unsigned short)(v[u][j].x >> 16)), bf2f((unsigned short)(v[u][j].y & 0xffffu)), bf2f((unsigned short)(v[u][j].y >> 16))};
                *(f32x4*)(dst + 256 * j + 4 * lane) = x * rs * gg[j]; } }
    }
}

template <bool FIRSTR, bool LASTR> __device__ __forceinline__ void tail_finish(const float* P, unsigned* cnt, const pg8::StaticOrder& base, int first, int ntail, int slices, int c, float* X, bf16* XB, float* ssq, lptr lds, int tid, const float* xp, const float* xs, const float* meta) {
    const int tu = c / slices; if (tu >= ntail) return;
    asm volatile("s_waitcnt vmcnt(0)" ::: "memory"); __syncthreads();
    if (tid == 0) { __builtin_amdgcn_fence(__ATOMIC_RELEASE, "agent"); asm volatile("s_waitcnt vmcnt(0)" ::: "memory");
        (void)__hip_atomic_fetch_add(cnt + tu, 1u, __ATOMIC_RELAXED, __HIP_MEMORY_SCOPE_AGENT);
        while (__hip_atomic_load(cnt + tu, __ATOMIC_RELAXED, __HIP_MEMORY_SCOPE_AGENT) < (unsigned)slices) __builtin_amdgcn_s_sleep(2); }
    __syncthreads();
    __builtin_amdgcn_fence(__ATOMIC_ACQUIRE, "agent"); asm volatile("s_waitcnt vmcnt(0)" ::: "memory");
    pg8::Unit u; base.map(first + tu, u);
    const int nrow = 256 / slices, rbase = (c % slices) * nrow;
    const int cc = tid & 31, r0 = tid >> 5;
    const float* p0 = P + (size_t)(tu * slices) * 65536 + cc * 8;
#pragma unroll 2
    for (int rr = 0; rr < nrow; rr += 16) { const int row = rbase + rr + r0;
        const size_t xoff = (size_t)(u.pm * 256 + row) * DM + u.pn * 256 + cc * 8;
        f32x4 a, b;
        if (FIRSTR) pg8::first_resid(xp, xs, meta, u.pm * 256 + row, u.pn * 256 + cc * 8, a, b);
        else { const u32x4 r = *(const u32x4*)(XB + xoff);
            a = (f32x4){__builtin_bit_cast(float, r.x << 16), __builtin_bit_cast(float, r.x & 0xffff0000u), __builtin_bit_cast(float, r.y << 16), __builtin_bit_cast(float, r.y & 0xffff0000u)};
            b = (f32x4){__builtin_bit_cast(float, r.z << 16), __builtin_bit_cast(float, r.z & 0xffff0000u), __builtin_bit_cast(float, r.w << 16), __builtin_bit_cast(float, r.w & 0xffff0000u)}; }
        for (int s = 0; s < slices; ++s) { a = a + *(const f32x4*)(p0 + (size_t)s * 65536 + row * 256); b = b + *(const f32x4*)(p0 + (size_t)s * 65536 + row * 256 + 4); }
        *(u32x4*)(XB + xoff) = pg8::pack8(a, b);
        float q = (a[0] * a[0] + a[1] * a[1]) + (a[2] * a[2] + a[3] * a[3]) + (b[0] * b[0] + b[1] * b[1]) + (b[2] * b[2] + b[3] * b[3]);
        q += __shfl_xor(q, 1); q += __shfl_xor(q, 2); q += __shfl_xor(q, 4);
        if ((cc & 7) == 0) ssq[(size_t)(u.pm * 256 + row) * 16 + u.pn * 4 + (cc >> 3)] = q; }
}

#define XB_TMO      128
#define XB_XCNT(j)  (256  + 64 * (j))
#define XB_XSUB(j)  (1280 + 64 * (j))
#define XB_XGEN(j)  (2304 + 64 * (j))
#define XB_TOP      3328
#define XB_TOPGEN   3392
#define XCD_BAR_WORDS 3456
#define XB_SPIN_CAP (1u << 18)

__device__ __forceinline__ unsigned xb_ld(unsigned* p)              { return __hip_atomic_load(p, __ATOMIC_RELAXED, __HIP_MEMORY_SCOPE_AGENT); }
__device__ __forceinline__ unsigned xb_add(unsigned* p, unsigned v) { return __hip_atomic_fetch_add(p, v, __ATOMIC_RELAXED, __HIP_MEMORY_SCOPE_AGENT); }
__device__ __forceinline__ unsigned xb_xcc_id() { return (unsigned)__builtin_amdgcn_s_getreg((3 << 11) | 20) & 0xFu; }
#define XB_SPIN(cond, bar) do { unsigned _sp = 0; while (cond) { __builtin_amdgcn_s_sleep(1); \
    if ((++_sp & 255u) == 0u) { if (xb_ld(&(bar)[XB_TMO])) break; if (_sp > XB_SPIN_CAP) { atomicAdd(&(bar)[XB_TMO], 1u); break; } } } } while (0)

struct XcdBarrier {
    unsigned* bar; unsigned x;
    volatile LAS unsigned* st;
};

__device__ __forceinline__ XcdBarrier xcd_barrier_post(unsigned* bar, volatile LAS unsigned* st) {
    XcdBarrier b; b.bar = bar; b.x = xb_xcc_id(); b.st = st;
    if (threadIdx.x == 0) (void)xb_add(&bar[XB_XCNT(b.x)], 1u);
    return b;
}
__device__ __forceinline__ void xcd_barrier_complete(unsigned* bar, unsigned x, unsigned& nloc, unsigned& nx) {
    const unsigned G = gridDim.x * gridDim.y * gridDim.z;
    unsigned sum, cnt, mine, sp = 0u;
    for (;;) {
        sum = 0u; cnt = 0u; mine = 0u;
#pragma unroll
        for (unsigned j = 0; j < 16; ++j) { const unsigned c = xb_ld(&bar[XB_XCNT(j)]); sum += c; cnt += (c > 0u) ? 1u : 0u; mine = (j == x) ? c : mine; }
        if (sum == G) break;
        __builtin_amdgcn_s_sleep(1);
        if ((++sp & 255u) == 0u) { if (xb_ld(&bar[XB_TMO])) break; if (sp > XB_SPIN_CAP) { atomicAdd(&bar[XB_TMO], 1u); break; } }
    }
    nloc = mine > 0u ? mine : 1u; nx = cnt > 0u ? cnt : 1u;
}

__device__ __forceinline__ void xcd_barrier(const XcdBarrier& b) {
    asm volatile("s_waitcnt vmcnt(0)" ::: "memory");
    __syncthreads();
    if (threadIdx.x == 0) {
        unsigned* bar = b.bar;
        __builtin_amdgcn_s_waitcnt(0);
        unsigned nloc = b.st[0], nx = b.st[1];
        if (nloc == 0u) { xcd_barrier_complete(bar, b.x, nloc, nx); b.st[0] = nloc; b.st[1] = nx; }
        const unsigned old = xb_add(&bar[XB_XSUB(b.x)], 1u);
        const unsigned gen = old / nloc;
        if (old + 1u == (gen + 1u) * nloc) {
            __builtin_amdgcn_fence(__ATOMIC_RELEASE, "agent");
            asm volatile("s_waitcnt vmcnt(0)" ::: "memory");
            const unsigned og = xb_add(&bar[XB_TOP], 1u);
            const unsigned tg = og / nx;
            if (og + 1u == (tg + 1u) * nx) xb_add(&bar[XB_TOPGEN], 1u);
            else XB_SPIN(xb_ld(&bar[XB_TOPGEN]) == tg, bar);
            __builtin_amdgcn_fence(__ATOMIC_ACQUIRE, "agent");
            xb_add(&bar[XB_XGEN(b.x)], 1u);
            asm volatile("s_waitcnt vmcnt(0)" ::: "memory");
        } else {
            XB_SPIN(xb_ld(&bar[XB_XGEN(b.x)]) == gen, bar);
            __builtin_amdgcn_fence(__ATOMIC_ACQUIRE, "agent");
            asm volatile("s_waitcnt vmcnt(0)" ::: "memory");
        }
    }
    __syncthreads();
}

__global__ void __launch_bounds__(NTHR, 2) fwd_megakernel(Args args) {
    extern __shared__ __attribute__((aligned(16))) unsigned char lds_raw[];
    cg::grid_group grid = cg::this_grid();
    { LAS unsigned* misc_ = (LAS unsigned*)(lds_raw) ; (void)misc_; }
#define GRID_SYNC() do { asm volatile("s_waitcnt vmcnt(0) lgkmcnt(0)" ::: "memory"); __syncthreads(); \
        if (threadIdx.x == 0) { __builtin_amdgcn_fence(__ATOMIC_RELEASE, "agent"); asm volatile("s_waitcnt vmcnt(0)" ::: "memory"); } \
        GSYNC(); \
        __builtin_amdgcn_fence(__ATOMIC_ACQUIRE, "agent"); asm volatile("s_waitcnt vmcnt(0)" ::: "memory"); __syncthreads(); } while (0)
    const lptr lds = (lptr)lds_raw;
    const int G = gridDim.x, bx = blockIdx.x, NGW = G * NWAVES;
#define TIDS int tid = threadIdx.x; asm volatile("" : "+v"(tid)); const int lane = tid & 63, w = __builtin_amdgcn_readfirstlane(tid >> 6), gw = bx * NWAVES + w; (void)gw; (void)lane
    unsigned char* ws = args.ws;
    bf16* XB = (bf16*)(ws + WS_XB); float* X = (float*)(ws + WS_X); float* ssq = (float*)(ws + WS_SSQ);
    volatile LAS unsigned* xb_st = (volatile LAS unsigned*)(lds + LDS_BYTES - 256);
    if (threadIdx.x < 2) xb_st[threadIdx.x] = 0u;
    __syncthreads();
    const XcdBarrier xbar = xcd_barrier_post((unsigned*)(ws + WS_CTL) + 4096, xb_st);
#ifndef USE_CG_SYNC
#define GSYNC() xcd_barrier(xbar)
#else
#define GSYNC() grid.sync()
#endif

#ifndef SKIP_P0
    { TIDS; p0_prologue(args, lds, gw, NGW, w, lane); }
#endif
#ifdef PROBE_P0
    { TIDS; p0_prologue(args, lds, gw, NGW, w, lane); }
#endif
    grid.sync();
    xcd_barrier(xbar);
#ifdef PROBE_P1
    { pg8::Gemm g{XB, (const bf16*)(ws + WS_WFIN), MPAD, NIN, DM}; pg8::StaticOrder S; S.init(MPAD, NIN, G, bx); pg8::EpiFoxIn E{ssq, args.in[13], args.in[14], args.in[12], ws, args.out};
      pg8::gemm_phase<pg8::EpiFoxIn, pg8::StaticOrder, PG8_ALIGN, PG8_SP2>(lds, g, S, E); }
    GSYNC();
#endif
#ifndef SKIP_P1
    {
        pg8::Gemm g{XB, (const bf16*)(ws + WS_WFIN), MPAD, NIN, DM}; pg8::StaticOrder S; S.init(MPAD, NIN, G, bx);
        pg8::EpiFoxIn E{ssq, args.in[13], args.in[14], args.in[12], ws, args.out};
        pg8::gemm_phase<pg8::EpiFoxIn, pg8::StaticOrder, PG8_ALIGN, PG8_SP2>(lds, g, S, E);
    }
#endif
    GSYNC();
#ifndef SKIP_P2
    { TIDS; p2_cumsum(args, gw, NGW, lane); }
#endif
    GSYNC();
#ifndef SKIP_P3
    { TIDS; p3_attention(args, lds, tid, w, lane, 0); }
#ifdef PROBE_P3
    GSYNC();
    { TIDS; p3_attention(args, lds, tid, w, lane, 1); }
#endif
#endif
    GSYNC();
#define RESID_GEMM(Ap, Wp, KK, CNTI, FIRSTF, LASTF) do { \
    pg8::StaticOrder S; S.init(MPAD, DM, G, bx); const int full_ = (S.nwg / G) * G, ntail_ = S.nwg - full_; S.lim = full_; \
    { pg8::Gemm g{(Ap), (Wp), MPAD, DM, (KK), (KK)}; pg8::EpiResidT<FIRSTF, LASTF> E{X, XB, ssq, args.in[0], args.in[1], args.in[8]}; pg8::gemm_phase<pg8::EpiResidT<FIRSTF, LASTF>, pg8::StaticOrder, PG8_ALIGN, PG8_SP2>(lds, g, S, E); } \
    if (ntail_ > 0) { const int sl_ = ntail_ * 8 <= G ? 8 : (ntail_ * 4 <= G ? 4 : (ntail_ * 2 <= G ? 2 : 1)); const int ks_ = (KK) / sl_; \
        pg8::TailOrder T{S, full_, ntail_, sl_, bx}; pg8::Gemm g{(Ap) + (bx % sl_) * ks_, (Wp) + (bx % sl_) * ks_, MPAD, DM, ks_, (KK)}; pg8::EpiPartial E{(float*)(ws + WS_P)}; \
        pg8::gemm_phase<pg8::EpiPartial, pg8::TailOrder, false, PG8_SP2>(lds, g, T, E); \
        { int tid_ = threadIdx.x; asm volatile("" : "+v"(tid_)); tail_finish<FIRSTF, LASTF>((const float*)(ws + WS_P), (unsigned*)(ws + WS_CTL) + 256 + (CNTI), S, full_, ntail_, sl_, bx, X, XB, ssq, lds, tid_, args.in[0], args.in[1], args.in[8]); } } } while (0)
#ifdef PROBE_UP
#define PROBE_UP_BODY(WUP) { pg8::Gemm g{XB, (const bf16*)(ws + (WUP)), MPAD, DFF, DM}; pg8::StaticOrder S; S.init(MPAD, DFF, G, bx); pg8::EpiUp E{ssq, (bf16*)(ws + WS_H)}; \
      pg8::gemm_phase<pg8::EpiUp, pg8::StaticOrder, PG8_ALIGN, PG8_SP2>(lds, g, S, E); } GSYNC();
#else
#define PROBE_UP_BODY(WUP)
#endif
#define LAYER_TAIL(AOP, WOUT, WUP, WDN, CNT0, FIRSTL, LASTL) do { \
    RESID_GEMM((const bf16*)(AOP), (const bf16*)(ws + (WOUT)), DM, CNT0, FIRSTL, false); \
    GSYNC(); \
    { pg8::Gemm g{XB, (const bf16*)(ws + (WUP)), MPAD, DFF, DM}; pg8::StaticOrder S; S.init(MPAD, DFF, G, bx); pg8::EpiUp E{ssq, (bf16*)(ws + WS_H)}; \
      pg8::gemm_phase<pg8::EpiUp, pg8::StaticOrder, PG8_ALIGN, PG8_SP2>(lds, g, S, E); } \
    GSYNC(); \
    PROBE_UP_BODY(WUP) \
    RESID_GEMM((const bf16*)(ws + WS_H), (const bf16*)(ws + (WDN)), DFF, CNT0 + 32, false, LASTL); \
    GSYNC(); } while (0)
#ifndef SKIP_L0
    LAYER_TAIL(ws + WS_OB, WS_WFOUT, WS_WUP0, WS_WDN0, 0, true, false);
#endif
#ifndef SKIP_P7
    {
        pg8::Gemm g{XB, (const bf16*)(ws + WS_WMIN), MPAD, NIN, DM}; pg8::StaticOrder S; S.init(MPAD, NIN, G, bx);
        pg8::EpiMlstmIn E{ssq, args.in[17], args.in[18], (bf16*)(ws + WS_MQ), (bf16*)(ws + WS_MK), (bf16*)(ws + WS_MV), (bf16*)(ws + WS_MO), (float*)(ws + WS_GI), (float*)(ws + WS_GF)};
        pg8::gemm_phase<pg8::EpiMlstmIn, pg8::StaticOrder, PG8_ALIGN, PG8_SP2>(lds, g, S, E);
    }
#endif
    GSYNC();
#ifndef SKIP_P8
    { TIDS; mlstm_a_phase(args, bx, G, lds, tid, w, lane); }
    GSYNC();
#ifdef PROBE_MA
    { TIDS; mlstm_a_phase(args, bx, G, lds, tid, w, lane); }
    GSYNC();
#endif
    { TIDS; for (int it = bx; it < 256 + 1024; it += G) mlstm_b_item(args, it, lds, tid, w, lane); }
#ifdef PROBE_MAB
    GSYNC();
    { TIDS; mlstm_a_phase(args, bx, G, lds, tid, w, lane); }
    GSYNC();
    { TIDS; for (int it = bx; it < 256 + 1024; it += G) mlstm_b_item(args, it, lds, tid, w, lane); }
#endif
#endif
    GSYNC();
#ifndef SKIP_P9
    { TIDS; p9_gate(args, gw, NGW, lane); }
#endif
    GSYNC();
#ifndef SKIP_L1
    LAYER_TAIL(ws + WS_MH, WS_WMOUT, WS_WUP1, WS_WDN1, 64, false, true);
#endif
#ifndef SKIP_P13
    { TIDS; p13_final(args, gw, NGW, lane); }
#ifdef PROBE_SYNC
    for (int i_ = 0; i_ < 16; ++i_) grid.sync();
#endif
#endif
}

extern "C" void kernel_launch(void* const* d_in, const int* in_sizes, int n_in, void* d_out, int out_size, void* d_ws, size_t ws_size, hipStream_t stream) {
    static int grid = 0;
    if (grid == 0) {
        if (n_in != 24 || (size_t)out_size != O_END || ws_size < WS_END) { fprintf(stderr, "kernel_launch: unexpected shapes: n_in %d out %d (want %zu) ws %zu (want >= %zu)\n", n_in, out_size, (size_t)O_END, ws_size, (size_t)WS_END); grid = -1; return; }
        int dev = 0, cus = 0, per_cu = 0;
        if (hipGetDevice(&dev) != hipSuccess || hipDeviceGetAttribute(&cus, hipDeviceAttributeMultiprocessorCount, dev) != hipSuccess) { grid = -1; return; }
        if (hipFuncSetAttribute((const void*)fwd_megakernel, hipFuncAttributeMaxDynamicSharedMemorySize, LDS_BYTES) != hipSuccess) { fprintf(stderr, "kernel_launch: hipFuncSetAttribute failed\n"); grid = -1; return; }
        if (hipOccupancyMaxActiveBlocksPerMultiprocessor(&per_cu, (const void*)fwd_megakernel, NTHR, LDS_BYTES) != hipSuccess || per_cu < 1) { fprintf(stderr, "kernel_launch: occupancy query says %d blocks per CU\n", per_cu); grid = -1; return; }
        grid = cus;
    }
    if (grid < 0) return;
    (void)hipMemsetAsync((char*)d_ws + WS_CTL, 0, 65536, stream);
    Args a{};
    for (int i = 0; i < 24; ++i) a.in[i] = (const float*)d_in[i];
    a.out = (float*)d_out; a.ws = (unsigned char*)d_ws;
    void* kargs[] = {&a};
    const hipError_t e = hipLaunchCooperativeKernel((const void*)fwd_megakernel, dim3(grid), dim3(NTHR), kargs, LDS_BYTES, stream);
    if (e != hipSuccess) fprintf(stderr, "kernel_launch: cooperative launch failed: %s (grid %d)\n", hipGetErrorString(e), grid);
}
```

```cpp
#include <hip/hip_runtime.h>
#include <hip/hip_cooperative_groups.h>
#include <cstdio>
#include <cstdint>
namespace cg = cooperative_groups;

constexpr int DM = 1024, TP = 4112, NB = 8, SEQL = 4096, NMETA = 16, DB = 32, DT = 32, PAST = 2048, DFF = 4096;
constexpr int MP = NB * TP;
constexpr int MTOT = MP + DB * DT;
constexpr int MPAD = 34048;
constexpr int NIN = 3328;
constexpr int PPAD = 240;
constexpr int PLEN = 4352;
constexpr int GSLEN = 2112;
constexpr float EPSN = 1e-6f;
constexpr float LOG2E = 1.4426950408889634f;
constexpr float QSCALE = 0.125f * LOG2E;

constexpr int NWAVES = 8, NTHR = 512;
constexpr int LDS_BYTES = 147456;
constexpr size_t MiB = 1u << 20;
constexpr size_t WS_CTL = 0;
constexpr size_t WS_WFIN = 1 * MiB, WS_WFOUT = 8 * MiB, WS_WMIN = 10 * MiB, WS_WMOUT = 17 * MiB, WS_WUP0 = 19 * MiB, WS_WUP1 = 27 * MiB, WS_WDN0 = 35 * MiB, WS_WDN1 = 43 * MiB;
constexpr size_t WS_SSQ = 51 * MiB, WS_G = 54 * MiB, WS_GS = 57 * MiB, WS_GI = 62 * MiB, WS_GF = 63 * MiB, WS_HSSQ = 64 * MiB;
constexpr size_t WS_X = 74 * MiB, WS_XB = 207 * MiB;
constexpr size_t WS_QB = 274 * MiB, WS_KB = 343 * MiB, WS_VB = 411 * MiB, WS_OB = 478 * MiB, WS_H = 274 * MiB;
constexpr size_t WS_MQ = 546 * MiB, WS_MK = 580 * MiB, WS_MV = 614 * MiB, WS_MO = 682 * MiB, WS_MH = 750 * MiB, WS_U = 818 * MiB, WS_RS = 958 * MiB, WS_NU = 959 * MiB, WS_P = 961 * MiB, WS_BBC = 1001 * MiB, WS_PMC = 1002 * MiB, WS_END = 1003 * MiB;
static_assert(WS_H + (size_t)MPAD * DFF * 2 <= WS_MQ && WS_OB + (size_t)MPAD * DM * 2 <= WS_MQ && WS_VB + (size_t)MPAD * DM * 2 <= WS_OB && WS_KB + (size_t)MPAD * DM * 2 <= WS_VB - MiB && WS_QB + (size_t)MPAD * DM * 2 <= WS_KB - MiB, "ws map");
static_assert(WS_G + (size_t)NB * 16 * PLEN * 4 <= WS_GS && WS_GS + (size_t)DB * 16 * GSLEN * 4 <= WS_GI && WS_HSSQ + (size_t)MPAD * 64 * 4 <= WS_X && WS_SSQ + (size_t)MPAD * 64 <= WS_G, "ws map 2");

struct Args { const float* in[24]; float* out; unsigned char* ws; };

constexpr size_t O_YP = 0, O_YS = O_YP + (size_t)NB * SEQL * DM, O_FKP = O_YS + (size_t)DB * DT * DM, O_FVP = O_FKP + (size_t)MP * DM, O_FLP = O_FVP + (size_t)MP * DM,
    O_MCP = O_FLP + (size_t)MP * 16, O_MNP = O_MCP + (size_t)NB * 4 * 256 * 128, O_MMP = O_MNP + (size_t)NB * 4 * 128, O_FKS = O_MMP + (size_t)NB * 4,
    O_FVS = O_FKS + (size_t)DB * DT * DM, O_FLS = O_FVS + (size_t)DB * DT * DM, O_MCS = O_FLS + (size_t)DB * DT * 16, O_MNS = O_MCS + (size_t)DB * 4 * 256 * 128,
    O_MMS = O_MNS + (size_t)DB * 4 * 128, O_END = O_MMS + (size_t)DB * 4;

namespace pg8 {
#define PG8_LAS __attribute__((address_space(3)))
typedef unsigned short bf16_t;
typedef short bf16x8 __attribute__((ext_vector_type(8)));
typedef float f32x4 __attribute__((ext_vector_type(4)));
typedef unsigned u32x4 __attribute__((ext_vector_type(4)));
constexpr int BM = 256, BK = 64, HALF = 128, HTB = HALF * BK * 2  , STAGE_BYTES = 8 * HTB, NXCD = 8, WGM = 8;

__host__ __device__ __forceinline__ int lds_byte(int r, int c) { const int st = (r >> 4) * 2 + (c >> 5), rr = r & 15, cc = c & 31, ob = rr * 64 + cc * 2; return st * 1024 + (ob ^ (((ob >> 9) & 1) << 5)); }
__host__ __device__ __forceinline__ void stage_rc(int b, int& R, int& C) { const int st = b / 1024, sb = b % 1024, swz = sb ^ (((sb >> 9) & 1) << 5); R = (st >> 1) * 16 + swz / 64; C = (st & 1) * 32 + (swz % 64) / 2; }
__host__ __device__ __forceinline__ int perm32(int rho) { const int n = rho >> 4, i = rho & 15; return 8 * (i >> 2) + 4 * n + (i & 3); }

struct Unit { int pm, pn, aux; };
struct Gemm { const bf16_t* A; const bf16_t* Bt; int M, N, K, ld; };

struct StaticOrder {
    int nM, nN, nwg, G, c, lim;
    __host__ __device__ void init(int M, int N, int G_, int c_) { nM = M / BM; nN = N / BM; nwg = nM * nN; G = G_; c = c_; lim = nwg; }
    __host__ __device__ bool next(int i, Unit& u) const { const long L = (long)i * G + c; if (L >= lim) return false; map((int)L, u); return true; }
    __host__ __device__ void map(int L, Unit& u) const {
        int wgid = L; { const int q = nwg / NXCD, r = nwg % NXCD, xcd = wgid % NXCD, off = wgid / NXCD; wgid = (xcd < r ? xcd * (q + 1) : r * (q + 1) + (xcd - r) * q) + off; }
        const int nig = WGM * nN, gid = wgid / nig, fm = gid * WGM, gsz = (nM - fm) < WGM ? (nM - fm) : WGM;
        u.pm = fm + ((wgid % nig) % gsz); u.pn = (wgid % nig) / gsz;
    }
    __device__ __forceinline__ void a_ready(const Unit&) const {}
    __device__ __forceinline__ void done(const Unit&) const {}
};


struct TailOrder {
    StaticOrder base; int first, ntail, slices, c;
    __device__ bool next(int i, Unit& u) const { if (i > 0) return false; const int tu = c / slices; if (tu >= ntail) return false; base.map(first + tu, u); u.aux = c; return true; }
    __device__ __forceinline__ void a_ready(const Unit&) const {}
    __device__ __forceinline__ void done(const Unit&) const {}
};

typedef float f32x2_cv __attribute__((ext_vector_type(2))); typedef __bf16 bf16x2_cv __attribute__((ext_vector_type(2)));
__device__ __forceinline__ unsigned cvt_pk_bf16(float lo, float hi) { const f32x2_cv v = {lo, hi}; const bf16x2_cv b = __builtin_convertvector(v, bf16x2_cv); return __builtin_bit_cast(unsigned, b); }
__device__ __forceinline__ u32x4 pack8(const f32x4 a, const f32x4 b) { u32x4 w; w.x = cvt_pk_bf16(a[0], a[1]); w.y = cvt_pk_bf16(a[2], a[3]); w.z = cvt_pk_bf16(b[0], b[1]); w.w = cvt_pk_bf16(b[2], b[3]); return w; }
__device__ __forceinline__ float row_rstd(const float* ssq, int row, int fq) {
    const f32x4 v = *(const f32x4*)(ssq + (size_t)row * 16 + 4 * fq);
    float s = (v[0] + v[1]) + (v[2] + v[3]);
    s += __shfl_xor(s, 16); s += __shfl_xor(s, 32);
    return __builtin_amdgcn_rsqf(s * (1.0f / 1024.0f) + EPSN);
}
__device__ __forceinline__ float log_sigmoid_f(float x) { return fminf(x, 0.f) - log1pf(__expf(-fabsf(x))); }

struct EpiFoxIn {
    static constexpr bool PERM = true, AFTER_DRAIN = false;
    const float* ssq; const float* gq; const float* gk; const float* bfv;
    unsigned char* ws; float* out;
    __device__ __forceinline__ void operator()(const f32x4 (&acc)[2][2][4][2], const Unit& u, int wr, int wc, int fr, int fq) const {
        const int pn = u.pn, sect = pn >> 2;
        f32x4 gv[2][2];
        if (sect < 2) {
#pragma unroll
            for (int bj = 0; bj < 2; ++bj)
#pragma unroll
                for (int n = 0; n < 2; ++n) { const f32x4 a = *(const f32x4*)(gq + 32 * bj + 8 * fq + 4 * n) * QSCALE, b = *(const f32x4*)(gk + 32 * bj + 8 * fq + 4 * n); gv[bj][n] = sect == 0 ? a : b; } }
        const int cb = (pn & 3) * 256 + wc * 64 + 8 * fq;
        float rsv[2][4];
#pragma unroll
        for (int ai = 0; ai < 2; ++ai)
#pragma unroll
            for (int m = 0; m < 4; ++m) rsv[ai][m] = row_rstd(ssq, u.pm * BM + ai * HALF + wr * 64 + m * 16 + fr, fq);
#pragma unroll
        for (int ai = 0; ai < 2; ++ai)
#pragma unroll
            for (int m = 0; m < 4; ++m) {
                const int row = u.pm * BM + ai * HALF + wr * 64 + m * 16 + fr;
                const float rs = rsv[ai][m];
                f32x4 v[2][2];
#pragma unroll
                for (int bj = 0; bj < 2; ++bj)
#pragma unroll
                    for (int n = 0; n < 2; ++n) v[bj][n] = acc[ai][bj][m][n] * rs;
                if (sect < 2) {
                    float ss = 0.f;
#pragma unroll
                    for (int bj = 0; bj < 2; ++bj)
#pragma unroll
                        for (int n = 0; n < 2; ++n) { const f32x4 x = v[bj][n]; ss += (x[0] * x[0] + x[1] * x[1]) + (x[2] * x[2] + x[3] * x[3]); }
                    ss += __shfl_xor(ss, 16); ss += __shfl_xor(ss, 32);
                    const float hr = __builtin_amdgcn_rsqf(ss * (1.0f / 64.0f) + EPSN);
#pragma unroll
                    for (int bj = 0; bj < 2; ++bj)
#pragma unroll
                        for (int n = 0; n < 2; ++n) v[bj][n] = v[bj][n] * hr * gv[bj][n];
                }
                const bool real = row < MTOT; const int grp = row < MP ? 0 : 1; const size_t orow = grp == 0 ? (size_t)row : (size_t)(row - MP);
                if (sect == 0) {
#pragma unroll
                    for (int bj = 0; bj < 2; ++bj) *(u32x4*)((bf16_t*)(ws + WS_QB) + (size_t)row * DM + cb + 32 * bj) = pack8(v[bj][0], v[bj][1]);
                } else if (sect < 3) {
                    bf16_t* B16 = (bf16_t*)(ws + (sect == 1 ? WS_KB : WS_VB)); float* of = out + (sect == 1 ? (grp == 0 ? O_FKP : O_FKS) : (grp == 0 ? O_FVP : O_FVS));
#pragma unroll
                    for (int bj = 0; bj < 2; ++bj) *(u32x4*)(B16 + (size_t)row * DM + cb + 32 * bj) = pack8(v[bj][0], v[bj][1]);
                    (void)of; (void)real;
                } else if (pn == 12 && wc == 0 && fq < 2 && real) {
#pragma unroll
                    for (int n = 0; n < 2; ++n) { const int h0 = 8 * fq + 4 * n; const f32x4 bb = *(const f32x4*)(bfv + h0); f32x4 o;
#pragma unroll
                        for (int j = 0; j < 4; ++j) o[j] = log_sigmoid_f(v[0][n][j] + bb[j]);
                        *(f32x4*)(out + (grp == 0 ? O_FLP : O_FLS) + orow * 16 + h0) = o; }
                }
            }
    }
};

__device__ __forceinline__ void first_resid(const float* xp, const float* xs, const float* meta, int row, int col, f32x4& x0, f32x4& x1) {
    x0 = (f32x4){0.f, 0.f, 0.f, 0.f}; x1 = x0;
    if (row < MP) { const int b = row / TP, t = row - b * TP;
        if (t < NMETA) { const float* p = meta + (size_t)t * DM + col; x0 = *(const f32x4*)p; x1 = *(const f32x4*)(p + 4); }
        else { const float* p = xp + ((size_t)b * SEQL + (t - NMETA)) * DM + col; x0 = *(const f32x4*)p; x1 = *(const f32x4*)(p + 4); } }
    else if (row < MTOT) { const float* p = xs + (size_t)(row - MP) * DM + col; x0 = *(const f32x4*)p; x1 = *(const f32x4*)(p + 4); }
}
template <bool FIRST, bool LAST = false> struct EpiResidT {
    static constexpr bool PERM = true, AFTER_DRAIN = false;
    float* X; bf16_t* XB; float* ssq; const float* xp; const float* xs; const float* meta;
    __device__ __forceinline__ void operator()(const f32x4 (&acc)[2][2][4][2], const Unit& u, int wr, int wc, int fr, int fq) const {
#pragma unroll
        for (int ai = 0; ai < 2; ++ai)
#pragma unroll
            for (int m = 0; m < 4; ++m) {
                const int row = u.pm * BM + ai * HALF + wr * 64 + m * 16 + fr; float ss = 0.f;
#pragma unroll
                for (int bj = 0; bj < 2; ++bj) { const size_t off = (size_t)row * DM + u.pn * BM + bj * HALF + wc * 32 + 8 * fq;
                    f32x4 x0, x1;
                    if (FIRST) first_resid(xp, xs, meta, row, u.pn * BM + bj * HALF + wc * 32 + 8 * fq, x0, x1);
                    else { const u32x4 r = *(const u32x4*)(XB + off);
                        x0 = (f32x4){__builtin_bit_cast(float, r.x << 16), __builtin_bit_cast(float, r.x & 0xffff0000u), __builtin_bit_cast(float, r.y << 16), __builtin_bit_cast(float, r.y & 0xffff0000u)};
                        x1 = (f32x4){__builtin_bit_cast(float, r.z << 16), __builtin_bit_cast(float, r.z & 0xffff0000u), __builtin_bit_cast(float, r.w << 16), __builtin_bit_cast(float, r.w & 0xffff0000u)}; }
                    x0 = x0 + acc[ai][bj][m][0]; x1 = x1 + acc[ai][bj][m][1];
                    *(u32x4*)(XB + off) = pack8(x0, x1);
                    ss += (x0[0] * x0[0] + x0[1] * x0[1]) + (x0[2] * x0[2] + x0[3] * x0[3]) + (x1[0] * x1[0] + x1[1] * x1[1]) + (x1[2] * x1[2] + x1[3] * x1[3]); }
                ss += __shfl_xor(ss, 16); ss += __shfl_xor(ss, 32);
                if (fq == 0) ssq[(size_t)row * 16 + u.pn * 4 + wc] = ss;
                if (m & 1) asm volatile("" ::: "memory");
            }
    }
};

struct EpiUp {
    static constexpr bool PERM = true, AFTER_DRAIN = false;
    const float* ssq; bf16_t* H;
    __device__ __forceinline__ void operator()(const f32x4 (&acc)[2][2][4][2], const Unit& u, int wr, int wc, int fr, int fq) const {
#pragma unroll
        for (int ai = 0; ai < 2; ++ai)
#pragma unroll
            for (int m = 0; m < 4; ++m) {
                const int row = u.pm * BM + ai * HALF + wr * 64 + m * 16 + fr; const float rs = row_rstd(ssq, row, fq);
#pragma unroll
                for (int bj = 0; bj < 2; ++bj) { f32x4 a = acc[ai][bj][m][0] * rs, b = acc[ai][bj][m][1] * rs;
#pragma unroll
                    for (int j = 0; j < 4; ++j) { a[j] = fmaxf(a[j], 0.f); a[j] *= a[j]; b[j] = fmaxf(b[j], 0.f); b[j] *= b[j]; }
                    *(u32x4*)(H + (size_t)row * DFF + u.pn * BM + bj * HALF + wc * 32 + 8 * fq) = pack8(a, b); }
            }
    }
};

struct EpiMlstmIn {
    static constexpr bool PERM = true, AFTER_DRAIN = false;
    const float* ssq; const float* bi; const float* bfv;
    bf16_t* MQ; bf16_t* MK; bf16_t* MV; bf16_t* MO; float* GI; float* GF;
    __device__ __forceinline__ void operator()(const f32x4 (&acc)[2][2][4][2], const Unit& u, int wr, int wc, int fr, int fq) const {
        const int pn = u.pn;
#pragma unroll
        for (int ai = 0; ai < 2; ++ai)
#pragma unroll
            for (int m = 0; m < 4; ++m) {
                const int row = u.pm * BM + ai * HALF + wr * 64 + m * 16 + fr; const float rs = row_rstd(ssq, row, fq);
                if (pn < 12) {
#pragma unroll
                    for (int bj = 0; bj < 2; ++bj) { f32x4 a = acc[ai][bj][m][0] * rs, b = acc[ai][bj][m][1] * rs; const int c = pn * BM + bj * HALF + wc * 32 + 8 * fq;
                        if (pn < 2) *(u32x4*)(MQ + (size_t)row * 512 + c) = pack8(a, b);
                        else if (pn < 4) { a = a * 0.08838834764831845f; b = b * 0.08838834764831845f; *(u32x4*)(MK + (size_t)row * 512 + (c - 512)) = pack8(a, b); }
                        else if (pn < 8) *(u32x4*)(MV + (size_t)row * DM + (c - 1024)) = pack8(a, b);
                        else {
#pragma unroll
                            for (int j = 0; j < 4; ++j) { a[j] = 1.0f / (1.0f + __expf(-a[j])); b[j] = 1.0f / (1.0f + __expf(-b[j])); }
                            *(u32x4*)(MO + (size_t)row * DM + (c - 2048)) = pack8(a, b); } }
                } else if (wc == 0 && fq == 0) {
                    const f32x4 a = acc[ai][0][m][0] * rs, b = acc[ai][0][m][1] * rs; const f32x4 vbi = *(const f32x4*)bi, vbf = *(const f32x4*)bfv; f32x4 oi, of;
#pragma unroll
                    for (int j = 0; j < 4; ++j) { oi[j] = a[j] + vbi[j]; of[j] = log_sigmoid_f(b[j] + vbf[j]); }
                    *(f32x4*)(GI + (size_t)row * 4) = oi; *(f32x4*)(GF + (size_t)row * 4) = of;
                }
            }
    }
};


struct EpiPartial {
    static constexpr bool PERM = true, AFTER_DRAIN = false;
    float* P;
    __device__ __forceinline__ void operator()(const f32x4 (&acc)[2][2][4][2], const Unit& u, int wr, int wc, int fr, int fq) const {
#pragma unroll
        for (int ai = 0; ai < 2; ++ai)
#pragma unroll
            for (int m = 0; m < 4; ++m)
#pragma unroll
                for (int bj = 0; bj < 2; ++bj) { float* p = P + (size_t)u.aux * 65536 + (size_t)(ai * HALF + wr * 64 + m * 16 + fr) * 256 + bj * HALF + wc * 32 + 8 * fq;
                    *(f32x4*)p = acc[ai][bj][m][0]; *(f32x4*)(p + 4) = acc[ai][bj][m][1]; }
    }
};
template <class Epi, class Sched, bool ALIGN_EPI = false, bool SP2 = false>
__device__ __forceinline__ void gemm_phase(PG8_LAS unsigned char* lds, const Gemm g, const Sched& S, const Epi& E) {
    int tid_o = threadIdx.x; asm volatile("" : "+v"(tid_o));
    const int tid = tid_o, wid = __builtin_amdgcn_readfirstlane(tid >> 6), lane = tid & 63, wr = wid >> 2, wc = wid & 3, fr = lane & 15, fq = lane >> 4;
    const int K = g.K, nt = K / BK, ld = g.ld ? g.ld : g.K;
    unsigned voffA[2], voffB[2];
#pragma unroll
    for (int i = 0; i < 2; ++i) { int R, C; stage_rc(tid * 16 + i * 8192, R, C); const int Rb = Epi::PERM ? ((R & ~31) + perm32(R & 31)) : R;
        voffA[i] = (unsigned)(R * ld + C) * 2u; voffB[i] = (unsigned)(Rb * ld + C) * 2u; }
    const size_t kstep = (size_t)(BK * 2);
    const size_t hstep = (size_t)HALF * ld * 2;
    const size_t tstep = 2 * hstep;
    const unsigned ldsw = (unsigned)wid * 1024u;
    const int aoff = lds_byte(wr * 64 + fr, fq * 8), boff = lds_byte(wc * 32 + fr, fq * 8);
#define PG8_SA(b, h) (((b) * 2 + (h)) * HTB)
#define PG8_SB(b, h) ((4 + (b) * 2 + (h)) * HTB)
#define PG8_STAGE(bufoff, gbase, voff) do { _Pragma("unroll") for (int _i = 0; _i < 2; ++_i) \
        __builtin_amdgcn_global_load_lds((const unsigned*)((const char*)(gbase) + (voff)[_i]), (PG8_LAS unsigned*)(lds + (bufoff) + ldsw + _i * 8192), 16, 0, 0); } while (0)
#define PG8_LDA(dst, b, h) do { _Pragma("unroll") for (int m = 0; m < 4; ++m) _Pragma("unroll") for (int k = 0; k < 2; ++k) dst[m][k] = *(const PG8_LAS bf16x8*)(lds + PG8_SA(b, h) + aoff + m * 2048 + k * 1024); } while (0)
#define PG8_LDB(dst, b, h) do { _Pragma("unroll") for (int n = 0; n < 2; ++n) _Pragma("unroll") for (int k = 0; k < 2; ++k) dst[n][k] = *(const PG8_LAS bf16x8*)(lds + PG8_SB(b, h) + boff + n * 2048 + k * 1024); } while (0)
#define PG8_MMA(ai, bj, At, Bt) do { __builtin_amdgcn_s_setprio(1); _Pragma("unroll") for (int m = 0; m < 4; ++m) _Pragma("unroll") for (int n = 0; n < 2; ++n) _Pragma("unroll") for (int k = 0; k < 2; ++k) \
        acc[ai][bj][m][n] = __builtin_amdgcn_mfma_f32_16x16x32_bf16(Bt[n][k], At[m][k], acc[ai][bj][m][n], 0, 0, 0); __builtin_amdgcn_s_setprio(0); } while (0)
#define PG8_WAIT_V(n) asm volatile("s_waitcnt vmcnt(" #n ")" ::: "memory")
#define PG8_WAIT_L(n) asm volatile("s_waitcnt lgkmcnt(" #n ")" ::: "memory")
#define PG8_BAR __builtin_amdgcn_s_barrier()
#define PG8_SCHED __builtin_amdgcn_sched_barrier(0)
    Unit cur, nxt; int ui = 0;
    if (!S.next(0, cur)) return;
    f32x4 acc[2][2][4][2];
#pragma unroll
    for (int a = 0; a < 2; ++a)
#pragma unroll
        for (int b = 0; b < 2; ++b)
#pragma unroll
            for (int m = 0; m < 4; ++m)
#pragma unroll
                for (int n = 0; n < 2; ++n) acc[a][b][m][n] = (f32x4){0.f, 0.f, 0.f, 0.f};
    bf16x8 At[4][2], B0[2][2], B1[2][2];
    const char* cA = (const char*)g.A + (size_t)cur.pm * tstep; const char* cB = (const char*)g.Bt + (size_t)cur.pn * tstep;
    S.a_ready(cur);
    if constexpr (SP2) {
        PG8_STAGE(PG8_SB(0, 0), cB, voffB); PG8_STAGE(PG8_SB(0, 1), cB + hstep, voffB); PG8_STAGE(PG8_SA(0, 0), cA, voffA); PG8_STAGE(PG8_SA(0, 1), cA + hstep, voffA);
        if (wr == 1) PG8_BAR;
        PG8_WAIT_V(2); PG8_BAR;
        PG8_STAGE(PG8_SB(1, 0), cB + kstep, voffB); PG8_STAGE(PG8_SA(1, 0), cA + kstep, voffA); PG8_STAGE(PG8_SB(1, 1), cB + hstep + kstep, voffB);
        PG8_WAIT_V(6); PG8_BAR;
    } else {
        PG8_STAGE(PG8_SB(0, 0), cB, voffB); PG8_STAGE(PG8_SA(0, 0), cA, voffA); PG8_STAGE(PG8_SB(0, 1), cB + hstep, voffB); PG8_STAGE(PG8_SA(0, 1), cA + hstep, voffA);
        if (wr == 1) PG8_BAR;
        PG8_WAIT_V(4); PG8_BAR;
        PG8_STAGE(PG8_SB(1, 0), cB + kstep, voffB); PG8_STAGE(PG8_SA(1, 0), cA + kstep, voffA); PG8_STAGE(PG8_SB(1, 1), cB + hstep + kstep, voffB);
        PG8_WAIT_V(6); PG8_BAR;
    }
    for (;;) {
        const bool has_next = S.next(ui + 1, nxt);
        const char* nA = has_next ? (const char*)g.A + (size_t)nxt.pm * tstep : cA; const char* nB = has_next ? (const char*)g.Bt + (size_t)nxt.pn * tstep : cB;
        for (int t = 0; t < nt; t += 2) {
            const bool last = (t == nt - 2);
            const char* a1 = cA + (size_t)(t + 1) * kstep;
            const char* a2 = last ? nA : cA + (size_t)(t + 2) * kstep; const char* b2 = last ? nB : cB + (size_t)(t + 2) * kstep;
            const char* a3 = a2 + kstep; const char* b3 = b2 + kstep;
            if (last && has_next) S.a_ready(nxt);
            if constexpr (SP2) {
            PG8_LDB(B0, 0, 0); PG8_LDB(B1, 0, 1); PG8_SCHED; PG8_LDA(At, 0, 0); PG8_STAGE(PG8_SA(1, 1), a1 + hstep, voffA);
            PG8_WAIT_V(8); PG8_WAIT_L(0); PG8_BAR; PG8_MMA(0, 0, At, B0); PG8_MMA(0, 1, At, B1); PG8_BAR; PG8_SCHED;
            PG8_LDA(At, 0, 1); PG8_STAGE(PG8_SB(0, 0), b2, voffB); PG8_STAGE(PG8_SB(0, 1), b2 + hstep, voffB); PG8_STAGE(PG8_SA(0, 0), a2, voffA);
            PG8_WAIT_V(8); PG8_WAIT_L(0); PG8_BAR; PG8_MMA(1, 0, At, B0); PG8_MMA(1, 1, At, B1); PG8_BAR; PG8_SCHED;
            PG8_LDB(B0, 1, 0); PG8_LDB(B1, 1, 1); PG8_SCHED; PG8_LDA(At, 1, 0); PG8_STAGE(PG8_SA(0, 1), a2 + hstep, voffA);
            PG8_WAIT_V(8); PG8_WAIT_L(0); PG8_BAR; PG8_MMA(0, 0, At, B0); PG8_MMA(0, 1, At, B1); PG8_BAR; PG8_SCHED;
            PG8_LDA(At, 1, 1); PG8_STAGE(PG8_SB(1, 0), b3, voffB); PG8_STAGE(PG8_SB(1, 1), b3 + hstep, voffB); PG8_STAGE(PG8_SA(1, 0), a3, voffA);
            PG8_WAIT_V(8); PG8_WAIT_L(0); PG8_BAR; PG8_MMA(1, 0, At, B0); PG8_MMA(1, 1, At, B1); PG8_BAR; PG8_SCHED;
            } else {
            PG8_LDB(B0, 0, 0); PG8_SCHED; PG8_LDA(At, 0, 0); PG8_STAGE(PG8_SA(1, 1), a1 + hstep, voffA);
            PG8_WAIT_L(8); PG8_BAR; PG8_WAIT_L(0); PG8_MMA(0, 0, At, B0); PG8_BAR; PG8_SCHED;
            PG8_LDB(B1, 0, 1); PG8_STAGE(PG8_SB(0, 0), b2, voffB);
            PG8_BAR; PG8_WAIT_L(0); PG8_MMA(0, 1, At, B1); PG8_BAR;
            PG8_LDA(At, 0, 1); PG8_STAGE(PG8_SA(0, 0), a2, voffA);
            PG8_BAR; PG8_WAIT_L(0); PG8_MMA(1, 0, At, B0); PG8_BAR; PG8_SCHED;
            PG8_STAGE(PG8_SB(0, 1), b2 + hstep, voffB);
            PG8_WAIT_V(6); PG8_BAR; PG8_MMA(1, 1, At, B1); PG8_BAR;
            PG8_LDB(B0, 1, 0); PG8_SCHED; PG8_LDA(At, 1, 0); PG8_STAGE(PG8_SA(0, 1), a2 + hstep, voffA);
            PG8_WAIT_L(8); PG8_BAR; PG8_WAIT_L(0); PG8_MMA(0, 0, At, B0); PG8_BAR; PG8_SCHED;
            PG8_LDB(B1, 1, 1); PG8_STAGE(PG8_SB(1, 0), b3, voffB);
            PG8_BAR; PG8_WAIT_L(0); PG8_MMA(0, 1, At, B1); PG8_BAR;
            PG8_LDA(At, 1, 1); PG8_STAGE(PG8_SA(1, 0), a3, voffA);
            PG8_BAR; PG8_WAIT_L(0); PG8_MMA(1, 0, At, B0); PG8_BAR; PG8_SCHED;
            PG8_STAGE(PG8_SB(1, 1), b3 + hstep, voffB);
            PG8_WAIT_V(6); PG8_BAR; PG8_MMA(1, 1, At, B1); PG8_BAR;
            }
        }
        if constexpr (ALIGN_EPI) { if (wr == 0) PG8_BAR; }
        if constexpr (!Epi::AFTER_DRAIN) { E(acc, cur, wr, wc, fr, fq); S.done(cur); }
        if (!has_next) break;
#pragma unroll
        for (int a = 0; a < 2; ++a)
#pragma unroll
            for (int b = 0; b < 2; ++b)
#pragma unroll
                for (int m = 0; m < 4; ++m)
#pragma unroll
                    for (int n = 0; n < 2; ++n) acc[a][b][m][n] = (f32x4){0.f, 0.f, 0.f, 0.f};
        cur = nxt; cA = nA; cB = nB; ++ui;
        if constexpr (ALIGN_EPI) { if (wr == 1) PG8_BAR; }
    }
    PG8_WAIT_V(0);
    if constexpr (!ALIGN_EPI) { if (wr == 0) PG8_BAR; }
    PG8_BAR;
    if constexpr (Epi::AFTER_DRAIN) { E.fused(acc, cur, wr, wc, fr, fq, lds, wid, lane); S.done(cur); }
#undef PG8_SA
#undef PG8_SB
#undef PG8_STAGE
#undef PG8_LDA
#undef PG8_LDB
#undef PG8_MMA
#undef PG8_WAIT_V
#undef PG8_WAIT_L
#undef PG8_BAR
#undef PG8_SCHED
}
}

#ifndef PG8_SP2
#define PG8_SP2 true
#endif
#ifndef PG8_ALIGN
#define PG8_ALIGN true
#endif

#define LAS __attribute__((address_space(3)))
typedef unsigned short bf16;
typedef unsigned u32x4 __attribute__((ext_vector_type(4)));
typedef unsigned u32x2 __attribute__((ext_vector_type(2)));
typedef float f32x4 __attribute__((ext_vector_type(4)));
typedef float f32x16 __attribute__((ext_vector_type(16)));
typedef short bf16x8 __attribute__((ext_vector_type(8)));
typedef short v4i16_t __attribute__((ext_vector_type(4)));
typedef LAS unsigned char* lptr;
typedef const LAS unsigned char* clptr;

__device__ __forceinline__ unsigned f2bf(float f) { unsigned u = __builtin_bit_cast(unsigned, f); return (u + 0x7fffu + ((u >> 16) & 1u)) >> 16; }
__device__ __forceinline__ unsigned pk2(float lo, float hi) { return pg8::cvt_pk_bf16(lo, hi); }
__device__ __forceinline__ float bf2f(unsigned short b) { return __builtin_bit_cast(float, (unsigned)b << 16); }
__device__ __forceinline__ float wave_sum(float v) {
#pragma unroll
    for (int o = 1; o < 64; o <<= 1) v += __shfl_xor(v, o);
    return v;
}
#define LDS_WAIT() asm volatile("s_waitcnt lgkmcnt(0)" ::: "memory")
#define LDS_BARRIER() asm volatile("s_waitcnt lgkmcnt(0)\n\ts_barrier" ::: "memory")

__device__ __forceinline__ void p0_transpose_item(const float* W, int K, int N, bf16* WT, const float* g, bool foxperm, LAS float* scr, int item, int nblk, int lane) {
    const int kb = item / nblk, nb = item % nblk, k0 = 64 * kb, n0 = 32 * nb;
#pragma unroll 8
    for (int i = 0; i < 32; ++i) { const int kk = 2 * i + (lane >> 5); const int n = n0 + (lane & 31); float v = n < N ? W[(size_t)(k0 + kk) * N + n] : 0.f; if (g) v *= g[k0 + kk]; scr[kk * 33 + (lane & 31)] = v; }
    LDS_WAIT(); asm volatile("" ::: "memory");
    const int c = lane & 7;
    int prow0 = n0;
    if (foxperm) { const int l = n0 & 255; prow0 = (n0 & ~255) + 128 * ((l >> 5) & 1) + 32 * ((l >> 6) & 3); }
#pragma unroll
    for (int j = 0; j < 4; ++j) { const int n = (lane >> 3) + 8 * j; const LAS float* s = scr + (8 * c) * 33 + n;
        u32x4 o; o.x = pk2(s[0 * 33], s[1 * 33]); o.y = pk2(s[2 * 33], s[3 * 33]); o.z = pk2(s[4 * 33], s[5 * 33]); o.w = pk2(s[6 * 33], s[7 * 33]);
        *(u32x4*)(WT + (size_t)(prow0 + n) * K + k0 + 8 * c) = o; }
    LDS_WAIT(); asm volatile("" ::: "memory");
}

__device__ __forceinline__ void p0_prologue(const Args& A, lptr lds, int gw, int NGW, int wave, int lane) {
    unsigned char* ws = A.ws;
    LAS float* scr = (LAS float*)(lds + wave * 16384);
    int base = 0;
#define WJOB(Wp, K_, N_, NP_, dst_, g_, perm_) do { const int nblk = (NP_) / 32, nitems = ((K_) / 64) * nblk; int first = (gw - base) % NGW; if (first < 0) first += NGW; \
        for (int it = first; it < nitems; it += NGW) p0_transpose_item((Wp), (K_), (N_), (bf16*)(ws + (dst_)), (g_), (perm_), scr, it, nblk, lane); base = (base + nitems) % NGW; } while (0)
    WJOB(A.in[11], DM, 3088, NIN, WS_WFIN, A.in[9], true);
    WJOB(A.in[15], DM, DM, DM, WS_WFOUT, (const float*)nullptr, false);
    WJOB(A.in[16], DM, 3080, NIN, WS_WMIN, A.in[9] + DM, false);
    WJOB(A.in[20], DM, DM, DM, WS_WMOUT, A.in[19], false);
    WJOB(A.in[21], DM, DFF, DFF, WS_WUP0, A.in[10], false);
    WJOB(A.in[21] + (size_t)DM * DFF, DM, DFF, DFF, WS_WUP1, A.in[10] + DM, false);
    WJOB(A.in[22], DFF, DM, DM, WS_WDN0, (const float*)nullptr, false);
    WJOB(A.in[22] + (size_t)DFF * DM, DFF, DM, DM, WS_WDN1, (const float*)nullptr, false);
#undef WJOB
    bf16* XB = (bf16*)(ws + WS_XB); float* ssq = (float*)(ws + WS_SSQ);
    for (int row0 = gw; row0 < MPAD; row0 += 4 * NGW) {
        f32x4 v[4][4];
#pragma unroll
        for (int u = 0; u < 4; ++u) { const int row = row0 + u * NGW; const float* src = nullptr;
            if (row < MP) { const int b = row / TP, t = row - b * TP; src = t < NMETA ? A.in[8] + (size_t)t * DM : A.in[0] + ((size_t)b * SEQL + (t - NMETA)) * DM; }
            else if (row < MTOT) src = A.in[1] + (size_t)(row - MP) * DM;
#pragma unroll
            for (int j = 0; j < 4; ++j) v[u][j] = src ? *(const f32x4*)(src + 256 * j + 4 * lane) : (f32x4){0.f, 0.f, 0.f, 0.f}; }
#pragma unroll
        for (int u = 0; u < 4; ++u) { const int row = row0 + u * NGW; if (row >= MPAD) break;
            float s = 0.f;
#pragma unroll
            for (int j = 0; j < 4; ++j) { const f32x4 x = v[u][j];
                u32x2 o;
                o.x = pk2(x[0], x[1]); o.y = pk2(x[2], x[3]); *(u32x2*)(XB + (size_t)row * DM + 256 * j + 4 * lane) = o;
                s += (x[0] * x[0] + x[1] * x[1]) + (x[2] * x[2] + x[3] * x[3]); }
            s = wave_sum(s);
            if (lane < 16) ssq[(size_t)row * 16 + lane] = lane == 0 ? s : 0.f; }
    }
    { const u32x4 z = {0u, 0u, 0u, 0u}; const int nchunk = PPAD * DM * 2 / 16;
        for (int i = gw * 64 + lane; i < nchunk; i += NGW * 64) { *(u32x4*)(ws + WS_KB - (size_t)PPAD * DM * 2 + (size_t)i * 16) = z; *(u32x4*)(ws + WS_VB - (size_t)PPAD * DM * 2 + (size_t)i * 16) = z; }
        const int nch2 = (MPAD - MTOT) * DM * 2 / 16;
        for (int i = gw * 64 + lane; i < nch2; i += NGW * 64) { *(u32x4*)(ws + WS_OB + (size_t)MTOT * DM * 2 + (size_t)i * 16) = z; *(u32x4*)(ws + WS_MH + (size_t)MTOT * DM * 2 + (size_t)i * 16) = z; } }
}

__device__ __forceinline__ float wave_scan_add(float v, int lane) {
#pragma unroll
    for (int o = 1; o < 64; o <<= 1) { const float t = __shfl_up(v, o); if (lane >= o) v += t; }
    return v;
}
__device__ __forceinline__ float wave_scan_max(float v, int lane) {
#pragma unroll
    for (int o = 1; o < 64; o <<= 1) { const float t = __shfl_up(v, o); if (lane >= o) v = fmaxf(v, t); }
    return v;
}
__device__ __forceinline__ void p2_cumsum(const Args& A, int gw, int NGW, int lane) {
    float* G = (float*)(A.ws + WS_G); float* GS = (float*)(A.ws + WS_GS);
    const float* lp = A.out + O_FLP; const float* lsn = A.out + O_FLS; const float* lc = A.in[4];
    for (int it = gw; it < NB * 16 + DB * 16; it += NGW) {
        if (it < NB * 16) { const int b = it >> 4, h = it & 15; float* g = G + (size_t)it * PLEN;
            for (int i = lane; i < PPAD; i += 64) g[i] = 0.f;
            float carry = 0.f;
#pragma unroll 1
            for (int c0 = 0; c0 < 65; c0 += 13) { float v[13];
#pragma unroll
                for (int c = 0; c < 13; ++c) { const int t = 64 * (c0 + c) + lane; v[c] = t < TP ? lp[((size_t)b * TP + t) * 16 + h] : 0.f; }
#pragma unroll
                for (int c = 0; c < 13; ++c) { const int t = 64 * (c0 + c) + lane; const float x = wave_scan_add(v[c], lane) + carry; if (t < TP) g[PPAD + t] = -LOG2E * x; carry = __shfl(x, 63); } }
        } else { const int i2 = it - NB * 16, b = i2 >> 4, h = i2 & 15; float* g = GS + (size_t)i2 * GSLEN;
            float carry = 0.f;
#pragma unroll 1
            for (int c0 = 0; c0 < 33; c0 += 11) { float v[11];
#pragma unroll
                for (int c = 0; c < 11; ++c) { const int s = 64 * (c0 + c) + lane; v[c] = 0.f; if (s < PAST) v[c] = lc[((size_t)b * PAST + s) * 16 + h]; else if (s < PAST + DT) v[c] = lsn[((size_t)b * DT + (s - PAST)) * 16 + h]; }
#pragma unroll
                for (int c = 0; c < 11; ++c) { const int s = 64 * (c0 + c) + lane; const float x = wave_scan_add(v[c], lane) + carry; g[s] = s < PAST + DT ? -LOG2E * x : 0.f; carry = __shfl(x, 63); } }
        }
    }
}

__device__ __forceinline__ int crow(int r, int hi) { return (r & 3) + 8 * (r >> 2) + 4 * hi; }
__device__ __forceinline__ v4i16_t vtr(clptr p) { return __builtin_amdgcn_ds_read_tr16_b64_v4i16((LAS v4i16_t*)p); }
constexpr int AT_KSTR = 144, AT_V = 9216, AT_B = 17408, AT_BUF = 17664;

template <bool MASK>
__device__ __forceinline__ void attn_tile(clptr Kt, clptr Vt, clptr Bt, const bf16x8 (&qr)[4], f32x16& o0, f32x16& o1, float& m, float& l, int qpos, int kpos0, int kmin, int lane) {
    const int r32 = lane & 31, hi = lane >> 5;
    f32x16 p0, p1;
#pragma unroll
    for (int g = 0; g < 4; ++g) { const f32x4 b0 = *(const LAS f32x4*)(Bt + (8 * g + 4 * hi) * 4), b1 = *(const LAS f32x4*)(Bt + (32 + 8 * g + 4 * hi) * 4);
#pragma unroll
        for (int i = 0; i < 4; ++i) { p0[4 * g + i] = b0[i] - m; p1[4 * g + i] = b1[i] - m; } }
#pragma unroll
    for (int d0 = 0; d0 < 4; ++d0) {
        const bf16x8 a0 = *(const LAS bf16x8*)(Kt + r32 * AT_KSTR + d0 * 32 + hi * 16);
        const bf16x8 a1 = *(const LAS bf16x8*)(Kt + (32 + r32) * AT_KSTR + d0 * 32 + hi * 16);
        p0 = __builtin_amdgcn_mfma_f32_32x32x16_bf16(a0, qr[d0], p0, 0, 0, 0);
        p1 = __builtin_amdgcn_mfma_f32_32x32x16_bf16(a1, qr[d0], p1, 0, 0, 0);
    }
    if (MASK) {
#pragma unroll
        for (int r = 0; r < 16; ++r) { const int kp = kpos0 + crow(r, hi); if (kp > qpos || kp < kmin) p0[r] = -INFINITY; if (kp + 32 > qpos || kp + 32 < kmin) p1[r] = -INFINITY; }
    }
    float mx = fmaxf(p0[0], p1[0]);
#pragma unroll
    for (int r = 1; r < 16; ++r) mx = fmaxf(mx, fmaxf(p0[r], p1[r]));
    { const auto rr = __builtin_amdgcn_permlane32_swap(__float_as_uint(mx), __float_as_uint(mx), false, false); mx = fmaxf(__uint_as_float(rr[0]), __uint_as_float(rr[1])); }
    if (__any(mx > 0.f)) {
        const float dl = fmaxf(mx, 0.f), alpha = __builtin_amdgcn_exp2f(-dl); m += dl; l *= alpha;
#pragma unroll
        for (int r = 0; r < 16; ++r) { o0[r] *= alpha; o1[r] *= alpha; p0[r] -= dl; p1[r] -= dl; } }
    float ls = 0.f;
#pragma unroll
    for (int r = 0; r < 16; ++r) { p0[r] = __builtin_amdgcn_exp2f(p0[r]); p1[r] = __builtin_amdgcn_exp2f(p1[r]); ls += p0[r] + p1[r]; }
    l += ls;
    u32x4 pw[4];
#pragma unroll
    for (int i = 0; i < 4; ++i) { pw[0][i] = pk2(p0[2 * i], p0[2 * i + 1]); pw[1][i] = pk2(p0[8 + 2 * i], p0[9 + 2 * i]); pw[2][i] = pk2(p1[2 * i], p1[2 * i + 1]); pw[3][i] = pk2(p1[8 + 2 * i], p1[9 + 2 * i]); }
    const clptr vb = Vt + ((lane >> 5) * 4 + ((lane & 15) >> 2)) * 64 + (((lane >> 4) & 1) * 16 + (lane & 3) * 4) * 2;
#pragma unroll
    for (int ks = 0; ks < 4; ++ks) {
        const v4i16_t l0 = vtr(vb + ks * 1024), h0 = vtr(vb + ks * 1024 + 512), l1 = vtr(vb + 4096 + ks * 1024), h1 = vtr(vb + 4096 + ks * 1024 + 512);
        const bf16x8 v0 = {l0[0], l0[1], l0[2], l0[3], h0[0], h0[1], h0[2], h0[3]}, v1 = {l1[0], l1[1], l1[2], l1[3], h1[0], h1[1], h1[2], h1[3]};
        const bf16x8 pb = __builtin_bit_cast(bf16x8, pw[ks]);
        o0 = __builtin_amdgcn_mfma_f32_32x32x16_bf16(v0, pb, o0, 0, 0, 0);
        o1 = __builtin_amdgcn_mfma_f32_32x32x16_bf16(v1, pb, o1, 0, 0, 0);
    }
}

__device__ __forceinline__ void kv_out_rows(const bf16* KB, const bf16* VB, float* outK, float* outV, size_t wsrow0, size_t outrow0, int nrows, int h, int tid) {
    const int ch = tid & 7, tsel = (tid >> 3) & 1, r0 = tid >> 4;
    const bf16* src = (tsel ? VB : KB) + h * 64 + ch * 8; float* dst = (tsel ? outV : outK) + h * 64 + ch * 8;
    asm volatile("" ::: "memory");
#pragma unroll 1
    for (int i0 = 0; i0 < 8; i0 += 4) { u32x4 v[4];
#pragma unroll
        for (int i = 0; i < 4; ++i) { const int r = r0 + 32 * (i0 + i); v[i] = r < nrows ? *(const u32x4*)(src + (wsrow0 + r) * DM) : (u32x4){0u, 0u, 0u, 0u}; }
#pragma unroll
        for (int i = 0; i < 4; ++i) { const int r = r0 + 32 * (i0 + i); if (r < nrows) { f32x4 a, b;
            a[0] = bf2f((unsigned short)(v[i].x & 0xffffu)); a[1] = bf2f((unsigned short)(v[i].x >> 16)); a[2] = bf2f((unsigned short)(v[i].y & 0xffffu)); a[3] = bf2f((unsigned short)(v[i].y >> 16));
            b[0] = bf2f((unsigned short)(v[i].z & 0xffffu)); b[1] = bf2f((unsigned short)(v[i].z >> 16)); b[2] = bf2f((unsigned short)(v[i].w & 0xffffu)); b[3] = bf2f((unsigned short)(v[i].w >> 16));
            *(f32x4*)(dst + (outrow0 + r) * DM) = a; *(f32x4*)(dst + (outrow0 + r) * DM + 4) = b; } } }
}

__device__ __forceinline__ void store8_f32(float* dst, const u32x4 v) {
    *(f32x4*)dst = (f32x4){__builtin_bit_cast(float, v.x << 16), __builtin_bit_cast(float, v.x & 0xffff0000u), __builtin_bit_cast(float, v.y << 16), __builtin_bit_cast(float, v.y & 0xffff0000u)};
    *(f32x4*)(dst + 4) = (f32x4){__builtin_bit_cast(float, v.z << 16), __builtin_bit_cast(float, v.z & 0xffff0000u), __builtin_bit_cast(float, v.w << 16), __builtin_bit_cast(float, v.w & 0xffff0000u)};
}
constexpr float AT_SKIP_T = 40.0f;
__device__ __forceinline__ void attn_prompt_unit(int b, int h, int j, const bf16* QB, const bf16* KB, const bf16* VB, const float* G, bf16* OB, lptr lds, int tid, int w, int lane, float kb, float* outK, float* outV) {
    const int r32 = lane & 31, hi = lane >> 5;
    const int qp = 256 * j + 32 * w + r32, t = qp - PPAD; const bool qvalid = t >= 0; const bool wave_active = (256 * j + 32 * w + 31) >= PPAD;
    const size_t qrow = (size_t)b * TP + (t > 0 ? t : 0);
    bf16x8 qr[4];
#pragma unroll
    for (int d0 = 0; d0 < 4; ++d0) qr[d0] = *(const bf16x8*)(QB + qrow * DM + h * 64 + d0 * 16 + hi * 8);
    const int lrow = tid >> 3, lch = tid & 7;
    const long krow0 = (long)b * TP - PPAD + lrow;
    const bf16* kg = KB + krow0 * DM + h * 64 + lch * 8; const bf16* vg = VB + krow0 * DM + h * 64 + lch * 8; const float* gg = G + (size_t)(b * 16 + h) * PLEN;
    f32x16 o0, o1;
#pragma unroll
    for (int r = 0; r < 16; ++r) { o0[r] = 0.f; o1[r] = 0.f; }
    float m = 0.f, l = 0.f;
    const int kt1 = 4 * j + 3, ktw = 4 * j + (w >> 1), kmin = qp >= PPAD ? PPAD : 0;
    u32x4 kreg[2][2], vreg[2][2]; float breg[2] = {0.f, 0.f};
    LAS int* vote = (LAS int*)(lds + 4 * AT_BUF);
#define AT_LOADPAIR(S, KH, LO) do { _Pragma("unroll") for (int i_ = 0; i_ < 2; ++i_) { const int kk_ = (KH) - i_ >= (LO) ? (KH) - i_ : (LO); kreg[S][i_] = *(const u32x4*)(kg + (size_t)kk_ * 64 * DM); vreg[S][i_] = *(const u32x4*)(vg + (size_t)kk_ * 64 * DM); } \
        if (tid < 128) { const int kk_ = (KH) - (tid >> 6) >= (LO) ? (KH) - (tid >> 6) : (LO); breg[S] = gg[kk_ * 64 + (tid & 63)]; } } while (0)
#define AT_STEP(S, KH, STEPI) { const int kh_ = (KH); const lptr base = lds + (S) * 2 * AT_BUF; \
        _Pragma("unroll") for (int i = 0; i < 2; ++i) { *(LAS u32x4*)(base + i * AT_BUF + lrow * AT_KSTR + lch * 16) = kreg[S][i]; *(LAS u32x4*)(base + i * AT_BUF + AT_V + (lch >> 2) * 4096 + lrow * 64 + (lch & 3) * 16) = vreg[S][i]; } \
        if (tid < 128) *(LAS float*)(base + (tid >> 6) * AT_BUF + AT_B + (tid & 63) * 4) = breg[S]; \
        _Pragma("unroll") for (int i = 0; i < 2; ++i) { const int k2 = kh_ - i; if (k2 >= 4 * j && k2 >= kt0) { const int t_ = 64 * k2 + lrow - PPAD;     \
            if (t_ >= 0) { const size_t o_ = ((size_t)b * TP + t_) * DM + h * 64 + lch * 8; store8_f32(outK + o_, kreg[S][i]); store8_f32(outV + o_, vreg[S][i]); } } } \
        LDS_BARRIER(); \
        if ((STEPI) > 0) { const LAS int* vp_ = vote + (((STEPI) - 1) & 1) * 8; int all_ = 1; _Pragma("unroll") for (int i = 0; i < 8; ++i) all_ &= vp_[i]; if (all_) break; } \
        if (kh_ - 4 >= kt0) AT_LOADPAIR(S, kh_ - 4, kt0); \
        int done_ = wave_active ? 0 : 1; \
        _Pragma("unroll") for (int i = 0; i < 2; ++i) { const int k2 = kh_ - i; const lptr b2 = base + i * AT_BUF; \
            if (wave_active && k2 <= ktw && k2 >= kt0) { \
                if (k2 == 3 || k2 == ktw) attn_tile<true>(b2, b2 + AT_V, b2 + AT_B, qr, o0, o1, m, l, qp, 64 * k2, kmin, lane); \
                else attn_tile<false>(b2, b2 + AT_V, b2 + AT_B, qr, o0, o1, m, l, qp, 64 * k2, kmin, lane); \
                done_ = k2 > kt0 ? (__all(kb + *(const LAS float*)(b2 + AT_B) <= m - AT_SKIP_T) ? 1 : 0) : 1; } } \
        if (lane == 0) vote[((STEPI) & 1) * 8 + w] = done_; }
    AT_LOADPAIR(0, kt1, 3);
    if (j > 0) AT_LOADPAIR(1, kt1 - 2, 3);
    int kt0 = 3;
    { const int ta = 3 + lane, tb = 67 + lane;
        const float g0 = gg[j == 0 ? PPAD : 256 * j], ga = ta < 4 * j ? gg[64 * ta + 63] : 3.0e38f, gb = tb < 4 * j ? gg[64 * tb + 63] : 3.0e38f;
        const float thr = g0 - 2.0f * kb - AT_SKIP_T;
        const bool sa = ga <= thr, sb = gb <= thr;
        kt0 = 3 + __popcll(__ballot(sa)) + __popcll(__ballot(sb)); }
    for (int kh = kt1, si = 0; kh >= kt0; kh -= 4, si += 2) { AT_STEP(0, kh, si) if (kh - 2 >= kt0) AT_STEP(1, kh - 2, si + 1) }
#undef AT_STEP
#undef AT_LOADPAIR
    const float lt = l + __shfl_xor(l, 32), inv = 1.0f / lt;
    if (wave_active && qvalid) { bf16* op = OB + qrow * DM + h * 64 + 4 * hi;
#pragma unroll
        for (int g = 0; g < 4; ++g) { u32x2 a, c; a.x = pk2(o0[4 * g] * inv, o0[4 * g + 1] * inv); a.y = pk2(o0[4 * g + 2] * inv, o0[4 * g + 3] * inv); c.x = pk2(o1[4 * g] * inv, o1[4 * g + 1] * inv); c.y = pk2(o1[4 * g + 2] * inv, o1[4 * g + 3] * inv);
            *(u32x2*)(op + 8 * g) = a; *(u32x2*)(op + 32 + 8 * g) = c; } }
    __syncthreads();
}

__device__ __forceinline__ void attn_sample_unit(int b, int h, const float* cK, const float* cV, const bf16* QB, const bf16* KB, const bf16* VB, const float* GS, bf16* OB, lptr lds, int tid, int w, int lane, float kb, float* outK, float* outV) {
    const int r32 = lane & 31, hi = lane >> 5;
    const lptr base = lds + w * AT_BUF;
    const size_t qrow = (size_t)MP + b * DT + r32;
    bf16x8 qr[4];
#pragma unroll
    for (int d0 = 0; d0 < 4; ++d0) qr[d0] = *(const bf16x8*)(QB + qrow * DM + h * 64 + d0 * 16 + hi * 8);
    f32x16 o0, o1;
#pragma unroll
    for (int r = 0; r < 16; ++r) { o0[r] = 0.f; o1[r] = 0.f; }
    float m = 0.f, l = 0.f;
    const float* gs = GS + (size_t)(b * 16 + h) * GSLEN;
    int ti0 = 0;
    { const float thr = gs[PAST] - 2.0f * kb - AT_SKIP_T; const bool sk = lane < 32 && gs[64 * lane + 63] <= thr; ti0 = __popcll(__ballot(sk)); }
#pragma unroll 1
    for (int ti = ti0 + w; ti < 33; ti += 8) {
        const float bias_l = gs[64 * ti + lane];
        if (ti < 32) {
            const float* ck0 = cK + (((size_t)b * PAST + 64 * ti + (lane >> 4)) * 16 + h) * 64 + 4 * (lane & 15); const float* cv0 = cV + (ck0 - cK);
            const lptr kw0 = base + (lane >> 4) * AT_KSTR + (lane & 15) * 8, vw0 = base + AT_V + ((lane & 15) >> 3) * 4096 + (lane >> 4) * 64 + (lane & 7) * 8;
#pragma unroll
            for (int half = 0; half < 2; ++half) {
                f32x4 kv[8], vv[8];
#pragma unroll
                for (int i = 0; i < 8; ++i) { kv[i] = *(const f32x4*)(ck0 + (half * 32 + i * 4) * 1024); vv[i] = *(const f32x4*)(cv0 + (half * 32 + i * 4) * 1024); }
#pragma unroll
                for (int i = 0; i < 8; ++i) { u32x2 a, c; a.x = pk2(kv[i][0], kv[i][1]); a.y = pk2(kv[i][2], kv[i][3]); c.x = pk2(vv[i][0], vv[i][1]); c.y = pk2(vv[i][2], vv[i][3]);
                    *(LAS u32x2*)(kw0 + (half * 32 + i * 4) * AT_KSTR) = a; *(LAS u32x2*)(vw0 + (half * 32 + i * 4) * 64) = c; }
                asm volatile("" ::: "memory");
            }
        } else {
            const size_t off0 = ((size_t)MP + b * DT + (lane >> 3)) * DM + h * 64 + (lane & 7) * 8;
            const lptr kw0 = base + (lane >> 3) * AT_KSTR + (lane & 7) * 16, vw0 = base + AT_V + ((lane & 7) >> 2) * 4096 + (lane >> 3) * 64 + (lane & 3) * 16;
#pragma unroll
            for (int i = 0; i < 8; ++i) { const u32x4 a = *(const u32x4*)(KB + off0 + (size_t)i * 8 * DM), c = *(const u32x4*)(VB + off0 + (size_t)i * 8 * DM);
                *(LAS u32x4*)(kw0 + i * 8 * AT_KSTR) = a; *(LAS u32x4*)(vw0 + i * 8 * 64) = c; }
        }
        *(LAS float*)(base + AT_B + lane * 4) = bias_l;
        LDS_WAIT();
        if (ti < 32) attn_tile<false>(base, base + AT_V, base + AT_B, qr, o0, o1, m, l, 0, 0, 0, lane);
        else attn_tile<true>(base, base + AT_V, base + AT_B, qr, o0, o1, m, l, r32, 0, 0, lane);
        asm volatile("" ::: "memory");
    }
    const float lt = l + __shfl_xor(l, 32);
    LDS_WAIT();
    LAS float* of = (LAS float*)base;
#pragma unroll
    for (int r = 0; r < 16; ++r) { of[crow(r, hi) * 32 + r32] = o0[r]; of[(32 + crow(r, hi)) * 32 + r32] = o1[r]; }
    if (hi == 0) { of[2048 + r32] = m; of[2080 + r32] = lt; }
    __syncthreads();
    { const int q = tid & 31, dg = tid >> 5; float M = -1e30f;
#pragma unroll
        for (int ww = 0; ww < 8; ++ww) M = fmaxf(M, ((LAS float*)(lds + ww * AT_BUF))[2048 + q]);
        float L = 0.f, o[4] = {0.f, 0.f, 0.f, 0.f};
#pragma unroll
        for (int ww = 0; ww < 8; ++ww) { const LAS float* p = (LAS float*)(lds + ww * AT_BUF); const float f = __builtin_amdgcn_exp2f(p[2048 + q] - M); L += f * p[2080 + q];
#pragma unroll
            for (int i = 0; i < 4; ++i) o[i] += f * p[(4 * dg + i) * 32 + q]; }
        const float inv = 1.0f / L; u32x2 a; a.x = pk2(o[0] * inv, o[1] * inv); a.y = pk2(o[2] * inv, o[3] * inv);
        *(u32x2*)(OB + ((size_t)MP + b * DT + q) * DM + h * 64 + 4 * dg) = a; }
    kv_out_rows(KB, VB, outK, outV, (size_t)MP + b * DT, (size_t)b * DT, DT, h, tid);
    __syncthreads();
}

__device__ __forceinline__ void p3_attention(const Args& A, lptr lds, int tid, int w, int lane, int rep) {
    unsigned char* ws = A.ws;
    const bf16* QB = (const bf16*)(ws + WS_QB); const bf16* KB = (const bf16*)(ws + WS_KB); const bf16* VB = (const bf16*)(ws + WS_VB); bf16* OB = (bf16*)(ws + WS_OB);
    const float* G = (const float*)(ws + WS_G); const float* GS = (const float*)(ws + WS_GS);
    unsigned* ctr = (unsigned*)(ws + WS_CTL) + 64 * rep;
    LAS unsigned* su = (LAS unsigned*)(lds + LDS_BYTES - 64);
    constexpr int NPU = 17 * NB * 16, NSU = DB * 16, NU = NPU + NSU;
    float gqm = 0.f, gkm = 0.f;
    for (int i = 0; i < 64; ++i) { gqm = fmaxf(gqm, fabsf(A.in[13][i])); gkm = fmaxf(gkm, fabsf(A.in[14][i])); }
    const float kb = 8.0f * LOG2E * gqm * gkm * 1.02f;
    for (;;) {
        if (tid == 0) *su = atomicAdd(ctr, 1u);
        __syncthreads();
        const int u = (int)*su;
        __syncthreads();
        if (u >= NU) break;
        const bool is_s = (u % 5 == 4) && (u / 5 < NSU);
        if (is_s) { const int s = u / 5; attn_sample_unit(s >> 4, s & 15, A.in[2], A.in[3], QB, KB, VB, GS, OB, lds, tid, w, lane, kb, A.out + O_FKS, A.out + O_FVS); }
        else { const int k = u / 5, pidx = u - (k < NSU ? k : NSU); const int j = 16 - pidx / (NB * 16), bh = pidx % (NB * 16); attn_prompt_unit(bh >> 4, bh & 15, j, QB, KB, VB, G, OB, lds, tid, w, lane, kb, A.out + O_FKP, A.out + O_FVP); }
    }
#ifdef PROBE_SAMPLE
    for (;;) { if (tid == 0) *su = atomicAdd(ctr + 128, 1u); __syncthreads(); const int u = (int)*su; __syncthreads(); if (u >= NSU) break;
        attn_sample_unit(u >> 4, u & 15, A.in[2], A.in[3], QB, KB, VB, GS, OB, lds, tid, w, lane, kb, A.out + O_FKS, A.out + O_FVS); }
#endif
}

constexpr int ML_QS = 272, ML_TS = 144;
constexpr int MA_VS = 544;
constexpr int MA_Q = 0, MA_K = 17408, MA_KW = 34816, MA_V = 52224, MA_SP = 87040, MA_VEC = 96256;
__device__ __forceinline__ bf16x8 tr_frag(clptr p, int rowstride4) { const v4i16_t lo = vtr(p), hi = vtr(p + rowstride4); return (bf16x8){lo[0], lo[1], lo[2], lo[3], hi[0], hi[1], hi[2], hi[3]}; }
constexpr int NUA = NB * 4 * 65 + DB * 4;
__device__ __forceinline__ f32x4 mfma16(bf16x8 a, bf16x8 b, f32x4 c) { return __builtin_amdgcn_mfma_f32_16x16x32_bf16(a, b, c, 0, 0, 0); }

__device__ __forceinline__ void mlstm_a_phase(const Args& A, int first, int stride, lptr lds, int tid, int w, int lane) {
    unsigned char* ws = A.ws;
    u32x4 pq[2], pk[2], pv[4]; float pgi = -1e30f, pgf = 0.f;
#define MA_LOAD(UID) do { const int uid_ = (UID); const bool pr_ = uid_ < NB * 4 * 65; const int bh_ = pr_ ? uid_ / 65 : uid_ - NB * 4 * 65, c_ = pr_ ? uid_ - bh_ * 65 : 0, b_ = bh_ >> 2, h_ = bh_ & 3; \
        const size_t rb_ = pr_ ? (size_t)b_ * TP : (size_t)MP + (size_t)b_ * DT; const int t0_ = pr_ ? 64 * c_ - 48 : 0, tl_ = pr_ ? TP : DT; \
        { const int tk_ = t0_ + lane; pgi = -1e30f; pgf = 0.f; if (tk_ >= 0 && tk_ < tl_) { pgi = ((const float*)(ws + WS_GI))[(rb_ + tk_) * 4 + h_]; pgf = ((const float*)(ws + WS_GF))[(rb_ + tk_) * 4 + h_]; } } \
        _Pragma("unroll") for (int i_ = 0; i_ < 2; ++i_) { const int id_ = tid + 512 * i_, r_ = id_ >> 4, ch_ = id_ & 15; const int tk_ = t0_ + r_; pq[i_] = (u32x4){0u, 0u, 0u, 0u}; pk[i_] = (u32x4){0u, 0u, 0u, 0u}; \
            if (tk_ >= 0 && tk_ < tl_) { pq[i_] = *(const u32x4*)((const bf16*)(ws + WS_MQ) + (rb_ + tk_) * 512 + h_ * 128 + ch_ * 8); pk[i_] = *(const u32x4*)((const bf16*)(ws + WS_MK) + (rb_ + tk_) * 512 + h_ * 128 + ch_ * 8); } } \
        _Pragma("unroll") for (int i_ = 0; i_ < 4; ++i_) { const int id_ = tid + 512 * i_, r_ = id_ >> 5, ch_ = id_ & 31; const int tk_ = t0_ + r_; pv[i_] = (u32x4){0u, 0u, 0u, 0u}; \
            if (tk_ >= 0 && tk_ < tl_) pv[i_] = *(const u32x4*)((const bf16*)(ws + WS_MV) + (rb_ + tk_) * DM + h_ * 256 + ch_ * 8); } } while (0)
    if (first < NUA) MA_LOAD(first);
#pragma unroll 1
    for (int uid = first; uid < NUA; uid += stride) {
    bf16* MH = (bf16*)(ws + WS_MH);
    float* RS = (float*)(ws + WS_RS); float* NU = (float*)(ws + WS_NU); bf16* U = (bf16*)(ws + WS_U) + (size_t)uid * 32768;
    const bool prompt = uid < NB * 4 * 65; const int bh = prompt ? uid / 65 : uid - NB * 4 * 65, c = prompt ? uid - bh * 65 : 0, b = bh >> 2, h = bh & 3;
    const size_t row_base = prompt ? (size_t)b * TP : (size_t)MP + (size_t)b * DT; const int tok0 = prompt ? 64 * c - 48 : 0, tlim = prompt ? TP : DT;
    LAS float* vec = (LAS float*)(lds + MA_VEC); LAS float* v_b = vec, *v_a = vec + 64, *v_ml = vec + 128, *v_rs = vec + 192;
    const int l15 = lane & 15, lg = lane >> 4;
    const float gi = pgi, gf = pgf;
    const float bb = wave_scan_add(gf, lane), aa = gi - bb, pm = wave_scan_max(aa, lane), mloc = bb + pm;
    const float b_last = __shfl(bb, 63), ml_last = __shfl(mloc, 63), wgl = __expf(b_last + aa - ml_last);
    if (w == 0) { v_b[lane] = bb; v_a[lane] = aa; v_ml[lane] = mloc; }
    if (w == 0) { ((float*)(ws + WS_BBC))[(size_t)uid * 64 + lane] = bb; ((float*)(ws + WS_PMC))[(size_t)uid * 64 + lane] = pm; }
#pragma unroll
    for (int i = 0; i < 2; ++i) { const int id = tid + 512 * i, r = id >> 4, ch = id & 15; const int tk = tok0 + r; const bool ok = tk >= 0 && tk < tlim;
        const u32x4 q = pq[i], k = pk[i]; (void)ok;
        *(LAS u32x4*)(lds + MA_Q + r * ML_QS + ch * 16) = q; *(LAS u32x4*)(lds + MA_K + r * ML_QS + ch * 16) = k;
        const float wgr = __shfl(wgl, r); u32x4 kw;
#pragma unroll
        for (int e = 0; e < 4; ++e) kw[e] = pk2(bf2f((unsigned short)(k[e] & 0xffffu)) * wgr, bf2f((unsigned short)(k[e] >> 16)) * wgr);
        *(LAS u32x4*)(lds + MA_KW + r * ML_QS + ch * 16) = kw; }
#pragma unroll
    for (int i = 0; i < 4; ++i) { const int id = tid + 512 * i, r = id >> 5, ch = id & 31; const int tk = tok0 + r; const bool ok = tk >= 0 && tk < tlim;
        const u32x4 v = pv[i]; (void)ok;
        *(LAS u32x4*)(lds + MA_V + r * MA_VS + ch * 16) = v; }
    LDS_BARRIER();
    if (uid + stride < NUA) MA_LOAD(uid + stride);
    { const int tr = w >> 1; float rs[4] = {0.f, 0.f, 0.f, 0.f};
#pragma unroll
        for (int i = 0; i < 2; ++i) { const int tc = 2 * (w & 1) + i; f32x4 acc = {0.f, 0.f, 0.f, 0.f};
#pragma unroll
            for (int k0 = 0; k0 < 128; k0 += 32) { const bf16x8 a = *(const LAS bf16x8*)(lds + MA_Q + (16 * tr + l15) * ML_QS + (k0 + 8 * lg) * 2), bq = *(const LAS bf16x8*)(lds + MA_K + (16 * tc + l15) * ML_QS + (k0 + 8 * lg) * 2); acc = mfma16(a, bq, acc); }
            const int s = 16 * tc + l15; const float as = v_a[s];
#pragma unroll
            for (int r = 0; r < 4; ++r) { const int t = 16 * tr + 4 * lg + r; const float d = s <= t ? __expf(v_b[t] + as - v_ml[t]) : 0.f; const float sp = acc[r] * d; rs[r] += sp;
                *(LAS unsigned short*)(lds + MA_SP + t * ML_TS + s * 2) = (unsigned short)f2bf(sp); } }
#pragma unroll
        for (int r = 0; r < 4; ++r) { float x = rs[r]; x += __shfl_xor(x, 1); x += __shfl_xor(x, 2); x += __shfl_xor(x, 4); x += __shfl_xor(x, 8); if (l15 == 0) v_rs[(w & 1) * 64 + 16 * tr + 4 * lg + r] = x; } }
    const clptr vtb = lds + MA_V + (8 * lg + (l15 >> 2)) * MA_VS + (l15 & 3) * 8;
    {
        const clptr kwb = lds + MA_KW + (8 * lg + (l15 >> 2)) * ML_QS + (l15 & 3) * 8 + w * 32;
        const bf16x8 a0 = tr_frag(kwb, 4 * ML_QS), a1 = tr_frag(kwb + 32 * ML_QS, 4 * ML_QS);
#pragma unroll 4
        for (int dvt = 0; dvt < 16; ++dvt) { const bf16x8 b0 = tr_frag(vtb + dvt * 32, 4 * MA_VS), b1 = tr_frag(vtb + 32 * MA_VS + dvt * 32, 4 * MA_VS);
            f32x4 acc = {0.f, 0.f, 0.f, 0.f}; acc = mfma16(a0, b0, acc); acc = mfma16(a1, b1, acc);
            u32x2 o; o.x = pk2(acc[0], acc[1]); o.y = pk2(acc[2], acc[3]); *(u32x2*)(U + (size_t)(16 * dvt + l15) * 128 + 16 * w + 4 * lg) = o; } }
    if (tid < 128) { float x = 0.f;
#pragma unroll 8
        for (int s = 0; s < 64; ++s) x += bf2f(*(const LAS unsigned short*)(lds + MA_KW + s * ML_QS + tid * 2));
        NU[(size_t)uid * 128 + tid] = x; }
    LDS_BARRIER();
    if (tid < 64) { const int tk = tok0 + tid; if (tk >= 0 && tk < tlim) RS[(row_base + tk) * 4 + h] = v_rs[tid] + v_rs[64 + tid]; }
    {
        const int tt = w & 3; const bf16x8 b0 = *(const LAS bf16x8*)(lds + MA_SP + (16 * tt + l15) * ML_TS + (8 * lg) * 2), b1 = *(const LAS bf16x8*)(lds + MA_SP + (16 * tt + l15) * ML_TS + (32 + 8 * lg) * 2);
        const int tk = tok0 + 16 * tt + l15; const bool ok = tk >= 0 && tk < tlim; bf16* dst = MH + (row_base + (ok ? tk : 0)) * DM + h * 256 + 4 * lg;
#pragma unroll 4
        for (int i = 0; i < 8; ++i) { const int dvt = 8 * (w >> 2) + i; const bf16x8 a0 = tr_frag(vtb + dvt * 32, 4 * MA_VS), a1 = tr_frag(vtb + 32 * MA_VS + dvt * 32, 4 * MA_VS);
            f32x4 acc = {0.f, 0.f, 0.f, 0.f}; acc = mfma16(a0, b0, acc); acc = mfma16(a1, b1, acc);
            if (ok) { u32x2 o; o.x = pk2(acc[0], acc[1]); o.y = pk2(acc[2], acc[3]); *(u32x2*)(dst + 16 * dvt) = o; } } }
    LDS_BARRIER();
    }
#undef MA_LOAD
    __syncthreads();
}

constexpr int MB_QSZ = 17408, MB_CBSZ = 48 * ML_QS, MB_Q = 0, MB_CB = 2 * MB_QSZ, MB_END = MB_CB + 2 * MB_CBSZ;
__device__ __forceinline__ void mlstm_b_item(const Args& A, int it, lptr lds, int tid, int w, int lane) {
    unsigned char* ws = A.ws;
    const bf16* MQ = (const bf16*)(ws + WS_MQ); bf16* MH = (bf16*)(ws + WS_MH); const float* GI = (const float*)(ws + WS_GI); const float* GF = (const float*)(ws + WS_GF);
    const float* RS = (const float*)(ws + WS_RS); const float* NU = (const float*)(ws + WS_NU); float* HSSQ = (float*)(ws + WS_HSSQ);
    const bool prompt = it < 256; const int i2 = prompt ? it : it - 256; const int b = i2 >> 5, h = (i2 >> 3) & 3, sl = i2 & 7; const int nch = prompt ? 65 : 1;
    const int uid0 = prompt ? (b * 4 + h) * 65 : NB * 4 * 65 + (b * 4 + h);
    const size_t row_base = prompt ? (size_t)b * TP : (size_t)MP + (size_t)b * DT; const int tlim = prompt ? TP : DT;
    const bf16* Ub = (const bf16*)(ws + WS_U) + (size_t)uid0 * 32768 + (size_t)(sl * 32 + (tid >> 4)) * 128 + (tid & 15) * 8;
    const int l15 = lane & 15, lg = lane >> 4, tt = w & 3, dvt = w >> 2, cdv = tid >> 4, cdk = (tid & 15) * 8;
    float C[8]; float nreg = 0.f, m_run = 0.f;
    {
        if (prompt) {
#pragma unroll
            for (int i = 0; i < 8; ++i) C[i] = 0.f;
        } else { const float* C0 = A.in[5] + ((size_t)(b * 4 + h) * 256 + sl * 32 + cdv) * 128 + cdk; const f32x4 c0 = *(const f32x4*)C0, c1 = *(const f32x4*)(C0 + 4);
#pragma unroll
            for (int i = 0; i < 4; ++i) { C[i] = c0[i]; C[4 + i] = c1[i]; }
            if (tid < 128) nreg = A.in[6][(size_t)(b * 4 + h) * 128 + tid]; m_run = A.in[7][b * 4 + h]; }
        u32x4 o; o.x = pk2(C[0], C[1]); o.y = pk2(C[2], C[3]); o.z = pk2(C[4], C[5]); o.w = pk2(C[6], C[7]);
        *(LAS u32x4*)(lds + MB_CB + cdv * ML_QS + cdk * 2) = o;
        if (tid < 256) { const int r = 32 + (tid >> 4); const u32x4 z = {0u, 0u, 0u, 0u}; *(LAS u32x4*)(lds + MB_CB + r * ML_QS + (tid & 15) * 16) = z; *(LAS u32x4*)(lds + MB_CB + MB_CBSZ + r * ML_QS + (tid & 15) * 16) = z; }
    }
    __syncthreads();
    if (tid < 128) *(LAS unsigned short*)(lds + MB_CB + 32 * ML_QS + tid * 2) = (unsigned short)f2bf(nreg);
    u32x4 q0_[2], q1_[2], uc_[2]; u32x2 nl_[2]; float gi_[2], gf_[2], rs_[2], nu_[2];
#define MB_LOADQ(S, cc) do { const int tok0_ = prompt ? 64 * (cc) - 48 : 0; \
        { const int r_ = tid >> 4, tk_ = tok0_ + r_; const bool ok_ = tk_ >= 0 && tk_ < tlim; q0_[S] = (u32x4){0u, 0u, 0u, 0u}; if (ok_) q0_[S] = *(const u32x4*)(MQ + (row_base + tk_) * 512 + h * 128 + (tid & 15) * 8); } \
        { const int r_ = 32 + (tid >> 4), tk_ = tok0_ + r_; const bool ok_ = tk_ >= 0 && tk_ < tlim; q1_[S] = (u32x4){0u, 0u, 0u, 0u}; if (ok_) q1_[S] = *(const u32x4*)(MQ + (row_base + tk_) * 512 + h * 128 + (tid & 15) * 8); } } while (0)
#define MB_LOAD(S, cc) do { const int tok0_ = prompt ? 64 * (cc) - 48 : 0; \
        uc_[S] = *(const u32x4*)(Ub + (size_t)(cc) * 32768); \
        { const int tk_ = tok0_ + lane; gi_[S] = ((const float*)(ws + WS_PMC))[(size_t)(uid0 + (cc)) * 64 + lane]; gf_[S] = ((const float*)(ws + WS_BBC))[(size_t)(uid0 + (cc)) * 64 + lane]; rs_[S] = 0.f; if (tk_ >= 0 && tk_ < tlim) rs_[S] = RS[(row_base + tk_) * 4 + h]; } \
        nu_[S] = tid < 128 ? NU[(size_t)(uid0 + (cc)) * 128 + tid] : 0.f; \
        { const int tk_ = tok0_ + 16 * tt + l15; nl_[S] = (u32x2){0u, 0u}; if (tk_ >= 0 && tk_ < tlim) nl_[S] = *(const u32x2*)(MH + (row_base + tk_) * DM + h * 256 + sl * 32 + 16 * dvt + 4 * lg); } } while (0)
    MB_LOADQ(0, 0); MB_LOAD(0, 0);
    if (nch > 1) MB_LOAD(1, 1);
    *(LAS u32x4*)(lds + MB_Q + (tid >> 4) * ML_QS + (tid & 15) * 16) = q0_[0]; *(LAS u32x4*)(lds + MB_Q + (32 + (tid >> 4)) * ML_QS + (tid & 15) * 16) = q1_[0];
    __syncthreads();
    if (nch > 1) MB_LOADQ(1, 1);
    if (nch > 2) MB_LOADQ(0, 2);
#pragma unroll 1
    for (int c2 = 0; c2 < nch; c2 += 2) {
        { constexpr int S = 0; const int c = c2;
        const int tok0 = prompt ? 64 * c - 48 : 0;
        const float bb = gf_[S], pm = gi_[S];
        const float mx = fmaxf(m_run, pm), mt = bb + mx, win = __expf(m_run - mx), scl = __expf(pm - mx), einv = __expf(-mt);
        const float b_last = __shfl(bb, 63), m_new = __shfl(mt, 63), pm_last = __shfl(pm, 63), mx_last = fmaxf(m_run, pm_last);
        const float decay = __expf(m_run - mx_last), usc = __expf(pm_last - mx_last);
        (void)b_last;
        const u32x4 uc = uc_[S]; const u32x2 nlc = nl_[S]; const float rsc = rs_[S], nuc = nu_[S];
        f32x4 acc = {0.f, 0.f, 0.f, 0.f}, acc2 = {0.f, 0.f, 0.f, 0.f};
#pragma unroll
        for (int k0 = 0; k0 < 128; k0 += 32) { const bf16x8 bq = *(const LAS bf16x8*)(lds + MB_Q + S * MB_QSZ + (16 * tt + l15) * ML_QS + (k0 + 8 * lg) * 2);
            const bf16x8 a = *(const LAS bf16x8*)(lds + MB_CB + S * MB_CBSZ + (16 * dvt + l15) * ML_QS + (k0 + 8 * lg) * 2), an = *(const LAS bf16x8*)(lds + MB_CB + S * MB_CBSZ + (32 + l15) * ML_QS + (k0 + 8 * lg) * 2);
            acc = mfma16(a, bq, acc); acc2 = mfma16(an, bq, acc2); }
        {
            const int t = 16 * tt + l15; const int tk = tok0 + t; const bool ok = tk >= 0 && tk < tlim;
            const float qn = __shfl(acc2[0], l15), win_t = __shfl(win, t), scl_t = __shfl(scl, t), einv_t = __shfl(einv, t), rs_t = __shfl(rsc, t);
            const float den = win_t * qn + scl_t * rs_t, rden = 1.0f / fmaxf(fabsf(den), einv_t);
            const float n0 = bf2f((unsigned short)(nlc.x & 0xffffu)), n1 = bf2f((unsigned short)(nlc.x >> 16)), n2 = bf2f((unsigned short)(nlc.y & 0xffffu)), n3 = bf2f((unsigned short)(nlc.y >> 16));
            const float h0 = (win_t * acc[0] + scl_t * n0) * rden, h1 = (win_t * acc[1] + scl_t * n1) * rden, h2 = (win_t * acc[2] + scl_t * n2) * rden, h3 = (win_t * acc[3] + scl_t * n3) * rden;
            float x = (h0 * h0 + h1 * h1) + (h2 * h2 + h3 * h3); x += __shfl_xor(x, 16); x += __shfl_xor(x, 32);
            if (ok) { u32x2 o; o.x = pk2(h0, h1); o.y = pk2(h2, h3); *(u32x2*)(MH + (row_base + tk) * DM + h * 256 + sl * 32 + 16 * dvt + 4 * lg) = o; if (lg == 0) HSSQ[((row_base + tk) * 4 + h) * 16 + sl * 2 + dvt] = x; }
        }
        {
            C[0] = decay * C[0] + usc * bf2f((unsigned short)(uc.x & 0xffffu)); C[1] = decay * C[1] + usc * bf2f((unsigned short)(uc.x >> 16));
            C[2] = decay * C[2] + usc * bf2f((unsigned short)(uc.y & 0xffffu)); C[3] = decay * C[3] + usc * bf2f((unsigned short)(uc.y >> 16));
            C[4] = decay * C[4] + usc * bf2f((unsigned short)(uc.z & 0xffffu)); C[5] = decay * C[5] + usc * bf2f((unsigned short)(uc.z >> 16));
            C[6] = decay * C[6] + usc * bf2f((unsigned short)(uc.w & 0xffffu)); C[7] = decay * C[7] + usc * bf2f((unsigned short)(uc.w >> 16));
            u32x4 o; o.x = pk2(C[0], C[1]); o.y = pk2(C[2], C[3]); o.z = pk2(C[4], C[5]); o.w = pk2(C[6], C[7]);
            *(LAS u32x4*)(lds + MB_CB + (S ^ 1) * MB_CBSZ + cdv * ML_QS + cdk * 2) = o;
            if (tid < 128) { nreg = decay * nreg + usc * nuc; *(LAS unsigned short*)(lds + MB_CB + (S ^ 1) * MB_CBSZ + 32 * ML_QS + tid * 2) = (unsigned short)f2bf(nreg); }
            if (c + 1 < nch) { *(LAS u32x4*)(lds + MB_Q + (S ^ 1) * MB_QSZ + (tid >> 4) * ML_QS + (tid & 15) * 16) = q0_[S ^ 1]; *(LAS u32x4*)(lds + MB_Q + (S ^ 1) * MB_QSZ + (32 + (tid >> 4)) * ML_QS + (tid & 15) * 16) = q1_[S ^ 1]; }
        }
        m_run = m_new;
        LDS_BARRIER();
        if (c + 2 < nch) MB_LOAD(S, c + 2);
        if (c + 3 < nch) MB_LOADQ(S ^ 1, c + 3);
        }
        if (c2 + 1 < nch) { constexpr int S = 1; const int c = c2 + 1;
        const int tok0 = prompt ? 64 * c - 48 : 0;
        const float bb = gf_[S], pm = gi_[S];
        const float mx = fmaxf(m_run, pm), mt = bb + mx, win = __expf(m_run - mx), scl = __expf(pm - mx), einv = __expf(-mt);
        const float b_last = __shfl(bb, 63), m_new = __shfl(mt, 63), pm_last = __shfl(pm, 63), mx_last = fmaxf(m_run, pm_last);
        const float decay = __expf(m_run - mx_last), usc = __expf(pm_last - mx_last);
        (void)b_last;
        const u32x4 uc = uc_[S]; const u32x2 nlc = nl_[S]; const float rsc = rs_[S], nuc = nu_[S];
        f32x4 acc = {0.f, 0.f, 0.f, 0.f}, acc2 = {0.f, 0.f, 0.f, 0.f};
#pragma unroll
        for (int k0 = 0; k0 < 128; k0 += 32) { const bf16x8 bq = *(const LAS bf16x8*)(lds + MB_Q + S * MB_QSZ + (16 * tt + l15) * ML_QS + (k0 + 8 * lg) * 2);
            const bf16x8 a = *(const LAS bf16x8*)(lds + MB_CB + S * MB_CBSZ + (16 * dvt + l15) * ML_QS + (k0 + 8 * lg) * 2), an = *(const LAS bf16x8*)(lds + MB_CB + S * MB_CBSZ + (32 + l15) * ML_QS + (k0 + 8 * lg) * 2);
            acc = mfma16(a, bq, acc); acc2 = mfma16(an, bq, acc2); }
        {
            const int t = 16 * tt + l15; const int tk = tok0 + t; const bool ok = tk >= 0 && tk < tlim;
            const float qn = __shfl(acc2[0], l15), win_t = __shfl(win, t), scl_t = __shfl(scl, t), einv_t = __shfl(einv, t), rs_t = __shfl(rsc, t);
            const float den = win_t * qn + scl_t * rs_t, rden = 1.0f / fmaxf(fabsf(den), einv_t);
            const float n0 = bf2f((unsigned short)(nlc.x & 0xffffu)), n1 = bf2f((unsigned short)(nlc.x >> 16)), n2 = bf2f((unsigned short)(nlc.y & 0xffffu)), n3 = bf2f((unsigned short)(nlc.y >> 16));
            const float h0 = (win_t * acc[0] + scl_t * n0) * rden, h1 = (win_t * acc[1] + scl_t * n1) * rden, h2 = (win_t * acc[2] + scl_t * n2) * rden, h3 = (win_t * acc[3] + scl_t * n3) * rden;
            float x = (h0 * h0 + h1 * h1) + (h2 * h2 + h3 * h3); x += __shfl_xor(x, 16); x += __shfl_xor(x, 32);
            if (ok) { u32x2 o; o.x = pk2(h0, h1); o.y = pk2(h2, h3); *(u32x2*)(MH + (row_base + tk) * DM + h * 256 + sl * 32 + 16 * dvt + 4 * lg) = o; if (lg == 0) HSSQ[((row_base + tk) * 4 + h) * 16 + sl * 2 + dvt] = x; }
        }
        {
            C[0] = decay * C[0] + usc * bf2f((unsigned short)(uc.x & 0xffffu)); C[1] = decay * C[1] + usc * bf2f((unsigned short)(uc.x >> 16));
            C[2] = decay * C[2] + usc * bf2f((unsigned short)(uc.y & 0xffffu)); C[3] = decay * C[3] + usc * bf2f((unsigned short)(uc.y >> 16));
            C[4] = decay * C[4] + usc * bf2f((unsigned short)(uc.z & 0xffffu)); C[5] = decay * C[5] + usc * bf2f((unsigned short)(uc.z >> 16));
            C[6] = decay * C[6] + usc * bf2f((unsigned short)(uc.w & 0xffffu)); C[7] = decay * C[7] + usc * bf2f((unsigned short)(uc.w >> 16));
            u32x4 o; o.x = pk2(C[0], C[1]); o.y = pk2(C[2], C[3]); o.z = pk2(C[4], C[5]); o.w = pk2(C[6], C[7]);
            *(LAS u32x4*)(lds + MB_CB + (S ^ 1) * MB_CBSZ + cdv * ML_QS + cdk * 2) = o;
            if (tid < 128) { nreg = decay * nreg + usc * nuc; *(LAS unsigned short*)(lds + MB_CB + (S ^ 1) * MB_CBSZ + 32 * ML_QS + tid * 2) = (unsigned short)f2bf(nreg); }
            if (c + 1 < nch) { *(LAS u32x4*)(lds + MB_Q + (S ^ 1) * MB_QSZ + (tid >> 4) * ML_QS + (tid & 15) * 16) = q0_[S ^ 1]; *(LAS u32x4*)(lds + MB_Q + (S ^ 1) * MB_QSZ + (32 + (tid >> 4)) * ML_QS + (tid & 15) * 16) = q1_[S ^ 1]; }
        }
        m_run = m_new;
        LDS_BARRIER();
        if (c + 2 < nch) MB_LOAD(S, c + 2);
        if (c + 3 < nch) MB_LOADQ(S ^ 1, c + 3);
        }
    }
#undef MB_LOAD
#undef MB_LOADQ
    { float* Co = A.out + (prompt ? O_MCP : O_MCS) + ((size_t)(b * 4 + h) * 256 + sl * 32 + cdv) * 128 + cdk;
        *(f32x4*)Co = (f32x4){C[0], C[1], C[2], C[3]}; *(f32x4*)(Co + 4) = (f32x4){C[4], C[5], C[6], C[7]};
        if (sl == 0) { if (tid < 128) (A.out + (prompt ? O_MNP : O_MNS))[(size_t)(b * 4 + h) * 128 + tid] = nreg; if (tid == 0) (A.out + (prompt ? O_MMP : O_MMS))[b * 4 + h] = m_run; } }
    __syncthreads();
}

__device__ __forceinline__ void p9_gate(const Args& A, int gw, int NGW, int lane) {
    unsigned char* ws = A.ws; bf16* MH = (bf16*)(ws + WS_MH); const bf16* MO = (const bf16*)(ws + WS_MO); const float* HSSQ = (const float*)(ws + WS_HSSQ);
    const int hd = lane >> 4;
    for (int row0 = gw; row0 < MTOT; row0 += 4 * NGW) {
        f32x4 p[4][4]; u32x4 hv[4][2], ov[4][2];
#pragma unroll
        for (int u = 0; u < 4; ++u) { const int row = row0 + u * NGW < MTOT ? row0 + u * NGW : row0; const float* pp = HSSQ + ((size_t)row * 4 + hd) * 16;
#pragma unroll
            for (int i = 0; i < 4; ++i) p[u][i] = *(const f32x4*)(pp + 4 * i);
#pragma unroll
            for (int i = 0; i < 2; ++i) { const size_t off = (size_t)row * DM + lane * 16 + i * 8; hv[u][i] = *(const u32x4*)(MH + off); ov[u][i] = *(const u32x4*)(MO + off); } }
#pragma unroll
        for (int u = 0; u < 4; ++u) { const int row = row0 + u * NGW; if (row >= MTOT) break;
            float s = 0.f;
#pragma unroll
            for (int i = 0; i < 4; ++i) s += (p[u][i][0] + p[u][i][1]) + (p[u][i][2] + p[u][i][3]);
            const float rs = __builtin_amdgcn_rsqf(s * (1.0f / 256.0f) + EPSN);
#pragma unroll
            for (int i = 0; i < 2; ++i) { const size_t off = (size_t)row * DM + lane * 16 + i * 8; u32x4 o;
#pragma unroll
                for (int e2 = 0; e2 < 4; ++e2) { const float a = bf2f((unsigned short)(hv[u][i][e2] & 0xffffu)) * rs * bf2f((unsigned short)(ov[u][i][e2] & 0xffffu)), c = bf2f((unsigned short)(hv[u][i][e2] >> 16)) * rs * bf2f((unsigned short)(ov[u][i][e2] >> 16)); o[e2] = pk2(a, c); }
                *(u32x4*)(MH + off) = o; } }
    }
}

__device__ __forceinline__ void p13_final(const Args& A, int gw, int NGW, int lane) {
    unsigned char* ws = A.ws; const bf16* XB = (const bf16*)(ws + WS_XB); const float* ssq = (const float*)(ws + WS_SSQ); const float* g = A.in[23];
    f32x4 gg[4];
#pragma unroll
    for (int j = 0; j < 4; ++j) gg[j] = *(const f32x4*)(g + 256 * j + 4 * lane);
    for (int row0 = gw; row0 < MTOT; row0 += 4 * NGW) {
        u32x2 v[4][4]; float sq[4];
#pragma unroll
        for (int u = 0; u < 4; ++u) { const int row = row0 + u * NGW < MTOT ? row0 + u * NGW : row0; sq[u] = lane < 16 ? ssq[(size_t)row * 16 + lane] : 0.f;
#pragma unroll
            for (int j = 0; j < 4; ++j) v[u][j] = *(const u32x2*)(XB + (size_t)row * DM + 256 * j + 4 * lane); }
#pragma unroll
        for (int u = 0; u < 4; ++u) { const int row = row0 + u * NGW; if (row >= MTOT) break;
            float* dst;
            if (row < MP) { const int b = row / TP, t = row - b * TP; if (t < NMETA) continue; dst = A.out + O_YP + ((size_t)b * SEQL + (t - NMETA)) * DM; }
            else dst = A.out + O_YS + (size_t)(row - MP) * DM;
            const float rs = __builtin_amdgcn_rsqf(wave_sum(sq[u]) * (1.0f / 1024.0f) + EPSN);
#pragma unroll
            for (int j = 0; j < 4; ++j) { const f32x4 x = {bf2f((unsigned short)(v[u][j].x & 0xffffu)), bf2f((unsigned short)(v[u][j].x >> 16)), bf2f((unsigned short)(v[u][j].y & 0xffffu)), bf2f((unsigned short)(v[u][j].y >> 16))};
                *(f32x4*)(dst + 256 * j + 4 * lane) = x * rs * gg[j]; } }
    }
}

template <bool FIRSTR, bool LASTR> __device__ __forceinline__ void tail_finish(const float* P, unsigned* cnt, const pg8::StaticOrder& base, int first, int ntail, int slices, int c, float* X, bf16* XB, float* ssq, lptr lds, int tid, const float* xp, const float* xs, const float* meta) {
    const int tu = c / slices; if (tu >= ntail) return;
    asm volatile("s_waitcnt vmcnt(0)" ::: "memory"); __syncthreads();
    if (tid == 0) { __builtin_amdgcn_fence(__ATOMIC_RELEASE, "agent"); asm volatile("s_waitcnt vmcnt(0)" ::: "memory");
        (void)__hip_atomic_fetch_add(cnt + tu, 1u, __ATOMIC_RELAXED, __HIP_MEMORY_SCOPE_AGENT);
        while (__hip_atomic_load(cnt + tu, __ATOMIC_RELAXED, __HIP_MEMORY_SCOPE_AGENT) < (unsigned)slices) __builtin_amdgcn_s_sleep(2); }
    __syncthreads();
    __builtin_amdgcn_fence(__ATOMIC_ACQUIRE, "agent"); asm volatile("s_waitcnt vmcnt(0)" ::: "memory");
    pg8::Unit u; base.map(first + tu, u);
    const int nrow = 256 / slices, rbase = (c % slices) * nrow;
    const int cc = tid & 31, r0 = tid >> 5;
    const float* p0 = P + (size_t)(tu * slices) * 65536 + cc * 8;
#pragma unroll 2
    for (int rr = 0; rr < nrow; rr += 16) { const int row = rbase + rr + r0;
        const size_t xoff = (size_t)(u.pm * 256 + row) * DM + u.pn * 256 + cc * 8;
        f32x4 a, b;
        if (FIRSTR) pg8::first_resid(xp, xs, meta, u.pm * 256 + row, u.pn * 256 + cc * 8, a, b);
        else { const u32x4 r = *(const u32x4*)(XB + xoff);
            a = (f32x4){__builtin_bit_cast(float, r.x << 16), __builtin_bit_cast(float, r.x & 0xffff0000u), __builtin_bit_cast(float, r.y << 16), __builtin_bit_cast(float, r.y & 0xffff0000u)};
            b = (f32x4){__builtin_bit_cast(float, r.z << 16), __builtin_bit_cast(float, r.z & 0xffff0000u), __builtin_bit_cast(float, r.w << 16), __builtin_bit_cast(float, r.w & 0xffff0000u)}; }
        for (int s = 0; s < slices; ++s) { a = a + *(const f32x4*)(p0 + (size_t)s * 65536 + row * 256); b = b + *(const f32x4*)(p0 + (size_t)s * 65536 + row * 256 + 4); }
        *(u32x4*)(XB + xoff) = pg8::pack8(a, b);
        float q = (a[0] * a[0] + a[1] * a[1]) + (a[2] * a[2] + a[3] * a[3]) + (b[0] * b[0] + b[1] * b[1]) + (b[2] * b[2] + b[3] * b[3]);
        q += __shfl_xor(q, 1); q += __shfl_xor(q, 2); q += __shfl_xor(q, 4);
        if ((cc & 7) == 0) ssq[(size_t)(u.pm * 256 + row) * 16 + u.pn * 4 + (cc >> 3)] = q; }
}

#define XB_TMO      128
#define XB_XCNT(j)  (256  + 64 * (j))
#define XB_XSUB(j)  (1280 + 64 * (j))
#define XB_XGEN(j)  (2304 + 64 * (j))
#define XB_TOP      3328
#define XB_TOPGEN   3392
#define XCD_BAR_WORDS 3456
#define XB_SPIN_CAP (1u << 18)

__device__ __forceinline__ unsigned xb_ld(unsigned* p)              { return __hip_atomic_load(p, __ATOMIC_RELAXED, __HIP_MEMORY_SCOPE_AGENT); }
__device__ __forceinline__ unsigned xb_add(unsigned* p, unsigned v) { return __hip_atomic_fetch_add(p, v, __ATOMIC_RELAXED, __HIP_MEMORY_SCOPE_AGENT); }
__device__ __forceinline__ unsigned xb_xcc_id() { return (unsigned)__builtin_amdgcn_s_getreg((3 << 11) | 20) & 0xFu; }
#define XB_SPIN(cond, bar) do { unsigned _sp = 0; while (cond) { __builtin_amdgcn_s_sleep(1); \
    if ((++_sp & 255u) == 0u) { if (xb_ld(&(bar)[XB_TMO])) break; if (_sp > XB_SPIN_CAP) { atomicAdd(&(bar)[XB_TMO], 1u); break; } } } } while (0)

struct XcdBarrier {
    unsigned* bar; unsigned x;
    volatile LAS unsigned* st;
};

__device__ __forceinline__ XcdBarrier xcd_barrier_post(unsigned* bar, volatile LAS unsigned* st) {
    XcdBarrier b; b.bar = bar; b.x = xb_xcc_id(); b.st = st;
    if (threadIdx.x == 0) (void)xb_add(&bar[XB_XCNT(b.x)], 1u);
    return b;
}
__device__ __forceinline__ void xcd_barrier_complete(unsigned* bar, unsigned x, unsigned& nloc, unsigned& nx) {
    const unsigned G = gridDim.x * gridDim.y * gridDim.z;
    unsigned sum, cnt, mine, sp = 0u;
    for (;;) {
        sum = 0u; cnt = 0u; mine = 0u;
#pragma unroll
        for (unsigned j = 0; j < 16; ++j) { const unsigned c = xb_ld(&bar[XB_XCNT(j)]); sum += c; cnt += (c > 0u) ? 1u : 0u; mine = (j == x) ? c : mine; }
        if (sum == G) break;
        __builtin_amdgcn_s_sleep(1);
        if ((++sp & 255u) == 0u) { if (xb_ld(&bar[XB_TMO])) break; if (sp > XB_SPIN_CAP) { atomicAdd(&bar[XB_TMO], 1u); break; } }
    }
    nloc = mine > 0u ? mine : 1u; nx = cnt > 0u ? cnt : 1u;
}

__device__ __forceinline__ void xcd_barrier(const XcdBarrier& b) {
    asm volatile("s_waitcnt vmcnt(0)" ::: "memory");
    __syncthreads();
    if (threadIdx.x == 0) {
        unsigned* bar = b.bar;
        __builtin_amdgcn_s_waitcnt(0);
        unsigned nloc = b.st[0], nx = b.st[1];
        if (nloc == 0u) { xcd_barrier_complete(bar, b.x, nloc, nx); b.st[0] = nloc; b.st[1] = nx; }
        const unsigned old = xb_add(&bar[XB_XSUB(b.x)], 1u);
        const unsigned gen = old / nloc;
        if (old + 1u == (gen + 1u) * nloc) {
            __builtin_amdgcn_fence(__ATOMIC_RELEASE, "agent");
            asm volatile("s_waitcnt vmcnt(0)" ::: "memory");
            const unsigned og = xb_add(&bar[XB_TOP], 1u);
            const unsigned tg = og / nx;
            if (og + 1u == (tg + 1u) * nx) xb_add(&bar[XB_TOPGEN], 1u);
            else XB_SPIN(xb_ld(&bar[XB_TOPGEN]) == tg, bar);
            __builtin_amdgcn_fence(__ATOMIC_ACQUIRE, "agent");
            xb_add(&bar[XB_XGEN(b.x)], 1u);
            asm volatile("s_waitcnt vmcnt(0)" ::: "memory");
        } else {
            XB_SPIN(xb_ld(&bar[XB_XGEN(b.x)]) == gen, bar);
            __builtin_amdgcn_fence(__ATOMIC_ACQUIRE, "agent");
            asm volatile("s_waitcnt vmcnt(0)" ::: "memory");
        }
    }
    __syncthreads();
}

__global__ void __launch_bounds__(NTHR, 2) fwd_megakernel(Args args) {
    extern __shared__ __attribute__((aligned(16))) unsigned char lds_raw[];
    cg::grid_group grid = cg::this_grid();
    { LAS unsigned* misc_ = (LAS unsigned*)(lds_raw) ; (void)misc_; }
#define GRID_SYNC() do { asm volatile("s_waitcnt vmcnt(0) lgkmcnt(0)" ::: "memory"); __syncthreads(); \
        if (threadIdx.x == 0) { __builtin_amdgcn_fence(__ATOMIC_RELEASE, "agent"); asm volatile("s_waitcnt vmcnt(0)" ::: "memory"); } \
        GSYNC(); \
        __builtin_amdgcn_fence(__ATOMIC_ACQUIRE, "agent"); asm volatile("s_waitcnt vmcnt(0)" ::: "memory"); __syncthreads(); } while (0)
    const lptr lds = (lptr)lds_raw;
    const int G = gridDim.x, bx = blockIdx.x, NGW = G * NWAVES;
#define TIDS int tid = threadIdx.x; asm volatile("" : "+v"(tid)); const int lane = tid & 63, w = __builtin_amdgcn_readfirstlane(tid >> 6), gw = bx * NWAVES + w; (void)gw; (void)lane
    unsigned char* ws = args.ws;
    bf16* XB = (bf16*)(ws + WS_XB); float* X = (float*)(ws + WS_X); float* ssq = (float*)(ws + WS_SSQ);
    volatile LAS unsigned* xb_st = (volatile LAS unsigned*)(lds + LDS_BYTES - 256);
    if (threadIdx.x < 2) xb_st[threadIdx.x] = 0u;
    __syncthreads();
    const XcdBarrier xbar = xcd_barrier_post((unsigned*)(ws + WS_CTL) + 4096, xb_st);
#ifndef USE_CG_SYNC
#define GSYNC() xcd_barrier(xbar)
#else
#define GSYNC() grid.sync()
#endif

#ifndef SKIP_P0
    { TIDS; p0_prologue(args, lds, gw, NGW, w, lane); }
#endif
#ifdef PROBE_P0
    { TIDS; p0_prologue(args, lds, gw, NGW, w, lane); }
#endif
    grid.sync();
    xcd_barrier(xbar);
#ifdef PROBE_P1
    { pg8::Gemm g{XB, (const bf16*)(ws + WS_WFIN), MPAD, NIN, DM}; pg8::StaticOrder S; S.init(MPAD, NIN, G, bx); pg8::EpiFoxIn E{ssq, args.in[13], args.in[14], args.in[12], ws, args.out};
      pg8::gemm_phase<pg8::EpiFoxIn, pg8::StaticOrder, PG8_ALIGN, PG8_SP2>(lds, g, S, E); }
    GSYNC();
#endif
#ifndef SKIP_P1
    {
        pg8::Gemm g{XB, (const bf16*)(ws + WS_WFIN), MPAD, NIN, DM}; pg8::StaticOrder S; S.init(MPAD, NIN, G, bx);
        pg8::EpiFoxIn E{ssq, args.in[13], args.in[14], args.in[12], ws, args.out};
        pg8::gemm_phase<pg8::EpiFoxIn, pg8::StaticOrder, PG8_ALIGN, PG8_SP2>(lds, g, S, E);
    }
#endif
    GSYNC();
#ifndef SKIP_P2
    { TIDS; p2_cumsum(args, gw, NGW, lane); }
#endif
    GSYNC();
#ifndef SKIP_P3
    { TIDS; p3_attention(args, lds, tid, w, lane, 0); }
#ifdef PROBE_P3
    GSYNC();
    { TIDS; p3_attention(args, lds, tid, w, lane, 1); }
#endif
#endif
    GSYNC();
#define RESID_GEMM(Ap, Wp, KK, CNTI, FIRSTF, LASTF) do { \
    pg8::StaticOrder S; S.init(MPAD, DM, G, bx); const int full_ = (S.nwg / G) * G, ntail_ = S.nwg - full_; S.lim = full_; \
    { pg8::Gemm g{(Ap), (Wp), MPAD, DM, (KK), (KK)}; pg8::EpiResidT<FIRSTF, LASTF> E{X, XB, ssq, args.in[0], args.in[1], args.in[8]}; pg8::gemm_phase<pg8::EpiResidT<FIRSTF, LASTF>, pg8::StaticOrder, PG8_ALIGN, PG8_SP2>(lds, g, S, E); } \
    if (ntail_ > 0) { const int sl_ = ntail_ * 8 <= G ? 8 : (ntail_ * 4 <= G ? 4 : (ntail_ * 2 <= G ? 2 : 1)); const int ks_ = (KK) / sl_; \
        pg8::TailOrder T{S, full_, ntail_, sl_, bx}; pg8::Gemm g{(Ap) + (bx % sl_) * ks_, (Wp) + (bx % sl_) * ks_, MPAD, DM, ks_, (KK)}; pg8::EpiPartial E{(float*)(ws + WS_P)}; \
        pg8::gemm_phase<pg8::EpiPartial, pg8::TailOrder, false, PG8_SP2>(lds, g, T, E); \
        { int tid_ = threadIdx.x; asm volatile("" : "+v"(tid_)); tail_finish<FIRSTF, LASTF>((const float*)(ws + WS_P), (unsigned*)(ws + WS_CTL) + 256 + (CNTI), S, full_, ntail_, sl_, bx, X, XB, ssq, lds, tid_, args.in[0], args.in[1], args.in[8]); } } } while (0)
#ifdef PROBE_UP
#define PROBE_UP_BODY(WUP) { pg8::Gemm g{XB, (const bf16*)(ws + (WUP)), MPAD, DFF, DM}; pg8::StaticOrder S; S.init(MPAD, DFF, G, bx); pg8::EpiUp E{ssq, (bf16*)(ws + WS_H)}; \
      pg8::gemm_phase<pg8::EpiUp, pg8::StaticOrder, PG8_ALIGN, PG8_SP2>(lds, g, S, E); } GSYNC();
#else
#define PROBE_UP_BODY(WUP)
#endif
#define LAYER_TAIL(AOP, WOUT, WUP, WDN, CNT0, FIRSTL, LASTL) do { \
    RESID_GEMM((const bf16*)(AOP), (const bf16*)(ws + (WOUT)), DM, CNT0, FIRSTL, false); \
    GSYNC(); \
    { pg8::Gemm g{XB, (const bf16*)(ws + (WUP)), MPAD, DFF, DM}; pg8::StaticOrder S; S.init(MPAD, DFF, G, bx); pg8::EpiUp E{ssq, (bf16*)(ws + WS_H)}; \
      pg8::gemm_phase<pg8::EpiUp, pg8::StaticOrder, PG8_ALIGN, PG8_SP2>(lds, g, S, E); } \
    GSYNC(); \
    PROBE_UP_BODY(WUP) \
    RESID_GEMM((const bf16*)(ws + WS_H), (const bf16*)(ws + (WDN)), DFF, CNT0 + 32, false, LASTL); \
    GSYNC(); } while (0)
#ifndef SKIP_L0
    LAYER_TAIL(ws + WS_OB, WS_WFOUT, WS_WUP0, WS_WDN0, 0, true, false);
#endif
#ifndef SKIP_P7
    {
        pg8::Gemm g{XB, (const bf16*)(ws + WS_WMIN), MPAD, NIN, DM}; pg8::StaticOrder S; S.init(MPAD, NIN, G, bx);
        pg8::EpiMlstmIn E{ssq, args.in[17], args.in[18], (bf16*)(ws + WS_MQ), (bf16*)(ws + WS_MK), (bf16*)(ws + WS_MV), (bf16*)(ws + WS_MO), (float*)(ws + WS_GI), (float*)(ws + WS_GF)};
        pg8::gemm_phase<pg8::EpiMlstmIn, pg8::StaticOrder, PG8_ALIGN, PG8_SP2>(lds, g, S, E);
    }
#endif
    GSYNC();
#ifndef SKIP_P8
    { TIDS; mlstm_a_phase(args, bx, G, lds, tid, w, lane); }
    GSYNC();
#ifdef PROBE_MA
    { TIDS; mlstm_a_phase(args, bx, G, lds, tid, w, lane); }
    GSYNC();
#endif
    { TIDS; for (int it = bx; it < 256 + 1024; it += G) mlstm_b_item(args, it, lds, tid, w, lane); }
#ifdef PROBE_MAB
    GSYNC();
    { TIDS; mlstm_a_phase(args, bx, G, lds, tid, w, lane); }
    GSYNC();
    { TIDS; for (int it = bx; it < 256 + 1024; it += G) mlstm_b_item(args, it, lds, tid, w, lane); }
#endif
#endif
    GSYNC();
#ifndef SKIP_P9
    { TIDS; p9_gate(args, gw, NGW, lane); }
#endif
    GSYNC();
#ifndef SKIP_L1
    LAYER_TAIL(ws + WS_MH, WS_WMOUT, WS_WUP1, WS_WDN1, 64, false, true);
#endif
#ifndef SKIP_P13
    { TIDS; p13_final(args, gw, NGW, lane); }
#ifdef PROBE_SYNC
    for (int i_ = 0; i_ < 16; ++i_) grid.sync();
#endif
#endif
}

extern "C" void kernel_launch(void* const* d_in, const int* in_sizes, int n_in, void* d_out, int out_size, void* d_ws, size_t ws_size, hipStream_t stream) {
    static int grid = 0;
    if (grid == 0) {
        if (n_in != 24 || (size_t)out_size != O_END || ws_size < WS_END) { fprintf(stderr, "kernel_launch: unexpected shapes: n_in %d out %d (want %zu) ws %zu (want >= %zu)\n", n_in, out_size, (size_t)O_END, ws_size, (size_t)WS_END); grid = -1; return; }
        int dev = 0, cus = 0, per_cu = 0;
        if (hipGetDevice(&dev) != hipSuccess || hipDeviceGetAttribute(&cus, hipDeviceAttributeMultiprocessorCount, dev) != hipSuccess) { grid = -1; return; }
        if (hipFuncSetAttribute((const void*)fwd_megakernel, hipFuncAttributeMaxDynamicSharedMemorySize, LDS_BYTES) != hipSuccess) { fprintf(stderr, "kernel_launch: hipFuncSetAttribute failed\n"); grid = -1; return; }
        if (hipOccupancyMaxActiveBlocksPerMultiprocessor(&per_cu, (const void*)fwd_megakernel, NTHR, LDS_BYTES) != hipSuccess || per_cu < 1) { fprintf(stderr, "kernel_launch: occupancy query says %d blocks per CU\n", per_cu); grid = -1; return; }
        grid = cus;
    }
    if (grid < 0) return;
    (void)hipMemsetAsync((char*)d_ws + WS_CTL, 0, 65536, stream);
    Args a{};
    for (int i = 0; i < 24; ++i) a.in[i] = (const float*)d_in[i];
    a.out = (float*)d_out; a.ws = (unsigned char*)d_ws;
    void* kargs[] = {&a};
    const hipError_t e = hipLaunchCooperativeKernel((const void*)fwd_megakernel, dim3(grid), dim3(NTHR), kargs, LDS_BYTES, stream);
    if (e != hipSuccess) fprintf(stderr, "kernel_launch: cooperative launch failed: %s (grid %d)\n", hipGetErrorString(e), grid);
}
```

```cpp
#include <hip/hip_runtime.h>
#include <hip/hip_cooperative_groups.h>
#include <cstdio>
#include <cstdint>
namespace cg = cooperative_groups;

constexpr int DM = 1024, TP = 4112, NB = 8, SEQL = 4096, NMETA = 16, DB = 32, DT = 32, PAST = 2048, DFF = 4096;
constexpr int MP = NB * TP;
constexpr int MTOT = MP + DB * DT;
constexpr int MPAD = 34048;
constexpr int NIN = 3328;
constexpr int PPAD = 240;
constexpr int PLEN = 4352;
constexpr int GSLEN = 2112;
constexpr float EPSN = 1e-6f;
constexpr float LOG2E = 1.4426950408889634f;
constexpr float QSCALE = 0.125f * LOG2E;

constexpr int NWAVES = 8, NTHR = 512;
constexpr int LDS_BYTES = 147456;
constexpr size_t MiB = 1u << 20;
constexpr size_t WS_CTL = 0;
constexpr size_t WS_WFIN = 1 * MiB, WS_WFOUT = 8 * MiB, WS_WMIN = 10 * MiB, WS_WMOUT = 17 * MiB, WS_WUP0 = 19 * MiB, WS_WUP1 = 27 * MiB, WS_WDN0 = 35 * MiB, WS_WDN1 = 43 * MiB;
constexpr size_t WS_SSQ = 51 * MiB, WS_G = 54 * MiB, WS_GS = 57 * MiB, WS_GI = 62 * MiB, WS_GF = 63 * MiB, WS_HSSQ = 64 * MiB;
constexpr size_t WS_X = 74 * MiB, WS_XB = 207 * MiB;
constexpr size_t WS_QB = 274 * MiB, WS_KB = 343 * MiB, WS_VB = 411 * MiB, WS_OB = 478 * MiB, WS_H = 274 * MiB;
constexpr size_t WS_MQ = 546 * MiB, WS_MK = 580 * MiB, WS_MV = 614 * MiB, WS_MO = 682 * MiB, WS_MH = 750 * MiB, WS_U = 818 * MiB, WS_RS = 958 * MiB, WS_NU = 959 * MiB, WS_P = 961 * MiB, WS_BBC = 1001 * MiB, WS_PMC = 1002 * MiB, WS_END = 1003 * MiB;
static_assert(WS_H + (size_t)MPAD * DFF * 2 <= WS_MQ && WS_OB + (size_t)MPAD * DM * 2 <= WS_MQ && WS_VB + (size_t)MPAD * DM * 2 <= WS_OB && WS_KB + (size_t)MPAD * DM * 2 <= WS_VB - MiB && WS_QB + (size_t)MPAD * DM * 2 <= WS_KB - MiB, "ws map");
static_assert(WS_G + (size_t)NB * 16 * PLEN * 4 <= WS_GS && WS_GS + (size_t)DB * 16 * GSLEN * 4 <= WS_GI && WS_HSSQ + (size_t)MPAD * 64 * 4 <= WS_X && WS_SSQ + (size_t)MPAD * 64 <= WS_G, "ws map 2");

struct Args { const float* in[24]; float* out; unsigned char* ws; };

constexpr size_t O_YP = 0, O_YS = O_YP + (size_t)NB * SEQL * DM, O_FKP = O_YS + (size_t)DB * DT * DM, O_FVP = O_FKP + (size_t)MP * DM, O_FLP = O_FVP + (size_t)MP * DM,
    O_MCP = O_FLP + (size_t)MP * 16, O_MNP = O_MCP + (size_t)NB * 4 * 256 * 128, O_MMP = O_MNP + (size_t)NB * 4 * 128, O_FKS = O_MMP + (size_t)NB * 4,
    O_FVS = O_FKS + (size_t)DB * DT * DM, O_FLS = O_FVS + (size_t)DB * DT * DM, O_MCS = O_FLS + (size_t)DB * DT * 16, O_MNS = O_MCS + (size_t)DB * 4 * 256 * 128,
    O_MMS = O_MNS + (size_t)DB * 4 * 128, O_END = O_MMS + (size_t)DB * 4;

namespace pg8 {
#define PG8_LAS __attribute__((address_space(3)))
typedef unsigned short bf16_t;
typedef short bf16x8 __attribute__((ext_vector_type(8)));
typedef float f32x4 __attribute__((ext_vector_type(4)));
typedef unsigned u32x4 __attribute__((ext_vector_type(4)));
constexpr int BM = 256, BK = 64, HALF = 128, HTB = HALF * BK * 2  , STAGE_BYTES = 8 * HTB, NXCD = 8, WGM = 8;

__host__ __device__ __forceinline__ int lds_byte(int r, int c) { const int st = (r >> 4) * 2 + (c >> 5), rr = r & 15, cc = c & 31, ob = rr * 64 + cc * 2; return st * 1024 + (ob ^ (((ob >> 9) & 1) << 5)); }
__host__ __device__ __forceinline__ void stage_rc(int b, int& R, int& C) { const int st = b / 1024, sb = b % 1024, swz = sb ^ (((sb >> 9) & 1) << 5); R = (st >> 1) * 16 + swz / 64; C = (st & 1) * 32 + (swz % 64) / 2; }
__host__ __device__ __forceinline__ int perm32(int rho) { const int n = rho >> 4, i = rho & 15; return 8 * (i >> 2) + 4 * n + (i & 3); }

struct Unit { int pm, pn, aux; };
struct Gemm { const bf16_t* A; const bf16_t* Bt; int M, N, K, ld; };

struct StaticOrder {
    int nM, nN, nwg, G, c, lim;
    __host__ __device__ void init(int M, int N, int G_, int c_) { nM = M / BM; nN = N / BM; nwg = nM * nN; G = G_; c = c_; lim = nwg; }
    __host__ __device__ bool next(int i, Unit& u) const { const long L = (long)i * G + c; if (L >= lim) return false; map((int)L, u); return true; }
    __host__ __device__ void map(int L, Unit& u) const {
        int wgid = L; { const int q = nwg / NXCD, r = nwg % NXCD, xcd = wgid % NXCD, off = wgid / NXCD; wgid = (xcd < r ? xcd * (q + 1) : r * (q + 1) + (xcd - r) * q) + off; }
        const int nig = WGM * nN, gid = wgid / nig, fm = gid * WGM, gsz = (nM - fm) < WGM ? (nM - fm) : WGM;
        u.pm = fm + ((wgid % nig) % gsz); u.pn = (wgid % nig) / gsz;
    }
    __device__ __forceinline__ void a_ready(const Unit&) const {}
    __device__ __forceinline__ void done(const Unit&) const {}
};


struct TailOrder {
    StaticOrder base; int first, ntail, slices, c;
    __device__ bool next(int i, Unit& u) const { if (i > 0) return false; const int tu = c / slices; if (tu >= ntail) return false; base.map(first + tu, u); u.aux = c; return true; }
    __device__ __forceinline__ void a_ready(const Unit&) const {}
    __device__ __forceinline__ void done(const Unit&) const {}
};

typedef float f32x2_cv __attribute__((ext_vector_type(2))); typedef __bf16 bf16x2_cv __attribute__((ext_vector_type(2)));
__device__ __forceinline__ unsigned cvt_pk_bf16(float lo, float hi) { const f32x2_cv v = {lo, hi}; const bf16x2_cv b = __builtin_convertvector(v, bf16x2_cv); return __builtin_bit_cast(unsigned, b); }
__device__ __forceinline__ u32x4 pack8(const f32x4 a, const f32x4 b) { u32x4 w; w.x = cvt_pk_bf16(a[0], a[1]); w.y = cvt_pk_bf16(a[2], a[3]); w.z = cvt_pk_bf16(b[0], b[1]); w.w = cvt_pk_bf16(b[2], b[3]); return w; }
__device__ __forceinline__ float row_rstd(const float* ssq, int row, int fq) {
    const f32x4 v = *(const f32x4*)(ssq + (size_t)row * 16 + 4 * fq);
    float s = (v[0] + v[1]) + (v[2] + v[3]);
    s += __shfl_xor(s, 16); s += __shfl_xor(s, 32);
    return __builtin_amdgcn_rsqf(s * (1.0f / 1024.0f) + EPSN);
}
__device__ __forceinline__ float log_sigmoid_f(float x) { return fminf(x, 0.f) - log1pf(__expf(-fabsf(x))); }

struct EpiFoxIn {
    static constexpr bool PERM = true, AFTER_DRAIN = false;
    const float* ssq; const float* gq; const float* gk; const float* bfv;
    unsigned char* ws; float* out;
    __device__ __forceinline__ void operator()(const f32x4 (&acc)[2][2][4][2], const Unit& u, int wr, int wc, int fr, int fq) const {
        const int pn = u.pn, sect = pn >> 2;
        f32x4 gv[2][2];
        if (sect < 2) {
#pragma unroll
            for (int bj = 0; bj < 2; ++bj)
#pragma unroll
                for (int n = 0; n < 2; ++n) { const f32x4 a = *(const f32x4*)(gq + 32 * bj + 8 * fq + 4 * n) * QSCALE, b = *(const f32x4*)(gk + 32 * bj + 8 * fq + 4 * n); gv[bj][n] = sect == 0 ? a : b; } }
        const int cb = (pn & 3) * 256 + wc * 64 + 8 * fq;
        float rsv[2][4];
#pragma unroll
        for (int ai = 0; ai < 2; ++ai)
#pragma unroll
            for (int m = 0; m < 4; ++m) rsv[ai][m] = row_rstd(ssq, u.pm * BM + ai * HALF + wr * 64 + m * 16 + fr, fq);
#pragma unroll
        for (int ai = 0; ai < 2; ++ai)
#pragma unroll
            for (int m = 0; m < 4; ++m) {
                const int row = u.pm * BM + ai * HALF + wr * 64 + m * 16 + fr;
                const float rs = rsv[ai][m];
                f32x4 v[2][2];
#pragma unroll
                for (int bj = 0; bj < 2; ++bj)
#pragma unroll
                    for (int n = 0; n < 2; ++n) v[bj][n] = acc[ai][bj][m][n] * rs;
                if (sect < 2) {
                    float ss = 0.f;
#pragma unroll
                    for (int bj = 0; bj < 2; ++bj)
#pragma unroll
                        for (int n = 0; n < 2; ++n) { const f32x4 x = v[bj][n]; ss += (x[0] * x[0] + x[1] * x[1]) + (x[2] * x[2] + x[3] * x[3]); }
                    ss += __shfl_xor(ss, 16); ss += __shfl_xor(ss, 32);
                    const float hr = __builtin_amdgcn_rsqf(ss * (1.0f / 64.0f) + EPSN);
#pragma unroll
                    for (int bj = 0; bj < 2; ++bj)
#pragma unroll
                        for (int n = 0; n < 2; ++n) v[bj][n] = v[bj][n] * hr * gv[bj][n];
                }
                const bool real = row < MTOT; const int grp = row < MP ? 0 : 1; const size_t orow = grp == 0 ? (size_t)row : (size_t)(row - MP);
                if (sect == 0) {
#pragma unroll
                    for (int bj = 0; bj < 2; ++bj) __builtin_nontemporal_store(pack8(v[bj][0], v[bj][1]), (u32x4*)((bf16_t*)(ws + WS_QB) + (size_t)row * DM + cb + 32 * bj));
                } else if (sect < 3) {
                    bf16_t* B16 = (bf16_t*)(ws + (sect == 1 ? WS_KB : WS_VB)); float* of = out + (sect == 1 ? (grp == 0 ? O_FKP : O_FKS) : (grp == 0 ? O_FVP : O_FVS));
#pragma unroll
                    for (int bj = 0; bj < 2; ++bj) __builtin_nontemporal_store(pack8(v[bj][0], v[bj][1]), (u32x4*)(B16 + (size_t)row * DM + cb + 32 * bj));
                    (void)of; (void)real;
                } else if (pn == 12 && wc == 0 && fq < 2 && real) {
#pragma unroll
                    for (int n = 0; n < 2; ++n) { const int h0 = 8 * fq + 4 * n; const f32x4 bb = *(const f32x4*)(bfv + h0); f32x4 o;
#pragma unroll
                        for (int j = 0; j < 4; ++j) o[j] = log_sigmoid_f(v[0][n][j] + bb[j]);
                        *(f32x4*)(out + (grp == 0 ? O_FLP : O_FLS) + orow * 16 + h0) = o; }
                }
            }
    }
};

__device__ __forceinline__ void first_resid(const float* xp, const float* xs, const float* meta, int row, int col, f32x4& x0, f32x4& x1) {
    x0 = (f32x4){0.f, 0.f, 0.f, 0.f}; x1 = x0;
    if (row < MP) { const int b = row / TP, t = row - b * TP;
        if (t < NMETA) { const float* p = meta + (size_t)t * DM + col; x0 = *(const f32x4*)p; x1 = *(const f32x4*)(p + 4); }
        else { const float* p = xp + ((size_t)b * SEQL + (t - NMETA)) * DM + col; x0 = *(const f32x4*)p; x1 = *(const f32x4*)(p + 4); } }
    else if (row < MTOT) { const float* p = xs + (size_t)(row - MP) * DM + col; x0 = *(const f32x4*)p; x1 = *(const f32x4*)(p + 4); }
}
template <bool FIRST, bool LAST = false> struct EpiResidT {
    static constexpr bool PERM = true, AFTER_DRAIN = false;
    float* X; bf16_t* XB; float* ssq; const float* xp; const float* xs; const float* meta;
    __device__ __forceinline__ void operator()(const f32x4 (&acc)[2][2][4][2], const Unit& u, int wr, int wc, int fr, int fq) const {
#pragma unroll
        for (int ai = 0; ai < 2; ++ai)
#pragma unroll
            for (int m = 0; m < 4; ++m) {
                const int row = u.pm * BM + ai * HALF + wr * 64 + m * 16 + fr; float ss = 0.f;
#pragma unroll
                for (int bj = 0; bj < 2; ++bj) { const size_t off = (size_t)row * DM + u.pn * BM + bj * HALF + wc * 32 + 8 * fq;
                    f32x4 x0, x1;
                    if (FIRST) first_resid(xp, xs, meta, row, u.pn * BM + bj * HALF + wc * 32 + 8 * fq, x0, x1);
                    else { const u32x4 r = *(const u32x4*)(XB + off);
                        x0 = (f32x4){__builtin_bit_cast(float, r.x << 16), __builtin_bit_cast(float, r.x & 0xffff0000u), __builtin_bit_cast(float, r.y << 16), __builtin_bit_cast(float, r.y & 0xffff0000u)};
                        x1 = (f32x4){__builtin_bit_cast(float, r.z << 16), __builtin_bit_cast(float, r.z & 0xffff0000u), __builtin_bit_cast(float, r.w << 16), __builtin_bit_cast(float, r.w & 0xffff0000u)}; }
                    x0 = x0 + acc[ai][bj][m][0]; x1 = x1 + acc[ai][bj][m][1];
                    *(u32x4*)(XB + off) = pack8(x0, x1);
                    ss += (x0[0] * x0[0] + x0[1] * x0[1]) + (x0[2] * x0[2] + x0[3] * x0[3]) + (x1[0] * x1[0] + x1[1] * x1[1]) + (x1[2] * x1[2] + x1[3] * x1[3]); }
                ss += __shfl_xor(ss, 16); ss += __shfl_xor(ss, 32);
                if (fq == 0) ssq[(size_t)row * 16 + u.pn * 4 + wc] = ss;
                if (m & 1) asm volatile("" ::: "memory");
            }
    }
};

struct EpiUp {
    static constexpr bool PERM = true, AFTER_DRAIN = false;
    const float* ssq; bf16_t* H;
    __device__ __forceinline__ void operator()(const f32x4 (&acc)[2][2][4][2], const Unit& u, int wr, int wc, int fr, int fq) const {
#pragma unroll
        for (int ai = 0; ai < 2; ++ai)
#pragma unroll
            for (int m = 0; m < 4; ++m) {
                const int row = u.pm * BM + ai * HALF + wr * 64 + m * 16 + fr; const float rs = row_rstd(ssq, row, fq);
#pragma unroll
                for (int bj = 0; bj < 2; ++bj) { f32x4 a = acc[ai][bj][m][0] * rs, b = acc[ai][bj][m][1] * rs;
#pragma unroll
                    for (int j = 0; j < 4; ++j) { a[j] = fmaxf(a[j], 0.f); a[j] *= a[j]; b[j] = fmaxf(b[j], 0.f); b[j] *= b[j]; }
                    __builtin_nontemporal_store(pack8(a, b), (u32x4*)(H + (size_t)row * DFF + u.pn * BM + bj * HALF + wc * 32 + 8 * fq)); }
            }
    }
};

struct EpiMlstmIn {
    static constexpr bool PERM = true, AFTER_DRAIN = false;
    const float* ssq; const float* bi; const float* bfv;
    bf16_t* MQ; bf16_t* MK; bf16_t* MV; bf16_t* MO; float* GI; float* GF;
    __device__ __forceinline__ void operator()(const f32x4 (&acc)[2][2][4][2], const Unit& u, int wr, int wc, int fr, int fq) const {
        const int pn = u.pn;
#pragma unroll
        for (int ai = 0; ai < 2; ++ai)
#pragma unroll
            for (int m = 0; m < 4; ++m) {
                const int row = u.pm * BM + ai * HALF + wr * 64 + m * 16 + fr; const float rs = row_rstd(ssq, row, fq);
                if (pn < 12) {
#pragma unroll
                    for (int bj = 0; bj < 2; ++bj) { f32x4 a = acc[ai][bj][m][0] * rs, b = acc[ai][bj][m][1] * rs; const int c = pn * BM + bj * HALF + wc * 32 + 8 * fq;
                        if (pn < 2) __builtin_nontemporal_store(pack8(a, b), (u32x4*)(MQ + (size_t)row * 512 + c));
                        else if (pn < 4) { a = a * 0.08838834764831845f; b = b * 0.08838834764831845f; __builtin_nontemporal_store(pack8(a, b), (u32x4*)(MK + (size_t)row * 512 + (c - 512))); }
                        else if (pn < 8) __builtin_nontemporal_store(pack8(a, b), (u32x4*)(MV + (size_t)row * DM + (c - 1024)));
                        else {
#pragma unroll
                            for (int j = 0; j < 4; ++j) { a[j] = 1.0f / (1.0f + __expf(-a[j])); b[j] = 1.0f / (1.0f + __expf(-b[j])); }
                            __builtin_nontemporal_store(pack8(a, b), (u32x4*)(MO + (size_t)row * DM + (c - 2048))); } }
                } else if (wc == 0 && fq == 0) {
                    const f32x4 a = acc[ai][0][m][0] * rs, b = acc[ai][0][m][1] * rs; const f32x4 vbi = *(const f32x4*)bi, vbf = *(const f32x4*)bfv; f32x4 oi, of;
#pragma unroll
                    for (int j = 0; j < 4; ++j) { oi[j] = a[j] + vbi[j]; of[j] = log_sigmoid_f(b[j] + vbf[j]); }
                    *(f32x4*)(GI + (size_t)row * 4) = oi; *(f32x4*)(GF + (size_t)row * 4) = of;
                }
            }
    }
};


struct EpiPartial {
    static constexpr bool PERM = true, AFTER_DRAIN = false;
    float* P;
    __device__ __forceinline__ void operator()(const f32x4 (&acc)[2][2][4][2], const Unit& u, int wr, int wc, int fr, int fq) const {
#pragma unroll
        for (int ai = 0; ai < 2; ++ai)
#pragma unroll
            for (int m = 0; m < 4; ++m)
#pragma unroll
                for (int bj = 0; bj < 2; ++bj) { float* p = P + (size_t)u.aux * 65536 + (size_t)(ai * HALF + wr * 64 + m * 16 + fr) * 256 + bj * HALF + wc * 32 + 8 * fq;
                    *(f32x4*)p = acc[ai][bj][m][0]; *(f32x4*)(p + 4) = acc[ai][bj][m][1]; }
    }
};
template <class Epi, class Sched, bool ALIGN_EPI = false, bool SP2 = false>
__device__ __forceinline__ void gemm_phase(PG8_LAS unsigned char* lds, const Gemm g, const Sched& S, const Epi& E) {
    int tid_o = threadIdx.x; asm volatile("" : "+v"(tid_o));
    const int tid = tid_o, wid = __builtin_amdgcn_readfirstlane(tid >> 6), lane = tid & 63, wr = wid >> 2, wc = wid & 3, fr = lane & 15, fq = lane >> 4;
    const int K = g.K, nt = K / BK, ld = g.ld ? g.ld : g.K;
    unsigned voffA[2], voffB[2];
#pragma unroll
    for (int i = 0; i < 2; ++i) { int R, C; stage_rc(tid * 16 + i * 8192, R, C); const int Rb = Epi::PERM ? ((R & ~31) + perm32(R & 31)) : R;
        voffA[i] = (unsigned)(R * ld + C) * 2u; voffB[i] = (unsigned)(Rb * ld + C) * 2u; }
    const size_t kstep = (size_t)(BK * 2);
    const size_t hstep = (size_t)HALF * ld * 2;
    const size_t tstep = 2 * hstep;
    const unsigned ldsw = (unsigned)wid * 1024u;
    const int aoff = lds_byte(wr * 64 + fr, fq * 8), boff = lds_byte(wc * 32 + fr, fq * 8);
#define PG8_SA(b, h) (((b) * 2 + (h)) * HTB)
#define PG8_SB(b, h) ((4 + (b) * 2 + (h)) * HTB)
#define PG8_STAGE(bufoff, gbase, voff) do { _Pragma("unroll") for (int _i = 0; _i < 2; ++_i) \
        __builtin_amdgcn_global_load_lds((const unsigned*)((const char*)(gbase) + (voff)[_i]), (PG8_LAS unsigned*)(lds + (bufoff) + ldsw + _i * 8192), 16, 0, 0); } while (0)
#define PG8_LDA(dst, b, h) do { _Pragma("unroll") for (int m = 0; m < 4; ++m) _Pragma("unroll") for (int k = 0; k < 2; ++k) dst[m][k] = *(const PG8_LAS bf16x8*)(lds + PG8_SA(b, h) + aoff + m * 2048 + k * 1024); } while (0)
#define PG8_LDB(dst, b, h) do { _Pragma("unroll") for (int n = 0; n < 2; ++n) _Pragma("unroll") for (int k = 0; k < 2; ++k) dst[n][k] = *(const PG8_LAS bf16x8*)(lds + PG8_SB(b, h) + boff + n * 2048 + k * 1024); } while (0)
#define PG8_MMA(ai, bj, At, Bt) do { __builtin_amdgcn_s_setprio(1); _Pragma("unroll") for (int m = 0; m < 4; ++m) _Pragma("unroll") for (int n = 0; n < 2; ++n) _Pragma("unroll") for (int k = 0; k < 2; ++k) \
        acc[ai][bj][m][n] = __builtin_amdgcn_mfma_f32_16x16x32_bf16(Bt[n][k], At[m][k], acc[ai][bj][m][n], 0, 0, 0); __builtin_amdgcn_s_setprio(0); } while (0)
#define PG8_WAIT_V(n) asm volatile("s_waitcnt vmcnt(" #n ")" ::: "memory")
#define PG8_WAIT_L(n) asm volatile("s_waitcnt lgkmcnt(" #n ")" ::: "memory")
#define PG8_BAR __builtin_amdgcn_s_barrier()
#define PG8_SCHED __builtin_amdgcn_sched_barrier(0)
    Unit cur, nxt; int ui = 0;
    if (!S.next(0, cur)) return;
    f32x4 acc[2][2][4][2];
#pragma unroll
    for (int a = 0; a < 2; ++a)
#pragma unroll
        for (int b = 0; b < 2; ++b)
#pragma unroll
            for (int m = 0; m < 4; ++m)
#pragma unroll
                for (int n = 0; n < 2; ++n) acc[a][b][m][n] = (f32x4){0.f, 0.f, 0.f, 0.f};
    bf16x8 At[4][2], B0[2][2], B1[2][2];
    const char* cA = (const char*)g.A + (size_t)cur.pm * tstep; const char* cB = (const char*)g.Bt + (size_t)cur.pn * tstep;
    S.a_ready(cur);
    if constexpr (SP2) {
        PG8_STAGE(PG8_SB(0, 0), cB, voffB); PG8_STAGE(PG8_SB(0, 1), cB + hstep, voffB); PG8_STAGE(PG8_SA(0, 0), cA, voffA); PG8_STAGE(PG8_SA(0, 1), cA + hstep, voffA);
        if (wr == 1) PG8_BAR;
        PG8_WAIT_V(2); PG8_BAR;
        PG8_STAGE(PG8_SB(1, 0), cB + kstep, voffB); PG8_STAGE(PG8_SA(1, 0), cA + kstep, voffA); PG8_STAGE(PG8_SB(1, 1), cB + hstep + kstep, voffB);
        PG8_WAIT_V(6); PG8_BAR;
    } else {
        PG8_STAGE(PG8_SB(0, 0), cB, voffB); PG8_STAGE(PG8_SA(0, 0), cA, voffA); PG8_STAGE(PG8_SB(0, 1), cB + hstep, voffB); PG8_STAGE(PG8_SA(0, 1), cA + hstep, voffA);
        if (wr == 1) PG8_BAR;
        PG8_WAIT_V(4); PG8_BAR;
        PG8_STAGE(PG8_SB(1, 0), cB + kstep, voffB); PG8_STAGE(PG8_SA(1, 0), cA + kstep, voffA); PG8_STAGE(PG8_SB(1, 1), cB + hstep + kstep, voffB);
        PG8_WAIT_V(6); PG8_BAR;
    }
    for (;;) {
        const bool has_next = S.next(ui + 1, nxt);
        const char* nA = has_next ? (const char*)g.A + (size_t)nxt.pm * tstep : cA; const char* nB = has_next ? (const char*)g.Bt + (size_t)nxt.pn * tstep : cB;
        for (int t = 0; t < nt; t += 2) {
            const bool last = (t == nt - 2);
            const char* a1 = cA + (size_t)(t + 1) * kstep;
            const char* a2 = last ? nA : cA + (size_t)(t + 2) * kstep; const char* b2 = last ? nB : cB + (size_t)(t + 2) * kstep;
            const char* a3 = a2 + kstep; const char* b3 = b2 + kstep;
            if (last && has_next) S.a_ready(nxt);
            if constexpr (SP2) {
            PG8_LDB(B0, 0, 0); PG8_LDB(B1, 0, 1); PG8_SCHED; PG8_LDA(At, 0, 0); PG8_STAGE(PG8_SA(1, 1), a1 + hstep, voffA);
            PG8_WAIT_V(8); PG8_WAIT_L(0); PG8_BAR; PG8_MMA(0, 0, At, B0); PG8_MMA(0, 1, At, B1); PG8_BAR; PG8_SCHED;
            PG8_LDA(At, 0, 1); PG8_STAGE(PG8_SB(0, 0), b2, voffB); PG8_STAGE(PG8_SB(0, 1), b2 + hstep, voffB); PG8_STAGE(PG8_SA(0, 0), a2, voffA);
            PG8_WAIT_V(8); PG8_WAIT_L(0); PG8_BAR; PG8_MMA(1, 0, At, B0); PG8_MMA(1, 1, At, B1); PG8_BAR; PG8_SCHED;
            PG8_LDB(B0, 1, 0); PG8_LDB(B1, 1, 1); PG8_SCHED; PG8_LDA(At, 1, 0); PG8_STAGE(PG8_SA(0, 1), a2 + hstep, voffA);
            PG8_WAIT_V(8); PG8_WAIT_L(0); PG8_BAR; PG8_MMA(0, 0, At, B0); PG8_MMA(0, 1, At, B1); PG8_BAR; PG8_SCHED;
            PG8_LDA(At, 1, 1); PG8_STAGE(PG8_SB(1, 0), b3, voffB); PG8_STAGE(PG8_SB(1, 1), b3 + hstep, voffB); PG8_STAGE(PG8_SA(1, 0), a3, voffA);
            PG8_WAIT_V(8); PG8_WAIT_L(0); PG8_BAR; PG8_MMA(1, 0, At, B0); PG8_MMA(1, 1, At, B1); PG8_BAR; PG8_SCHED;
            } else {
            PG8_LDB(B0, 0, 0); PG8_SCHED; PG8_LDA(At, 0, 0); PG8_STAGE(PG8_SA(1, 1), a1 + hstep, voffA);
            PG8_WAIT_L(8); PG8_BAR; PG8_WAIT_L(0); PG8_MMA(0, 0, At, B0); PG8_BAR; PG8_SCHED;
            PG8_LDB(B1, 0, 1); PG8_STAGE(PG8_SB(0, 0), b2, voffB);
            PG8_BAR; PG8_WAIT_L(0); PG8_MMA(0, 1, At, B1); PG8_BAR;
            PG8_LDA(At, 0, 1); PG8_STAGE(PG8_SA(0, 0), a2, voffA);
            PG8_BAR; PG8_WAIT_L(0); PG8_MMA(1, 0, At, B0); PG8_BAR; PG8_SCHED;
            PG8_STAGE(PG8_SB(0, 1), b2 + hstep, voffB);
            PG8_WAIT_V(6); PG8_BAR; PG8_MMA(1, 1, At, B1); PG8_BAR;
            PG8_LDB(B0, 1, 0); PG8_SCHED; PG8_LDA(At, 1, 0); PG8_STAGE(PG8_SA(0, 1), a2 + hstep, voffA);
            PG8_WAIT_L(8); PG8_BAR; PG8_WAIT_L(0); PG8_MMA(0, 0, At, B0); PG8_BAR; PG8_SCHED;
            PG8_LDB(B1, 1, 1); PG8_STAGE(PG8_SB(1, 0), b3, voffB);
            PG8_BAR; PG8_WAIT_L(0); PG8_MMA(0, 1, At, B1); PG8_BAR;
            PG8_LDA(At, 1, 1); PG8_STAGE(PG8_SA(1, 0), a3, voffA);
            PG8_BAR; PG8_WAIT_L(0); PG8_MMA(1, 0, At, B0); PG8_BAR; PG8_SCHED;
            PG8_STAGE(PG8_SB(1, 1), b3 + hstep, voffB);
            PG8_WAIT_V(6); PG8_BAR; PG8_MMA(1, 1, At, B1); PG8_BAR;
            }
        }
        if constexpr (ALIGN_EPI) { if (wr == 0) PG8_BAR; }
        if constexpr (!Epi::AFTER_DRAIN) { E(acc, cur, wr, wc, fr, fq); S.done(cur); }
        if (!has_next) break;
#pragma unroll
        for (int a = 0; a < 2; ++a)
#pragma unroll
            for (int b = 0; b < 2; ++b)
#pragma unroll
                for (int m = 0; m < 4; ++m)
#pragma unroll
                    for (int n = 0; n < 2; ++n) acc[a][b][m][n] = (f32x4){0.f, 0.f, 0.f, 0.f};
        cur = nxt; cA = nA; cB = nB; ++ui;
        if constexpr (ALIGN_EPI) { if (wr == 1) PG8_BAR; }
    }
    PG8_WAIT_V(0);
    if constexpr (!ALIGN_EPI) { if (wr == 0) PG8_BAR; }
    PG8_BAR;
    if constexpr (Epi::AFTER_DRAIN) { E.fused(acc, cur, wr, wc, fr, fq, lds, wid, lane); S.done(cur); }
#undef PG8_SA
#undef PG8_SB
#undef PG8_STAGE
#undef PG8_LDA
#undef PG8_LDB
#undef PG8_MMA
#undef PG8_WAIT_V
#undef PG8_WAIT_L
#undef PG8_BAR
#undef PG8_SCHED
}
}

#ifndef PG8_SP2
#define PG8_SP2 true
#endif
#ifndef PG8_ALIGN
#define PG8_ALIGN true
#endif

#define LAS __attribute__((address_space(3)))
typedef unsigned short bf16;
typedef unsigned u32x4 __attribute__((ext_vector_type(4)));
typedef unsigned u32x2 __attribute__((ext_vector_type(2)));
typedef float f32x4 __attribute__((ext_vector_type(4)));
typedef float f32x16 __attribute__((ext_vector_type(16)));
typedef short bf16x8 __attribute__((ext_vector_type(8)));
typedef short v4i16_t __attribute__((ext_vector_type(4)));
typedef LAS unsigned char* lptr;
typedef const LAS unsigned char* clptr;

__device__ __forceinline__ unsigned f2bf(float f) { unsigned u = __builtin_bit_cast(unsigned, f); return (u + 0x7fffu + ((u >> 16) & 1u)) >> 16; }
__device__ __forceinline__ unsigned pk2(float lo, float hi) { return pg8::cvt_pk_bf16(lo, hi); }
__device__ __forceinline__ float bf2f(unsigned short b) { return __builtin_bit_cast(float, (unsigned)b << 16); }
__device__ __forceinline__ float wave_sum(float v) {
#pragma unroll
    for (int o = 1; o < 64; o <<= 1) v += __shfl_xor(v, o);
    return v;
}
#define LDS_WAIT() asm volatile("s_waitcnt lgkmcnt(0)" ::: "memory")
#define LDS_BARRIER() asm volatile("s_waitcnt lgkmcnt(0)\n\ts_barrier" ::: "memory")

__device__ __forceinline__ void p0_transpose_item(const float* W, int K, int N, bf16* WT, const float* g, bool foxperm, LAS float* scr, int item, int nblk, int lane) {
    const int kb = item / nblk, nb = item % nblk, k0 = 64 * kb, n0 = 32 * nb;
#pragma unroll 8
    for (int i = 0; i < 32; ++i) { const int kk = 2 * i + (lane >> 5); const int n = n0 + (lane & 31); float v = n < N ? W[(size_t)(k0 + kk) * N + n] : 0.f; if (g) v *= g[k0 + kk]; scr[kk * 33 + (lane & 31)] = v; }
    LDS_WAIT(); asm volatile("" ::: "memory");
    const int c = lane & 7;
    int prow0 = n0;
    if (foxperm) { const int l = n0 & 255; prow0 = (n0 & ~255) + 128 * ((l >> 5) & 1) + 32 * ((l >> 6) & 3); }
#pragma unroll
    for (int j = 0; j < 4; ++j) { const int n = (lane >> 3) + 8 * j; const LAS float* s = scr + (8 * c) * 33 + n;
        u32x4 o; o.x = pk2(s[0 * 33], s[1 * 33]); o.y = pk2(s[2 * 33], s[3 * 33]); o.z = pk2(s[4 * 33], s[5 * 33]); o.w = pk2(s[6 * 33], s[7 * 33]);
        *(u32x4*)(WT + (size_t)(prow0 + n) * K + k0 + 8 * c) = o; }
    LDS_WAIT(); asm volatile("" ::: "memory");
}

__device__ __forceinline__ void p0_prologue(const Args& A, lptr lds, int gw, int NGW, int wave, int lane) {
    unsigned char* ws = A.ws;
    LAS float* scr = (LAS float*)(lds + wave * 16384);
    int base = 0;
#define WJOB(Wp, K_, N_, NP_, dst_, g_, perm_) do { const int nblk = (NP_) / 32, nitems = ((K_) / 64) * nblk; int first = (gw - base) % NGW; if (first < 0) first += NGW; \
        for (int it = first; it < nitems; it += NGW) p0_transpose_item((Wp), (K_), (N_), (bf16*)(ws + (dst_)), (g_), (perm_), scr, it, nblk, lane); base = (base + nitems) % NGW; } while (0)
    WJOB(A.in[11], DM, 3088, NIN, WS_WFIN, A.in[9], true);
    WJOB(A.in[15], DM, DM, DM, WS_WFOUT, (const float*)nullptr, false);
    WJOB(A.in[16], DM, 3080, NIN, WS_WMIN, A.in[9] + DM, false);
    WJOB(A.in[20], DM, DM, DM, WS_WMOUT, A.in[19], false);
    WJOB(A.in[21], DM, DFF, DFF, WS_WUP0, A.in[10], false);
    WJOB(A.in[21] + (size_t)DM * DFF, DM, DFF, DFF, WS_WUP1, A.in[10] + DM, false);
    WJOB(A.in[22], DFF, DM, DM, WS_WDN0, (const float*)nullptr, false);
    WJOB(A.in[22] + (size_t)DFF * DM, DFF, DM, DM, WS_WDN1, (const float*)nullptr, false);
#undef WJOB
    bf16* XB = (bf16*)(ws + WS_XB); float* ssq = (float*)(ws + WS_SSQ);
    for (int row0 = gw; row0 < MPAD; row0 += 4 * NGW) {
        f32x4 v[4][4];
#pragma unroll
        for (int u = 0; u < 4; ++u) { const int row = row0 + u * NGW; const float* src = nullptr;
            if (row < MP) { const int b = row / TP, t = row - b * TP; src = t < NMETA ? A.in[8] + (size_t)t * DM : A.in[0] + ((size_t)b * SEQL + (t - NMETA)) * DM; }
            else if (row < MTOT) src = A.in[1] + (size_t)(row - MP) * DM;
#pragma unroll
            for (int j = 0; j < 4; ++j) v[u][j] = src ? *(const f32x4*)(src + 256 * j + 4 * lane) : (f32x4){0.f, 0.f, 0.f, 0.f}; }
#pragma unroll
        for (int u = 0; u < 4; ++u) { const int row = row0 + u * NGW; if (row >= MPAD) break;
            float s = 0.f;
#pragma unroll
            for (int j = 0; j < 4; ++j) { const f32x4 x = v[u][j];
                u32x2 o;
                o.x = pk2(x[0], x[1]); o.y = pk2(x[2], x[3]); *(u32x2*)(XB + (size_t)row * DM + 256 * j + 4 * lane) = o;
                s += (x[0] * x[0] + x[1] * x[1]) + (x[2] * x[2] + x[3] * x[3]); }
            s = wave_sum(s);
            if (lane < 16) ssq[(size_t)row * 16 + lane] = lane == 0 ? s : 0.f; }
    }
    { const u32x4 z = {0u, 0u, 0u, 0u}; const int nchunk = PPAD * DM * 2 / 16;
        for (int i = gw * 64 + lane; i < nchunk; i += NGW * 64) { *(u32x4*)(ws + WS_KB - (size_t)PPAD * DM * 2 + (size_t)i * 16) = z; *(u32x4*)(ws + WS_VB - (size_t)PPAD * DM * 2 + (size_t)i * 16) = z; }
        const int nch2 = (MPAD - MTOT) * DM * 2 / 16;
        for (int i = gw * 64 + lane; i < nch2; i += NGW * 64) { *(u32x4*)(ws + WS_OB + (size_t)MTOT * DM * 2 + (size_t)i * 16) = z; *(u32x4*)(ws + WS_MH + (size_t)MTOT * DM * 2 + (size_t)i * 16) = z; } }
}

__device__ __forceinline__ float wave_scan_add(float v, int lane) {
#pragma unroll
    for (int o = 1; o < 64; o <<= 1) { const float t = __shfl_up(v, o); if (lane >= o) v += t; }
    return v;
}
__device__ __forceinline__ float wave_scan_max(float v, int lane) {
#pragma unroll
    for (int o = 1; o < 64; o <<= 1) { const float t = __shfl_up(v, o); if (lane >= o) v = fmaxf(v, t); }
    return v;
}
__device__ __forceinline__ void p2_cumsum(const Args& A, int gw, int NGW, int lane) {
    float* G = (float*)(A.ws + WS_G); float* GS = (float*)(A.ws + WS_GS);
    const float* lp = A.out + O_FLP; const float* lsn = A.out + O_FLS; const float* lc = A.in[4];
    for (int it = gw; it < NB * 16 + DB * 16; it += NGW) {
        if (it < NB * 16) { const int b = it >> 4, h = it & 15; float* g = G + (size_t)it * PLEN;
            for (int i = lane; i < PPAD; i += 64) g[i] = 0.f;
            float carry = 0.f;
#pragma unroll 1
            for (int c0 = 0; c0 < 65; c0 += 13) { float v[13];
#pragma unroll
                for (int c = 0; c < 13; ++c) { const int t = 64 * (c0 + c) + lane; v[c] = t < TP ? lp[((size_t)b * TP + t) * 16 + h] : 0.f; }
#pragma unroll
                for (int c = 0; c < 13; ++c) { const int t = 64 * (c0 + c) + lane; const float x = wave_scan_add(v[c], lane) + carry; if (t < TP) g[PPAD + t] = -LOG2E * x; carry = __shfl(x, 63); } }
        } else { const int i2 = it - NB * 16, b = i2 >> 4, h = i2 & 15; float* g = GS + (size_t)i2 * GSLEN;
            float carry = 0.f;
#pragma unroll 1
            for (int c0 = 0; c0 < 33; c0 += 11) { float v[11];
#pragma unroll
                for (int c = 0; c < 11; ++c) { const int s = 64 * (c0 + c) + lane; v[c] = 0.f; if (s < PAST) v[c] = lc[((size_t)b * PAST + s) * 16 + h]; else if (s < PAST + DT) v[c] = lsn[((size_t)b * DT + (s - PAST)) * 16 + h]; }
#pragma unroll
                for (int c = 0; c < 11; ++c) { const int s = 64 * (c0 + c) + lane; const float x = wave_scan_add(v[c], lane) + carry; g[s] = s < PAST + DT ? -LOG2E * x : 0.f; carry = __shfl(x, 63); } }
        }
    }
}

__device__ __forceinline__ int crow(int r, int hi) { return (r & 3) + 8 * (r >> 2) + 4 * hi; }
__device__ __forceinline__ v4i16_t vtr(clptr p) { return __builtin_amdgcn_ds_read_tr16_b64_v4i16((LAS v4i16_t*)p); }
constexpr int AT_KSTR = 144, AT_V = 9216, AT_B = 17408, AT_BUF = 17664;

template <bool MASK>
__device__ __forceinline__ void attn_tile(clptr Kt, clptr Vt, clptr Bt, const bf16x8 (&qr)[4], f32x16& o0, f32x16& o1, float& m, float& l, int qpos, int kpos0, int kmin, int lane) {
    const int r32 = lane & 31, hi = lane >> 5;
    f32x16 p0, p1;
#pragma unroll
    for (int g = 0; g < 4; ++g) { const f32x4 b0 = *(const LAS f32x4*)(Bt + (8 * g + 4 * hi) * 4), b1 = *(const LAS f32x4*)(Bt + (32 + 8 * g + 4 * hi) * 4);
#pragma unroll
        for (int i = 0; i < 4; ++i) { p0[4 * g + i] = b0[i] - m; p1[4 * g + i] = b1[i] - m; } }
#pragma unroll
    for (int d0 = 0; d0 < 4; ++d0) {
        const bf16x8 a0 = *(const LAS bf16x8*)(Kt + r32 * AT_KSTR + d0 * 32 + hi * 16);
        const bf16x8 a1 = *(const LAS bf16x8*)(Kt + (32 + r32) * AT_KSTR + d0 * 32 + hi * 16);
        p0 = __builtin_amdgcn_mfma_f32_32x32x16_bf16(a0, qr[d0], p0, 0, 0, 0);
        p1 = __builtin_amdgcn_mfma_f32_32x32x16_bf16(a1, qr[d0], p1, 0, 0, 0);
    }
    if (MASK) {
#pragma unroll
        for (int r = 0; r < 16; ++r) { const int kp = kpos0 + crow(r, hi); if (kp > qpos || kp < kmin) p0[r] = -INFINITY; if (kp + 32 > qpos || kp + 32 < kmin) p1[r] = -INFINITY; }
    }
    float mx = fmaxf(p0[0], p1[0]);
#pragma unroll
    for (int r = 1; r < 16; ++r) mx = fmaxf(mx, fmaxf(p0[r], p1[r]));
    { const auto rr = __builtin_amdgcn_permlane32_swap(__float_as_uint(mx), __float_as_uint(mx), false, false); mx = fmaxf(__uint_as_float(rr[0]), __uint_as_float(rr[1])); }
    if (__any(mx > 0.f)) {
        const float dl = fmaxf(mx, 0.f), alpha = __builtin_amdgcn_exp2f(-dl); m += dl; l *= alpha;
#pragma unroll
        for (int r = 0; r < 16; ++r) { o0[r] *= alpha; o1[r] *= alpha; p0[r] -= dl; p1[r] -= dl; } }
    float ls = 0.f;
#pragma unroll
    for (int r = 0; r < 16; ++r) { p0[r] = __builtin_amdgcn_exp2f(p0[r]); p1[r] = __builtin_amdgcn_exp2f(p1[r]); ls += p0[r] + p1[r]; }
    l += ls;
    u32x4 pw[4];
#pragma unroll
    for (int i = 0; i < 4; ++i) { pw[0][i] = pk2(p0[2 * i], p0[2 * i + 1]); pw[1][i] = pk2(p0[8 + 2 * i], p0[9 + 2 * i]); pw[2][i] = pk2(p1[2 * i], p1[2 * i + 1]); pw[3][i] = pk2(p1[8 + 2 * i], p1[9 + 2 * i]); }
    const clptr vb = Vt + ((lane >> 5) * 4 + ((lane & 15) >> 2)) * 64 + (((lane >> 4) & 1) * 16 + (lane & 3) * 4) * 2;
#pragma unroll
    for (int ks = 0; ks < 4; ++ks) {
        const v4i16_t l0 = vtr(vb + ks * 1024), h0 = vtr(vb + ks * 1024 + 512), l1 = vtr(vb + 4096 + ks * 1024), h1 = vtr(vb + 4096 + ks * 1024 + 512);
        const bf16x8 v0 = {l0[0], l0[1], l0[2], l0[3], h0[0], h0[1], h0[2], h0[3]}, v1 = {l1[0], l1[1], l1[2], l1[3], h1[0], h1[1], h1[2], h1[3]};
        const bf16x8 pb = __builtin_bit_cast(bf16x8, pw[ks]);
        o0 = __builtin_amdgcn_mfma_f32_32x32x16_bf16(v0, pb, o0, 0, 0, 0);
        o1 = __builtin_amdgcn_mfma_f32_32x32x16_bf16(v1, pb, o1, 0, 0, 0);
    }
}

__device__ __forceinline__ void kv_out_rows(const bf16* KB, const bf16* VB, float* outK, float* outV, size_t wsrow0, size_t outrow0, int nrows, int h, int tid) {
    const int ch = tid & 7, tsel = (tid >> 3) & 1, r0 = tid >> 4;
    const bf16* src = (tsel ? VB : KB) + h * 64 + ch * 8; float* dst = (tsel ? outV : outK) + h * 64 + ch * 8;
    asm volatile("" ::: "memory");
#pragma unroll 1
    for (int i0 = 0; i0 < 8; i0 += 4) { u32x4 v[4];
#pragma unroll
        for (int i = 0; i < 4; ++i) { const int r = r0 + 32 * (i0 + i); v[i] = r < nrows ? *(const u32x4*)(src + (wsrow0 + r) * DM) : (u32x4){0u, 0u, 0u, 0u}; }
#pragma unroll
        for (int i = 0; i < 4; ++i) { const int r = r0 + 32 * (i0 + i); if (r < nrows) { f32x4 a, b;
            a[0] = bf2f((unsigned short)(v[i].x & 0xffffu)); a[1] = bf2f((unsigned short)(v[i].x >> 16)); a[2] = bf2f((unsigned short)(v[i].y & 0xffffu)); a[3] = bf2f((unsigned short)(v[i].y >> 16));
            b[0] = bf2f((unsigned short)(v[i].z & 0xffffu)); b[1] = bf2f((unsigned short)(v[i].z >> 16)); b[2] = bf2f((unsigned short)(v[i].w & 0xffffu)); b[3] = bf2f((unsigned short)(v[i].w >> 16));
            *(f32x4*)(dst + (outrow0 + r) * DM) = a; *(f32x4*)(dst + (outrow0 + r) * DM + 4) = b; } } }
}

__device__ __forceinline__ void store8_f32(float* dst, const u32x4 v) {
    *(f32x4*)dst = (f32x4){__builtin_bit_cast(float, v.x << 16), __builtin_bit_cast(float, v.x & 0xffff0000u), __builtin_bit_cast(float, v.y << 16), __builtin_bit_cast(float, v.y & 0xffff0000u)};
    *(f32x4*)(dst + 4) = (f32x4){__builtin_bit_cast(float, v.z << 16), __builtin_bit_cast(float, v.z & 0xffff0000u), __builtin_bit_cast(float, v.w << 16), __builtin_bit_cast(float, v.w & 0xffff0000u)};
}
constexpr float AT_SKIP_T = 40.0f;
__device__ __forceinline__ void attn_prompt_unit(int b, int h, int j, const bf16* QB, const bf16* KB, const bf16* VB, const float* G, bf16* OB, lptr lds, int tid, int w, int lane, float kb, float* outK, float* outV) {
    const int r32 = lane & 31, hi = lane >> 5;
    const int qp = 256 * j + 32 * w + r32, t = qp - PPAD; const bool qvalid = t >= 0; const bool wave_active = (256 * j + 32 * w + 31) >= PPAD;
    const size_t qrow = (size_t)b * TP + (t > 0 ? t : 0);
    bf16x8 qr[4];
#pragma unroll
    for (int d0 = 0; d0 < 4; ++d0) qr[d0] = *(const bf16x8*)(QB + qrow * DM + h * 64 + d0 * 16 + hi * 8);
    const int lrow = tid >> 3, lch = tid & 7;
    const long krow0 = (long)b * TP - PPAD + lrow;
    const bf16* kg = KB + krow0 * DM + h * 64 + lch * 8; const bf16* vg = VB + krow0 * DM + h * 64 + lch * 8; const float* gg = G + (size_t)(b * 16 + h) * PLEN;
    f32x16 o0, o1;
#pragma unroll
    for (int r = 0; r < 16; ++r) { o0[r] = 0.f; o1[r] = 0.f; }
    float m = 0.f, l = 0.f;
    const int kt1 = 4 * j + 3, ktw = 4 * j + (w >> 1), kmin = qp >= PPAD ? PPAD : 0;
    u32x4 kreg[2][2], vreg[2][2]; float breg[2] = {0.f, 0.f};
    LAS int* vote = (LAS int*)(lds + 4 * AT_BUF);
#define AT_LOADPAIR(S, KH, LO) do { _Pragma("unroll") for (int i_ = 0; i_ < 2; ++i_) { const int kk_ = (KH) - i_ >= (LO) ? (KH) - i_ : (LO); kreg[S][i_] = *(const u32x4*)(kg + (size_t)kk_ * 64 * DM); vreg[S][i_] = *(const u32x4*)(vg + (size_t)kk_ * 64 * DM); } \
        if (tid < 128) { const int kk_ = (KH) - (tid >> 6) >= (LO) ? (KH) - (tid >> 6) : (LO); breg[S] = gg[kk_ * 64 + (tid & 63)]; } } while (0)
#define AT_STEP(S, KH, STEPI) { const int kh_ = (KH); const lptr base = lds + (S) * 2 * AT_BUF; \
        _Pragma("unroll") for (int i = 0; i < 2; ++i) { *(LAS u32x4*)(base + i * AT_BUF + lrow * AT_KSTR + lch * 16) = kreg[S][i]; *(LAS u32x4*)(base + i * AT_BUF + AT_V + (lch >> 2) * 4096 + lrow * 64 + (lch & 3) * 16) = vreg[S][i]; } \
        if (tid < 128) *(LAS float*)(base + (tid >> 6) * AT_BUF + AT_B + (tid & 63) * 4) = breg[S]; \
        _Pragma("unroll") for (int i = 0; i < 2; ++i) { const int k2 = kh_ - i; if (k2 >= 4 * j && k2 >= kt0) { const int t_ = 64 * k2 + lrow - PPAD;     \
            if (t_ >= 0) { const size_t o_ = ((size_t)b * TP + t_) * DM + h * 64 + lch * 8; store8_f32(outK + o_, kreg[S][i]); store8_f32(outV + o_, vreg[S][i]); } } } \
        LDS_BARRIER(); \
        if ((STEPI) > 0) { const LAS int* vp_ = vote + (((STEPI) - 1) & 1) * 8; int all_ = 1; _Pragma("unroll") for (int i = 0; i < 8; ++i) all_ &= vp_[i]; if (all_) break; } \
        if (kh_ - 4 >= kt0) AT_LOADPAIR(S, kh_ - 4, kt0); \
        int done_ = wave_active ? 0 : 1; \
        _Pragma("unroll") for (int i = 0; i < 2; ++i) { const int k2 = kh_ - i; const lptr b2 = base + i * AT_BUF; \
            if (wave_active && k2 <= ktw && k2 >= kt0) { \
                if (k2 == 3 || k2 == ktw) attn_tile<true>(b2, b2 + AT_V, b2 + AT_B, qr, o0, o1, m, l, qp, 64 * k2, kmin, lane); \
                else attn_tile<false>(b2, b2 + AT_V, b2 + AT_B, qr, o0, o1, m, l, qp, 64 * k2, kmin, lane); \
                done_ = k2 > kt0 ? (__all(kb + *(const LAS float*)(b2 + AT_B) <= m - AT_SKIP_T) ? 1 : 0) : 1; } } \
        if (lane == 0) vote[((STEPI) & 1) * 8 + w] = done_; }
    AT_LOADPAIR(0, kt1, 3);
    if (j > 0) AT_LOADPAIR(1, kt1 - 2, 3);
    int kt0 = 3;
    { const int ta = 3 + lane, tb = 67 + lane;
        const float g0 = gg[j == 0 ? PPAD : 256 * j], ga = ta < 4 * j ? gg[64 * ta + 63] : 3.0e38f, gb = tb < 4 * j ? gg[64 * tb + 63] : 3.0e38f;
        const float thr = g0 - 2.0f * kb - AT_SKIP_T;
        const bool sa = ga <= thr, sb = gb <= thr;
        kt0 = 3 + __popcll(__ballot(sa)) + __popcll(__ballot(sb)); }
    for (int kh = kt1, si = 0; kh >= kt0; kh -= 4, si += 2) { AT_STEP(0, kh, si) if (kh - 2 >= kt0) AT_STEP(1, kh - 2, si + 1) }
#undef AT_STEP
#undef AT_LOADPAIR
    const float lt = l + __shfl_xor(l, 32), inv = 1.0f / lt;
    if (wave_active && qvalid) { bf16* op = OB + qrow * DM + h * 64 + 4 * hi;
#pragma unroll
        for (int g = 0; g < 4; ++g) { u32x2 a, c; a.x = pk2(o0[4 * g] * inv, o0[4 * g + 1] * inv); a.y = pk2(o0[4 * g + 2] * inv, o0[4 * g + 3] * inv); c.x = pk2(o1[4 * g] * inv, o1[4 * g + 1] * inv); c.y = pk2(o1[4 * g + 2] * inv, o1[4 * g + 3] * inv);
            *(u32x2*)(op + 8 * g) = a; *(u32x2*)(op + 32 + 8 * g) = c; } }
    __syncthreads();
}

__device__ __forceinline__ void attn_sample_unit(int b, int h, const float* cK, const float* cV, const bf16* QB, const bf16* KB, const bf16* VB, const float* GS, bf16* OB, lptr lds, int tid, int w, int lane, float kb, float* outK, float* outV) {
    const int r32 = lane & 31, hi = lane >> 5;
    const lptr base = lds + w * AT_BUF;
    const size_t qrow = (size_t)MP + b * DT + r32;
    bf16x8 qr[4];
#pragma unroll
    for (int d0 = 0; d0 < 4; ++d0) qr[d0] = *(const bf16x8*)(QB + qrow * DM + h * 64 + d0 * 16 + hi * 8);
    f32x16 o0, o1;
#pragma unroll
    for (int r = 0; r < 16; ++r) { o0[r] = 0.f; o1[r] = 0.f; }
    float m = 0.f, l = 0.f;
    const float* gs = GS + (size_t)(b * 16 + h) * GSLEN;
    int ti0 = 0;
    { const float thr = gs[PAST] - 2.0f * kb - AT_SKIP_T; const bool sk = lane < 32 && gs[64 * lane + 63] <= thr; ti0 = __popcll(__ballot(sk)); }
#pragma unroll 1
    for (int ti = ti0 + w; ti < 33; ti += 8) {
        const float bias_l = gs[64 * ti + lane];
        if (ti < 32) {
            const float* ck0 = cK + (((size_t)b * PAST + 64 * ti + (lane >> 4)) * 16 + h) * 64 + 4 * (lane & 15); const float* cv0 = cV + (ck0 - cK);
            const lptr kw0 = base + (lane >> 4) * AT_KSTR + (lane & 15) * 8, vw0 = base + AT_V + ((lane & 15) >> 3) * 4096 + (lane >> 4) * 64 + (lane & 7) * 8;
#pragma unroll
            for (int half = 0; half < 2; ++half) {
                f32x4 kv[8], vv[8];
#pragma unroll
                for (int i = 0; i < 8; ++i) { kv[i] = *(const f32x4*)(ck0 + (half * 32 + i * 4) * 1024); vv[i] = *(const f32x4*)(cv0 + (half * 32 + i * 4) * 1024); }
#pragma unroll
                for (int i = 0; i < 8; ++i) { u32x2 a, c; a.x = pk2(kv[i][0], kv[i][1]); a.y = pk2(kv[i][2], kv[i][3]); c.x = pk2(vv[i][0], vv[i][1]); c.y = pk2(vv[i][2], vv[i][3]);
                    *(LAS u32x2*)(kw0 + (half * 32 + i * 4) * AT_KSTR) = a; *(LAS u32x2*)(vw0 + (half * 32 + i * 4) * 64) = c; }
                asm volatile("" ::: "memory");
            }
        } else {
            const size_t off0 = ((size_t)MP + b * DT + (lane >> 3)) * DM + h * 64 + (lane & 7) * 8;
            const lptr kw0 = base + (lane >> 3) * AT_KSTR + (lane & 7) * 16, vw0 = base + AT_V + ((lane & 7) >> 2) * 4096 + (lane >> 3) * 64 + (lane & 3) * 16;
#pragma unroll
            for (int i = 0; i < 8; ++i) { const u32x4 a = *(const u32x4*)(KB + off0 + (size_t)i * 8 * DM), c = *(const u32x4*)(VB + off0 + (size_t)i * 8 * DM);
                *(LAS u32x4*)(kw0 + i * 8 * AT_KSTR) = a; *(LAS u32x4*)(vw0 + i * 8 * 64) = c; }
        }
        *(LAS float*)(base + AT_B + lane * 4) = bias_l;
        LDS_WAIT();
        if (ti < 32) attn_tile<false>(base, base + AT_V, base + AT_B, qr, o0, o1, m, l, 0, 0, 0, lane);
        else attn_tile<true>(base, base + AT_V, base + AT_B, qr, o0, o1, m, l, r32, 0, 0, lane);
        asm volatile("" ::: "memory");
    }
    const float lt = l + __shfl_xor(l, 32);
    LDS_WAIT();
    LAS float* of = (LAS float*)base;
#pragma unroll
    for (int r = 0; r < 16; ++r) { of[crow(r, hi) * 32 + r32] = o0[r]; of[(32 + crow(r, hi)) * 32 + r32] = o1[r]; }
    if (hi == 0) { of[2048 + r32] = m; of[2080 + r32] = lt; }
    __syncthreads();
    { const int q = tid & 31, dg = tid >> 5; float M = -1e30f;
#pragma unroll
        for (int ww = 0; ww < 8; ++ww) M = fmaxf(M, ((LAS float*)(lds + ww * AT_BUF))[2048 + q]);
        float L = 0.f, o[4] = {0.f, 0.f, 0.f, 0.f};
#pragma unroll
        for (int ww = 0; ww < 8; ++ww) { const LAS float* p = (LAS float*)(lds + ww * AT_BUF); const float f = __builtin_amdgcn_exp2f(p[2048 + q] - M); L += f * p[2080 + q];
#pragma unroll
            for (int i = 0; i < 4; ++i) o[i] += f * p[(4 * dg + i) * 32 + q]; }
        const float inv = 1.0f / L; u32x2 a; a.x = pk2(o[0] * inv, o[1] * inv); a.y = pk2(o[2] * inv, o[3] * inv);
        *(u32x2*)(OB + ((size_t)MP + b * DT + q) * DM + h * 64 + 4 * dg) = a; }
    kv_out_rows(KB, VB, outK, outV, (size_t)MP + b * DT, (size_t)b * DT, DT, h, tid);
    __syncthreads();
}

__device__ __forceinline__ void p3_attention(const Args& A, lptr lds, int tid, int w, int lane, int rep) {
    unsigned char* ws = A.ws;
    const bf16* QB = (const bf16*)(ws + WS_QB); const bf16* KB = (const bf16*)(ws + WS_KB); const bf16* VB = (const bf16*)(ws + WS_VB); bf16* OB = (bf16*)(ws + WS_OB);
    const float* G = (const float*)(ws + WS_G); const float* GS = (const float*)(ws + WS_GS);
    unsigned* ctr = (unsigned*)(ws + WS_CTL) + 64 * rep;
    LAS unsigned* su = (LAS unsigned*)(lds + LDS_BYTES - 64);
    constexpr int NPU = 17 * NB * 16, NSU = DB * 16, NU = NPU + NSU;
    float gqm = 0.f, gkm = 0.f;
    for (int i = 0; i < 64; ++i) { gqm = fmaxf(gqm, fabsf(A.in[13][i])); gkm = fmaxf(gkm, fabsf(A.in[14][i])); }
    const float kb = 8.0f * LOG2E * gqm * gkm * 1.02f;
    for (;;) {
        if (tid == 0) *su = atomicAdd(ctr, 1u);
        __syncthreads();
        const int u = (int)*su;
        __syncthreads();
        if (u >= NU) break;
        const bool is_s = (u % 5 == 4) && (u / 5 < NSU);
        if (is_s) { const int s = u / 5; attn_sample_unit(s >> 4, s & 15, A.in[2], A.in[3], QB, KB, VB, GS, OB, lds, tid, w, lane, kb, A.out + O_FKS, A.out + O_FVS); }
        else { const int k = u / 5, pidx = u - (k < NSU ? k : NSU); const int j = 16 - pidx / (NB * 16), bh = pidx % (NB * 16); attn_prompt_unit(bh >> 4, bh & 15, j, QB, KB, VB, G, OB, lds, tid, w, lane, kb, A.out + O_FKP, A.out + O_FVP); }
    }
#ifdef PROBE_SAMPLE
    for (;;) { if (tid == 0) *su = atomicAdd(ctr + 128, 1u); __syncthreads(); const int u = (int)*su; __syncthreads(); if (u >= NSU) break;
        attn_sample_unit(u >> 4, u & 15, A.in[2], A.in[3], QB, KB, VB, GS, OB, lds, tid, w, lane, kb, A.out + O_FKS, A.out + O_FVS); }
#endif
}

constexpr int ML_QS = 272, ML_TS = 144;
constexpr int MA_VS = 544;
constexpr int MA_Q = 0, MA_K = 17408, MA_KW = 34816, MA_V = 52224, MA_SP = 87040, MA_VEC = 96256;
__device__ __forceinline__ bf16x8 tr_frag(clptr p, int rowstride4) { const v4i16_t lo = vtr(p), hi = vtr(p + rowstride4); return (bf16x8){lo[0], lo[1], lo[2], lo[3], hi[0], hi[1], hi[2], hi[3]}; }
constexpr int NUA = NB * 4 * 65 + DB * 4;
__device__ __forceinline__ f32x4 mfma16(bf16x8 a, bf16x8 b, f32x4 c) { return __builtin_amdgcn_mfma_f32_16x16x32_bf16(a, b, c, 0, 0, 0); }

__device__ __forceinline__ void mlstm_a_phase(const Args& A, int first, int stride, lptr lds, int tid, int w, int lane) {
    unsigned char* ws = A.ws;
    u32x4 pq[2], pk[2], pv[4]; float pgi = -1e30f, pgf = 0.f;
#define MA_LOAD(UID) do { const int uid_ = (UID); const bool pr_ = uid_ < NB * 4 * 65; const int bh_ = pr_ ? uid_ / 65 : uid_ - NB * 4 * 65, c_ = pr_ ? uid_ - bh_ * 65 : 0, b_ = bh_ >> 2, h_ = bh_ & 3; \
        const size_t rb_ = pr_ ? (size_t)b_ * TP : (size_t)MP + (size_t)b_ * DT; const int t0_ = pr_ ? 64 * c_ - 48 : 0, tl_ = pr_ ? TP : DT; \
        { const int tk_ = t0_ + lane; pgi = -1e30f; pgf = 0.f; if (tk_ >= 0 && tk_ < tl_) { pgi = ((const float*)(ws + WS_GI))[(rb_ + tk_) * 4 + h_]; pgf = ((const float*)(ws + WS_GF))[(rb_ + tk_) * 4 + h_]; } } \
        _Pragma("unroll") for (int i_ = 0; i_ < 2; ++i_) { const int id_ = tid + 512 * i_, r_ = id_ >> 4, ch_ = id_ & 15; const int tk_ = t0_ + r_; pq[i_] = (u32x4){0u, 0u, 0u, 0u}; pk[i_] = (u32x4){0u, 0u, 0u, 0u}; \
            if (tk_ >= 0 && tk_ < tl_) { pq[i_] = *(const u32x4*)((const bf16*)(ws + WS_MQ) + (rb_ + tk_) * 512 + h_ * 128 + ch_ * 8); pk[i_] = *(const u32x4*)((const bf16*)(ws + WS_MK) + (rb_ + tk_) * 512 + h_ * 128 + ch_ * 8); } } \
        _Pragma("unroll") for (int i_ = 0; i_ < 4; ++i_) { const int id_ = tid + 512 * i_, r_ = id_ >> 5, ch_ = id_ & 31; const int tk_ = t0_ + r_; pv[i_] = (u32x4){0u, 0u, 0u, 0u}; \
            if (tk_ >= 0 && tk_ < tl_) pv[i_] = *(const u32x4*)((const bf16*)(ws + WS_MV) + (rb_ + tk_) * DM + h_ * 256 + ch_ * 8); } } while (0)
    if (first < NUA) MA_LOAD(first);
#pragma unroll 1
    for (int uid = first; uid < NUA; uid += stride) {
    bf16* MH = (bf16*)(ws + WS_MH);
    float* RS = (float*)(ws + WS_RS); float* NU = (float*)(ws + WS_NU); bf16* U = (bf16*)(ws + WS_U) + (size_t)uid * 32768;
    const bool prompt = uid < NB * 4 * 65; const int bh = prompt ? uid / 65 : uid - NB * 4 * 65, c = prompt ? uid - bh * 65 : 0, b = bh >> 2, h = bh & 3;
    const size_t row_base = prompt ? (size_t)b * TP : (size_t)MP + (size_t)b * DT; const int tok0 = prompt ? 64 * c - 48 : 0, tlim = prompt ? TP : DT;
    LAS float* vec = (LAS float*)(lds + MA_VEC); LAS float* v_b = vec, *v_a = vec + 64, *v_ml = vec + 128, *v_rs = vec + 192;
    const int l15 = lane & 15, lg = lane >> 4;
    const float gi = pgi, gf = pgf;
    const float bb = wave_scan_add(gf, lane), aa = gi - bb, pm = wave_scan_max(aa, lane), mloc = bb + pm;
    const float b_last = __shfl(bb, 63), ml_last = __shfl(mloc, 63), wgl = __expf(b_last + aa - ml_last);
    if (w == 0) { v_b[lane] = bb; v_a[lane] = aa; v_ml[lane] = mloc; }
    if (w == 0) { ((float*)(ws + WS_BBC))[(size_t)uid * 64 + lane] = bb; ((float*)(ws + WS_PMC))[(size_t)uid * 64 + lane] = pm; }
#pragma unroll
    for (int i = 0; i < 2; ++i) { const int id = tid + 512 * i, r = id >> 4, ch = id & 15; const int tk = tok0 + r; const bool ok = tk >= 0 && tk < tlim;
        const u32x4 q = pq[i], k = pk[i]; (void)ok;
        *(LAS u32x4*)(lds + MA_Q + r * ML_QS + ch * 16) = q; *(LAS u32x4*)(lds + MA_K + r * ML_QS + ch * 16) = k;
        const float wgr = __shfl(wgl, r); u32x4 kw;
#pragma unroll
        for (int e = 0; e < 4; ++e) kw[e] = pk2(bf2f((unsigned short)(k[e] & 0xffffu)) * wgr, bf2f((unsigned short)(k[e] >> 16)) * wgr);
        *(LAS u32x4*)(lds + MA_KW + r * ML_QS + ch * 16) = kw; }
#pragma unroll
    for (int i = 0; i < 4; ++i) { const int id = tid + 512 * i, r = id >> 5, ch = id & 31; const int tk = tok0 + r; const bool ok = tk >= 0 && tk < tlim;
        const u32x4 v = pv[i]; (void)ok;
        *(LAS u32x4*)(lds + MA_V + r * MA_VS + ch * 16) = v; }
    LDS_BARRIER();
    if (uid + stride < NUA) MA_LOAD(uid + stride);
    { const int tr = w >> 1; float rs[4] = {0.f, 0.f, 0.f, 0.f};
#pragma unroll
        for (int i = 0; i < 2; ++i) { const int tc = 2 * (w & 1) + i; f32x4 acc = {0.f, 0.f, 0.f, 0.f};
#pragma unroll
            for (int k0 = 0; k0 < 128; k0 += 32) { const bf16x8 a = *(const LAS bf16x8*)(lds + MA_Q + (16 * tr + l15) * ML_QS + (k0 + 8 * lg) * 2), bq = *(const LAS bf16x8*)(lds + MA_K + (16 * tc + l15) * ML_QS + (k0 + 8 * lg) * 2); acc = mfma16(a, bq, acc); }
            const int s = 16 * tc + l15; const float as = v_a[s];
#pragma unroll
            for (int r = 0; r < 4; ++r) { const int t = 16 * tr + 4 * lg + r; const float d = s <= t ? __expf(v_b[t] + as - v_ml[t]) : 0.f; const float sp = acc[r] * d; rs[r] += sp;
                *(LAS unsigned short*)(lds + MA_SP + t * ML_TS + s * 2) = (unsigned short)f2bf(sp); } }
#pragma unroll
        for (int r = 0; r < 4; ++r) { float x = rs[r]; x += __shfl_xor(x, 1); x += __shfl_xor(x, 2); x += __shfl_xor(x, 4); x += __shfl_xor(x, 8); if (l15 == 0) v_rs[(w & 1) * 64 + 16 * tr + 4 * lg + r] = x; } }
    const clptr vtb = lds + MA_V + (8 * lg + (l15 >> 2)) * MA_VS + (l15 & 3) * 8;
    {
        const clptr kwb = lds + MA_KW + (8 * lg + (l15 >> 2)) * ML_QS + (l15 & 3) * 8 + w * 32;
        const bf16x8 a0 = tr_frag(kwb, 4 * ML_QS), a1 = tr_frag(kwb + 32 * ML_QS, 4 * ML_QS);
#pragma unroll 4
        for (int dvt = 0; dvt < 16; ++dvt) { const bf16x8 b0 = tr_frag(vtb + dvt * 32, 4 * MA_VS), b1 = tr_frag(vtb + 32 * MA_VS + dvt * 32, 4 * MA_VS);
            f32x4 acc = {0.f, 0.f, 0.f, 0.f}; acc = mfma16(a0, b0, acc); acc = mfma16(a1, b1, acc);
            u32x2 o; o.x = pk2(acc[0], acc[1]); o.y = pk2(acc[2], acc[3]); *(u32x2*)(U + (size_t)(16 * dvt + l15) * 128 + 16 * w + 4 * lg) = o; } }
    if (tid < 128) { float x = 0.f;
#pragma unroll 8
        for (int s = 0; s < 64; ++s) x += bf2f(*(const LAS unsigned short*)(lds + MA_KW + s * ML_QS + tid * 2));
        NU[(size_t)uid * 128 + tid] = x; }
    LDS_BARRIER();
    if (tid < 64) { const int tk = tok0 + tid; if (tk >= 0 && tk < tlim) RS[(row_base + tk) * 4 + h] = v_rs[tid] + v_rs[64 + tid]; }
    {
        const int tt = w & 3; const bf16x8 b0 = *(const LAS bf16x8*)(lds + MA_SP + (16 * tt + l15) * ML_TS + (8 * lg) * 2), b1 = *(const LAS bf16x8*)(lds + MA_SP + (16 * tt + l15) * ML_TS + (32 + 8 * lg) * 2);
        const int tk = tok0 + 16 * tt + l15; const bool ok = tk >= 0 && tk < tlim; bf16* dst = MH + (row_base + (ok ? tk : 0)) * DM + h * 256 + 4 * lg;
#pragma unroll 4
        for (int i = 0; i < 8; ++i) { const int dvt = 8 * (w >> 2) + i; const bf16x8 a0 = tr_frag(vtb + dvt * 32, 4 * MA_VS), a1 = tr_frag(vtb + 32 * MA_VS + dvt * 32, 4 * MA_VS);
            f32x4 acc = {0.f, 0.f, 0.f, 0.f}; acc = mfma16(a0, b0, acc); acc = mfma16(a1, b1, acc);
            if (ok) { u32x2 o; o.x = pk2(acc[0], acc[1]); o.y = pk2(acc[2], acc[3]); *(u32x2*)(dst + 16 * dvt) = o; } } }
    LDS_BARRIER();
    }
#undef MA_LOAD
    __syncthreads();
}

constexpr int MB_QSZ = 17408, MB_CBSZ = 48 * ML_QS, MB_Q = 0, MB_CB = 2 * MB_QSZ, MB_END = MB_CB + 2 * MB_CBSZ;
__device__ __forceinline__ void mlstm_b_item(const Args& A, int it, lptr lds, int tid, int w, int lane) {
    unsigned char* ws = A.ws;
    const bf16* MQ = (const bf16*)(ws + WS_MQ); bf16* MH = (bf16*)(ws + WS_MH); const float* GI = (const float*)(ws + WS_GI); const float* GF = (const float*)(ws + WS_GF);
    const float* RS = (const float*)(ws + WS_RS); const float* NU = (const float*)(ws + WS_NU); float* HSSQ = (float*)(ws + WS_HSSQ);
    const bool prompt = it < 256; const int i2 = prompt ? it : it - 256; const int b = i2 >> 5, h = (i2 >> 3) & 3, sl = i2 & 7; const int nch = prompt ? 65 : 1;
    const int uid0 = prompt ? (b * 4 + h) * 65 : NB * 4 * 65 + (b * 4 + h);
    const size_t row_base = prompt ? (size_t)b * TP : (size_t)MP + (size_t)b * DT; const int tlim = prompt ? TP : DT;
    const bf16* Ub = (const bf16*)(ws + WS_U) + (size_t)uid0 * 32768 + (size_t)(sl * 32 + (tid >> 4)) * 128 + (tid & 15) * 8;
    const int l15 = lane & 15, lg = lane >> 4, tt = w & 3, dvt = w >> 2, cdv = tid >> 4, cdk = (tid & 15) * 8;
    float C[8]; float nreg = 0.f, m_run = 0.f;
    {
        if (prompt) {
#pragma unroll
            for (int i = 0; i < 8; ++i) C[i] = 0.f;
        } else { const float* C0 = A.in[5] + ((size_t)(b * 4 + h) * 256 + sl * 32 + cdv) * 128 + cdk; const f32x4 c0 = *(const f32x4*)C0, c1 = *(const f32x4*)(C0 + 4);
#pragma unroll
            for (int i = 0; i < 4; ++i) { C[i] = c0[i]; C[4 + i] = c1[i]; }
            if (tid < 128) nreg = A.in[6][(size_t)(b * 4 + h) * 128 + tid]; m_run = A.in[7][b * 4 + h]; }
        u32x4 o; o.x = pk2(C[0], C[1]); o.y = pk2(C[2], C[3]); o.z = pk2(C[4], C[5]); o.w = pk2(C[6], C[7]);
        *(LAS u32x4*)(lds + MB_CB + cdv * ML_QS + cdk * 2) = o;
        if (tid < 256) { const int r = 32 + (tid >> 4); const u32x4 z = {0u, 0u, 0u, 0u}; *(LAS u32x4*)(lds + MB_CB + r * ML_QS + (tid & 15) * 16) = z; *(LAS u32x4*)(lds + MB_CB + MB_CBSZ + r * ML_QS + (tid & 15) * 16) = z; }
    }
    __syncthreads();
    if (tid < 128) *(LAS unsigned short*)(lds + MB_CB + 32 * ML_QS + tid * 2) = (unsigned short)f2bf(nreg);
    u32x4 q0_[2], q1_[2], uc_[2]; u32x2 nl_[2]; float gi_[2], gf_[2], rs_[2], nu_[2];
#define MB_LOADQ(S, cc) do { const int tok0_ = prompt ? 64 * (cc) - 48 : 0; \
        { const int r_ = tid >> 4, tk_ = tok0_ + r_; const bool ok_ = tk_ >= 0 && tk_ < tlim; q0_[S] = (u32x4){0u, 0u, 0u, 0u}; if (ok_) q0_[S] = *(const u32x4*)(MQ + (row_base + tk_) * 512 + h * 128 + (tid & 15) * 8); } \
        { const int r_ = 32 + (tid >> 4), tk_ = tok0_ + r_; const bool ok_ = tk_ >= 0 && tk_ < tlim; q1_[S] = (u32x4){0u, 0u, 0u, 0u}; if (ok_) q1_[S] = *(const u32x4*)(MQ + (row_base + tk_) * 512 + h * 128 + (tid & 15) * 8); } } while (0)
#define MB_LOAD(S, cc) do { const int tok0_ = prompt ? 64 * (cc) - 48 : 0; \
        uc_[S] = *(const u32x4*)(Ub + (size_t)(cc) * 32768); \
        { const int tk_ = tok0_ + lane; gi_[S] = ((const float*)(ws + WS_PMC))[(size_t)(uid0 + (cc)) * 64 + lane]; gf_[S] = ((const float*)(ws + WS_BBC))[(size_t)(uid0 + (cc)) * 64 + lane]; rs_[S] = 0.f; if (tk_ >= 0 && tk_ < tlim) rs_[S] = RS[(row_base + tk_) * 4 + h]; } \
        nu_[S] = tid < 128 ? NU[(size_t)(uid0 + (cc)) * 128 + tid] : 0.f; \
        { const int tk_ = tok0_ + 16 * tt + l15; nl_[S] = (u32x2){0u, 0u}; if (tk_ >= 0 && tk_ < tlim) nl_[S] = *(const u32x2*)(MH + (row_base + tk_) * DM + h * 256 + sl * 32 + 16 * dvt + 4 * lg); } } while (0)
    MB_LOADQ(0, 0); MB_LOAD(0, 0);
    if (nch > 1) MB_LOAD(1, 1);
    *(LAS u32x4*)(lds + MB_Q + (tid >> 4) * ML_QS + (tid & 15) * 16) = q0_[0]; *(LAS u32x4*)(lds + MB_Q + (32 + (tid >> 4)) * ML_QS + (tid & 15) * 16) = q1_[0];
    __syncthreads();
    if (nch > 1) MB_LOADQ(1, 1);
    if (nch > 2) MB_LOADQ(0, 2);
#pragma unroll 1
    for (int c2 = 0; c2 < nch; c2 += 2) {
        { constexpr int S = 0; const int c = c2;
        const int tok0 = prompt ? 64 * c - 48 : 0;
        const float bb = gf_[S], pm = gi_[S];
        const float mx = fmaxf(m_run, pm), mt = bb + mx, win = __expf(m_run - mx), scl = __expf(pm - mx), einv = __expf(-mt);
        const float b_last = __shfl(bb, 63), m_new = __shfl(mt, 63), pm_last = __shfl(pm, 63), mx_last = fmaxf(m_run, pm_last);
        const float decay = __expf(m_run - mx_last), usc = __expf(pm_last - mx_last);
        (void)b_last;
        const u32x4 uc = uc_[S]; const u32x2 nlc = nl_[S]; const float rsc = rs_[S], nuc = nu_[S];
        f32x4 acc = {0.f, 0.f, 0.f, 0.f}, acc2 = {0.f, 0.f, 0.f, 0.f};
#pragma unroll
        for (int k0 = 0; k0 < 128; k0 += 32) { const bf16x8 bq = *(const LAS bf16x8*)(lds + MB_Q + S * MB_QSZ + (16 * tt + l15) * ML_QS + (k0 + 8 * lg) * 2);
            const bf16x8 a = *(const LAS bf16x8*)(lds + MB_CB + S * MB_CBSZ + (16 * dvt + l15) * ML_QS + (k0 + 8 * lg) * 2), an = *(const LAS bf16x8*)(lds + MB_CB + S * MB_CBSZ + (32 + l15) * ML_QS + (k0 + 8 * lg) * 2);
            acc = mfma16(a, bq, acc); acc2 = mfma16(an, bq, acc2); }
        {
            const int t = 16 * tt + l15; const int tk = tok0 + t; const bool ok = tk >= 0 && tk < tlim;
            const float qn = __shfl(acc2[0], l15), win_t = __shfl(win, t), scl_t = __shfl(scl, t), einv_t = __shfl(einv, t), rs_t = __shfl(rsc, t);
            const float den = win_t * qn + scl_t * rs_t, rden = 1.0f / fmaxf(fabsf(den), einv_t);
            const float n0 = bf2f((unsigned short)(nlc.x & 0xffffu)), n1 = bf2f((unsigned short)(nlc.x >> 16)), n2 = bf2f((unsigned short)(nlc.y & 0xffffu)), n3 = bf2f((unsigned short)(nlc.y >> 16));
            const float h0 = (win_t * acc[0] + scl_t * n0) * rden, h1 = (win_t * acc[1] + scl_t * n1) * rden, h2 = (win_t * acc[2] + scl_t * n2) * rden, h3 = (win_t * acc[3] + scl_t * n3) * rden;
            float x = (h0 * h0 + h1 * h1) + (h2 * h2 + h3 * h3); x += __shfl_xor(x, 16); x += __shfl_xor(x, 32);
            if (ok) { u32x2 o; o.x = pk2(h0, h1); o.y = pk2(h2, h3); *(u32x2*)(MH + (row_base + tk) * DM + h * 256 + sl * 32 + 16 * dvt + 4 * lg) = o; if (lg == 0) HSSQ[((row_base + tk) * 4 + h) * 16 + sl * 2 + dvt] = x; }
        }
        {
            C[0] = decay * C[0] + usc * bf2f((unsigned short)(uc.x & 0xffffu)); C[1] = decay * C[1] + usc * bf2f((unsigned short)(uc.x >> 16));
            C[2] = decay * C[2] + usc * bf2f((unsigned short)(uc.y & 0xffffu)); C[3] = decay * C[3] + usc * bf2f((unsigned short)(uc.y >> 16));
            C[4] = decay * C[4] + usc * bf2f((unsigned short)(uc.z & 0xffffu)); C[5] = decay * C[5] + usc * bf2f((unsigned short)(uc.z >> 16));
            C[6] = decay * C[6] + usc * bf2f((unsigned short)(uc.w & 0xffffu)); C[7] = decay * C[7] + usc * bf2f((unsigned short)(uc.w >> 16));
            u32x4 o; o.x = pk2(C[0], C[1]); o.y = pk2(C[2], C[3]); o.z = pk2(C[4], C[5]); o.w = pk2(C[6], C[7]);
            *(LAS u32x4*)(lds + MB_CB + (S ^ 1) * MB_CBSZ + cdv * ML_QS + cdk * 2) = o;
            if (tid < 128) { nreg = decay * nreg + usc * nuc; *(LAS unsigned short*)(lds + MB_CB + (S ^ 1) * MB_CBSZ + 32 * ML_QS + tid * 2) = (unsigned short)f2bf(nreg); }
            if (c + 1 < nch) { *(LAS u32x4*)(lds + MB_Q + (S ^ 1) * MB_QSZ + (tid >> 4) * ML_QS + (tid & 15) * 16) = q0_[S ^ 1]; *(LAS u32x4*)(lds + MB_Q + (S ^ 1) * MB_QSZ + (32 + (tid >> 4)) * ML_QS + (tid & 15) * 16) = q1_[S ^ 1]; }
        }
        m_run = m_new;
        LDS_BARRIER();
        if (c + 2 < nch) MB_LOAD(S, c + 2);
        if (c + 3 < nch) MB_LOADQ(S ^ 1, c + 3);
        }
        if (c2 + 1 < nch) { constexpr int S = 1; const int c = c2 + 1;
        const int tok0 = prompt ? 64 * c - 48 : 0;
        const float bb = gf_[S], pm = gi_[S];
        const float mx = fmaxf(m_run, pm), mt = bb + mx, win = __expf(m_run - mx), scl = __expf(pm - mx), einv = __expf(-mt);
        const float b_last = __shfl(bb, 63), m_new = __shfl(mt, 63), pm_last = __shfl(pm, 63), mx_last = fmaxf(m_run, pm_last);
        const float decay = __expf(m_run - mx_last), usc = __expf(pm_last - mx_last);
        (void)b_last;
        const u32x4 uc = uc_[S]; const u32x2 nlc = nl_[S]; const float rsc = rs_[S], nuc = nu_[S];
        f32x4 acc = {0.f, 0.f, 0.f, 0.f}, acc2 = {0.f, 0.f, 0.f, 0.f};
#pragma unroll
        for (int k0 = 0; k0 < 128; k0 += 32) { const bf16x8 bq = *(const LAS bf16x8*)(lds + MB_Q + S * MB_QSZ + (16 * tt + l15) * ML_QS + (k0 + 8 * lg) * 2);
            const bf16x8 a = *(const LAS bf16x8*)(lds + MB_CB + S * MB_CBSZ + (16 * dvt + l15) * ML_QS + (k0 + 8 * lg) * 2), an = *(const LAS bf16x8*)(lds + MB_CB + S * MB_CBSZ + (32 + l15) * ML_QS + (k0 + 8 * lg) * 2);
            acc = mfma16(a, bq, acc); acc2 = mfma16(an, bq, acc2); }
        {
            const int t = 16 * tt + l15; const int tk = tok0 + t; const bool ok = tk >= 0 && tk < tlim;
            const float qn = __shfl(acc2[0], l15), win_t = __shfl(win, t), scl_t = __shfl(scl, t), einv_t = __shfl(einv, t), rs_t = __shfl(rsc, t);
            const float den = win_t * qn + scl_t * rs_t, rden = 1.0f / fmaxf(fabsf(den), einv_t);
            const float n0 = bf2f((unsigned short)(nlc.x & 0xffffu)), n1 = bf2f((unsigned short)(nlc.x >> 16)), n2 = bf2f((unsigned short)(nlc.y & 0xffffu)), n3 = bf2f((unsigned short)(nlc.y >> 16));
            const float h0 = (win_t * acc[0] + scl_t * n0) * rden, h1 = (win_t * acc[1] + scl_t * n1) * rden, h2 = (win_t * acc[2] + scl_t * n2) * rden, h3 = (win_t * acc[3] + scl_t * n3) * rden;
            float x = (h0 * h0 + h1 * h1) + (h2 * h2 + h3 * h3); x += __shfl_xor(x, 16); x += __shfl_xor(x, 32);
            if (ok) { u32x2 o; o.x = pk2(h0, h1); o.y = pk2(h2, h3); *(u32x2*)(MH + (row_base + tk) * DM + h * 256 + sl * 32 + 16 * dvt + 4 * lg) = o; if (lg == 0) HSSQ[((row_base + tk) * 4 + h) * 16 + sl * 2 + dvt] = x; }
        }
        {
            C[0] = decay * C[0] + usc * bf2f((unsigned short)(uc.x & 0xffffu)); C[1] = decay * C[1] + usc * bf2f((unsigned short)(uc.x >> 16));
            C[2] = decay * C[2] + usc * bf2f((unsigned short)(uc.y & 0xffffu)); C[3] = decay * C[3] + usc * bf2f((unsigned short)(uc.y >> 16));
            C[4] = decay * C[4] + usc * bf2f((unsigned short)(uc.z & 0xffffu)); C[5] = decay * C[5] + usc * bf2f((unsigned short)(uc.z >> 16));
            C[6] = decay * C[6] + usc * bf2f((unsigned short)(uc.w & 0xffffu)); C[7] = decay * C[7] + usc * bf2f((unsigned short)(uc.w >> 16));
            u32x4 o; o.x = pk2(C[0], C[1]); o.y = pk2(C[2], C[3]); o.z = pk2(C[4], C[5]); o.w = pk2(C[6], C[7]);
            *(LAS u32x4*)(lds + MB_CB + (S ^ 1) * MB_CBSZ + cdv * ML_QS + cdk * 2) = o;
            if (tid < 128) { nreg = decay * nreg + usc * nuc; *(LAS unsigned short*)(lds + MB_CB + (S ^ 1) * MB_CBSZ + 32 * ML_QS + tid * 2) = (unsigned short)f2bf(nreg); }
            if (c + 1 < nch) { *(LAS u32x4*)(lds + MB_Q + (S ^ 1) * MB_QSZ + (tid >> 4) * ML_QS + (tid & 15) * 16) = q0_[S ^ 1]; *(LAS u32x4*)(lds + MB_Q + (S ^ 1) * MB_QSZ + (32 + (tid >> 4)) * ML_QS + (tid & 15) * 16) = q1_[S ^ 1]; }
        }
        m_run = m_new;
        LDS_BARRIER();
        if (c + 2 < nch) MB_LOAD(S, c + 2);
        if (c + 3 < nch) MB_LOADQ(S ^ 1, c + 3);
        }
    }
#undef MB_LOAD
#undef MB_LOADQ
    { float* Co = A.out + (prompt ? O_MCP : O_MCS) + ((size_t)(b * 4 + h) * 256 + sl * 32 + cdv) * 128 + cdk;
        *(f32x4*)Co = (f32x4){C[0], C[1], C[2], C[3]}; *(f32x4*)(Co + 4) = (f32x4){C[4], C[5], C[6], C[7]};
        if (sl == 0) { if (tid < 128) (A.out + (prompt ? O_MNP : O_MNS))[(size_t)(b * 4 + h) * 128 + tid] = nreg; if (tid == 0) (A.out + (prompt ? O_MMP : O_MMS))[b * 4 + h] = m_run; } }
    __syncthreads();
}

__device__ __forceinline__ void p9_gate(const Args& A, int gw, int NGW, int lane) {
    unsigned char* ws = A.ws; bf16* MH = (bf16*)(ws + WS_MH); const bf16* MO = (const bf16*)(ws + WS_MO); const float* HSSQ = (const float*)(ws + WS_HSSQ);
    const int hd = lane >> 4;
    for (int row0 = gw; row0 < MTOT; row0 += 4 * NGW) {
        f32x4 p[4][4]; u32x4 hv[4][2], ov[4][2];
#pragma unroll
        for (int u = 0; u < 4; ++u) { const int row = row0 + u * NGW < MTOT ? row0 + u * NGW : row0; const float* pp = HSSQ + ((size_t)row * 4 + hd) * 16;
#pragma unroll
            for (int i = 0; i < 4; ++i) p[u][i] = *(const f32x4*)(pp + 4 * i);
#pragma unroll
            for (int i = 0; i < 2; ++i) { const size_t off = (size_t)row * DM + lane * 16 + i * 8; hv[u][i] = *(const u32x4*)(MH + off); ov[u][i] = *(const u32x4*)(MO + off); } }
#pragma unroll
        for (int u = 0; u < 4; ++u) { const int row = row0 + u * NGW; if (row >= MTOT) break;
            float s = 0.f;
#pragma unroll
            for (int i = 0; i < 4; ++i) s += (p[u][i][0] + p[u][i][1]) + (p[u][i][2] + p[u][i][3]);
            const float rs = __builtin_amdgcn_rsqf(s * (1.0f / 256.0f) + EPSN);
#pragma unroll
            for (int i = 0; i < 2; ++i) { const size_t off = (size_t)row * DM + lane * 16 + i * 8; u32x4 o;
#pragma unroll
                for (int e2 = 0; e2 < 4; ++e2) { const float a = bf2f((unsigned short)(hv[u][i][e2] & 0xffffu)) * rs * bf2f((unsigned short)(ov[u][i][e2] & 0xffffu)), c = bf2f((unsigned short)(hv[u][i][e2] >> 16)) * rs * bf2f((unsigned short)(ov[u][i][e2] >> 16)); o[e2] = pk2(a, c); }
                *(u32x4*)(MH + off) = o; } }
    }
}

__device__ __forceinline__ void p13_final(const Args& A, int gw, int NGW, int lane) {
    unsigned char* ws = A.ws; const bf16* XB = (const bf16*)(ws + WS_XB); const float* ssq = (const float*)(ws + WS_SSQ); const float* g = A.in[23];
    f32x4 gg[4];
#pragma unroll
    for (int j = 0; j < 4; ++j) gg[j] = *(const f32x4*)(g + 256 * j + 4 * lane);
    for (int row0 = gw; row0 < MTOT; row0 += 4 * NGW) {
        u32x2 v[4][4]; float sq[4];
#pragma unroll
        for (int u = 0; u < 4; ++u) { const int row = row0 + u * NGW < MTOT ? row0 + u * NGW : row0; sq[u] = lane < 16 ? ssq[(size_t)row * 16 + lane] : 0.f;
#pragma unroll
            for (int j = 0; j < 4; ++j) v[u][j] = *(const u32x2*)(XB + (size_t)row * DM + 256 * j + 4 * lane); }
#pragma unroll
        for (int u = 0; u < 4; ++u) { const int row = row0 + u * NGW; if (row >= MTOT) break;
            float* dst;
            if (row < MP) { const int b = row / TP, t = row - b * TP; if (t < NMETA) continue; dst = A.out + O_YP + ((size_t)b * SEQL + (t - NMETA)) * DM; }
            else dst = A.out + O_YS + (size_t)(row - MP) * DM;
            const float rs = __builtin_amdgcn_rsqf(wave_sum(sq[u]) * (1.0f / 1024.0f) + EPSN);
#pragma unroll
            for (int j = 0; j < 4; ++j) { const f32x4 x = {bf2f((unsigned short)(v[u][j].x & 0xffffu)), bf2f((unsigned short)(v[u][j].x >> 16)), bf2f((unsigned short)(v[u][j].y & 0xffffu)), bf2f((unsigned short)(v[u][j].y >> 16))};
                *(f32x4*)(dst + 256 * j + 4 * lane) = x * rs * gg[j]; } }
    }
}

template <bool FIRSTR, bool LASTR> __device__ __forceinline__ void tail_finish(const float* P, unsigned* cnt, const pg8::StaticOrder& base, int first, int ntail, int slices, int c, float* X, bf16* XB, float* ssq, lptr lds, int tid, const float* xp, const float* xs, const float* meta) {
    const int tu = c / slices; if (tu >= ntail) return;
    asm volatile("s_waitcnt vmcnt(0)" ::: "memory"); __syncthreads();
    if (tid == 0) { __builtin_amdgcn_fence(__ATOMIC_RELEASE, "agent"); asm volatile("s_waitcnt vmcnt(0)" ::: "memory");
        (void)__hip_atomic_fetch_add(cnt + tu, 1u, __ATOMIC_RELAXED, __HIP_MEMORY_SCOPE_AGENT);
        while (__hip_atomic_load(cnt + tu, __ATOMIC_RELAXED, __HIP_MEMORY_SCOPE_AGENT) < (unsigned)slices) __builtin_amdgcn_s_sleep(2); }
    __syncthreads();
    __builtin_amdgcn_fence(__ATOMIC_ACQUIRE, "agent"); asm volatile("s_waitcnt vmcnt(0)" ::: "memory");
    pg8::Unit u; base.map(first + tu, u);
    const int nrow = 256 / slices, rbase = (c % slices) * nrow;
    const int cc = tid & 31, r0 = tid >> 5;
    const float* p0 = P + (size_t)(tu * slices) * 65536 + cc * 8;
#pragma unroll 2
    for (int rr = 0; rr < nrow; rr += 16) { const int row = rbase + rr + r0;
        const size_t xoff = (size_t)(u.pm * 256 + row) * DM + u.pn * 256 + cc * 8;
        f32x4 a, b;
        if (FIRSTR) pg8::first_resid(xp, xs, meta, u.pm * 256 + row, u.pn * 256 + cc * 8, a, b);
        else { const u32x4 r = *(const u32x4*)(XB + xoff);
            a = (f32x4){__builtin_bit_cast(float, r.x << 16), __builtin_bit_cast(float, r.x & 0xffff0000u), __builtin_bit_cast(float, r.y << 16), __builtin_bit_cast(float, r.y & 0xffff0000u)};
            b = (f32x4){__builtin_bit_cast(float, r.z << 16), __builtin_bit_cast(float, r.z & 0xffff0000u), __builtin_bit_cast(float, r.w << 16), __builtin_bit_cast(float, r.w & 0xffff0000u)}; }
        for (int s = 0; s < slices; ++s) { a = a + *(const f32x4*)(p0 + (size_t)s * 65536 + row * 256); b = b + *(const f32x4*)(p0 + (size_t)s * 65536 + row * 256 + 4); }
        *(u32x4*)(XB + xoff) = pg8::pack8(a, b);
        float q = (a[0] * a[0] + a[1] * a[1]) + (a[2] * a[2] + a[3] * a[3]) + (b[0] * b[0] + b[1] * b[1]) + (b[2] * b[2] + b[3] * b[3]);
        q += __shfl_xor(q, 1); q += __shfl_xor(q, 2); q += __shfl_xor(q, 4);
        if ((cc & 7) == 0) ssq[(size_t)(u.pm * 256 + row) * 16 + u.pn * 4 + (cc >> 3)] = q; }
}

#define XB_TMO      128
#define XB_XCNT(j)  (256  + 64 * (j))
#define XB_XSUB(j)  (1280 + 64 * (j))
#define XB_XGEN(j)  (2304 + 64 * (j))
#define XB_TOP      3328
#define XB_TOPGEN   3392
#define XCD_BAR_WORDS 3456
#define XB_SPIN_CAP (1u << 18)

__device__ __forceinline__ unsigned xb_ld(unsigned* p)              { return __hip_atomic_load(p, __ATOMIC_RELAXED, __HIP_MEMORY_SCOPE_AGENT); }
__device__ __forceinline__ unsigned xb_add(unsigned* p, unsigned v) { return __hip_atomic_fetch_add(p, v, __ATOMIC_RELAXED, __HIP_MEMORY_SCOPE_AGENT); }
__device__ __forceinline__ unsigned xb_xcc_id() { return (unsigned)__builtin_amdgcn_s_getreg((3 << 11) | 20) & 0xFu; }
#define XB_SPIN(cond, bar) do { unsigned _sp = 0; while (cond) { __builtin_amdgcn_s_sleep(1); \
    if ((++_sp & 255u) == 0u) { if (xb_ld(&(bar)[XB_TMO])) break; if (_sp > XB_SPIN_CAP) { atomicAdd(&(bar)[XB_TMO], 1u); break; } } } } while (0)

struct XcdBarrier {
    unsigned* bar; unsigned x;
    volatile LAS unsigned* st;
};

__device__ __forceinline__ XcdBarrier xcd_barrier_post(unsigned* bar, volatile LAS unsigned* st) {
    XcdBarrier b; b.bar = bar; b.x = xb_xcc_id(); b.st = st;
    if (threadIdx.x == 0) (void)xb_add(&bar[XB_XCNT(b.x)], 1u);
    return b;
}
__device__ __forceinline__ void xcd_barrier_complete(unsigned* bar, unsigned x, unsigned& nloc, unsigned& nx) {
    const unsigned G = gridDim.x * gridDim.y * gridDim.z;
    unsigned sum, cnt, mine, sp = 0u;
    for (;;) {
        sum = 0u; cnt = 0u; mine = 0u;
#pragma unroll
        for (unsigned j = 0; j < 16; ++j) { const unsigned c = xb_ld(&bar[XB_XCNT(j)]); sum += c; cnt += (c > 0u) ? 1u : 0u; mine = (j == x) ? c : mine; }
        if (sum == G) break;
        __builtin_amdgcn_s_sleep(1);
        if ((++sp & 255u) == 0u) { if (xb_ld(&bar[XB_TMO])) break; if (sp > XB_SPIN_CAP) { atomicAdd(&bar[XB_TMO], 1u); break; } }
    }
    nloc = mine > 0u ? mine : 1u; nx = cnt > 0u ? cnt : 1u;
}

__device__ __forceinline__ void xcd_barrier(const XcdBarrier& b) {
    asm volatile("s_waitcnt vmcnt(0)" ::: "memory");
    __syncthreads();
    if (threadIdx.x == 0) {
        unsigned* bar = b.bar;
        __builtin_amdgcn_s_waitcnt(0);
        unsigned nloc = b.st[0], nx = b.st[1];
        if (nloc == 0u) { xcd_barrier_complete(bar, b.x, nloc, nx); b.st[0] = nloc; b.st[1] = nx; }
        const unsigned old = xb_add(&bar[XB_XSUB(b.x)], 1u);
        const unsigned gen = old / nloc;
        if (old + 1u == (gen + 1u) * nloc) {
            __builtin_amdgcn_fence(__ATOMIC_RELEASE, "agent");
            asm volatile("s_waitcnt vmcnt(0)" ::: "memory");
            const unsigned og = xb_add(&bar[XB_TOP], 1u);
            const unsigned tg = og / nx;
            if (og + 1u == (tg + 1u) * nx) xb_add(&bar[XB_TOPGEN], 1u);
            else XB_SPIN(xb_ld(&bar[XB_TOPGEN]) == tg, bar);
            __builtin_amdgcn_fence(__ATOMIC_ACQUIRE, "agent");
            xb_add(&bar[XB_XGEN(b.x)], 1u);
            asm volatile("s_waitcnt vmcnt(0)" ::: "memory");
        } else {
            XB_SPIN(xb_ld(&bar[XB_XGEN(b.x)]) == gen, bar);
            __builtin_amdgcn_fence(__ATOMIC_ACQUIRE, "agent");
            asm volatile("s_waitcnt vmcnt(0)" ::: "memory");
        }
    }
    __syncthreads();
}

__global__ void __launch_bounds__(NTHR, 2) fwd_megakernel(Args args) {
    extern __shared__ __attribute__((aligned(16))) unsigned char lds_raw[];
    cg::grid_group grid = cg::this_grid();
    { LAS unsigned* misc_ = (LAS unsigned*)(lds_raw) ; (void)misc_; }
#define GRID_SYNC() do { asm volatile("s_waitcnt vmcnt(0) lgkmcnt(0)" ::: "memory"); __syncthreads(); \
        if (threadIdx.x == 0) { __builtin_amdgcn_fence(__ATOMIC_RELEASE, "agent"); asm volatile("s_waitcnt vmcnt(0)" ::: "memory"); } \
        GSYNC(); \
        __builtin_amdgcn_fence(__ATOMIC_ACQUIRE, "agent"); asm volatile("s_waitcnt vmcnt(0)" ::: "memory"); __syncthreads(); } while (0)
    const lptr lds = (lptr)lds_raw;
    const int G = gridDim.x, bx = blockIdx.x, NGW = G * NWAVES;
#define TIDS int tid = threadIdx.x; asm volatile("" : "+v"(tid)); const int lane = tid & 63, w = __builtin_amdgcn_readfirstlane(tid >> 6), gw = bx * NWAVES + w; (void)gw; (void)lane
    unsigned char* ws = args.ws;
    bf16* XB = (bf16*)(ws + WS_XB); float* X = (float*)(ws + WS_X); float* ssq = (float*)(ws + WS_SSQ);
    volatile LAS unsigned* xb_st = (volatile LAS unsigned*)(lds + LDS_BYTES - 256);
    if (threadIdx.x < 2) xb_st[threadIdx.x] = 0u;
    __syncthreads();
    const XcdBarrier xbar = xcd_barrier_post((unsigned*)(ws + WS_CTL) + 4096, xb_st);
#ifndef USE_CG_SYNC
#define GSYNC() xcd_barrier(xbar)
#else
#define GSYNC() grid.sync()
#endif

#ifndef SKIP_P0
    { TIDS; p0_prologue(args, lds, gw, NGW, w, lane); }
#endif
#ifdef PROBE_P0
    { TIDS; p0_prologue(args, lds, gw, NGW, w, lane); }
#endif
    grid.sync();
    xcd_barrier(xbar);
#ifdef PROBE_P1
    { pg8::Gemm g{XB, (const bf16*)(ws + WS_WFIN), MPAD, NIN, DM}; pg8::StaticOrder S; S.init(MPAD, NIN, G, bx); pg8::EpiFoxIn E{ssq, args.in[13], args.in[14], args.in[12], ws, args.out};
      pg8::gemm_phase<pg8::EpiFoxIn, pg8::StaticOrder, PG8_ALIGN, PG8_SP2>(lds, g, S, E); }
    GSYNC();
#endif
#ifndef SKIP_P1
    {
        pg8::Gemm g{XB, (const bf16*)(ws + WS_WFIN), MPAD, NIN, DM}; pg8::StaticOrder S; S.init(MPAD, NIN, G, bx);
        pg8::EpiFoxIn E{ssq, args.in[13], args.in[14], args.in[12], ws, args.out};
        pg8::gemm_phase<pg8::EpiFoxIn, pg8::StaticOrder, PG8_ALIGN, PG8_SP2>(lds, g, S, E);
    }
#endif
    GSYNC();
#ifndef SKIP_P2
    { TIDS; p2_cumsum(args, gw, NGW, lane); }
#endif
    GSYNC();
#ifndef SKIP_P3
    { TIDS; p3_attention(args, lds, tid, w, lane, 0); }
#ifdef PROBE_P3
    GSYNC();
    { TIDS; p3_attention(args, lds, tid, w, lane, 1); }
#endif
#endif
    GSYNC();
#define RESID_GEMM(Ap, Wp, KK, CNTI, FIRSTF, LASTF) do { \
    pg8::StaticOrder S; S.init(MPAD, DM, G, bx); const int full_ = (S.nwg / G) * G, ntail_ = S.nwg - full_; S.lim = full_; \
    { pg8::Gemm g{(Ap), (Wp), MPAD, DM, (KK), (KK)}; pg8::EpiResidT<FIRSTF, LASTF> E{X, XB, ssq, args.in[0], args.in[1], args.in[8]}; pg8::gemm_phase<pg8::EpiResidT<FIRSTF, LASTF>, pg8::StaticOrder, PG8_ALIGN, PG8_SP2>(lds, g, S, E); } \
    if (ntail_ > 0) { const int sl_ = ntail_ * 8 <= G ? 8 : (ntail_ * 4 <= G ? 4 : (ntail_ * 2 <= G ? 2 : 1)); const int ks_ = (KK) / sl_; \
        pg8::TailOrder T{S, full_, ntail_, sl_, bx}; pg8::Gemm g{(Ap) + (bx % sl_) * ks_, (Wp) + (bx % sl_) * ks_, MPAD, DM, ks_, (KK)}; pg8::EpiPartial E{(float*)(ws + WS_P)}; \
        pg8::gemm_phase<pg8::EpiPartial, pg8::TailOrder, false, PG8_SP2>(lds, g, T, E); \
        { int tid_ = threadIdx.x; asm volatile("" : "+v"(tid_)); tail_finish<FIRSTF, LASTF>((const float*)(ws + WS_P), (unsigned*)(ws + WS_CTL) + 256 + (CNTI), S, full_, ntail_, sl_, bx, X, XB, ssq, lds, tid_, args.in[0], args.in[1], args.in[8]); } } } while (0)
#ifdef PROBE_UP
#define PROBE_UP_BODY(WUP) { pg8::Gemm g{XB, (const bf16*)(ws + (WUP)), MPAD, DFF, DM}; pg8::StaticOrder S; S.init(MPAD, DFF, G, bx); pg8::EpiUp E{ssq, (bf16*)(ws + WS_H)}; \
      pg8::gemm_phase<pg8::EpiUp, pg8::StaticOrder, PG8_ALIGN, PG8_SP2>(lds, g, S, E); } GSYNC();
#else
#define PROBE_UP_BODY(WUP)
#endif
#define LAYER_TAIL(AOP, WOUT, WUP, WDN, CNT0, FIRSTL, LASTL) do { \
    RESID_GEMM((const bf16*)(AOP), (const bf16*)(ws + (WOUT)), DM, CNT0, FIRSTL, false); \
    GSYNC(); \
    { pg8::Gemm g{XB, (const bf16*)(ws + (WUP)), MPAD, DFF, DM}; pg8::StaticOrder S; S.init(MPAD, DFF, G, bx); pg8::EpiUp E{ssq, (bf16*)(ws + WS_H)}; \
      pg8::gemm_phase<pg8::EpiUp, pg8::StaticOrder, PG8_ALIGN, PG8_SP2>(lds, g, S, E); } \
    GSYNC(); \
    PROBE_UP_BODY(WUP) \
    RESID_GEMM((const bf16*)(ws + WS_H), (const bf16*)(ws + (WDN)), DFF, CNT0 + 32, false, LASTL); \
    GSYNC(); } while (0)
#ifndef SKIP_L0
    LAYER_TAIL(ws + WS_OB, WS_WFOUT, WS_WUP0, WS_WDN0, 0, true, false);
#endif
#ifndef SKIP_P7
    {
        pg8::Gemm g{XB, (const bf16*)(ws + WS_WMIN), MPAD, NIN, DM}; pg8::StaticOrder S; S.init(MPAD, NIN, G, bx);
        pg8::EpiMlstmIn E{ssq, args.in[17], args.in[18], (bf16*)(ws + WS_MQ), (bf16*)(ws + WS_MK), (bf16*)(ws + WS_MV), (bf16*)(ws + WS_MO), (float*)(ws + WS_GI), (float*)(ws + WS_GF)};
        pg8::gemm_phase<pg8::EpiMlstmIn, pg8::StaticOrder, PG8_ALIGN, PG8_SP2>(lds, g, S, E);
    }
#endif
    GSYNC();
#ifndef SKIP_P8
    { TIDS; mlstm_a_phase(args, bx, G, lds, tid, w, lane); }
    GSYNC();
#ifdef PROBE_MA
    { TIDS; mlstm_a_phase(args, bx, G, lds, tid, w, lane); }
    GSYNC();
#endif
    { TIDS; for (int it = bx; it < 256 + 1024; it += G) mlstm_b_item(args, it, lds, tid, w, lane); }
#ifdef PROBE_MAB
    GSYNC();
    { TIDS; mlstm_a_phase(args, bx, G, lds, tid, w, lane); }
    GSYNC();
    { TIDS; for (int it = bx; it < 256 + 1024; it += G) mlstm_b_item(args, it, lds, tid, w, lane); }
#endif
#endif
    GSYNC();
#ifndef SKIP_P9
    { TIDS; p9_gate(args, gw, NGW, lane); }
#endif
    GSYNC();
#ifndef SKIP_L1
    LAYER_TAIL(ws + WS_MH, WS_WMOUT, WS_WUP1, WS_WDN1, 64, false, true);
#endif
#ifndef SKIP_P13
    { TIDS; p13_final(args, gw, NGW, lane); }
#ifdef PROBE_SYNC
    for (int i_ = 0; i_ < 16; ++i_) grid.sync();
#endif
#endif
}

extern "C" void kernel_launch(void* const* d_in, const int* in_sizes, int n_in, void* d_out, int out_size, void* d_ws, size_t ws_size, hipStream_t stream) {
    static int grid = 0;
    if (grid == 0) {
        if (n_in != 24 || (size_t)out_size != O_END || ws_size < WS_END) { fprintf(stderr, "kernel_launch: unexpected shapes: n_in %d out %d (want %zu) ws %zu (want >= %zu)\n", n_in, out_size, (size_t)O_END, ws_size, (size_t)WS_END); grid = -1; return; }
        int dev = 0, cus = 0, per_cu = 0;
        if (hipGetDevice(&dev) != hipSuccess || hipDeviceGetAttribute(&cus, hipDeviceAttributeMultiprocessorCount, dev) != hipSuccess) { grid = -1; return; }
        if (hipFuncSetAttribute((const void*)fwd_megakernel, hipFuncAttributeMaxDynamicSharedMemorySize, LDS_BYTES) != hipSuccess) { fprintf(stderr, "kernel_launch: hipFuncSetAttribute failed\n"); grid = -1; return; }
        if (hipOccupancyMaxActiveBlocksPerMultiprocessor(&per_cu, (const void*)fwd_megakernel, NTHR, LDS_BYTES) != hipSuccess || per_cu < 1) { fprintf(stderr, "kernel_launch: occupancy query says %d blocks per CU\n", per_cu); grid = -1; return; }
        grid = cus;
    }
    if (grid < 0) return;
    (void)hipMemsetAsync((char*)d_ws + WS_CTL, 0, 65536, stream);
    Args a{};
    for (int i = 0; i < 24; ++i) a.in[i] = (const float*)d_in[i];
    a.out = (float*)d_out; a.ws = (unsigned char*)d_ws;
    void* kargs[] = {&a};
    const hipError_t e = hipLaunchCooperativeKernel((const void*)fwd_megakernel, dim3(grid), dim3(NTHR), kargs, LDS_BYTES, stream);
    if (e != hipSuccess) fprintf(stderr, "kernel_launch: cooperative launch failed: %s (grid %d)\n", hipGetErrorString(e), grid);
}
```

```cpp
#include <hip/hip_runtime.h>
#include <hip/hip_cooperative_groups.h>
#include <cstdio>
#include <cstdint>
namespace cg = cooperative_groups;

constexpr int DM = 1024, TP = 4112, NB = 8, SEQL = 4096, NMETA = 16, DB = 32, DT = 32, PAST = 2048, DFF = 4096;
constexpr int MP = NB * TP;
constexpr int MTOT = MP + DB * DT;
constexpr int MPAD = 34048;
constexpr int NIN = 3328;
constexpr int PPAD = 240;
constexpr int PLEN = 4352;
constexpr int GSLEN = 2112;
constexpr float EPSN = 1e-6f;
constexpr float LOG2E = 1.4426950408889634f;
constexpr float QSCALE = 0.125f * LOG2E;

constexpr int NWAVES = 8, NTHR = 512;
constexpr int LDS_BYTES = 147456;
constexpr size_t MiB = 1u << 20;
constexpr size_t WS_CTL = 0;
constexpr size_t WS_WFIN = 1 * MiB, WS_WFOUT = 8 * MiB, WS_WMIN = 10 * MiB, WS_WMOUT = 17 * MiB, WS_WUP0 = 19 * MiB, WS_WUP1 = 27 * MiB, WS_WDN0 = 35 * MiB, WS_WDN1 = 43 * MiB;
constexpr size_t WS_SSQ = 51 * MiB, WS_G = 54 * MiB, WS_GS = 57 * MiB, WS_GI = 62 * MiB, WS_GF = 63 * MiB, WS_HSSQ = 64 * MiB;
constexpr size_t WS_X = 74 * MiB, WS_XB = 207 * MiB;
constexpr size_t WS_QB = 274 * MiB, WS_KB = 343 * MiB, WS_VB = 411 * MiB, WS_OB = 478 * MiB, WS_H = 274 * MiB;
constexpr size_t WS_MQ = 546 * MiB, WS_MK = 580 * MiB, WS_MV = 614 * MiB, WS_MO = 682 * MiB, WS_MH = 750 * MiB, WS_U = 818 * MiB, WS_RS = 958 * MiB, WS_NU = 959 * MiB, WS_P = 961 * MiB, WS_BBC = 1001 * MiB, WS_PMC = 1002 * MiB, WS_END = 1003 * MiB;
static_assert(WS_H + (size_t)MPAD * DFF * 2 <= WS_MQ && WS_OB + (size_t)MPAD * DM * 2 <= WS_MQ && WS_VB + (size_t)MPAD * DM * 2 <= WS_OB && WS_KB + (size_t)MPAD * DM * 2 <= WS_VB - MiB && WS_QB + (size_t)MPAD * DM * 2 <= WS_KB - MiB, "ws map");
static_assert(WS_G + (size_t)NB * 16 * PLEN * 4 <= WS_GS && WS_GS + (size_t)DB * 16 * GSLEN * 4 <= WS_GI && WS_HSSQ + (size_t)MPAD * 64 * 4 <= WS_X && WS_SSQ + (size_t)MPAD * 64 <= WS_G, "ws map 2");

struct Args { const float* in[24]; float* out; unsigned char* ws; };

constexpr size_t O_YP = 0, O_YS = O_YP + (size_t)NB * SEQL * DM, O_FKP = O_YS + (size_t)DB * DT * DM, O_FVP = O_FKP + (size_t)MP * DM, O_FLP = O_FVP + (size_t)MP * DM,
    O_MCP = O_FLP + (size_t)MP * 16, O_MNP = O_MCP + (size_t)NB * 4 * 256 * 128, O_MMP = O_MNP + (size_t)NB * 4 * 128, O_FKS = O_MMP + (size_t)NB * 4,
    O_FVS = O_FKS + (size_t)DB * DT * DM, O_FLS = O_FVS + (size_t)DB * DT * DM, O_MCS = O_FLS + (size_t)DB * DT * 16, O_MNS = O_MCS + (size_t)DB * 4 * 256 * 128,
    O_MMS = O_MNS + (size_t)DB * 4 * 128, O_END = O_MMS + (size_t)DB * 4;

namespace pg8 {
#define PG8_LAS __attribute__((address_space(3)))
typedef unsigned short bf16_t;
typedef short bf16x8 __attribute__((ext_vector_type(8)));
typedef float f32x4 __attribute__((ext_vector_type(4)));
typedef unsigned u32x4 __attribute__((ext_vector_type(4)));
constexpr int BM = 256, BK = 64, HALF = 128, HTB = HALF * BK * 2  , STAGE_BYTES = 8 * HTB, NXCD = 8, WGM = 8;

__host__ __device__ __forceinline__ int lds_byte(int r, int c) { const int st = (r >> 4) * 2 + (c >> 5), rr = r & 15, cc = c & 31, ob = rr * 64 + cc * 2; return st * 1024 + (ob ^ (((ob >> 9) & 1) << 5)); }
__host__ __device__ __forceinline__ void stage_rc(int b, int& R, int& C) { const int st = b / 1024, sb = b % 1024, swz = sb ^ (((sb >> 9) & 1) << 5); R = (st >> 1) * 16 + swz / 64; C = (st & 1) * 32 + (swz % 64) / 2; }
__host__ __device__ __forceinline__ int perm32(int rho) { const int n = rho >> 4, i = rho & 15; return 8 * (i >> 2) + 4 * n + (i & 3); }

struct Unit { int pm, pn, aux; };
struct Gemm { const bf16_t* A; const bf16_t* Bt; int M, N, K, ld; };

struct StaticOrder {
    int nM, nN, nwg, G, c, lim;
    __host__ __device__ void init(int M, int N, int G_, int c_) { nM = M / BM; nN = N / BM; nwg = nM * nN; G = G_; c = c_; lim = nwg; }
    __host__ __device__ bool next(int i, Unit& u) const { const long L = (long)i * G + c; if (L >= lim) return false; map((int)L, u); return true; }
    __host__ __device__ void map(int L, Unit& u) const {
        int wgid = L; { const int q = nwg / NXCD, r = nwg % NXCD, xcd = wgid % NXCD, off = wgid / NXCD; wgid = (xcd < r ? xcd * (q + 1) : r * (q + 1) + (xcd - r) * q) + off; }
        const int nig = WGM * nN, gid = wgid / nig, fm = gid * WGM, gsz = (nM - fm) < WGM ? (nM - fm) : WGM;
        u.pm = fm + ((wgid % nig) % gsz); u.pn = (wgid % nig) / gsz;
    }
    __device__ __forceinline__ void a_ready(const Unit&) const {}
    __device__ __forceinline__ void done(const Unit&) const {}
};


struct TailOrder {
    StaticOrder base; int first, ntail, slices, c;
    __device__ bool next(int i, Unit& u) const { if (i > 0) return false; const int tu = c / slices; if (tu >= ntail) return false; base.map(first + tu, u); u.aux = c; return true; }
    __device__ __forceinline__ void a_ready(const Unit&) const {}
    __device__ __forceinline__ void done(const Unit&) const {}
};

typedef float f32x2_cv __attribute__((ext_vector_type(2))); typedef __bf16 bf16x2_cv __attribute__((ext_vector_type(2)));
__device__ __forceinline__ unsigned cvt_pk_bf16(float lo, float hi) { const f32x2_cv v = {lo, hi}; const bf16x2_cv b = __builtin_convertvector(v, bf16x2_cv); return __builtin_bit_cast(unsigned, b); }
__device__ __forceinline__ u32x4 pack8(const f32x4 a, const f32x4 b) { u32x4 w; w.x = cvt_pk_bf16(a[0], a[1]); w.y = cvt_pk_bf16(a[2], a[3]); w.z = cvt_pk_bf16(b[0], b[1]); w.w = cvt_pk_bf16(b[2], b[3]); return w; }
__device__ __forceinline__ float row_rstd(const float* ssq, int row, int fq) {
    const f32x4 v = *(const f32x4*)(ssq + (size_t)row * 16 + 4 * fq);
    float s = (v[0] + v[1]) + (v[2] + v[3]);
    s += __shfl_xor(s, 16); s += __shfl_xor(s, 32);
    return __builtin_amdgcn_rsqf(s * (1.0f / 1024.0f) + EPSN);
}
__device__ __forceinline__ float log_sigmoid_f(float x) { return fminf(x, 0.f) - log1pf(__expf(-fabsf(x))); }

struct EpiFoxIn {
    static constexpr bool PERM = true, AFTER_DRAIN = false;
    const float* ssq; const float* gq; const float* gk; const float* bfv;
    unsigned char* ws; float* out;
    __device__ __forceinline__ void operator()(const f32x4 (&acc)[2][2][4][2], const Unit& u, int wr, int wc, int fr, int fq) const {
        const int pn = u.pn, sect = pn >> 2;
        f32x4 gv[2][2];
        if (sect < 2) {
#pragma unroll
            for (int bj = 0; bj < 2; ++bj)
#pragma unroll
                for (int n = 0; n < 2; ++n) { const f32x4 a = *(const f32x4*)(gq + 32 * bj + 8 * fq + 4 * n) * QSCALE, b = *(const f32x4*)(gk + 32 * bj + 8 * fq + 4 * n); gv[bj][n] = sect == 0 ? a : b; } }
        const int cb = (pn & 3) * 256 + wc * 64 + 8 * fq;
        float rsv[2][4];
#pragma unroll
        for (int ai = 0; ai < 2; ++ai)
#pragma unroll
            for (int m = 0; m < 4; ++m) rsv[ai][m] = row_rstd(ssq, u.pm * BM + ai * HALF + wr * 64 + m * 16 + fr, fq);
#pragma unroll
        for (int ai = 0; ai < 2; ++ai)
#pragma unroll
            for (int m = 0; m < 4; ++m) {
                const int row = u.pm * BM + ai * HALF + wr * 64 + m * 16 + fr;
                const float rs = rsv[ai][m];
                f32x4 v[2][2];
#pragma unroll
                for (int bj = 0; bj < 2; ++bj)
#pragma unroll
                    for (int n = 0; n < 2; ++n) v[bj][n] = acc[ai][bj][m][n] * rs;
                if (sect < 2) {
                    float ss = 0.f;
#pragma unroll
                    for (int bj = 0; bj < 2; ++bj)
#pragma unroll
                        for (int n = 0; n < 2; ++n) { const f32x4 x = v[bj][n]; ss += (x[0] * x[0] + x[1] * x[1]) + (x[2] * x[2] + x[3] * x[3]); }
                    ss += __shfl_xor(ss, 16); ss += __shfl_xor(ss, 32);
                    const float hr = __builtin_amdgcn_rsqf(ss * (1.0f / 64.0f) + EPSN);
#pragma unroll
                    for (int bj = 0; bj < 2; ++bj)
#pragma unroll
                        for (int n = 0; n < 2; ++n) v[bj][n] = v[bj][n] * hr * gv[bj][n];
                }
                const bool real = row < MTOT; const int grp = row < MP ? 0 : 1; const size_t orow = grp == 0 ? (size_t)row : (size_t)(row - MP);
                if (sect == 0) {
#pragma unroll
                    for (int bj = 0; bj < 2; ++bj) __builtin_nontemporal_store(pack8(v[bj][0], v[bj][1]), (u32x4*)((bf16_t*)(ws + WS_QB) + (size_t)row * DM + cb + 32 * bj));
                } else if (sect < 3) {
                    bf16_t* B16 = (bf16_t*)(ws + (sect == 1 ? WS_KB : WS_VB)); float* of = out + (sect == 1 ? (grp == 0 ? O_FKP : O_FKS) : (grp == 0 ? O_FVP : O_FVS));
#pragma unroll
                    for (int bj = 0; bj < 2; ++bj) __builtin_nontemporal_store(pack8(v[bj][0], v[bj][1]), (u32x4*)(B16 + (size_t)row * DM + cb + 32 * bj));
                    (void)of; (void)real;
                } else if (pn == 12 && wc == 0 && fq < 2 && real) {
#pragma unroll
                    for (int n = 0; n < 2; ++n) { const int h0 = 8 * fq + 4 * n; const f32x4 bb = *(const f32x4*)(bfv + h0); f32x4 o;
#pragma unroll
                        for (int j = 0; j < 4; ++j) o[j] = log_sigmoid_f(v[0][n][j] + bb[j]);
                        *(f32x4*)(out + (grp == 0 ? O_FLP : O_FLS) + orow * 16 + h0) = o; }
                }
            }
    }
};

__device__ __forceinline__ void first_resid(const float* xp, const float* xs, const float* meta, int row, int col, f32x4& x0, f32x4& x1) {
    x0 = (f32x4){0.f, 0.f, 0.f, 0.f}; x1 = x0;
    if (row < MP) { const int b = row / TP, t = row - b * TP;
        if (t < NMETA) { const float* p = meta + (size_t)t * DM + col; x0 = *(const f32x4*)p; x1 = *(const f32x4*)(p + 4); }
        else { const float* p = xp + ((size_t)b * SEQL + (t - NMETA)) * DM + col; x0 = *(const f32x4*)p; x1 = *(const f32x4*)(p + 4); } }
    else if (row < MTOT) { const float* p = xs + (size_t)(row - MP) * DM + col; x0 = *(const f32x4*)p; x1 = *(const f32x4*)(p + 4); }
}
template <bool FIRST, bool LAST = false> struct EpiResidT {
    static constexpr bool PERM = true, AFTER_DRAIN = false;
    float* X; bf16_t* XB; float* ssq; const float* xp; const float* xs; const float* meta;
    __device__ __forceinline__ void operator()(const f32x4 (&acc)[2][2][4][2], const Unit& u, int wr, int wc, int fr, int fq) const {
#pragma unroll
        for (int ai = 0; ai < 2; ++ai)
#pragma unroll
            for (int m = 0; m < 4; ++m) {
                const int row = u.pm * BM + ai * HALF + wr * 64 + m * 16 + fr; float ss = 0.f;
#pragma unroll
                for (int bj = 0; bj < 2; ++bj) { const size_t off = (size_t)row * DM + u.pn * BM + bj * HALF + wc * 32 + 8 * fq;
                    f32x4 x0, x1;
                    if (FIRST) first_resid(xp, xs, meta, row, u.pn * BM + bj * HALF + wc * 32 + 8 * fq, x0, x1);
                    else { const u32x4 r = *(const u32x4*)(XB + off);
                        x0 = (f32x4){__builtin_bit_cast(float, r.x << 16), __builtin_bit_cast(float, r.x & 0xffff0000u), __builtin_bit_cast(float, r.y << 16), __builtin_bit_cast(float, r.y & 0xffff0000u)};
                        x1 = (f32x4){__builtin_bit_cast(float, r.z << 16), __builtin_bit_cast(float, r.z & 0xffff0000u), __builtin_bit_cast(float, r.w << 16), __builtin_bit_cast(float, r.w & 0xffff0000u)}; }
                    x0 = x0 + acc[ai][bj][m][0]; x1 = x1 + acc[ai][bj][m][1];
                    *(u32x4*)(XB + off) = pack8(x0, x1);
                    ss += (x0[0] * x0[0] + x0[1] * x0[1]) + (x0[2] * x0[2] + x0[3] * x0[3]) + (x1[0] * x1[0] + x1[1] * x1[1]) + (x1[2] * x1[2] + x1[3] * x1[3]); }
                ss += __shfl_xor(ss, 16); ss += __shfl_xor(ss, 32);
                if (fq == 0) ssq[(size_t)row * 16 + u.pn * 4 + wc] = ss;
                if (m & 1) asm volatile("" ::: "memory");
            }
    }
};

struct EpiUp {
    static constexpr bool PERM = true, AFTER_DRAIN = false;
    const float* ssq; bf16_t* H;
    __device__ __forceinline__ void operator()(const f32x4 (&acc)[2][2][4][2], const Unit& u, int wr, int wc, int fr, int fq) const {
#pragma unroll
        for (int ai = 0; ai < 2; ++ai)
#pragma unroll
            for (int m = 0; m < 4; ++m) {
                const int row = u.pm * BM + ai * HALF + wr * 64 + m * 16 + fr; const float rs = row_rstd(ssq, row, fq);
#pragma unroll
                for (int bj = 0; bj < 2; ++bj) { f32x4 a = acc[ai][bj][m][0] * rs, b = acc[ai][bj][m][1] * rs;
#pragma unroll
                    for (int j = 0; j < 4; ++j) { a[j] = fmaxf(a[j], 0.f); a[j] *= a[j]; b[j] = fmaxf(b[j], 0.f); b[j] *= b[j]; }
                    __builtin_nontemporal_store(pack8(a, b), (u32x4*)(H + (size_t)row * DFF + u.pn * BM + bj * HALF + wc * 32 + 8 * fq)); }
            }
    }
};

struct EpiMlstmIn {
    static constexpr bool PERM = true, AFTER_DRAIN = false;
    const float* ssq; const float* bi; const float* bfv;
    bf16_t* MQ; bf16_t* MK; bf16_t* MV; bf16_t* MO; float* GI; float* GF;
    __device__ __forceinline__ void operator()(const f32x4 (&acc)[2][2][4][2], const Unit& u, int wr, int wc, int fr, int fq) const {
        const int pn = u.pn;
#pragma unroll
        for (int ai = 0; ai < 2; ++ai)
#pragma unroll
            for (int m = 0; m < 4; ++m) {
                const int row = u.pm * BM + ai * HALF + wr * 64 + m * 16 + fr; const float rs = row_rstd(ssq, row, fq);
                if (pn < 12) {
#pragma unroll
                    for (int bj = 0; bj < 2; ++bj) { f32x4 a = acc[ai][bj][m][0] * rs, b = acc[ai][bj][m][1] * rs; const int c = pn * BM + bj * HALF + wc * 32 + 8 * fq;
                        if (pn < 2) __builtin_nontemporal_store(pack8(a, b), (u32x4*)(MQ + (size_t)row * 512 + c));
                        else if (pn < 4) { a = a * 0.08838834764831845f; b = b * 0.08838834764831845f; __builtin_nontemporal_store(pack8(a, b), (u32x4*)(MK + (size_t)row * 512 + (c - 512))); }
                        else if (pn < 8) __builtin_nontemporal_store(pack8(a, b), (u32x4*)(MV + (size_t)row * DM + (c - 1024)));
                        else {
#pragma unroll
                            for (int j = 0; j < 4; ++j) { a[j] = 1.0f / (1.0f + __expf(-a[j])); b[j] = 1.0f / (1.0f + __expf(-b[j])); }
                            __builtin_nontemporal_store(pack8(a, b), (u32x4*)(MO + (size_t)row * DM + (c - 2048))); } }
                } else if (wc == 0 && fq == 0) {
                    const f32x4 a = acc[ai][0][m][0] * rs, b = acc[ai][0][m][1] * rs; const f32x4 vbi = *(const f32x4*)bi, vbf = *(const f32x4*)bfv; f32x4 oi, of;
#pragma unroll
                    for (int j = 0; j < 4; ++j) { oi[j] = a[j] + vbi[j]; of[j] = log_sigmoid_f(b[j] + vbf[j]); }
                    *(f32x4*)(GI + (size_t)row * 4) = oi; *(f32x4*)(GF + (size_t)row * 4) = of;
                }
            }
    }
};


struct EpiPartial {
    static constexpr bool PERM = true, AFTER_DRAIN = false;
    float* P;
    __device__ __forceinline__ void operator()(const f32x4 (&acc)[2][2][4][2], const Unit& u, int wr, int wc, int fr, int fq) const {
#pragma unroll
        for (int ai = 0; ai < 2; ++ai)
#pragma unroll
            for (int m = 0; m < 4; ++m)
#pragma unroll
                for (int bj = 0; bj < 2; ++bj) { float* p = P + (size_t)u.aux * 65536 + (size_t)(ai * HALF + wr * 64 + m * 16 + fr) * 256 + bj * HALF + wc * 32 + 8 * fq;
                    *(f32x4*)p = acc[ai][bj][m][0]; *(f32x4*)(p + 4) = acc[ai][bj][m][1]; }
    }
};
template <class Epi, class Sched, bool ALIGN_EPI = false, bool SP2 = false>
__device__ __forceinline__ void gemm_phase(PG8_LAS unsigned char* lds, const Gemm g, const Sched& S, const Epi& E) {
    int tid_o = threadIdx.x; asm volatile("" : "+v"(tid_o));
    const int tid = tid_o, wid = __builtin_amdgcn_readfirstlane(tid >> 6), lane = tid & 63, wr = wid >> 2, wc = wid & 3, fr = lane & 15, fq = lane >> 4;
    const int K = g.K, nt = K / BK, ld = g.ld ? g.ld : g.K;
    unsigned voffA[2], voffB[2];
#pragma unroll
    for (int i = 0; i < 2; ++i) { int R, C; stage_rc(tid * 16 + i * 8192, R, C); const int Rb = Epi::PERM ? ((R & ~31) + perm32(R & 31)) : R;
        voffA[i] = (unsigned)(R * ld + C) * 2u; voffB[i] = (unsigned)(Rb * ld + C) * 2u; }
    const size_t kstep = (size_t)(BK * 2);
    const size_t hstep = (size_t)HALF * ld * 2;
    const size_t tstep = 2 * hstep;
    const unsigned ldsw = (unsigned)wid * 1024u;
    const int aoff = lds_byte(wr * 64 + fr, fq * 8), boff = lds_byte(wc * 32 + fr, fq * 8);
#define PG8_SA(b, h) (((b) * 2 + (h)) * HTB)
#define PG8_SB(b, h) ((4 + (b) * 2 + (h)) * HTB)
#define PG8_STAGE(bufoff, gbase, voff) do { _Pragma("unroll") for (int _i = 0; _i < 2; ++_i) \
        __builtin_amdgcn_global_load_lds((const unsigned*)((const char*)(gbase) + (voff)[_i]), (PG8_LAS unsigned*)(lds + (bufoff) + ldsw + _i * 8192), 16, 0, 0); } while (0)
#define PG8_LDA(dst, b, h) do { _Pragma("unroll") for (int m = 0; m < 4; ++m) _Pragma("unroll") for (int k = 0; k < 2; ++k) dst[m][k] = *(const PG8_LAS bf16x8*)(lds + PG8_SA(b, h) + aoff + m * 2048 + k * 1024); } while (0)
#define PG8_LDB(dst, b, h) do { _Pragma("unroll") for (int n = 0; n < 2; ++n) _Pragma("unroll") for (int k = 0; k < 2; ++k) dst[n][k] = *(const PG8_LAS bf16x8*)(lds + PG8_SB(b, h) + boff + n * 2048 + k * 1024); } while (0)
#define PG8_MMA(ai, bj, At, Bt) do { __builtin_amdgcn_s_setprio(1); _Pragma("unroll") for (int m = 0; m < 4; ++m) _Pragma("unroll") for (int n = 0; n < 2; ++n) _Pragma("unroll") for (int k = 0; k < 2; ++k) \
        acc[ai][bj][m][n] = __builtin_amdgcn_mfma_f32_16x16x32_bf16(Bt[n][k], At[m][k], acc[ai][bj][m][n], 0, 0, 0); __builtin_amdgcn_s_setprio(0); } while (0)
#define PG8_WAIT_V(n) asm volatile("s_waitcnt vmcnt(" #n ")" ::: "memory")
#define PG8_WAIT_L(n) asm volatile("s_waitcnt lgkmcnt(" #n ")" ::: "memory")
#define PG8_BAR __builtin_amdgcn_s_barrier()
#define PG8_SCHED __builtin_amdgcn_sched_barrier(0)
    Unit cur, nxt; int ui = 0;
    if (!S.next(0, cur)) return;
    f32x4 acc[2][2][4][2];
#pragma unroll
    for (int a = 0; a < 2; ++a)
#pragma unroll
        for (int b = 0; b < 2; ++b)
#pragma unroll
            for (int m = 0; m < 4; ++m)
#pragma unroll
                for (int n = 0; n < 2; ++n) acc[a][b][m][n] = (f32x4){0.f, 0.f, 0.f, 0.f};
    bf16x8 At[4][2], B0[2][2], B1[2][2];
    const char* cA = (const char*)g.A + (size_t)cur.pm * tstep; const char* cB = (const char*)g.Bt + (size_t)cur.pn * tstep;
    S.a_ready(cur);
    if constexpr (SP2) {
        PG8_STAGE(PG8_SB(0, 0), cB, voffB); PG8_STAGE(PG8_SB(0, 1), cB + hstep, voffB); PG8_STAGE(PG8_SA(0, 0), cA, voffA); PG8_STAGE(PG8_SA(0, 1), cA + hstep, voffA);
        if (wr == 1) PG8_BAR;
        PG8_WAIT_V(2); PG8_BAR;
        PG8_STAGE(PG8_SB(1, 0), cB + kstep, voffB); PG8_STAGE(PG8_SA(1, 0), cA + kstep, voffA); PG8_STAGE(PG8_SB(1, 1), cB + hstep + kstep, voffB);
        PG8_WAIT_V(6); PG8_BAR;
    } else {
        PG8_STAGE(PG8_SB(0, 0), cB, voffB); PG8_STAGE(PG8_SA(0, 0), cA, voffA); PG8_STAGE(PG8_SB(0, 1), cB + hstep, voffB); PG8_STAGE(PG8_SA(0, 1), cA + hstep, voffA);
        if (wr == 1) PG8_BAR;
        PG8_WAIT_V(4); PG8_BAR;
        PG8_STAGE(PG8_SB(1, 0), cB + kstep, voffB); PG8_STAGE(PG8_SA(1, 0), cA + kstep, voffA); PG8_STAGE(PG8_SB(1, 1), cB + hstep + kstep, voffB);
        PG8_WAIT_V(6); PG8_BAR;
    }
    for (;;) {
        const bool has_next = S.next(ui + 1, nxt);
        const char* nA = has_next ? (const char*)g.A + (size_t)nxt.pm * tstep : cA; const char* nB = has_next ? (const char*)g.Bt + (size_t)nxt.pn * tstep : cB;
        for (int t = 0; t < nt; t += 2) {
            const bool last = (t == nt - 2);
            const char* a1 = cA + (size_t)(t + 1) * kstep;
            const char* a2 = last ? nA : cA + (size_t)(t + 2) * kstep; const char* b2 = last ? nB : cB + (size_t)(t + 2) * kstep;
            const char* a3 = a2 + kstep; const char* b3 = b2 + kstep;
            if (last && has_next) S.a_ready(nxt);
            if constexpr (SP2) {
            PG8_LDB(B0, 0, 0); PG8_LDB(B1, 0, 1); PG8_SCHED; PG8_LDA(At, 0, 0); PG8_STAGE(PG8_SA(1, 1), a1 + hstep, voffA);
            PG8_WAIT_V(8); PG8_WAIT_L(0); PG8_BAR; PG8_MMA(0, 0, At, B0); PG8_MMA(0, 1, At, B1); PG8_BAR; PG8_SCHED;
            PG8_LDA(At, 0, 1); PG8_STAGE(PG8_SB(0, 0), b2, voffB); PG8_STAGE(PG8_SB(0, 1), b2 + hstep, voffB); PG8_STAGE(PG8_SA(0, 0), a2, voffA);
            PG8_WAIT_V(8); PG8_WAIT_L(0); PG8_BAR; PG8_MMA(1, 0, At, B0); PG8_MMA(1, 1, At, B1); PG8_BAR; PG8_SCHED;
            PG8_LDB(B0, 1, 0); PG8_LDB(B1, 1, 1); PG8_SCHED; PG8_LDA(At, 1, 0); PG8_STAGE(PG8_SA(0, 1), a2 + hstep, voffA);
            PG8_WAIT_V(8); PG8_WAIT_L(0); PG8_BAR; PG8_MMA(0, 0, At, B0); PG8_MMA(0, 1, At, B1); PG8_BAR; PG8_SCHED;
            PG8_LDA(At, 1, 1); PG8_STAGE(PG8_SB(1, 0), b3, voffB); PG8_STAGE(PG8_SB(1, 1), b3 + hstep, voffB); PG8_STAGE(PG8_SA(1, 0), a3, voffA);
            PG8_WAIT_V(8); PG8_WAIT_L(0); PG8_BAR; PG8_MMA(1, 0, At, B0); PG8_MMA(1, 1, At, B1); PG8_BAR; PG8_SCHED;
            } else {
            PG8_LDB(B0, 0, 0); PG8_SCHED; PG8_LDA(At, 0, 0); PG8_STAGE(PG8_SA(1, 1), a1 + hstep, voffA);
            PG8_WAIT_L(8); PG8_BAR; PG8_WAIT_L(0); PG8_MMA(0, 0, At, B0); PG8_BAR; PG8_SCHED;
            PG8_LDB(B1, 0, 1); PG8_STAGE(PG8_SB(0, 0), b2, voffB);
            PG8_BAR; PG8_WAIT_L(0); PG8_MMA(0, 1, At, B1); PG8_BAR;
            PG8_LDA(At, 0, 1); PG8_STAGE(PG8_SA(0, 0), a2, voffA);
            PG8_BAR; PG8_WAIT_L(0); PG8_MMA(1, 0, At, B0); PG8_BAR; PG8_SCHED;
            PG8_STAGE(PG8_SB(0, 1), b2 + hstep, voffB);
            PG8_WAIT_V(6); PG8_BAR; PG8_MMA(1, 1, At, B1); PG8_BAR;
            PG8_LDB(B0, 1, 0); PG8_SCHED; PG8_LDA(At, 1, 0); PG8_STAGE(PG8_SA(0, 1), a2 + hstep, voffA);
            PG8_WAIT_L(8); PG8_BAR; PG8_WAIT_L(0); PG8_MMA(0, 0, At, B0); PG8_BAR; PG8_SCHED;
            PG8_LDB(B1, 1, 1); PG8_STAGE(PG8_SB(1, 0), b3, voffB);
            PG8_BAR; PG8_WAIT_L(0); PG8_MMA(0, 1, At, B1); PG8_BAR;
            PG8_LDA(At, 1, 1); PG8_STAGE(PG8_SA(1, 0), a3, voffA);
            PG8_BAR; PG8_WAIT_L(0); PG8_MMA(1, 0, At, B0); PG8_BAR; PG8_SCHED;
            PG8_STAGE(PG8_SB(1, 1), b3 + hstep, voffB);
            PG8_WAIT_V(6); PG8_BAR; PG8_MMA(1, 1, At, B1); PG8_BAR;
            }
        }
        if constexpr (ALIGN_EPI) { if (wr == 0) PG8_BAR; }
        if constexpr (!Epi::AFTER_DRAIN) { E(acc, cur, wr, wc, fr, fq); S.done(cur); }
        if (!has_next) break;
#pragma unroll
        for (int a = 0; a < 2; ++a)
#pragma unroll
            for (int b = 0; b < 2; ++b)
#pragma unroll
                for (int m = 0; m < 4; ++m)
#pragma unroll
                    for (int n = 0; n < 2; ++n) acc[a][b][m][n] = (f32x4){0.f, 0.f, 0.f, 0.f};
        cur = nxt; cA = nA; cB = nB; ++ui;
        if constexpr (ALIGN_EPI) { if (wr == 1) PG8_BAR; }
    }
    PG8_WAIT_V(0);
    if constexpr (!ALIGN_EPI) { if (wr == 0) PG8_BAR; }
    PG8_BAR;
    if constexpr (Epi::AFTER_DRAIN) { E.fused(acc, cur, wr, wc, fr, fq, lds, wid, lane); S.done(cur); }
#undef PG8_SA
#undef PG8_SB
#undef PG8_STAGE
#undef PG8_LDA
#undef PG8_LDB
#undef PG8_MMA
#undef PG8_WAIT_V
#undef PG8_WAIT_L
#undef PG8_BAR
#undef PG8_SCHED
}
}

#ifndef PG8_SP2
#define PG8_SP2 true
#endif
#ifndef PG8_ALIGN
#define PG8_ALIGN true
#endif

#define LAS __attribute__((address_space(3)))
typedef unsigned short bf16;
typedef unsigned u32x4 __attribute__((ext_vector_type(4)));
typedef unsigned u32x2 __attribute__((ext_vector_type(2)));
typedef float f32x4 __attribute__((ext_vector_type(4)));
typedef float f32x16 __attribute__((ext_vector_type(16)));
typedef short bf16x8 __attribute__((ext_vector_type(8)));
typedef short v4i16_t __attribute__((ext_vector_type(4)));
typedef LAS unsigned char* lptr;
typedef const LAS unsigned char* clptr;

__device__ __forceinline__ unsigned f2bf(float f) { unsigned u = __builtin_bit_cast(unsigned, f); return (u + 0x7fffu + ((u >> 16) & 1u)) >> 16; }
__device__ __forceinline__ unsigned pk2(float lo, float hi) { return pg8::cvt_pk_bf16(lo, hi); }
__device__ __forceinline__ float bf2f(unsigned short b) { return __builtin_bit_cast(float, (unsigned)b << 16); }
__device__ __forceinline__ float wave_sum(float v) {
#pragma unroll
    for (int o = 1; o < 64; o <<= 1) v += __shfl_xor(v, o);
    return v;
}
#define LDS_WAIT() asm volatile("s_waitcnt lgkmcnt(0)" ::: "memory")
#define LDS_BARRIER() asm volatile("s_waitcnt lgkmcnt(0)\n\ts_barrier" ::: "memory")

__device__ __forceinline__ void p0_transpose_item(const float* W, int K, int N, bf16* WT, const float* g, bool foxperm, LAS float* scr, int item, int nblk, int lane) {
    const int kb = item / nblk, nb = item % nblk, k0 = 64 * kb, n0 = 32 * nb;
    {
        const int n = n0 + (lane & 31); const bool inb = n < N; const float* wp = W + (size_t)(k0 + (lane >> 5)) * N + n; float wv[32], gv[32];
#pragma unroll
        for (int i = 0; i < 32; ++i) { wv[i] = inb ? wp[(size_t)(2 * i) * N] : 0.f; gv[i] = g ? g[k0 + 2 * i + (lane >> 5)] : 1.f; }
#pragma unroll
        for (int i = 0; i < 32; ++i) scr[(2 * i + (lane >> 5)) * 33 + (lane & 31)] = wv[i] * gv[i];
    }
    LDS_WAIT(); asm volatile("" ::: "memory");
    const int c = lane & 7;
    int prow0 = n0;
    if (foxperm) { const int l = n0 & 255; prow0 = (n0 & ~255) + 128 * ((l >> 5) & 1) + 32 * ((l >> 6) & 3); }
#pragma unroll
    for (int j = 0; j < 4; ++j) { const int n = (lane >> 3) + 8 * j; const LAS float* s = scr + (8 * c) * 33 + n;
        u32x4 o; o.x = pk2(s[0 * 33], s[1 * 33]); o.y = pk2(s[2 * 33], s[3 * 33]); o.z = pk2(s[4 * 33], s[5 * 33]); o.w = pk2(s[6 * 33], s[7 * 33]);
        *(u32x4*)(WT + (size_t)(prow0 + n) * K + k0 + 8 * c) = o; }
    LDS_WAIT(); asm volatile("" ::: "memory");
}

__device__ __forceinline__ void p0_prologue(const Args& A, lptr lds, int gw, int NGW, int wave, int lane) {
    unsigned char* ws = A.ws;
    LAS float* scr = (LAS float*)(lds + wave * 16384);
    int base = 0;
#define WJOB(Wp, K_, N_, NP_, dst_, g_, perm_) do { const int nblk = (NP_) / 32, nitems = ((K_) / 64) * nblk; int first = (gw - base) % NGW; if (first < 0) first += NGW; \
        for (int it = first; it < nitems; it += NGW) p0_transpose_item((Wp), (K_), (N_), (bf16*)(ws + (dst_)), (g_), (perm_), scr, it, nblk, lane); base = (base + nitems) % NGW; } while (0)
    WJOB(A.in[11], DM, 3088, NIN, WS_WFIN, A.in[9], true);
    WJOB(A.in[15], DM, DM, DM, WS_WFOUT, (const float*)nullptr, false);
    WJOB(A.in[16], DM, 3080, NIN, WS_WMIN, A.in[9] + DM, false);
    WJOB(A.in[20], DM, DM, DM, WS_WMOUT, A.in[19], false);
    WJOB(A.in[21], DM, DFF, DFF, WS_WUP0, A.in[10], false);
    WJOB(A.in[21] + (size_t)DM * DFF, DM, DFF, DFF, WS_WUP1, A.in[10] + DM, false);
    WJOB(A.in[22], DFF, DM, DM, WS_WDN0, (const float*)nullptr, false);
    WJOB(A.in[22] + (size_t)DFF * DM, DFF, DM, DM, WS_WDN1, (const float*)nullptr, false);
#undef WJOB
    bf16* XB = (bf16*)(ws + WS_XB); float* ssq = (float*)(ws + WS_SSQ);
    for (int row0 = gw; row0 < MPAD; row0 += 4 * NGW) {
        f32x4 v[4][4];
#pragma unroll
        for (int u = 0; u < 4; ++u) { const int row = row0 + u * NGW; const float* src = nullptr;
            if (row < MP) { const int b = row / TP, t = row - b * TP; src = t < NMETA ? A.in[8] + (size_t)t * DM : A.in[0] + ((size_t)b * SEQL + (t - NMETA)) * DM; }
            else if (row < MTOT) src = A.in[1] + (size_t)(row - MP) * DM;
#pragma unroll
            for (int j = 0; j < 4; ++j) v[u][j] = src ? *(const f32x4*)(src + 256 * j + 4 * lane) : (f32x4){0.f, 0.f, 0.f, 0.f}; }
#pragma unroll
        for (int u = 0; u < 4; ++u) { const int row = row0 + u * NGW; if (row >= MPAD) break;
            float s = 0.f;
#pragma unroll
            for (int j = 0; j < 4; ++j) { const f32x4 x = v[u][j];
                u32x2 o;
                o.x = pk2(x[0], x[1]); o.y = pk2(x[2], x[3]); *(u32x2*)(XB + (size_t)row * DM + 256 * j + 4 * lane) = o;
                s += (x[0] * x[0] + x[1] * x[1]) + (x[2] * x[2] + x[3] * x[3]); }
            s = wave_sum(s);
            if (lane < 16) ssq[(size_t)row * 16 + lane] = lane == 0 ? s : 0.f; }
    }
    { const u32x4 z = {0u, 0u, 0u, 0u}; const int nchunk = PPAD * DM * 2 / 16;
        for (int i = gw * 64 + lane; i < nchunk; i += NGW * 64) { *(u32x4*)(ws + WS_KB - (size_t)PPAD * DM * 2 + (size_t)i * 16) = z; *(u32x4*)(ws + WS_VB - (size_t)PPAD * DM * 2 + (size_t)i * 16) = z; }
        const int nch2 = (MPAD - MTOT) * DM * 2 / 16;
        for (int i = gw * 64 + lane; i < nch2; i += NGW * 64) { *(u32x4*)(ws + WS_OB + (size_t)MTOT * DM * 2 + (size_t)i * 16) = z; *(u32x4*)(ws + WS_MH + (size_t)MTOT * DM * 2 + (size_t)i * 16) = z; } }
}

__device__ __forceinline__ float wave_scan_add(float v, int lane) {
#pragma unroll
    for (int o = 1; o < 64; o <<= 1) { const float t = __shfl_up(v, o); if (lane >= o) v += t; }
    return v;
}
__device__ __forceinline__ float wave_scan_max(float v, int lane) {
#pragma unroll
    for (int o = 1; o < 64; o <<= 1) { const float t = __shfl_up(v, o); if (lane >= o) v = fmaxf(v, t); }
    return v;
}
__device__ __forceinline__ void p2_cumsum(const Args& A, int gw, int NGW, int lane) {
    float* G = (float*)(A.ws + WS_G); float* GS = (float*)(A.ws + WS_GS);
    const float* lp = A.out + O_FLP; const float* lsn = A.out + O_FLS; const float* lc = A.in[4];
    for (int it = gw; it < NB * 16 + DB * 16; it += NGW) {
        if (it < NB * 16) { const int b = it >> 4, h = it & 15; float* g = G + (size_t)it * PLEN;
            for (int i = lane; i < PPAD; i += 64) g[i] = 0.f;
            float carry = 0.f;
#pragma unroll 1
            for (int c0 = 0; c0 < 65; c0 += 13) { float v[13];
#pragma unroll
                for (int c = 0; c < 13; ++c) { const int t = 64 * (c0 + c) + lane; v[c] = t < TP ? lp[((size_t)b * TP + t) * 16 + h] : 0.f; }
#pragma unroll
                for (int c = 0; c < 13; ++c) { const int t = 64 * (c0 + c) + lane; const float x = wave_scan_add(v[c], lane) + carry; if (t < TP) g[PPAD + t] = -LOG2E * x; carry = __shfl(x, 63); } }
        } else { const int i2 = it - NB * 16, b = i2 >> 4, h = i2 & 15; float* g = GS + (size_t)i2 * GSLEN;
            float carry = 0.f;
#pragma unroll 1
            for (int c0 = 0; c0 < 33; c0 += 11) { float v[11];
#pragma unroll
                for (int c = 0; c < 11; ++c) { const int s = 64 * (c0 + c) + lane; v[c] = 0.f; if (s < PAST) v[c] = lc[((size_t)b * PAST + s) * 16 + h]; else if (s < PAST + DT) v[c] = lsn[((size_t)b * DT + (s - PAST)) * 16 + h]; }
#pragma unroll
                for (int c = 0; c < 11; ++c) { const int s = 64 * (c0 + c) + lane; const float x = wave_scan_add(v[c], lane) + carry; g[s] = s < PAST + DT ? -LOG2E * x : 0.f; carry = __shfl(x, 63); } }
        }
    }
}

__device__ __forceinline__ int crow(int r, int hi) { return (r & 3) + 8 * (r >> 2) + 4 * hi; }
__device__ __forceinline__ v4i16_t vtr(clptr p) { return __builtin_amdgcn_ds_read_tr16_b64_v4i16((LAS v4i16_t*)p); }
constexpr int AT_KSTR = 144, AT_V = 9216, AT_B = 17408, AT_BUF = 17664;

template <bool MASK>
__device__ __forceinline__ void attn_tile(clptr Kt, clptr Vt, clptr Bt, const bf16x8 (&qr)[4], f32x16& o0, f32x16& o1, float& m, float& l, int qpos, int kpos0, int kmin, int lane) {
    const int r32 = lane & 31, hi = lane >> 5;
    f32x16 p0, p1;
#pragma unroll
    for (int g = 0; g < 4; ++g) { const f32x4 b0 = *(const LAS f32x4*)(Bt + (8 * g + 4 * hi) * 4), b1 = *(const LAS f32x4*)(Bt + (32 + 8 * g + 4 * hi) * 4);
#pragma unroll
        for (int i = 0; i < 4; ++i) { p0[4 * g + i] = b0[i] - m; p1[4 * g + i] = b1[i] - m; } }
#pragma unroll
    for (int d0 = 0; d0 < 4; ++d0) {
        const bf16x8 a0 = *(const LAS bf16x8*)(Kt + r32 * AT_KSTR + d0 * 32 + hi * 16);
        const bf16x8 a1 = *(const LAS bf16x8*)(Kt + (32 + r32) * AT_KSTR + d0 * 32 + hi * 16);
        p0 = __builtin_amdgcn_mfma_f32_32x32x16_bf16(a0, qr[d0], p0, 0, 0, 0);
        p1 = __builtin_amdgcn_mfma_f32_32x32x16_bf16(a1, qr[d0], p1, 0, 0, 0);
    }
    if (MASK) {
#pragma unroll
        for (int r = 0; r < 16; ++r) { const int kp = kpos0 + crow(r, hi); if (kp > qpos || kp < kmin) p0[r] = -INFINITY; if (kp + 32 > qpos || kp + 32 < kmin) p1[r] = -INFINITY; }
    }
    float mx = fmaxf(p0[0], p1[0]);
#pragma unroll
    for (int r = 1; r < 16; ++r) mx = fmaxf(mx, fmaxf(p0[r], p1[r]));
    { const auto rr = __builtin_amdgcn_permlane32_swap(__float_as_uint(mx), __float_as_uint(mx), false, false); mx = fmaxf(__uint_as_float(rr[0]), __uint_as_float(rr[1])); }
    if (__any(mx > 0.f)) {
        const float dl = fmaxf(mx, 0.f), alpha = __builtin_amdgcn_exp2f(-dl); m += dl; l *= alpha;
#pragma unroll
        for (int r = 0; r < 16; ++r) { o0[r] *= alpha; o1[r] *= alpha; p0[r] -= dl; p1[r] -= dl; } }
    float ls = 0.f;
#pragma unroll
    for (int r = 0; r < 16; ++r) { p0[r] = __builtin_amdgcn_exp2f(p0[r]); p1[r] = __builtin_amdgcn_exp2f(p1[r]); ls += p0[r] + p1[r]; }
    l += ls;
    u32x4 pw[4];
#pragma unroll
    for (int i = 0; i < 4; ++i) { pw[0][i] = pk2(p0[2 * i], p0[2 * i + 1]); pw[1][i] = pk2(p0[8 + 2 * i], p0[9 + 2 * i]); pw[2][i] = pk2(p1[2 * i], p1[2 * i + 1]); pw[3][i] = pk2(p1[8 + 2 * i], p1[9 + 2 * i]); }
    const clptr vb = Vt + ((lane >> 5) * 4 + ((lane & 15) >> 2)) * 64 + (((lane >> 4) & 1) * 16 + (lane & 3) * 4) * 2;
#pragma unroll
    for (int ks = 0; ks < 4; ++ks) {
        const v4i16_t l0 = vtr(vb + ks * 1024), h0 = vtr(vb + ks * 1024 + 512), l1 = vtr(vb + 4096 + ks * 1024), h1 = vtr(vb + 4096 + ks * 1024 + 512);
        const bf16x8 v0 = {l0[0], l0[1], l0[2], l0[3], h0[0], h0[1], h0[2], h0[3]}, v1 = {l1[0], l1[1], l1[2], l1[3], h1[0], h1[1], h1[2], h1[3]};
        const bf16x8 pb = __builtin_bit_cast(bf16x8, pw[ks]);
        o0 = __builtin_amdgcn_mfma_f32_32x32x16_bf16(v0, pb, o0, 0, 0, 0);
        o1 = __builtin_amdgcn_mfma_f32_32x32x16_bf16(v1, pb, o1, 0, 0, 0);
    }
}

__device__ __forceinline__ void kv_out_rows(const bf16* KB, const bf16* VB, float* outK, float* outV, size_t wsrow0, size_t outrow0, int nrows, int h, int tid) {
    const int ch = tid & 7, tsel = (tid >> 3) & 1, r0 = tid >> 4;
    const bf16* src = (tsel ? VB : KB) + h * 64 + ch * 8; float* dst = (tsel ? outV : outK) + h * 64 + ch * 8;
    asm volatile("" ::: "memory");
#pragma unroll 1
    for (int i0 = 0; i0 < 8; i0 += 4) { u32x4 v[4];
#pragma unroll
        for (int i = 0; i < 4; ++i) { const int r = r0 + 32 * (i0 + i); v[i] = r < nrows ? *(const u32x4*)(src + (wsrow0 + r) * DM) : (u32x4){0u, 0u, 0u, 0u}; }
#pragma unroll
        for (int i = 0; i < 4; ++i) { const int r = r0 + 32 * (i0 + i); if (r < nrows) { f32x4 a, b;
            a[0] = bf2f((unsigned short)(v[i].x & 0xffffu)); a[1] = bf2f((unsigned short)(v[i].x >> 16)); a[2] = bf2f((unsigned short)(v[i].y & 0xffffu)); a[3] = bf2f((unsigned short)(v[i].y >> 16));
            b[0] = bf2f((unsigned short)(v[i].z & 0xffffu)); b[1] = bf2f((unsigned short)(v[i].z >> 16)); b[2] = bf2f((unsigned short)(v[i].w & 0xffffu)); b[3] = bf2f((unsigned short)(v[i].w >> 16));
            *(f32x4*)(dst + (outrow0 + r) * DM) = a; *(f32x4*)(dst + (outrow0 + r) * DM + 4) = b; } } }
}

__device__ __forceinline__ void store8_f32(float* dst, const u32x4 v) {
    *(f32x4*)dst = (f32x4){__builtin_bit_cast(float, v.x << 16), __builtin_bit_cast(float, v.x & 0xffff0000u), __builtin_bit_cast(float, v.y << 16), __builtin_bit_cast(float, v.y & 0xffff0000u)};
    *(f32x4*)(dst + 4) = (f32x4){__builtin_bit_cast(float, v.z << 16), __builtin_bit_cast(float, v.z & 0xffff0000u), __builtin_bit_cast(float, v.w << 16), __builtin_bit_cast(float, v.w & 0xffff0000u)};
}
constexpr float AT_SKIP_T = 40.0f;
__device__ __forceinline__ void attn_prompt_unit(int b, int h, int j, const bf16* QB, const bf16* KB, const bf16* VB, const float* G, bf16* OB, lptr lds, int tid, int w, int lane, float kb, float* outK, float* outV) {
    const int r32 = lane & 31, hi = lane >> 5;
    const int qp = 256 * j + 32 * w + r32, t = qp - PPAD; const bool qvalid = t >= 0; const bool wave_active = (256 * j + 32 * w + 31) >= PPAD;
    const size_t qrow = (size_t)b * TP + (t > 0 ? t : 0);
    bf16x8 qr[4];
#pragma unroll
    for (int d0 = 0; d0 < 4; ++d0) qr[d0] = *(const bf16x8*)(QB + qrow * DM + h * 64 + d0 * 16 + hi * 8);
    const int lrow = tid >> 3, lch = tid & 7;
    const long krow0 = (long)b * TP - PPAD + lrow;
    const bf16* kg = KB + krow0 * DM + h * 64 + lch * 8; const bf16* vg = VB + krow0 * DM + h * 64 + lch * 8; const float* gg = G + (size_t)(b * 16 + h) * PLEN;
    f32x16 o0, o1;
#pragma unroll
    for (int r = 0; r < 16; ++r) { o0[r] = 0.f; o1[r] = 0.f; }
    float m = 0.f, l = 0.f;
    const int kt1 = 4 * j + 3, ktw = 4 * j + (w >> 1), kmin = qp >= PPAD ? PPAD : 0;
    u32x4 kreg[2][2], vreg[2][2]; float breg[2] = {0.f, 0.f};
    LAS int* vote = (LAS int*)(lds + 4 * AT_BUF);
#define AT_LOADPAIR(S, KH, LO) do { _Pragma("unroll") for (int i_ = 0; i_ < 2; ++i_) { const int kk_ = (KH) - i_ >= (LO) ? (KH) - i_ : (LO); kreg[S][i_] = *(const u32x4*)(kg + (size_t)kk_ * 64 * DM); vreg[S][i_] = *(const u32x4*)(vg + (size_t)kk_ * 64 * DM); } \
        if (tid < 128) { const int kk_ = (KH) - (tid >> 6) >= (LO) ? (KH) - (tid >> 6) : (LO); breg[S] = gg[kk_ * 64 + (tid & 63)]; } } while (0)
#define AT_STEP(S, KH, STEPI) { const int kh_ = (KH); const lptr base = lds + (S) * 2 * AT_BUF; \
        _Pragma("unroll") for (int i = 0; i < 2; ++i) { *(LAS u32x4*)(base + i * AT_BUF + lrow * AT_KSTR + lch * 16) = kreg[S][i]; *(LAS u32x4*)(base + i * AT_BUF + AT_V + (lch >> 2) * 4096 + lrow * 64 + (lch & 3) * 16) = vreg[S][i]; } \
        if (tid < 128) *(LAS float*)(base + (tid >> 6) * AT_BUF + AT_B + (tid & 63) * 4) = breg[S]; \
        _Pragma("unroll") for (int i = 0; i < 2; ++i) { const int k2 = kh_ - i; if (k2 >= 4 * j && k2 >= kt0) { const int t_ = 64 * k2 + lrow - PPAD;     \
            if (t_ >= 0) { const size_t o_ = ((size_t)b * TP + t_) * DM + h * 64 + lch * 8; store8_f32(outK + o_, kreg[S][i]); store8_f32(outV + o_, vreg[S][i]); } } } \
        LDS_BARRIER(); \
        if ((STEPI) > 0) { const LAS int* vp_ = vote + (((STEPI) - 1) & 1) * 8; int all_ = 1; _Pragma("unroll") for (int i = 0; i < 8; ++i) all_ &= vp_[i]; if (all_) break; } \
        if (kh_ - 4 >= kt0) AT_LOADPAIR(S, kh_ - 4, kt0); \
        int done_ = wave_active ? 0 : 1; \
        _Pragma("unroll") for (int i = 0; i < 2; ++i) { const int k2 = kh_ - i; const lptr b2 = base + i * AT_BUF; \
            if (wave_active && k2 <= ktw && k2 >= kt0) { \
                if (k2 == 3 || k2 == ktw) attn_tile<true>(b2, b2 + AT_V, b2 + AT_B, qr, o0, o1, m, l, qp, 64 * k2, kmin, lane); \
                else attn_tile<false>(b2, b2 + AT_V, b2 + AT_B, qr, o0, o1, m, l, qp, 64 * k2, kmin, lane); \
                done_ = k2 > kt0 ? (__all(kb + *(const LAS float*)(b2 + AT_B) <= m - AT_SKIP_T) ? 1 : 0) : 1; } } \
        if (lane == 0) vote[((STEPI) & 1) * 8 + w] = done_; }
    AT_LOADPAIR(0, kt1, 3);
    if (j > 0) AT_LOADPAIR(1, kt1 - 2, 3);
    int kt0 = 3;
    { const int ta = 3 + lane, tb = 67 + lane;
        const float g0 = gg[j == 0 ? PPAD : 256 * j], ga = ta < 4 * j ? gg[64 * ta + 63] : 3.0e38f, gb = tb < 4 * j ? gg[64 * tb + 63] : 3.0e38f;
        const float thr = g0 - 2.0f * kb - AT_SKIP_T;
        const bool sa = ga <= thr, sb = gb <= thr;
        kt0 = 3 + __popcll(__ballot(sa)) + __popcll(__ballot(sb)); }
    for (int kh = kt1, si = 0; kh >= kt0; kh -= 4, si += 2) { AT_STEP(0, kh, si) if (kh - 2 >= kt0) AT_STEP(1, kh - 2, si + 1) }
#undef AT_STEP
#undef AT_LOADPAIR
    const float lt = l + __shfl_xor(l, 32), inv = 1.0f / lt;
    if (wave_active && qvalid) { bf16* op = OB + qrow * DM + h * 64 + 4 * hi;
#pragma unroll
        for (int g = 0; g < 4; ++g) { u32x2 a, c; a.x = pk2(o0[4 * g] * inv, o0[4 * g + 1] * inv); a.y = pk2(o0[4 * g + 2] * inv, o0[4 * g + 3] * inv); c.x = pk2(o1[4 * g] * inv, o1[4 * g + 1] * inv); c.y = pk2(o1[4 * g + 2] * inv, o1[4 * g + 3] * inv);
            *(u32x2*)(op + 8 * g) = a; *(u32x2*)(op + 32 + 8 * g) = c; } }
    __syncthreads();
}

__device__ __forceinline__ void attn_sample_unit(int b, int h, const float* cK, const float* cV, const bf16* QB, const bf16* KB, const bf16* VB, const float* GS, bf16* OB, lptr lds, int tid, int w, int lane, float kb, float* outK, float* outV) {
    const int r32 = lane & 31, hi = lane >> 5;
    const lptr base = lds + w * AT_BUF;
    const size_t qrow = (size_t)MP + b * DT + r32;
    bf16x8 qr[4];
#pragma unroll
    for (int d0 = 0; d0 < 4; ++d0) qr[d0] = *(const bf16x8*)(QB + qrow * DM + h * 64 + d0 * 16 + hi * 8);
    f32x16 o0, o1;
#pragma unroll
    for (int r = 0; r < 16; ++r) { o0[r] = 0.f; o1[r] = 0.f; }
    float m = 0.f, l = 0.f;
    const float* gs = GS + (size_t)(b * 16 + h) * GSLEN;
    int ti0 = 0;
    { const float thr = gs[PAST] - 2.0f * kb - AT_SKIP_T; const bool sk = lane < 32 && gs[64 * lane + 63] <= thr; ti0 = __popcll(__ballot(sk)); }
#pragma unroll 1
    for (int ti = ti0 + w; ti < 33; ti += 8) {
        const float bias_l = gs[64 * ti + lane];
        if (ti < 32) {
            const float* ck0 = cK + (((size_t)b * PAST + 64 * ti + (lane >> 4)) * 16 + h) * 64 + 4 * (lane & 15); const float* cv0 = cV + (ck0 - cK);
            const lptr kw0 = base + (lane >> 4) * AT_KSTR + (lane & 15) * 8, vw0 = base + AT_V + ((lane & 15) >> 3) * 4096 + (lane >> 4) * 64 + (lane & 7) * 8;
#pragma unroll
            for (int half = 0; half < 2; ++half) {
                f32x4 kv[8], vv[8];
#pragma unroll
                for (int i = 0; i < 8; ++i) { kv[i] = *(const f32x4*)(ck0 + (half * 32 + i * 4) * 1024); vv[i] = *(const f32x4*)(cv0 + (half * 32 + i * 4) * 1024); }
#pragma unroll
                for (int i = 0; i < 8; ++i) { u32x2 a, c; a.x = pk2(kv[i][0], kv[i][1]); a.y = pk2(kv[i][2], kv[i][3]); c.x = pk2(vv[i][0], vv[i][1]); c.y = pk2(vv[i][2], vv[i][3]);
                    *(LAS u32x2*)(kw0 + (half * 32 + i * 4) * AT_KSTR) = a; *(LAS u32x2*)(vw0 + (half * 32 + i * 4) * 64) = c; }
                asm volatile("" ::: "memory");
            }
        } else {
            const size_t off0 = ((size_t)MP + b * DT + (lane >> 3)) * DM + h * 64 + (lane & 7) * 8;
            const lptr kw0 = base + (lane >> 3) * AT_KSTR + (lane & 7) * 16, vw0 = base + AT_V + ((lane & 7) >> 2) * 4096 + (lane >> 3) * 64 + (lane & 3) * 16;
#pragma unroll
            for (int i = 0; i < 8; ++i) { const u32x4 a = *(const u32x4*)(KB + off0 + (size_t)i * 8 * DM), c = *(const u32x4*)(VB + off0 + (size_t)i * 8 * DM);
                *(LAS u32x4*)(kw0 + i * 8 * AT_KSTR) = a; *(LAS u32x4*)(vw0 + i * 8 * 64) = c; }
        }
        *(LAS float*)(base + AT_B + lane * 4) = bias_l;
        LDS_WAIT();
        if (ti < 32) attn_tile<false>(base, base + AT_V, base + AT_B, qr, o0, o1, m, l, 0, 0, 0, lane);
        else attn_tile<true>(base, base + AT_V, base + AT_B, qr, o0, o1, m, l, r32, 0, 0, lane);
        asm volatile("" ::: "memory");
    }
    const float lt = l + __shfl_xor(l, 32);
    LDS_WAIT();
    LAS float* of = (LAS float*)base;
#pragma unroll
    for (int r = 0; r < 16; ++r) { of[crow(r, hi) * 32 + r32] = o0[r]; of[(32 + crow(r, hi)) * 32 + r32] = o1[r]; }
    if (hi == 0) { of[2048 + r32] = m; of[2080 + r32] = lt; }
    __syncthreads();
    { const int q = tid & 31, dg = tid >> 5; float M = -1e30f;
#pragma unroll
        for (int ww = 0; ww < 8; ++ww) M = fmaxf(M, ((LAS float*)(lds + ww * AT_BUF))[2048 + q]);
        float L = 0.f, o[4] = {0.f, 0.f, 0.f, 0.f};
#pragma unroll
        for (int ww = 0; ww < 8; ++ww) { const LAS float* p = (LAS float*)(lds + ww * AT_BUF); const float f = __builtin_amdgcn_exp2f(p[2048 + q] - M); L += f * p[2080 + q];
#pragma unroll
            for (int i = 0; i < 4; ++i) o[i] += f * p[(4 * dg + i) * 32 + q]; }
        const float inv = 1.0f / L; u32x2 a; a.x = pk2(o[0] * inv, o[1] * inv); a.y = pk2(o[2] * inv, o[3] * inv);
        *(u32x2*)(OB + ((size_t)MP + b * DT + q) * DM + h * 64 + 4 * dg) = a; }
    kv_out_rows(KB, VB, outK, outV, (size_t)MP + b * DT, (size_t)b * DT, DT, h, tid);
    __syncthreads();
}

__device__ __forceinline__ void p3_attention(const Args& A, lptr lds, int tid, int w, int lane, int rep) {
    unsigned char* ws = A.ws;
    const bf16* QB = (const bf16*)(ws + WS_QB); const bf16* KB = (const bf16*)(ws + WS_KB); const bf16* VB = (const bf16*)(ws + WS_VB); bf16* OB = (bf16*)(ws + WS_OB);
    const float* G = (const float*)(ws + WS_G); const float* GS = (const float*)(ws + WS_GS);
    unsigned* ctr = (unsigned*)(ws + WS_CTL) + 64 * rep;
    LAS unsigned* su = (LAS unsigned*)(lds + LDS_BYTES - 64);
    constexpr int NPU = 17 * NB * 16, NSU = DB * 16, NU = NPU + NSU;
    float gqm = 0.f, gkm = 0.f;
    for (int i = 0; i < 64; ++i) { gqm = fmaxf(gqm, fabsf(A.in[13][i])); gkm = fmaxf(gkm, fabsf(A.in[14][i])); }
    const float kb = 8.0f * LOG2E * gqm * gkm * 1.02f;
    for (;;) {
        if (tid == 0) *su = atomicAdd(ctr, 1u);
        __syncthreads();
        const int u = (int)*su;
        __syncthreads();
        if (u >= NU) break;
        const bool is_s = (u % 5 == 4) && (u / 5 < NSU);
        if (is_s) { const int s = u / 5; attn_sample_unit(s >> 4, s & 15, A.in[2], A.in[3], QB, KB, VB, GS, OB, lds, tid, w, lane, kb, A.out + O_FKS, A.out + O_FVS); }
        else { const int k = u / 5, pidx = u - (k < NSU ? k : NSU); const int j = 16 - pidx / (NB * 16), bh = pidx % (NB * 16); attn_prompt_unit(bh >> 4, bh & 15, j, QB, KB, VB, G, OB, lds, tid, w, lane, kb, A.out + O_FKP, A.out + O_FVP); }
    }
#ifdef PROBE_SAMPLE
    for (;;) { if (tid == 0) *su = atomicAdd(ctr + 128, 1u); __syncthreads(); const int u = (int)*su; __syncthreads(); if (u >= NSU) break;
        attn_sample_unit(u >> 4, u & 15, A.in[2], A.in[3], QB, KB, VB, GS, OB, lds, tid, w, lane, kb, A.out + O_FKS, A.out + O_FVS); }
#endif
}

constexpr int ML_QS = 272, ML_TS = 144;
constexpr int MA_VS = 544;
constexpr int MA_Q = 0, MA_K = 17408, MA_KW = 34816, MA_V = 52224, MA_SP = 87040, MA_VEC = 96256;
__device__ __forceinline__ bf16x8 tr_frag(clptr p, int rowstride4) { const v4i16_t lo = vtr(p), hi = vtr(p + rowstride4); return (bf16x8){lo[0], lo[1], lo[2], lo[3], hi[0], hi[1], hi[2], hi[3]}; }
constexpr int NUA = NB * 4 * 65 + DB * 4;
__device__ __forceinline__ f32x4 mfma16(bf16x8 a, bf16x8 b, f32x4 c) { return __builtin_amdgcn_mfma_f32_16x16x32_bf16(a, b, c, 0, 0, 0); }

__device__ __forceinline__ void mlstm_a_phase(const Args& A, int first, int stride, lptr lds, int tid, int w, int lane) {
    unsigned char* ws = A.ws;
    u32x4 pq[2], pk[2], pv[4]; float pgi = -1e30f, pgf = 0.f;
#define MA_LOAD(UID) do { const int uid_ = (UID); const bool pr_ = uid_ < NB * 4 * 65; const int bh_ = pr_ ? uid_ / 65 : uid_ - NB * 4 * 65, c_ = pr_ ? uid_ - bh_ * 65 : 0, b_ = bh_ >> 2, h_ = bh_ & 3; \
        const size_t rb_ = pr_ ? (size_t)b_ * TP : (size_t)MP + (size_t)b_ * DT; const int t0_ = pr_ ? 64 * c_ - 48 : 0, tl_ = pr_ ? TP : DT; \
        { const int tk_ = t0_ + lane; pgi = -1e30f; pgf = 0.f; if (tk_ >= 0 && tk_ < tl_) { pgi = ((const float*)(ws + WS_GI))[(rb_ + tk_) * 4 + h_]; pgf = ((const float*)(ws + WS_GF))[(rb_ + tk_) * 4 + h_]; } } \
        _Pragma("unroll") for (int i_ = 0; i_ < 2; ++i_) { const int id_ = tid + 512 * i_, r_ = id_ >> 4, ch_ = id_ & 15; const int tk_ = t0_ + r_; pq[i_] = (u32x4){0u, 0u, 0u, 0u}; pk[i_] = (u32x4){0u, 0u, 0u, 0u}; \
            if (tk_ >= 0 && tk_ < tl_) { pq[i_] = *(const u32x4*)((const bf16*)(ws + WS_MQ) + (rb_ + tk_) * 512 + h_ * 128 + ch_ * 8); pk[i_] = *(const u32x4*)((const bf16*)(ws + WS_MK) + (rb_ + tk_) * 512 + h_ * 128 + ch_ * 8); } } \
        _Pragma("unroll") for (int i_ = 0; i_ < 4; ++i_) { const int id_ = tid + 512 * i_, r_ = id_ >> 5, ch_ = id_ & 31; const int tk_ = t0_ + r_; pv[i_] = (u32x4){0u, 0u, 0u, 0u}; \
            if (tk_ >= 0 && tk_ < tl_) pv[i_] = *(const u32x4*)((const bf16*)(ws + WS_MV) + (rb_ + tk_) * DM + h_ * 256 + ch_ * 8); } } while (0)
    if (first < NUA) MA_LOAD(first);
#pragma unroll 1
    for (int uid = first; uid < NUA; uid += stride) {
    bf16* MH = (bf16*)(ws + WS_MH);
    float* RS = (float*)(ws + WS_RS); float* NU = (float*)(ws + WS_NU); bf16* U = (bf16*)(ws + WS_U) + (size_t)uid * 32768;
    const bool prompt = uid < NB * 4 * 65; const int bh = prompt ? uid / 65 : uid - NB * 4 * 65, c = prompt ? uid - bh * 65 : 0, b = bh >> 2, h = bh & 3;
    const size_t row_base = prompt ? (size_t)b * TP : (size_t)MP + (size_t)b * DT; const int tok0 = prompt ? 64 * c - 48 : 0, tlim = prompt ? TP : DT;
    LAS float* vec = (LAS float*)(lds + MA_VEC); LAS float* v_b = vec, *v_a = vec + 64, *v_ml = vec + 128, *v_rs = vec + 192;
    const int l15 = lane & 15, lg = lane >> 4;
    const float gi = pgi, gf = pgf;
    const float bb = wave_scan_add(gf, lane), aa = gi - bb, pm = wave_scan_max(aa, lane), mloc = bb + pm;
    const float b_last = __shfl(bb, 63), ml_last = __shfl(mloc, 63), wgl = __expf(b_last + aa - ml_last);
    if (w == 0) { v_b[lane] = bb; v_a[lane] = aa; v_ml[lane] = mloc; }
    if (w == 0) { ((float*)(ws + WS_BBC))[(size_t)uid * 64 + lane] = bb; ((float*)(ws + WS_PMC))[(size_t)uid * 64 + lane] = pm; }
#pragma unroll
    for (int i = 0; i < 2; ++i) { const int id = tid + 512 * i, r = id >> 4, ch = id & 15; const int tk = tok0 + r; const bool ok = tk >= 0 && tk < tlim;
        const u32x4 q = pq[i], k = pk[i]; (void)ok;
        *(LAS u32x4*)(lds + MA_Q + r * ML_QS + ch * 16) = q; *(LAS u32x4*)(lds + MA_K + r * ML_QS + ch * 16) = k;
        const float wgr = __shfl(wgl, r); u32x4 kw;
#pragma unroll
        for (int e = 0; e < 4; ++e) kw[e] = pk2(bf2f((unsigned short)(k[e] & 0xffffu)) * wgr, bf2f((unsigned short)(k[e] >> 16)) * wgr);
        *(LAS u32x4*)(lds + MA_KW + r * ML_QS + ch * 16) = kw; }
#pragma unroll
    for (int i = 0; i < 4; ++i) { const int id = tid + 512 * i, r = id >> 5, ch = id & 31; const int tk = tok0 + r; const bool ok = tk >= 0 && tk < tlim;
        const u32x4 v = pv[i]; (void)ok;
        *(LAS u32x4*)(lds + MA_V + r * MA_VS + ch * 16) = v; }
    LDS_BARRIER();
    if (uid + stride < NUA) MA_LOAD(uid + stride);
    { const int tr = w >> 1; float rs[4] = {0.f, 0.f, 0.f, 0.f};
#pragma unroll
        for (int i = 0; i < 2; ++i) { const int tc = 2 * (w & 1) + i; f32x4 acc = {0.f, 0.f, 0.f, 0.f};
#pragma unroll
            for (int k0 = 0; k0 < 128; k0 += 32) { const bf16x8 a = *(const LAS bf16x8*)(lds + MA_Q + (16 * tr + l15) * ML_QS + (k0 + 8 * lg) * 2), bq = *(const LAS bf16x8*)(lds + MA_K + (16 * tc + l15) * ML_QS + (k0 + 8 * lg) * 2); acc = mfma16(a, bq, acc); }
            const int s = 16 * tc + l15; const float as = v_a[s];
#pragma unroll
            for (int r = 0; r < 4; ++r) { const int t = 16 * tr + 4 * lg + r; const float d = s <= t ? __expf(v_b[t] + as - v_ml[t]) : 0.f; const float sp = acc[r] * d; rs[r] += sp;
                *(LAS unsigned short*)(lds + MA_SP + t * ML_TS + s * 2) = (unsigned short)f2bf(sp); } }
#pragma unroll
        for (int r = 0; r < 4; ++r) { float x = rs[r]; x += __shfl_xor(x, 1); x += __shfl_xor(x, 2); x += __shfl_xor(x, 4); x += __shfl_xor(x, 8); if (l15 == 0) v_rs[(w & 1) * 64 + 16 * tr + 4 * lg + r] = x; } }
    const clptr vtb = lds + MA_V + (8 * lg + (l15 >> 2)) * MA_VS + (l15 & 3) * 8;
    {
        const clptr kwb = lds + MA_KW + (8 * lg + (l15 >> 2)) * ML_QS + (l15 & 3) * 8 + w * 32;
        const bf16x8 a0 = tr_frag(kwb, 4 * ML_QS), a1 = tr_frag(kwb + 32 * ML_QS, 4 * ML_QS);
#pragma unroll 4
        for (int dvt = 0; dvt < 16; ++dvt) { const bf16x8 b0 = tr_frag(vtb + dvt * 32, 4 * MA_VS), b1 = tr_frag(vtb + 32 * MA_VS + dvt * 32, 4 * MA_VS);
            f32x4 acc = {0.f, 0.f, 0.f, 0.f}; acc = mfma16(a0, b0, acc); acc = mfma16(a1, b1, acc);
            u32x2 o; o.x = pk2(acc[0], acc[1]); o.y = pk2(acc[2], acc[3]); *(u32x2*)(U + (size_t)(16 * dvt + l15) * 128 + 16 * w + 4 * lg) = o; } }
    if (tid < 128) { float x = 0.f;
#pragma unroll 8
        for (int s = 0; s < 64; ++s) x += bf2f(*(const LAS unsigned short*)(lds + MA_KW + s * ML_QS + tid * 2));
        NU[(size_t)uid * 128 + tid] = x; }
    LDS_BARRIER();
    if (tid < 64) { const int tk = tok0 + tid; if (tk >= 0 && tk < tlim) RS[(row_base + tk) * 4 + h] = v_rs[tid] + v_rs[64 + tid]; }
    {
        const int tt = w & 3; const bf16x8 b0 = *(const LAS bf16x8*)(lds + MA_SP + (16 * tt + l15) * ML_TS + (8 * lg) * 2), b1 = *(const LAS bf16x8*)(lds + MA_SP + (16 * tt + l15) * ML_TS + (32 + 8 * lg) * 2);
        const int tk = tok0 + 16 * tt + l15; const bool ok = tk >= 0 && tk < tlim; bf16* dst = MH + (row_base + (ok ? tk : 0)) * DM + h * 256 + 4 * lg;
#pragma unroll 4
        for (int i = 0; i < 8; ++i) { const int dvt = 8 * (w >> 2) + i; const bf16x8 a0 = tr_frag(vtb + dvt * 32, 4 * MA_VS), a1 = tr_frag(vtb + 32 * MA_VS + dvt * 32, 4 * MA_VS);
            f32x4 acc = {0.f, 0.f, 0.f, 0.f}; acc = mfma16(a0, b0, acc); acc = mfma16(a1, b1, acc);
            if (ok) { u32x2 o; o.x = pk2(acc[0], acc[1]); o.y = pk2(acc[2], acc[3]); *(u32x2*)(dst + 16 * dvt) = o; } } }
    LDS_BARRIER();
    }
#undef MA_LOAD
    __syncthreads();
}

constexpr int MB_QSZ = 17408, MB_CBSZ = 48 * ML_QS, MB_Q = 0, MB_CB = 2 * MB_QSZ, MB_END = MB_CB + 2 * MB_CBSZ;
__device__ __forceinline__ void mlstm_b_item(const Args& A, int it, lptr lds, int tid, int w, int lane) {
    unsigned char* ws = A.ws;
    const bf16* MQ = (const bf16*)(ws + WS_MQ); bf16* MH = (bf16*)(ws + WS_MH); const float* GI = (const float*)(ws + WS_GI); const float* GF = (const float*)(ws + WS_GF);
    const float* RS = (const float*)(ws + WS_RS); const float* NU = (const float*)(ws + WS_NU); float* HSSQ = (float*)(ws + WS_HSSQ);
    const bool prompt = it < 256; const int i2 = prompt ? it : it - 256; const int b = i2 >> 5, h = (i2 >> 3) & 3, sl = i2 & 7; const int nch = prompt ? 65 : 1;
    const int uid0 = prompt ? (b * 4 + h) * 65 : NB * 4 * 65 + (b * 4 + h);
    const size_t row_base = prompt ? (size_t)b * TP : (size_t)MP + (size_t)b * DT; const int tlim = prompt ? TP : DT;
    const bf16* Ub = (const bf16*)(ws + WS_U) + (size_t)uid0 * 32768 + (size_t)(sl * 32 + (tid >> 4)) * 128 + (tid & 15) * 8;
    const int l15 = lane & 15, lg = lane >> 4, tt = w & 3, dvt = w >> 2, cdv = tid >> 4, cdk = (tid & 15) * 8;
    float C[8]; float nreg = 0.f, m_run = 0.f;
    {
        if (prompt) {
#pragma unroll
            for (int i = 0; i < 8; ++i) C[i] = 0.f;
        } else { const float* C0 = A.in[5] + ((size_t)(b * 4 + h) * 256 + sl * 32 + cdv) * 128 + cdk; const f32x4 c0 = *(const f32x4*)C0, c1 = *(const f32x4*)(C0 + 4);
#pragma unroll
            for (int i = 0; i < 4; ++i) { C[i] = c0[i]; C[4 + i] = c1[i]; }
            if (tid < 128) nreg = A.in[6][(size_t)(b * 4 + h) * 128 + tid]; m_run = A.in[7][b * 4 + h]; }
        u32x4 o; o.x = pk2(C[0], C[1]); o.y = pk2(C[2], C[3]); o.z = pk2(C[4], C[5]); o.w = pk2(C[6], C[7]);
        *(LAS u32x4*)(lds + MB_CB + cdv * ML_QS + cdk * 2) = o;
        if (tid < 256) { const int r = 32 + (tid >> 4); const u32x4 z = {0u, 0u, 0u, 0u}; *(LAS u32x4*)(lds + MB_CB + r * ML_QS + (tid & 15) * 16) = z; *(LAS u32x4*)(lds + MB_CB + MB_CBSZ + r * ML_QS + (tid & 15) * 16) = z; }
    }
    __syncthreads();
    if (tid < 128) *(LAS unsigned short*)(lds + MB_CB + 32 * ML_QS + tid * 2) = (unsigned short)f2bf(nreg);
    u32x4 q0_[2], q1_[2], uc_[2]; u32x2 nl_[2]; float gi_[2], gf_[2], rs_[2], nu_[2];
#define MB_LOADQ(S, cc) do { const int tok0_ = prompt ? 64 * (cc) - 48 : 0; \
        { const int r_ = tid >> 4, tk_ = tok0_ + r_; const bool ok_ = tk_ >= 0 && tk_ < tlim; q0_[S] = (u32x4){0u, 0u, 0u, 0u}; if (ok_) q0_[S] = *(const u32x4*)(MQ + (row_base + tk_) * 512 + h * 128 + (tid & 15) * 8); } \
        { const int r_ = 32 + (tid >> 4), tk_ = tok0_ + r_; const bool ok_ = tk_ >= 0 && tk_ < tlim; q1_[S] = (u32x4){0u, 0u, 0u, 0u}; if (ok_) q1_[S] = *(const u32x4*)(MQ + (row_base + tk_) * 512 + h * 128 + (tid & 15) * 8); } } while (0)
#define MB_LOAD(S, cc) do { const int tok0_ = prompt ? 64 * (cc) - 48 : 0; \
        uc_[S] = *(const u32x4*)(Ub + (size_t)(cc) * 32768); \
        { const int tk_ = tok0_ + lane; gi_[S] = ((const float*)(ws + WS_PMC))[(size_t)(uid0 + (cc)) * 64 + lane]; gf_[S] = ((const float*)(ws + WS_BBC))[(size_t)(uid0 + (cc)) * 64 + lane]; rs_[S] = 0.f; if (tk_ >= 0 && tk_ < tlim) rs_[S] = RS[(row_base + tk_) * 4 + h]; } \
        nu_[S] = tid < 128 ? NU[(size_t)(uid0 + (cc)) * 128 + tid] : 0.f; \
        { const int tk_ = tok0_ + 16 * tt + l15; nl_[S] = (u32x2){0u, 0u}; if (tk_ >= 0 && tk_ < tlim) nl_[S] = *(const u32x2*)(MH + (row_base + tk_) * DM + h * 256 + sl * 32 + 16 * dvt + 4 * lg); } } while (0)
    MB_LOADQ(0, 0); MB_LOAD(0, 0);
    if (nch > 1) MB_LOAD(1, 1);
    *(LAS u32x4*)(lds + MB_Q + (tid >> 4) * ML_QS + (tid & 15) * 16) = q0_[0]; *(LAS u32x4*)(lds + MB_Q + (32 + (tid >> 4)) * ML_QS + (tid & 15) * 16) = q1_[0];
    __syncthreads();
    if (nch > 1) MB_LOADQ(1, 1);
    if (nch > 2) MB_LOADQ(0, 2);
#pragma unroll 1
    for (int c2 = 0; c2 < nch; c2 += 2) {
        { constexpr int S = 0; const int c = c2;
        const int tok0 = prompt ? 64 * c - 48 : 0;
        const float bb = gf_[S], pm = gi_[S];
        const float mx = fmaxf(m_run, pm), mt = bb + mx, win = __expf(m_run - mx), scl = __expf(pm - mx), einv = __expf(-mt);
        const float b_last = __shfl(bb, 63), m_new = __shfl(mt, 63), pm_last = __shfl(pm, 63), mx_last = fmaxf(m_run, pm_last);
        const float decay = __expf(m_run - mx_last), usc = __expf(pm_last - mx_last);
        (void)b_last;
        const u32x4 uc = uc_[S]; const u32x2 nlc = nl_[S]; const float rsc = rs_[S], nuc = nu_[S];
        f32x4 acc = {0.f, 0.f, 0.f, 0.f}, acc2 = {0.f, 0.f, 0.f, 0.f};
#pragma unroll
        for (int k0 = 0; k0 < 128; k0 += 32) { const bf16x8 bq = *(const LAS bf16x8*)(lds + MB_Q + S * MB_QSZ + (16 * tt + l15) * ML_QS + (k0 + 8 * lg) * 2);
            const bf16x8 a = *(const LAS bf16x8*)(lds + MB_CB + S * MB_CBSZ + (16 * dvt + l15) * ML_QS + (k0 + 8 * lg) * 2), an = *(const LAS bf16x8*)(lds + MB_CB + S * MB_CBSZ + (32 + l15) * ML_QS + (k0 + 8 * lg) * 2);
            acc = mfma16(a, bq, acc); acc2 = mfma16(an, bq, acc2); }
        {
            const int t = 16 * tt + l15; const int tk = tok0 + t; const bool ok = tk >= 0 && tk < tlim;
            const float qn = __shfl(acc2[0], l15), win_t = __shfl(win, t), scl_t = __shfl(scl, t), einv_t = __shfl(einv, t), rs_t = __shfl(rsc, t);
            const float den = win_t * qn + scl_t * rs_t, rden = 1.0f / fmaxf(fabsf(den), einv_t);
            const float n0 = bf2f((unsigned short)(nlc.x & 0xffffu)), n1 = bf2f((unsigned short)(nlc.x >> 16)), n2 = bf2f((unsigned short)(nlc.y & 0xffffu)), n3 = bf2f((unsigned short)(nlc.y >> 16));
            const float h0 = (win_t * acc[0] + scl_t * n0) * rden, h1 = (win_t * acc[1] + scl_t * n1) * rden, h2 = (win_t * acc[2] + scl_t * n2) * rden, h3 = (win_t * acc[3] + scl_t * n3) * rden;
            float x = (h0 * h0 + h1 * h1) + (h2 * h2 + h3 * h3); x += __shfl_xor(x, 16); x += __shfl_xor(x, 32);
            if (ok) { u32x2 o; o.x = pk2(h0, h1); o.y = pk2(h2, h3); *(u32x2*)(MH + (row_base + tk) * DM + h * 256 + sl * 32 + 16 * dvt + 4 * lg) = o; if (lg == 0) HSSQ[((row_base + tk) * 4 + h) * 16 + sl * 2 + dvt] = x; }
        }
        {
            C[0] = decay * C[0] + usc * bf2f((unsigned short)(uc.x & 0xffffu)); C[1] = decay * C[1] + usc * bf2f((unsigned short)(uc.x >> 16));
            C[2] = decay * C[2] + usc * bf2f((unsigned short)(uc.y & 0xffffu)); C[3] = decay * C[3] + usc * bf2f((unsigned short)(uc.y >> 16));
            C[4] = decay * C[4] + usc * bf2f((unsigned short)(uc.z & 0xffffu)); C[5] = decay * C[5] + usc * bf2f((unsigned short)(uc.z >> 16));
            C[6] = decay * C[6] + usc * bf2f((unsigned short)(uc.w & 0xffffu)); C[7] = decay * C[7] + usc * bf2f((unsigned short)(uc.w >> 16));
            u32x4 o; o.x = pk2(C[0], C[1]); o.y = pk2(C[2], C[3]); o.z = pk2(C[4], C[5]); o.w = pk2(C[6], C[7]);
            *(LAS u32x4*)(lds + MB_CB + (S ^ 1) * MB_CBSZ + cdv * ML_QS + cdk * 2) = o;
            if (tid < 128) { nreg = decay * nreg + usc * nuc; *(LAS unsigned short*)(lds + MB_CB + (S ^ 1) * MB_CBSZ + 32 * ML_QS + tid * 2) = (unsigned short)f2bf(nreg); }
            if (c + 1 < nch) { *(LAS u32x4*)(lds + MB_Q + (S ^ 1) * MB_QSZ + (tid >> 4) * ML_QS + (tid & 15) * 16) = q0_[S ^ 1]; *(LAS u32x4*)(lds + MB_Q + (S ^ 1) * MB_QSZ + (32 + (tid >> 4)) * ML_QS + (tid & 15) * 16) = q1_[S ^ 1]; }
        }
        m_run = m_new;
        LDS_BARRIER();
        if (c + 2 < nch) MB_LOAD(S, c + 2);
        if (c + 3 < nch) MB_LOADQ(S ^ 1, c + 3);
        }
        if (c2 + 1 < nch) { constexpr int S = 1; const int c = c2 + 1;
        const int tok0 = prompt ? 64 * c - 48 : 0;
        const float bb = gf_[S], pm = gi_[S];
        const float mx = fmaxf(m_run, pm), mt = bb + mx, win = __expf(m_run - mx), scl = __expf(pm - mx), einv = __expf(-mt);
        const float b_last = __shfl(bb, 63), m_new = __shfl(mt, 63), pm_last = __shfl(pm, 63), mx_last = fmaxf(m_run, pm_last);
        const float decay = __expf(m_run - mx_last), usc = __expf(pm_last - mx_last);
        (void)b_last;
        const u32x4 uc = uc_[S]; const u32x2 nlc = nl_[S]; const float rsc = rs_[S], nuc = nu_[S];
        f32x4 acc = {0.f, 0.f, 0.f, 0.f}, acc2 = {0.f, 0.f, 0.f, 0.f};
#pragma unroll
        for (int k0 = 0; k0 < 128; k0 += 32) { const bf16x8 bq = *(const LAS bf16x8*)(lds + MB_Q + S * MB_QSZ + (16 * tt + l15) * ML_QS + (k0 + 8 * lg) * 2);
            const bf16x8 a = *(const LAS bf16x8*)(lds + MB_CB + S * MB_CBSZ + (16 * dvt + l15) * ML_QS + (k0 + 8 * lg) * 2), an = *(const LAS bf16x8*)(lds + MB_CB + S * MB_CBSZ + (32 + l15) * ML_QS + (k0 + 8 * lg) * 2);
            acc = mfma16(a, bq, acc); acc2 = mfma16(an, bq, acc2); }
        {
            const int t = 16 * tt + l15; const int tk = tok0 + t; const bool ok = tk >= 0 && tk < tlim;
            const float qn = __shfl(acc2[0], l15), win_t = __shfl(win, t), scl_t = __shfl(scl, t), einv_t = __shfl(einv, t), rs_t = __shfl(rsc, t);
            const float den = win_t * qn + scl_t * rs_t, rden = 1.0f / fmaxf(fabsf(den), einv_t);
            const float n0 = bf2f((unsigned short)(nlc.x & 0xffffu)), n1 = bf2f((unsigned short)(nlc.x >> 16)), n2 = bf2f((unsigned short)(nlc.y & 0xffffu)), n3 = bf2f((unsigned short)(nlc.y >> 16));
            const float h0 = (win_t * acc[0] + scl_t * n0) * rden, h1 = (win_t * acc[1] + scl_t * n1) * rden, h2 = (win_t * acc[2] + scl_t * n2) * rden, h3 = (win_t * acc[3] + scl_t * n3) * rden;
            float x = (h0 * h0 + h1 * h1) + (h2 * h2 + h3 * h3); x += __shfl_xor(x, 16); x += __shfl_xor(x, 32);
            if (ok) { u32x2 o; o.x = pk2(h0, h1); o.y = pk2(h2, h3); *(u32x2*)(MH + (row_base + tk) * DM + h * 256 + sl * 32 + 16 * dvt + 4 * lg) = o; if (lg == 0) HSSQ[((row_base + tk) * 4 + h) * 16 + sl * 2 + dvt] = x; }
        }
        {
            C[0] = decay * C[0] + usc * bf2f((unsigned short)(uc.x & 0xffffu)); C[1] = decay * C[1] + usc * bf2f((unsigned short)(uc.x >> 16));
            C[2] = decay * C[2] + usc * bf2f((unsigned short)(uc.y & 0xffffu)); C[3] = decay * C[3] + usc * bf2f((unsigned short)(uc.y >> 16));
            C[4] = decay * C[4] + usc * bf2f((unsigned short)(uc.z & 0xffffu)); C[5] = decay * C[5] + usc * bf2f((unsigned short)(uc.z >> 16));
            C[6] = decay * C[6] + usc * bf2f((unsigned short)(uc.w & 0xffffu)); C[7] = decay * C[7] + usc * bf2f((unsigned short)(uc.w >> 16));
            u32x4 o; o.x = pk2(C[0], C[1]); o.y = pk2(C[2], C[3]); o.z = pk2(C[4], C[5]); o.w = pk2(C[6], C[7]);
            *(LAS u32x4*)(lds + MB_CB + (S ^ 1) * MB_CBSZ + cdv * ML_QS + cdk * 2) = o;
            if (tid < 128) { nreg = decay * nreg + usc * nuc; *(LAS unsigned short*)(lds + MB_CB + (S ^ 1) * MB_CBSZ + 32 * ML_QS + tid * 2) = (unsigned short)f2bf(nreg); }
            if (c + 1 < nch) { *(LAS u32x4*)(lds + MB_Q + (S ^ 1) * MB_QSZ + (tid >> 4) * ML_QS + (tid & 15) * 16) = q0_[S ^ 1]; *(LAS u32x4*)(lds + MB_Q + (S ^ 1) * MB_QSZ + (32 + (tid >> 4)) * ML_QS + (tid & 15) * 16) = q1_[S ^ 1]; }
        }
        m_run = m_new;
        LDS_BARRIER();
        if (c + 2 < nch) MB_LOAD(S, c + 2);
        if (c + 3 < nch) MB_LOADQ(S ^ 1, c + 3);
        }
    }
#undef MB_LOAD
#undef MB_LOADQ
    { float* Co = A.out + (prompt ? O_MCP : O_MCS) + ((size_t)(b * 4 + h) * 256 + sl * 32 + cdv) * 128 + cdk;
        *(f32x4*)Co = (f32x4){C[0], C[1], C[2], C[3]}; *(f32x4*)(Co + 4) = (f32x4){C[4], C[5], C[6], C[7]};
        if (sl == 0) { if (tid < 128) (A.out + (prompt ? O_MNP : O_MNS))[(size_t)(b * 4 + h) * 128 + tid] = nreg; if (tid == 0) (A.out + (prompt ? O_MMP : O_MMS))[b * 4 + h] = m_run; } }
    __syncthreads();
}

__device__ __forceinline__ void p9_gate(const Args& A, int gw, int NGW, int lane) {
    unsigned char* ws = A.ws; bf16* MH = (bf16*)(ws + WS_MH); const bf16* MO = (const bf16*)(ws + WS_MO); const float* HSSQ = (const float*)(ws + WS_HSSQ);
    const int hd = lane >> 4;
    for (int row0 = gw; row0 < MTOT; row0 += 4 * NGW) {
        f32x4 p[4][4]; u32x4 hv[4][2], ov[4][2];
#pragma unroll
        for (int u = 0; u < 4; ++u) { const int row = row0 + u * NGW < MTOT ? row0 + u * NGW : row0; const float* pp = HSSQ + ((size_t)row * 4 + hd) * 16;
#pragma unroll
            for (int i = 0; i < 4; ++i) p[u][i] = *(const f32x4*)(pp + 4 * i);
#pragma unroll
            for (int i = 0; i < 2; ++i) { const size_t off = (size_t)row * DM + lane * 16 + i * 8; hv[u][i] = *(const u32x4*)(MH + off); ov[u][i] = *(const u32x4*)(MO + off); } }
#pragma unroll
        for (int u = 0; u < 4; ++u) { const int row = row0 + u * NGW; if (row >= MTOT) break;
            float s = 0.f;
#pragma unroll
            for (int i = 0; i < 4; ++i) s += (p[u][i][0] + p[u][i][1]) + (p[u][i][2] + p[u][i][3]);
            const float rs = __builtin_amdgcn_rsqf(s * (1.0f / 256.0f) + EPSN);
#pragma unroll
            for (int i = 0; i < 2; ++i) { const size_t off = (size_t)row * DM + lane * 16 + i * 8; u32x4 o;
#pragma unroll
                for (int e2 = 0; e2 < 4; ++e2) { const float a = bf2f((unsigned short)(hv[u][i][e2] & 0xffffu)) * rs * bf2f((unsigned short)(ov[u][i][e2] & 0xffffu)), c = bf2f((unsigned short)(hv[u][i][e2] >> 16)) * rs * bf2f((unsigned short)(ov[u][i][e2] >> 16)); o[e2] = pk2(a, c); }
                *(u32x4*)(MH + off) = o; } }
    }
}

__device__ __forceinline__ void p13_final(const Args& A, int gw, int NGW, int lane) {
    unsigned char* ws = A.ws; const bf16* XB = (const bf16*)(ws + WS_XB); const float* ssq = (const float*)(ws + WS_SSQ); const float* g = A.in[23];
    f32x4 gg[4];
#pragma unroll
    for (int j = 0; j < 4; ++j) gg[j] = *(const f32x4*)(g + 256 * j + 4 * lane);
    for (int row0 = gw; row0 < MTOT; row0 += 4 * NGW) {
        u32x2 v[4][4]; float sq[4];
#pragma unroll
        for (int u = 0; u < 4; ++u) { const int row = row0 + u * NGW < MTOT ? row0 + u * NGW : row0; sq[u] = lane < 16 ? ssq[(size_t)row * 16 + lane] : 0.f;
#pragma unroll
            for (int j = 0; j < 4; ++j) v[u][j] = *(const u32x2*)(XB + (size_t)row * DM + 256 * j + 4 * lane); }
#pragma unroll
        for (int u = 0; u < 4; ++u) { const int row = row0 + u * NGW; if (row >= MTOT) break;
            float* dst;
            if (row < MP) { const int b = row / TP, t = row - b * TP; if (t < NMETA) continue; dst = A.out + O_YP + ((size_t)b * SEQL + (t - NMETA)) * DM; }
            else dst = A.out + O_YS + (size_t)(row - MP) * DM;
            const float rs = __builtin_amdgcn_rsqf(wave_sum(sq[u]) * (1.0f / 1024.0f) + EPSN);
#pragma unroll
            for (int j = 0; j < 4; ++j) { const f32x4 x = {bf2f((unsigned short)(v[u][j].x & 0xffffu)), bf2f((unsigned short)(v[u][j].x >> 16)), bf2f((unsigned short)(v[u][j].y & 0xffffu)), bf2f((unsigned short)(v[u][j].y >> 16))};
                *(f32x4*)(dst + 256 * j + 4 * lane) = x * rs * gg[j]; } }
    }
}

template <bool FIRSTR, bool LASTR> __device__ __forceinline__ void tail_finish(const float* P, unsigned* cnt, const pg8::StaticOrder& base, int first, int ntail, int slices, int c, float* X, bf16* XB, float* ssq, lptr lds, int tid, const float* xp, const float* xs, const float* meta) {
    const int tu = c / slices; if (tu >= ntail) return;
    asm volatile("s_waitcnt vmcnt(0)" ::: "memory"); __syncthreads();
    if (tid == 0) { __builtin_amdgcn_fence(__ATOMIC_RELEASE, "agent"); asm volatile("s_waitcnt vmcnt(0)" ::: "memory");
        (void)__hip_atomic_fetch_add(cnt + tu, 1u, __ATOMIC_RELAXED, __HIP_MEMORY_SCOPE_AGENT);
        while (__hip_atomic_load(cnt + tu, __ATOMIC_RELAXED, __HIP_MEMORY_SCOPE_AGENT) < (unsigned)slices) __builtin_amdgcn_s_sleep(2); }
    __syncthreads();
    __builtin_amdgcn_fence(__ATOMIC_ACQUIRE, "agent"); asm volatile("s_waitcnt vmcnt(0)" ::: "memory");
    pg8::Unit u; base.map(first + tu, u);
    const int nrow = 256 / slices, rbase = (c % slices) * nrow;
    const int cc = tid & 31, r0 = tid >> 5;
    const float* p0 = P + (size_t)(tu * slices) * 65536 + cc * 8;
#pragma unroll 2
    for (int rr = 0; rr < nrow; rr += 16) { const int row = rbase + rr + r0;
        const size_t xoff = (size_t)(u.pm * 256 + row) * DM + u.pn * 256 + cc * 8;
        f32x4 a, b;
        if (FIRSTR) pg8::first_resid(xp, xs, meta, u.pm * 256 + row, u.pn * 256 + cc * 8, a, b);
        else { const u32x4 r = *(const u32x4*)(XB + xoff);
            a = (f32x4){__builtin_bit_cast(float, r.x << 16), __builtin_bit_cast(float, r.x & 0xffff0000u), __builtin_bit_cast(float, r.y << 16), __builtin_bit_cast(float, r.y & 0xffff0000u)};
            b = (f32x4){__builtin_bit_cast(float, r.z << 16), __builtin_bit_cast(float, r.z & 0xffff0000u), __builtin_bit_cast(float, r.w << 16), __builtin_bit_cast(float, r.w & 0xffff0000u)}; }
        for (int s = 0; s < slices; ++s) { a = a + *(const f32x4*)(p0 + (size_t)s * 65536 + row * 256); b = b + *(const f32x4*)(p0 + (size_t)s * 65536 + row * 256 + 4); }
        *(u32x4*)(XB + xoff) = pg8::pack8(a, b);
        float q = (a[0] * a[0] + a[1] * a[1]) + (a[2] * a[2] + a[3] * a[3]) + (b[0] * b[0] + b[1] * b[1]) + (b[2] * b[2] + b[3] * b[3]);
        q += __shfl_xor(q, 1); q += __shfl_xor(q, 2); q += __shfl_xor(q, 4);
        if ((cc & 7) == 0) ssq[(size_t)(u.pm * 256 + row) * 16 + u.pn * 4 + (cc >> 3)] = q; }
}

#define XB_TMO      128
#define XB_XCNT(j)  (256  + 64 * (j))
#define XB_XSUB(j)  (1280 + 64 * (j))
#define XB_XGEN(j)  (2304 + 64 * (j))
#define XB_TOP      3328
#define XB_TOPGEN   3392
#define XCD_BAR_WORDS 3456
#define XB_SPIN_CAP (1u << 18)

__device__ __forceinline__ unsigned xb_ld(unsigned* p)              { return __hip_atomic_load(p, __ATOMIC_RELAXED, __HIP_MEMORY_SCOPE_AGENT); }
__device__ __forceinline__ unsigned xb_add(unsigned* p, unsigned v) { return __hip_atomic_fetch_add(p, v, __ATOMIC_RELAXED, __HIP_MEMORY_SCOPE_AGENT); }
__device__ __forceinline__ unsigned xb_xcc_id() { return (unsigned)__builtin_amdgcn_s_getreg((3 << 11) | 20) & 0xFu; }
#define XB_SPIN(cond, bar) do { unsigned _sp = 0; while (cond) { __builtin_amdgcn_s_sleep(1); \
    if ((++_sp & 255u) == 0u) { if (xb_ld(&(bar)[XB_TMO])) break; if (_sp > XB_SPIN_CAP) { atomicAdd(&(bar)[XB_TMO], 1u); break; } } } } while (0)

struct XcdBarrier {
    unsigned* bar; unsigned x;
    volatile LAS unsigned* st;
};

__device__ __forceinline__ XcdBarrier xcd_barrier_post(unsigned* bar, volatile LAS unsigned* st) {
    XcdBarrier b; b.bar = bar; b.x = xb_xcc_id(); b.st = st;
    if (threadIdx.x == 0) (void)xb_add(&bar[XB_XCNT(b.x)], 1u);
    return b;
}
__device__ __forceinline__ void xcd_barrier_complete(unsigned* bar, unsigned x, unsigned& nloc, unsigned& nx) {
    const unsigned G = gridDim.x * gridDim.y * gridDim.z;
    unsigned sum, cnt, mine, sp = 0u;
    for (;;) {
        sum = 0u; cnt = 0u; mine = 0u;
#pragma unroll
        for (unsigned j = 0; j < 16; ++j) { const unsigned c = xb_ld(&bar[XB_XCNT(j)]); sum += c; cnt += (c > 0u) ? 1u : 0u; mine = (j == x) ? c : mine; }
        if (sum == G) break;
        __builtin_amdgcn_s_sleep(1);
        if ((++sp & 255u) == 0u) { if (xb_ld(&bar[XB_TMO])) break; if (sp > XB_SPIN_CAP) { atomicAdd(&bar[XB_TMO], 1u); break; } }
    }
    nloc = mine > 0u ? mine : 1u; nx = cnt > 0u ? cnt : 1u;
}

__device__ __forceinline__ void xcd_barrier(const XcdBarrier& b) {
    asm volatile("s_waitcnt vmcnt(0)" ::: "memory");
    __syncthreads();
    if (threadIdx.x == 0) {
        unsigned* bar = b.bar;
        __builtin_amdgcn_s_waitcnt(0);
        unsigned nloc = b.st[0], nx = b.st[1];
        if (nloc == 0u) { xcd_barrier_complete(bar, b.x, nloc, nx); b.st[0] = nloc; b.st[1] = nx; }
        const unsigned old = xb_add(&bar[XB_XSUB(b.x)], 1u);
        const unsigned gen = old / nloc;
        if (old + 1u == (gen + 1u) * nloc) {
            __builtin_amdgcn_fence(__ATOMIC_RELEASE, "agent");
            asm volatile("s_waitcnt vmcnt(0)" ::: "memory");
            const unsigned og = xb_add(&bar[XB_TOP], 1u);
            const unsigned tg = og / nx;
            if (og + 1u == (tg + 1u) * nx) xb_add(&bar[XB_TOPGEN], 1u);
            else XB_SPIN(xb_ld(&bar[XB_TOPGEN]) == tg, bar);
            __builtin_amdgcn_fence(__ATOMIC_ACQUIRE, "agent");
            xb_add(&bar[XB_XGEN(b.x)], 1u);
            asm volatile("s_waitcnt vmcnt(0)" ::: "memory");
        } else {
            XB_SPIN(xb_ld(&bar[XB_XGEN(b.x)]) == gen, bar);
            __builtin_amdgcn_fence(__ATOMIC_ACQUIRE, "agent");
            asm volatile("s_waitcnt vmcnt(0)" ::: "memory");
        }
    }
    __syncthreads();
}

__global__ void __launch_bounds__(NTHR, 2) fwd_megakernel(Args args) {
    extern __shared__ __attribute__((aligned(16))) unsigned char lds_raw[];
    cg::grid_group grid = cg::this_grid();
    { LAS unsigned* misc_ = (LAS unsigned*)(lds_raw) ; (void)misc_; }
#define GRID_SYNC() do { asm volatile("s_waitcnt vmcnt(0) lgkmcnt(0)" ::: "memory"); __syncthreads(); \
        if (threadIdx.x == 0) { __builtin_amdgcn_fence(__ATOMIC_RELEASE, "agent"); asm volatile("s_waitcnt vmcnt(0)" ::: "memory"); } \
        GSYNC(); \
        __builtin_amdgcn_fence(__ATOMIC_ACQUIRE, "agent"); asm volatile("s_waitcnt vmcnt(0)" ::: "memory"); __syncthreads(); } while (0)
    const lptr lds = (lptr)lds_raw;
    const int G = gridDim.x, bx = blockIdx.x, NGW = G * NWAVES;
#define TIDS int tid = threadIdx.x; asm volatile("" : "+v"(tid)); const int lane = tid & 63, w = __builtin_amdgcn_readfirstlane(tid >> 6), gw = bx * NWAVES + w; (void)gw; (void)lane
    unsigned char* ws = args.ws;
    bf16* XB = (bf16*)(ws + WS_XB); float* X = (float*)(ws + WS_X); float* ssq = (float*)(ws + WS_SSQ);
    volatile LAS unsigned* xb_st = (volatile LAS unsigned*)(lds + LDS_BYTES - 256);
    if (threadIdx.x < 2) xb_st[threadIdx.x] = 0u;
    __syncthreads();
    const XcdBarrier xbar = xcd_barrier_post((unsigned*)(ws + WS_CTL) + 4096, xb_st);
#ifndef USE_CG_SYNC
#define GSYNC() xcd_barrier(xbar)
#else
#define GSYNC() grid.sync()
#endif

#ifndef SKIP_P0
    { TIDS; p0_prologue(args, lds, gw, NGW, w, lane); }
#endif
#ifdef PROBE_P0
    { TIDS; p0_prologue(args, lds, gw, NGW, w, lane); }
#endif
    grid.sync();
    xcd_barrier(xbar);
#ifdef PROBE_P1
    { pg8::Gemm g{XB, (const bf16*)(ws + WS_WFIN), MPAD, NIN, DM}; pg8::StaticOrder S; S.init(MPAD, NIN, G, bx); pg8::EpiFoxIn E{ssq, args.in[13], args.in[14], args.in[12], ws, args.out};
      pg8::gemm_phase<pg8::EpiFoxIn, pg8::StaticOrder, PG8_ALIGN, PG8_SP2>(lds, g, S, E); }
    GSYNC();
#endif
#ifndef SKIP_P1
    {
        pg8::Gemm g{XB, (const bf16*)(ws + WS_WFIN), MPAD, NIN, DM}; pg8::StaticOrder S; S.init(MPAD, NIN, G, bx);
        pg8::EpiFoxIn E{ssq, args.in[13], args.in[14], args.in[12], ws, args.out};
        pg8::gemm_phase<pg8::EpiFoxIn, pg8::StaticOrder, PG8_ALIGN, PG8_SP2>(lds, g, S, E);
    }
#endif
    GSYNC();
#ifndef SKIP_P2
    { TIDS; p2_cumsum(args, gw, NGW, lane); }
#endif
    GSYNC();
#ifndef SKIP_P3
    { TIDS; p3_attention(args, lds, tid, w, lane, 0); }
#ifdef PROBE_P3
    GSYNC();
    { TIDS; p3_attention(args, lds, tid, w, lane, 1); }
#endif
#endif
    GSYNC();
#define RESID_GEMM(Ap, Wp, KK, CNTI, FIRSTF, LASTF) do { \
    pg8::StaticOrder S; S.init(MPAD, DM, G, bx); const int full_ = (S.nwg / G) * G, ntail_ = S.nwg - full_; S.lim = full_; \
    { pg8::Gemm g{(Ap), (Wp), MPAD, DM, (KK), (KK)}; pg8::EpiResidT<FIRSTF, LASTF> E{X, XB, ssq, args.in[0], args.in[1], args.in[8]}; pg8::gemm_phase<pg8::EpiResidT<FIRSTF, LASTF>, pg8::StaticOrder, PG8_ALIGN, PG8_SP2>(lds, g, S, E); } \
    if (ntail_ > 0) { const int sl_ = ntail_ * 8 <= G ? 8 : (ntail_ * 4 <= G ? 4 : (ntail_ * 2 <= G ? 2 : 1)); const int ks_ = (KK) / sl_; \
        pg8::TailOrder T{S, full_, ntail_, sl_, bx}; pg8::Gemm g{(Ap) + (bx % sl_) * ks_, (Wp) + (bx % sl_) * ks_, MPAD, DM, ks_, (KK)}; pg8::EpiPartial E{(float*)(ws + WS_P)}; \
        pg8::gemm_phase<pg8::EpiPartial, pg8::TailOrder, false, PG8_SP2>(lds, g, T, E); \
        { int tid_ = threadIdx.x; asm volatile("" : "+v"(tid_)); tail_finish<FIRSTF, LASTF>((const float*)(ws + WS_P), (unsigned*)(ws + WS_CTL) + 256 + (CNTI), S, full_, ntail_, sl_, bx, X, XB, ssq, lds, tid_, args.in[0], args.in[1], args.in[8]); } } } while (0)
#ifdef PROBE_UP
#define PROBE_UP_BODY(WUP) { pg8::Gemm g{XB, (const bf16*)(ws + (WUP)), MPAD, DFF, DM}; pg8::StaticOrder S; S.init(MPAD, DFF, G, bx); pg8::EpiUp E{ssq, (bf16*)(ws + WS_H)}; \
      pg8::gemm_phase<pg8::EpiUp, pg8::StaticOrder, PG8_ALIGN, PG8_SP2>(lds, g, S, E); } GSYNC();
#else
#define PROBE_UP_BODY(WUP)
#endif
#define LAYER_TAIL(AOP, WOUT, WUP, WDN, CNT0, FIRSTL, LASTL) do { \
    RESID_GEMM((const bf16*)(AOP), (const bf16*)(ws + (WOUT)), DM, CNT0, FIRSTL, false); \
    GSYNC(); \
    { pg8::Gemm g{XB, (const bf16*)(ws + (WUP)), MPAD, DFF, DM}; pg8::StaticOrder S; S.init(MPAD, DFF, G, bx); pg8::EpiUp E{ssq, (bf16*)(ws + WS_H)}; \
      pg8::gemm_phase<pg8::EpiUp, pg8::StaticOrder, PG8_ALIGN, PG8_SP2>(lds, g, S, E); } \
    GSYNC(); \
    PROBE_UP_BODY(WUP) \
    RESID_GEMM((const bf16*)(ws + WS_H), (const bf16*)(ws + (WDN)), DFF, CNT0 + 32, false, LASTL); \
    GSYNC(); } while (0)
#ifndef SKIP_L0
    LAYER_TAIL(ws + WS_OB, WS_WFOUT, WS_WUP0, WS_WDN0, 0, true, false);
#endif
#ifndef SKIP_P7
    {
        pg8::Gemm g{XB, (const bf16*)(ws + WS_WMIN), MPAD, NIN, DM}; pg8::StaticOrder S; S.init(MPAD, NIN, G, bx);
        pg8::EpiMlstmIn E{ssq, args.in[17], args.in[18], (bf16*)(ws + WS_MQ), (bf16*)(ws + WS_MK), (bf16*)(ws + WS_MV), (bf16*)(ws + WS_MO), (float*)(ws + WS_GI), (float*)(ws + WS_GF)};
        pg8::gemm_phase<pg8::EpiMlstmIn, pg8::StaticOrder, PG8_ALIGN, PG8_SP2>(lds, g, S, E);
    }
#endif
    GSYNC();
#ifndef SKIP_P8
    { TIDS; mlstm_a_phase(args, bx, G, lds, tid, w, lane); }
    GSYNC();
#ifdef PROBE_MA
    { TIDS; mlstm_a_phase(args, bx, G, lds, tid, w, lane); }
    GSYNC();
#endif
    { TIDS; for (int it = bx; it < 256 + 1024; it += G) mlstm_b_item(args, it, lds, tid, w, lane); }
#ifdef PROBE_MAB
    GSYNC();
    { TIDS; mlstm_a_phase(args, bx, G, lds, tid, w, lane); }
    GSYNC();
    { TIDS; for (int it = bx; it < 256 + 1024; it += G) mlstm_b_item(args, it, lds, tid, w, lane); }
#endif
#endif
    GSYNC();
#ifndef SKIP_P9
    { TIDS; p9_gate(args, gw, NGW, lane); }
#endif
    GSYNC();
#ifndef SKIP_L1
    LAYER_TAIL(ws + WS_MH, WS_WMOUT, WS_WUP1, WS_WDN1, 64, false, true);
#endif
#ifndef SKIP_P13
    { TIDS; p13_final(args, gw, NGW, lane); }
#ifdef PROBE_SYNC
    for (int i_ = 0; i_ < 16; ++i_) grid.sync();
#endif
#endif
}

extern "C" void kernel_launch(void* const* d_in, const int* in_sizes, int n_in, void* d_out, int out_size, void* d_ws, size_t ws_size, hipStream_t stream) {
    static int grid = 0;
    if (grid == 0) {
        if (n_in != 24 || (size_t)out_size != O_END || ws_size < WS_END) { fprintf(stderr, "kernel_launch: unexpected shapes: n_in %d out %d (want %zu) ws %zu (want >= %zu)\n", n_in, out_size, (size_t)O_END, ws_size, (size_t)WS_END); grid = -1; return; }
        int dev = 0, cus = 0, per_cu = 0;
        if (hipGetDevice(&dev) != hipSuccess || hipDeviceGetAttribute(&cus, hipDeviceAttributeMultiprocessorCount, dev) != hipSuccess) { grid = -1; return; }
        if (hipFuncSetAttribute((const void*)fwd_megakernel, hipFuncAttributeMaxDynamicSharedMemorySize, LDS_BYTES) != hipSuccess) { fprintf(stderr, "kernel_launch: hipFuncSetAttribute failed\n"); grid = -1; return; }
        if (hipOccupancyMaxActiveBlocksPerMultiprocessor(&per_cu, (const void*)fwd_megakernel, NTHR, LDS_BYTES) != hipSuccess || per_cu < 1) { fprintf(stderr, "kernel_launch: occupancy query says %d blocks per CU\n", per_cu); grid = -1; return; }
        grid = cus;
    }
    if (grid < 0) return;
    (void)hipMemsetAsync((char*)d_ws + WS_CTL, 0, 65536, stream);
    Args a{};
    for (int i = 0; i < 24; ++i) a.in[i] = (const float*)d_in[i];
    a.out = (float*)d_out; a.ws = (unsigned char*)d_ws;
    void* kargs[] = {&a};
    const hipError_t e = hipLaunchCooperativeKernel((const void*)fwd_megakernel, dim3(grid), dim3(NTHR), kargs, LDS_BYTES, stream);
    if (e != hipSuccess) fprintf(stderr, "kernel_launch: cooperative launch failed: %s (grid %d)\n", hipGetErrorString(e), grid);
}
```
